# Optimizing an MI355X kernel written in HIP

```python
import jax, jax.numpy as jnp
from jax import lax
import numpy as np

D_MODEL = 1024
BATCH = 16
SEQ = 2048
DEPTH = 1

HEAD_DIM = 64
N_HEADS_DIL = 8
N_HEADS_SB = 8
DIL_WIDTH = N_HEADS_DIL * HEAD_DIM
SB_WIDTH = N_HEADS_SB * HEAD_DIM
DIL_PATTERNS = ((128, 1), (512, 4), (2048, 16))
BLOCK = 128
ROPE_THETA = 500000.0
ROPE_DIM = HEAD_DIM // 4
N_MEM = 256
N_HEADS_MEM = 4
MEM_HEAD_DIM = 128
MEM_WIDTH = N_HEADS_MEM * MEM_HEAD_DIM
D_FF = -(-(8 * D_MODEL) // (3 * 256)) * 256
IN_COLS = 3 * DIL_WIDTH + 3 * SB_WIDTH + 2 * D_MODEL
RMS_EPS = 1e-6
MAX_POS_OFFSET = 1024

kernel_name = "hybrid_dilated_stickbreak_gated_block"


def _rmsnorm(x, g):
    xf = x.astype(jnp.float32)
    y = xf * lax.rsqrt(jnp.mean(xf * xf, axis=-1, keepdims=True) + RMS_EPS)
    return (y * g.astype(jnp.float32)).astype(x.dtype)


def _partial_rope(x, positions):
    half = ROPE_DIM // 2
    inv_freq = ROPE_THETA ** (-jnp.arange(half, dtype=jnp.float32) / half)
    ang = positions.astype(jnp.float32)[:, None, :, None] * inv_freq
    cos, sin = jnp.cos(ang), jnp.sin(ang)
    xf = x.astype(jnp.float32)
    x1, x2 = xf[..., :half], xf[..., half:ROPE_DIM]
    out = jnp.concatenate([x1 * cos - x2 * sin, x2 * cos + x1 * sin, xf[..., ROPE_DIM:]], axis=-1)
    return out.astype(x.dtype)


def _dilated_pattern(q, k, v, window, dilation):
    B, H, S, hd = q.shape
    L = S // dilation
    n_back = window // dilation
    C = BLOCK
    nb = -(-L // C)
    Lp = nb * C

    def to_stream(t):
        t = t.reshape(B, H, L, dilation, hd).transpose(0, 1, 3, 2, 4)
        t = jnp.pad(t, ((0, 0), (0, 0), (0, 0), (0, Lp - L), (0, 0)))
        return t.reshape(B, H, dilation, nb, C, hd)

    def with_prev(t):
        prev = jnp.pad(t, ((0, 0), (0, 0), (0, 0), (1, 0), (0, 0), (0, 0)))[:, :, :, :-1]
        return jnp.concatenate([prev, t], axis=4)

    qs = to_stream(q)
    kb = with_prev(to_stream(k))
    vb = with_prev(to_stream(v)).astype(jnp.float32)
    s = jnp.einsum('bhrnqd,bhrnkd->bhrnqk', qs, kb,
                   preferred_element_type=jnp.float32) * (hd ** -0.5)
    i = jnp.arange(C)[:, None]
    j = jnp.arange(2 * C)[None, :]
    dist = C + i - j
    band = (dist >= 0) & (dist <= n_back)
    in_cur = j >= C
    blk = jnp.arange(nb)[:, None, None]
    valid = band[None] & ((blk > 0) | in_cur[None])
    s = jnp.where(valid, s, -jnp.inf)
    m = jnp.max(s, axis=-1, keepdims=True)
    p = jnp.exp(s - m)
    den = jnp.sum(p, axis=-1)
    o = jnp.einsum('bhrnqk,bhrnkd->bhrnqd', p, vb) / den[..., None]
    lse = m[..., 0] + jnp.log(den)

    def from_stream(t):
        rest = t.shape[5:]
        t = t.reshape((B, H, dilation, Lp) + rest)[:, :, :, :L]
        t = jnp.moveaxis(t, 2, 3)
        return t.reshape((B, H, S) + rest)

    return from_stream(o), from_stream(lse)


def _dilated_attention(q, k, v):
    outs, lses = [], []
    for window, dilation in DIL_PATTERNS:
        o, lse = _dilated_pattern(q, k, v, window, dilation)
        outs.append(o)
        lses.append(lse)
    alpha = jax.nn.softmax(jnp.stack(lses, axis=0), axis=0)
    return jnp.einsum('gbhs,gbhsd->bhsd', alpha, jnp.stack(outs, axis=0))


def _stick_breaking(q, k, v):
    B, H, S, hd = q.shape
    nb = S // BLOCK
    qb = q.reshape(B, H, nb, BLOCK, hd).transpose(2, 0, 1, 3, 4)
    vf = v.astype(jnp.float32)
    kpos = jnp.arange(S)

    def block(args):
        qi, bi = args
        z = jnp.einsum('bhqd,bhkd->bhqk', qi, k,
                       preferred_element_type=jnp.float32) * (hd ** -0.5)
        qpos = bi * BLOCK + jnp.arange(BLOCK)
        strict = kpos[None, :] < qpos[:, None]
        log1m = jnp.where(strict, jax.nn.log_sigmoid(-z), 0.0)
        between = lax.cumsum(log1m, axis=3, reverse=True) - log1m
        a = jnp.where(strict, jnp.exp(jax.nn.log_sigmoid(z) + between), 0.0)
        return jnp.einsum('bhqk,bhkd->bhqd', a, vf)

    o = lax.map(block, (qb, jnp.arange(nb)))
    return o.transpose(1, 2, 0, 3, 4).reshape(B, H, S, hd)


def _memory_attention(hn, mem_n, w_q, w_kv, w_o):
    B, S, _ = hn.shape
    q = (hn @ w_q).reshape(B, S, N_HEADS_MEM, MEM_HEAD_DIM)
    kv = mem_n @ w_kv
    k = kv[..., :MEM_WIDTH].reshape(B, N_MEM, N_HEADS_MEM, MEM_HEAD_DIM)
    v = kv[..., MEM_WIDTH:].reshape(B, N_MEM, N_HEADS_MEM, MEM_HEAD_DIM)
    s = jnp.einsum('bshd,bmhd->bhsm', q, k,
                   preferred_element_type=jnp.float32) * (MEM_HEAD_DIM ** -0.5)
    p = jax.nn.softmax(s, axis=-1)
    o = jnp.einsum('bhsm,bmhd->bshd', p, v.astype(jnp.float32))
    return o.reshape(B, S, MEM_WIDTH).astype(hn.dtype) @ w_o


def _swiglu(n, w_gate, w_up, w_down):
    return (jax.nn.silu(n @ w_gate) * (n @ w_up)) @ w_down


def setup_inputs(seed: int = 0) -> dict:
    key = jax.random.key(seed)
    ks = jax.random.split(key, 20)

    def w(k, shape):
        return jax.random.normal(k, shape, jnp.float32) * (shape[-2] ** -0.5)

    def gain(k, shape):
        return 1.0 + 0.01 * jax.random.normal(k, shape, jnp.float32)

    x = jax.random.normal(ks[0], (BATCH, SEQ, D_MODEL), jnp.float32)
    mem = jax.random.normal(ks[1], (BATCH, N_MEM, D_MODEL), jnp.float32)
    offs = jax.random.randint(ks[2], (BATCH, 1), 0, MAX_POS_OFFSET, dtype=jnp.int32)
    positions = offs + jnp.arange(SEQ, dtype=jnp.int32)[None, :]
    return {
        "x": x,
        "mem": mem,
        "positions": positions,
        "g_mix": gain(ks[3], (DEPTH, D_MODEL)),
        "w_in": w(ks[4], (DEPTH, D_MODEL, IN_COLS)),
        "w_up_a": w(ks[5], (DEPTH, DIL_WIDTH, D_MODEL)),
        "w_up_b": w(ks[6], (DEPTH, SB_WIDTH, D_MODEL)),
        "w_out": w(ks[7], (DEPTH, D_MODEL, D_MODEL)),
        "g_mem_q": gain(ks[8], (DEPTH, D_MODEL)),
        "g_mem_kv": gain(ks[9], (DEPTH, D_MODEL)),
        "w_q_mem": w(ks[10], (DEPTH, D_MODEL, MEM_WIDTH)),
        "w_kv_mem": w(ks[11], (DEPTH, D_MODEL, 2 * MEM_WIDTH)),
        "w_o_mem": w(ks[12], (DEPTH, MEM_WIDTH, D_MODEL)),
        "g_ffn": gain(ks[13], (DEPTH, D_MODEL)),
        "w_ffn_gate": w(ks[14], (DEPTH, D_MODEL, D_FF)),
        "w_ffn_up": w(ks[15], (DEPTH, D_MODEL, D_FF)),
        "w_ffn_down": w(ks[16], (DEPTH, D_FF, D_MODEL)),
        "g_final": gain(ks[17], (D_MODEL,)),
    }


def reference(x, mem, positions, g_mix, w_in, w_up_a, w_up_b, w_out, g_mem_q, g_mem_kv,
              w_q_mem, w_kv_mem, w_o_mem, g_ffn, w_ffn_gate, w_ffn_up, w_ffn_down, g_final):
    B, S, _ = x.shape
    split_at = list(np.cumsum([DIL_WIDTH, DIL_WIDTH, DIL_WIDTH,
                               SB_WIDTH, SB_WIDTH, SB_WIDTH, D_MODEL]))

    def heads(t, nh):
        return t.reshape(B, S, nh, HEAD_DIM).transpose(0, 2, 1, 3)

    def merge(t):
        return t.transpose(0, 2, 1, 3).reshape(B, S, -1).astype(x.dtype)

    h = x
    for l in range(DEPTH):
        n = _rmsnorm(h, g_mix[l])
        proj = n @ w_in[l]
        qa, ka, va, qb, kb, vb, gate_a, gate_b = jnp.split(proj, split_at, axis=-1)
        qa = _partial_rope(heads(qa, N_HEADS_DIL), positions)
        ka = _partial_rope(heads(ka, N_HEADS_DIL), positions)
        o_a = merge(_dilated_attention(qa, ka, heads(va, N_HEADS_DIL)))
        o_b = merge(_stick_breaking(heads(qb, N_HEADS_SB), heads(kb, N_HEADS_SB),
                                    heads(vb, N_HEADS_SB)))
        mixed = (jax.nn.sigmoid(gate_a) * (o_a @ w_up_a[l])
                 + jax.nn.sigmoid(gate_b) * (o_b @ w_up_b[l]))
        h = h + mixed @ w_out[l]
        h = h + _memory_attention(_rmsnorm(h, g_mem_q[l]), _rmsnorm(mem, g_mem_kv[l]),
                                  w_q_mem[l], w_kv_mem[l], w_o_mem[l])
        h = h + _swiglu(_rmsnorm(h, g_ffn[l]), w_ffn_gate[l], w_ffn_up[l], w_ffn_down[l])
    return _rmsnorm(h, g_final)
```

```cpp
#include <hip/hip_runtime.h>
#include <hip/hip_cooperative_groups.h>
#include <cstdio>
namespace cg = cooperative_groups;

#define LAS __attribute__((address_space(3)))
typedef unsigned short bf16_t;
typedef short bf16x8 __attribute__((ext_vector_type(8)));
typedef float f32x4 __attribute__((ext_vector_type(4)));
typedef unsigned u32x4 __attribute__((ext_vector_type(4)));
typedef unsigned u32x2 __attribute__((ext_vector_type(2)));

constexpr int BATCH = 16, SEQ = 2048, DM = 1024, T = BATCH * SEQ;
constexpr int HD = 64, NHA = 8, NHB = 8;
constexpr int INC = 5120;
constexpr int C_QA = 0, C_KA = 512, C_VA = 1024, C_QB = 1536, C_KB = 2048, C_VB = 2560, C_GA = 3072, C_GB = 4096;
constexpr int NMEM = 256, MEMW = 512, DFF = 2816;
constexpr float EPS = 1e-6f;

constexpr size_t MiB = 1ull << 20;
constexpr size_t WS_WIN = 0, WS_WUPA = 10 * MiB, WS_WUPB = 11 * MiB, WS_WOUT = 12 * MiB, WS_WQM = 14 * MiB, WS_WKVM = 15 * MiB,
                 WS_WOM = 17 * MiB, WS_WGU = 18 * MiB, WS_WDN = 29 * MiB, WS_MEMN = 36 * MiB, WS_KVM = 44 * MiB,
                 WS_SS1 = 52 * MiB, WS_SS2 = 54 * MiB, WS_SS3 = 56 * MiB, WS_ROPE = 58 * MiB;
constexpr size_t WS_R1 = 64 * MiB;
constexpr size_t WS_PROJ = 128 * MiB;
constexpr size_t WS_H1 = 128 * MiB, WS_H1B = 256 * MiB, WS_QM = 320 * MiB, WS_OM = 352 * MiB, WS_H2 = 384 * MiB, WS_ACT = 128 * MiB;
constexpr size_t WS_OA = 448 * MiB, WS_OB = 480 * MiB;
constexpr size_t WS_END = 512 * MiB;

struct Params {
    const float* x; const float* mem; const int* pos; const float* g_mix; const float* w_in; const float* w_up_a; const float* w_up_b; const float* w_out;
    const float* g_mem_q; const float* g_mem_kv; const float* w_q_mem; const float* w_kv_mem; const float* w_o_mem; const float* g_ffn;
    const float* w_ffn_gate; const float* w_ffn_up; const float* w_ffn_down; const float* g_final;
    float* out; unsigned char* ws;
};

__device__ __forceinline__ unsigned pk_bf16(float lo, float hi) { unsigned r; asm("v_cvt_pk_bf16_f32 %0, %1, %2" : "=v"(r) : "v"(lo), "v"(hi)); return r; }
__device__ __forceinline__ bf16_t f2bf(float f) { return (bf16_t)(pk_bf16(f, 0.f) & 0xffffu); }
__device__ __forceinline__ float bf2f(bf16_t b) { return __uint_as_float(((unsigned)b) << 16); }
__device__ __forceinline__ float bflo(unsigned u) { return __uint_as_float(u << 16); }
__device__ __forceinline__ float bfhi(unsigned u) { return __uint_as_float(u & 0xffff0000u); }
__device__ __forceinline__ float wave_sum(float v) {
#pragma unroll
    for (int o = 1; o < 64; o <<= 1) v += __shfl_xor(v, o);
    return v;
}
__device__ __forceinline__ float sigmoidf_(float x) { return 1.f / (1.f + __expf(-x)); }
__device__ __forceinline__ float rstd_of(const float* ss, int row) {
    const f32x4* p = (const f32x4*)(ss + (size_t)row * 16);
    f32x4 a = p[0], b = p[1], c = p[2], d = p[3];
    float s = ((a[0] + a[1]) + (a[2] + a[3])) + ((b[0] + b[1]) + (b[2] + b[3])) + ((c[0] + c[1]) + (c[2] + c[3])) + ((d[0] + d[1]) + (d[2] + d[3]));
    return rsqrtf(s * (1.f / DM) + EPS);
}

namespace pg8 {
constexpr int BM = 256, BK = 64, HALF = 128, HTB = HALF * BK * 2, STAGE_BYTES = 8 * HTB, NXCD = 8, WGM = 8;
__host__ __device__ __forceinline__ int lds_byte(int r, int c) { const int st = (r >> 4) * 2 + (c >> 5), rr = r & 15, cc = c & 31, ob = rr * 64 + cc * 2; return st * 1024 + (ob ^ (((ob >> 9) & 1) << 5)); }
__host__ __device__ __forceinline__ void stage_rc(int b, int& R, int& C) { const int st = b / 1024, sb = b % 1024, swz = sb ^ (((sb >> 9) & 1) << 5); R = (st >> 1) * 16 + swz / 64; C = (st & 1) * 32 + (swz % 64) / 2; }
__host__ __device__ __forceinline__ int perm32(int rho) { const int n = rho >> 4, i = rho & 15; return 8 * (i >> 2) + 4 * n + (i & 3); }
struct Unit { int pm, pn; };
struct Gemm { const bf16_t* A; const bf16_t* Bt; int M, N, K; };
struct StaticOrder {
    int nM, nN, nwg, G, c;
    __host__ __device__ void init(int M, int N, int G_, int c_) { nM = M / BM; nN = N / BM; nwg = nM * nN; G = G_; c = c_; }
    __host__ __device__ bool next(int i, Unit& u) const {
        const long L = (long)i * G + c; if (L >= nwg) return false;
        int wgid = (int)L; { const int q = nwg / NXCD, r = nwg % NXCD, xcd = wgid % NXCD, off = wgid / NXCD; wgid = (xcd < r ? xcd * (q + 1) : r * (q + 1) + (xcd - r) * q) + off; }
        const int nig = WGM * nN, gid = wgid / nig, fm = gid * WGM, gsz = (nM - fm) < WGM ? (nM - fm) : WGM;
        u.pm = fm + ((wgid % nig) % gsz); u.pn = (wgid % nig) / gsz; return true;
    }
};

template <class Epi>
__device__ __forceinline__ void gemm_phase(LAS unsigned char* lds, const Gemm g, const StaticOrder& S, const Epi& E) {
    int tid = threadIdx.x; asm volatile("" : "+v"(tid));
    const int wid = __builtin_amdgcn_readfirstlane(tid >> 6), lane = tid & 63, wr = wid >> 2, wc = wid & 3, fr = lane & 15, fq = lane >> 4;
    const int K = g.K, nt = K / BK;
    unsigned voffA[2], voffB[2];
#pragma unroll
    for (int i = 0; i < 2; ++i) { int R, C; stage_rc(tid * 16 + i * 8192, R, C); const int Rb = Epi::PERM ? ((R & ~31) + perm32(R & 31)) : R;
        voffA[i] = (unsigned)(R * K + C) * 2u; voffB[i] = (unsigned)(Rb * K + C) * 2u; }
    const size_t kstep = (size_t)(BK * 2);
    const size_t hstep = (size_t)HALF * K * 2;
    const size_t tstep = 2 * hstep;
    const unsigned ldsw = (unsigned)wid * 1024u;
    const int aoff = lds_byte(wr * 64 + fr, fq * 8), boff = lds_byte(wc * 32 + fr, fq * 8);
#define PG8_SA(b, h) (((b) * 2 + (h)) * HTB)
#define PG8_SB(b, h) ((4 + (b) * 2 + (h)) * HTB)
#define PG8_STAGE(bufoff, gbase, voff) do { _Pragma("unroll") for (int _i = 0; _i < 2; ++_i) \
        __builtin_amdgcn_global_load_lds((const unsigned*)((const char*)(gbase) + (voff)[_i]), (LAS unsigned*)(lds + (bufoff) + ldsw + _i * 8192), 16, 0, 0); } while (0)
#define PG8_LDA(dst, b, h) do { _Pragma("unroll") for (int m = 0; m < 4; ++m) _Pragma("unroll") for (int k = 0; k < 2; ++k) dst[m][k] = *(const LAS bf16x8*)(lds + PG8_SA(b, h) + aoff + m * 2048 + k * 1024); } while (0)
#define PG8_LDB(dst, b, h) do { _Pragma("unroll") for (int n = 0; n < 2; ++n) _Pragma("unroll") for (int k = 0; k < 2; ++k) dst[n][k] = *(const LAS bf16x8*)(lds + PG8_SB(b, h) + boff + n * 2048 + k * 1024); } while (0)
#define PG8_MMA(ai, bj, At, Bt) do { __builtin_amdgcn_s_setprio(1); _Pragma("unroll") for (int m = 0; m < 4; ++m) _Pragma("unroll") for (int n = 0; n < 2; ++n) _Pragma("unroll") for (int k = 0; k < 2; ++k) \
        acc[ai][bj][m][n] = __builtin_amdgcn_mfma_f32_16x16x32_bf16(Bt[n][k], At[m][k], acc[ai][bj][m][n], 0, 0, 0); __builtin_amdgcn_s_setprio(0); } while (0)
#define PG8_WAIT_V(n) asm volatile("s_waitcnt vmcnt(" #n ")" ::: "memory")
#define PG8_WAIT_L(n) asm volatile("s_waitcnt lgkmcnt(" #n ")" ::: "memory")
#define PG8_BAR __builtin_amdgcn_s_barrier()
#define PG8_SCHED __builtin_amdgcn_sched_barrier(0)
    Unit cur, nxt; int ui = 0;
    if (!S.next(0, cur)) return;
    f32x4 acc[2][2][4][2];
#pragma unroll
    for (int a = 0; a < 2; ++a)
#pragma unroll
        for (int b = 0; b < 2; ++b)
#pragma unroll
            for (int m = 0; m < 4; ++m)
#pragma unroll
                for (int n = 0; n < 2; ++n) acc[a][b][m][n] = (f32x4){0.f, 0.f, 0.f, 0.f};
    bf16x8 At[4][2], B0[2][2], B1[2][2];
    const char* cA = (const char*)g.A + (size_t)cur.pm * tstep; const char* cB = (const char*)g.Bt + (size_t)cur.pn * tstep;
    PG8_STAGE(PG8_SB(0, 0), cB, voffB); PG8_STAGE(PG8_SA(0, 0), cA, voffA); PG8_STAGE(PG8_SB(0, 1), cB + hstep, voffB); PG8_STAGE(PG8_SA(0, 1), cA + hstep, voffA);
    if (wr == 1) PG8_BAR;
    PG8_WAIT_V(4); PG8_BAR;
    PG8_STAGE(PG8_SB(1, 0), cB + kstep, voffB); PG8_STAGE(PG8_SA(1, 0), cA + kstep, voffA); PG8_STAGE(PG8_SB(1, 1), cB + hstep + kstep, voffB);
    PG8_WAIT_V(6); PG8_BAR;
    for (;;) {
        const bool has_next = S.next(ui + 1, nxt);
        const char* nA = has_next ? (const char*)g.A + (size_t)nxt.pm * tstep : cA; const char* nB = has_next ? (const char*)g.Bt + (size_t)nxt.pn * tstep : cB;
        for (int t = 0; t < nt; t += 2) {
            const bool last = (t == nt - 2);
            const char* a1 = cA + (size_t)(t + 1) * kstep;
            const char* a2 = last ? nA : cA + (size_t)(t + 2) * kstep; const char* b2 = last ? nB : cB + (size_t)(t + 2) * kstep;
            const char* a3 = a2 + kstep; const char* b3 = b2 + kstep;
            PG8_LDB(B0, 0, 0); PG8_SCHED; PG8_LDA(At, 0, 0); PG8_STAGE(PG8_SA(1, 1), a1 + hstep, voffA);
            PG8_WAIT_L(8); PG8_BAR; PG8_WAIT_L(0); PG8_MMA(0, 0, At, B0); PG8_BAR; PG8_SCHED;
            PG8_LDB(B1, 0, 1); PG8_STAGE(PG8_SB(0, 0), b2, voffB);
            PG8_BAR; PG8_WAIT_L(0); PG8_MMA(0, 1, At, B1); PG8_BAR;
            PG8_LDA(At, 0, 1); PG8_STAGE(PG8_SA(0, 0), a2, voffA);
            PG8_BAR; PG8_WAIT_L(0); PG8_MMA(1, 0, At, B0); PG8_BAR; PG8_SCHED;
            PG8_STAGE(PG8_SB(0, 1), b2 + hstep, voffB);
            PG8_WAIT_V(6); PG8_BAR; PG8_MMA(1, 1, At, B1); PG8_BAR;
            PG8_LDB(B0, 1, 0); PG8_SCHED; PG8_LDA(At, 1, 0); PG8_STAGE(PG8_SA(0, 1), a2 + hstep, voffA);
            PG8_WAIT_L(8); PG8_BAR; PG8_WAIT_L(0); PG8_MMA(0, 0, At, B0); PG8_BAR; PG8_SCHED;
            PG8_LDB(B1, 1, 1); PG8_STAGE(PG8_SB(1, 0), b3, voffB);
            PG8_BAR; PG8_WAIT_L(0); PG8_MMA(0, 1, At, B1); PG8_BAR;
            PG8_LDA(At, 1, 1); PG8_STAGE(PG8_SA(1, 0), a3, voffA);
            PG8_BAR; PG8_WAIT_L(0); PG8_MMA(1, 0, At, B0); PG8_BAR; PG8_SCHED;
            PG8_STAGE(PG8_SB(1, 1), b3 + hstep, voffB);
            PG8_WAIT_V(6); PG8_BAR; PG8_MMA(1, 1, At, B1); PG8_BAR;
        }
        E(acc, cur, wr, wc, fr, fq);
        if (!has_next) break;
#pragma unroll
        for (int a = 0; a < 2; ++a)
#pragma unroll
            for (int b = 0; b < 2; ++b)
#pragma unroll
                for (int m = 0; m < 4; ++m)
#pragma unroll
                    for (int n = 0; n < 2; ++n) acc[a][b][m][n] = (f32x4){0.f, 0.f, 0.f, 0.f};
        cur = nxt; cA = nA; cB = nB; ++ui;
    }
    PG8_WAIT_V(0);
    if (wr == 0) PG8_BAR;
    PG8_BAR;
#undef PG8_SA
#undef PG8_SB
#undef PG8_STAGE
#undef PG8_LDA
#undef PG8_LDB
#undef PG8_MMA
#undef PG8_WAIT_V
#undef PG8_WAIT_L
#undef PG8_BAR
#undef PG8_SCHED
}
}
using pg8::Unit; using pg8::Gemm;

struct EpiBf16 {
    static constexpr bool PERM = true;
    bf16_t* O; int ldc; const float* ss; int sig_from;
    __device__ __forceinline__ void operator()(const f32x4 (&acc)[2][2][4][2], const Unit& u, int wr, int wc, int fr, int fq) const {
        const int row0 = u.pm * 256 + wr * 64 + fr, col0 = u.pn * 256 + wc * 32 + 8 * fq;
        const bool sig = u.pn >= sig_from;
#pragma unroll
        for (int ai = 0; ai < 2; ++ai)
#pragma unroll
            for (int m = 0; m < 4; ++m) {
                const int row = row0 + ai * 128 + m * 16;
                const float rs = ss ? rstd_of(ss, row) : 1.f;
#pragma unroll
                for (int bj = 0; bj < 2; ++bj) {
                    f32x4 v0 = acc[ai][bj][m][0] * rs, v1 = acc[ai][bj][m][1] * rs;
                    if (sig) {
#pragma unroll
                        for (int j = 0; j < 4; ++j) { v0[j] = sigmoidf_(v0[j]); v1[j] = sigmoidf_(v1[j]); }
                    }
                    u32x4 o; o[0] = pk_bf16(v0[0], v0[1]); o[1] = pk_bf16(v0[2], v0[3]); o[2] = pk_bf16(v1[0], v1[1]); o[3] = pk_bf16(v1[2], v1[3]);
                    *(u32x4*)(O + (size_t)row * ldc + col0 + bj * 128) = o;
                }
            }
    }
};
struct EpiGateA {
    static constexpr bool PERM = false;
    float* M1; const bf16_t* proj;
    __device__ __forceinline__ void operator()(const f32x4 (&acc)[2][2][4][2], const Unit& u, int wr, int wc, int fr, int fq) const {
        const int row0 = u.pm * 256 + wr * 64 + fr, col0 = u.pn * 256 + wc * 32 + 4 * fq;
#pragma unroll
        for (int ai = 0; ai < 2; ++ai)
#pragma unroll
            for (int m = 0; m < 4; ++m) {
                const int row = row0 + ai * 128 + m * 16;
#pragma unroll
                for (int bj = 0; bj < 2; ++bj)
#pragma unroll
                    for (int n = 0; n < 2; ++n) {
                        const int col = col0 + bj * 128 + n * 16;
                        const u32x2 gq = *(const u32x2*)(proj + (size_t)row * INC + C_GA + col);
                        f32x4 a = acc[ai][bj][m][n], o;
                        o[0] = a[0] * bflo(gq[0]); o[1] = a[1] * bfhi(gq[0]); o[2] = a[2] * bflo(gq[1]); o[3] = a[3] * bfhi(gq[1]);
                        *(f32x4*)(M1 + (size_t)row * DM + col) = o;
                    }
            }
    }
};
struct EpiGateB {
    static constexpr bool PERM = true;
    const float* M1; const bf16_t* proj; bf16_t* O;
    __device__ __forceinline__ void operator()(const f32x4 (&acc)[2][2][4][2], const Unit& u, int wr, int wc, int fr, int fq) const {
        const int row0 = u.pm * 256 + wr * 64 + fr, col0 = u.pn * 256 + wc * 32 + 8 * fq;
#pragma unroll
        for (int ai = 0; ai < 2; ++ai)
#pragma unroll
            for (int m = 0; m < 4; ++m) {
                const int row = row0 + ai * 128 + m * 16;
#pragma unroll
                for (int bj = 0; bj < 2; ++bj) {
                    const int col = col0 + bj * 128;
                    const u32x4 gq = *(const u32x4*)(proj + (size_t)row * INC + C_GB + col);
                    const f32x4 m0 = *(const f32x4*)(M1 + (size_t)row * DM + col), m1 = *(const f32x4*)(M1 + (size_t)row * DM + col + 4);
                    const f32x4 a0 = acc[ai][bj][m][0], a1 = acc[ai][bj][m][1];
                    u32x4 o;
                    o[0] = pk_bf16(m0[0] + a0[0] * bflo(gq[0]), m0[1] + a0[1] * bfhi(gq[0]));
                    o[1] = pk_bf16(m0[2] + a0[2] * bflo(gq[1]), m0[3] + a0[3] * bfhi(gq[1]));
                    o[2] = pk_bf16(m1[0] + a1[0] * bflo(gq[2]), m1[1] + a1[1] * bfhi(gq[2]));
                    o[3] = pk_bf16(m1[2] + a1[2] * bflo(gq[3]), m1[3] + a1[3] * bfhi(gq[3]));
                    *(u32x4*)(O + (size_t)row * DM + col) = o;
                }
            }
    }
};
struct EpiRes {
    static constexpr bool PERM = false;
    const float* R; float* H; bf16_t* Hb; float* SS;
    __device__ __forceinline__ void operator()(const f32x4 (&acc)[2][2][4][2], const Unit& u, int wr, int wc, int fr, int fq) const {
        const int row0 = u.pm * 256 + wr * 64 + fr, col0 = u.pn * 256 + wc * 32 + 4 * fq;
#pragma unroll
        for (int ai = 0; ai < 2; ++ai)
#pragma unroll
            for (int m = 0; m < 4; ++m) {
                const int row = row0 + ai * 128 + m * 16;
                float s = 0.f;
#pragma unroll
                for (int bj = 0; bj < 2; ++bj)
#pragma unroll
                    for (int n = 0; n < 2; ++n) {
                        const int col = col0 + bj * 128 + n * 16;
                        const f32x4 h = *(const f32x4*)(R + (size_t)row * DM + col) + acc[ai][bj][m][n];
                        *(f32x4*)(H + (size_t)row * DM + col) = h;
                        if (Hb) { u32x2 o; o[0] = pk_bf16(h[0], h[1]); o[1] = pk_bf16(h[2], h[3]); *(u32x2*)(Hb + (size_t)row * DM + col) = o; }
                        s += (h[0] * h[0] + h[1] * h[1]) + (h[2] * h[2] + h[3] * h[3]);
                    }
                s += __shfl_xor(s, 16); s += __shfl_xor(s, 32);
                if (fq == 0) SS[(size_t)row * 16 + u.pn * 4 + wc] = s;
            }
    }
};
struct EpiSwiGLU {
    static constexpr bool PERM = true;
    bf16_t* O; const float* ss;
    __device__ __forceinline__ void operator()(const f32x4 (&acc)[2][2][4][2], const Unit& u, int wr, int wc, int fr, int fq) const {
        const int row0 = u.pm * 256 + wr * 64 + fr, col0 = u.pn * 128 + wc * 32 + 8 * fq;
#pragma unroll
        for (int ai = 0; ai < 2; ++ai)
#pragma unroll
            for (int m = 0; m < 4; ++m) {
                const int row = row0 + ai * 128 + m * 16;
                const float rs = rstd_of(ss, row);
                float r[8];
#pragma unroll
                for (int n = 0; n < 2; ++n)
#pragma unroll
                    for (int j = 0; j < 4; ++j) { const float gg = acc[ai][0][m][n][j] * rs, uu = acc[ai][1][m][n][j] * rs; r[n * 4 + j] = gg * sigmoidf_(gg) * uu; }
                u32x4 o; o[0] = pk_bf16(r[0], r[1]); o[1] = pk_bf16(r[2], r[3]); o[2] = pk_bf16(r[4], r[5]); o[3] = pk_bf16(r[6], r[7]);
                *(u32x4*)(O + (size_t)row * DFF + col0) = o;
            }
    }
};

struct Ctx { int tid, lane, wave, gw, ngw, gt, ngt; };

__device__ __forceinline__ void p_transpose(const Ctx& c, const float* W, bf16_t* Wt, int K, int N, const float* g, int mode) {
    const size_t total = (size_t)K * N;
    for (size_t i = c.gt; i < total; i += c.ngt) {
        const int k = (int)(i / N), n = (int)(i % N);
        float v = W[i]; if (g) v *= g[k];
        const int row = mode == 0 ? n : (256 * (n >> 7) + (n & 127) + (mode == 2 ? 128 : 0));
        Wt[(size_t)row * K + k] = f2bf(v);
    }
}
__device__ __forceinline__ void p_rmsnorm_rows(const Ctx& c, const float* x, const float* g, bf16_t* out, int rows) {
    for (int r = c.gw; r < rows; r += c.ngw) {
        const f32x4* xr = (const f32x4*)(x + (size_t)r * DM) + c.lane;
        f32x4 v[4]; float s = 0.f;
#pragma unroll
        for (int j = 0; j < 4; ++j) { v[j] = xr[64 * j]; s += (v[j][0] * v[j][0] + v[j][1] * v[j][1]) + (v[j][2] * v[j][2] + v[j][3] * v[j][3]); }
        const float rs = rsqrtf(wave_sum(s) * (1.f / DM) + EPS);
#pragma unroll
        for (int j = 0; j < 4; ++j) {
            const f32x4 gg = ((const f32x4*)g)[c.lane + 64 * j];
            u32x2 o; o[0] = pk_bf16(v[j][0] * rs * gg[0], v[j][1] * rs * gg[1]); o[1] = pk_bf16(v[j][2] * rs * gg[2], v[j][3] * rs * gg[3]);
            ((u32x2*)(out + (size_t)r * DM))[c.lane + 64 * j] = o;
        }
    }
}
__device__ __forceinline__ void p_rope_table(const Ctx& c, const int* pos, float* tab) {
    for (int i = c.gt; i < T * 8; i += c.ngt) {
        const int tok = i >> 3, f = i & 7;
        const double inv = exp2(-(double)f * (18.931568569324174 / 8.0));
        const double ang = (double)pos[tok] * inv;
        const double rev = ang * 0.15915494309189535;
        const float fr = (float)(rev - rint(rev));
        tab[(size_t)tok * 16 + f] = __builtin_amdgcn_cosf(fr);
        tab[(size_t)tok * 16 + 8 + f] = __builtin_amdgcn_sinf(fr);
    }
}
__device__ __forceinline__ void p_rope_apply(const Ctx& c, bf16_t* proj, const float* tab) {
    for (int i = c.gt; i < T * 2 * NHA * 8; i += c.ngt) {
        const int f = i & 7, h = (i >> 3) & 7, which = (i >> 6) & 1, tok = i >> 7;
        bf16_t* p = proj + (size_t)tok * INC + (which ? C_KA : C_QA) + h * HD + f;
        const float x1 = bf2f(p[0]), x2 = bf2f(p[8]), cs = tab[(size_t)tok * 16 + f], sn = tab[(size_t)tok * 16 + 8 + f];
        p[0] = f2bf(x1 * cs - x2 * sn); p[8] = f2bf(x2 * cs + x1 * sn);
    }
}
__device__ __forceinline__ void p_attn_a_naive(const Ctx& c, const bf16_t* proj, bf16_t* OA) {
    for (int it = c.gw; it < T * NHA; it += c.ngw) {
        const int h = it & 7, tok = it >> 3, t = tok & (SEQ - 1), tb = tok - t;
        const float q = bf2f(proj[(size_t)tok * INC + C_QA + h * HD + c.lane]) * 0.125f;
        float og[3], lse[3];
#pragma unroll
        for (int gi = 0; gi < 3; ++gi) {
            const int d = gi == 0 ? 1 : (gi == 1 ? 4 : 16);
            float m = -INFINITY, l = 0.f, o = 0.f;
            for (int j = 0; j <= 128; ++j) {
                const int tk = t - j * d; if (tk < 0) break;
                const bf16_t* kr = proj + (size_t)(tb + tk) * INC + h * HD + c.lane;
                const float s = wave_sum(q * bf2f(kr[C_KA]));
                const float mn = fmaxf(m, s), sc = __expf(m - mn), p = __expf(s - mn);
                l = l * sc + p; o = o * sc + p * bf2f(kr[C_VA]); m = mn;
            }
            og[gi] = o / l; lse[gi] = m + __logf(l);
        }
        const float M = fmaxf(lse[0], fmaxf(lse[1], lse[2]));
        const float w0 = __expf(lse[0] - M), w1 = __expf(lse[1] - M), w2 = __expf(lse[2] - M);
        OA[(size_t)tok * 512 + h * HD + c.lane] = f2bf((w0 * og[0] + w1 * og[1] + w2 * og[2]) / (w0 + w1 + w2));
    }
}
__device__ __forceinline__ void p_attn_b_naive(const Ctx& c, const bf16_t* proj, bf16_t* OB) {
    for (int it = c.gw; it < T * NHB; it += c.ngw) {
        const int h = it & 7, tok = it >> 3, t = tok & (SEQ - 1), tb = tok - t;
        const float q = bf2f(proj[(size_t)tok * INC + C_QB + h * HD + c.lane]) * 0.125f;
        float run = 0.f, o = 0.f;
        for (int tk = t - 1; tk >= 0; --tk) {
            const bf16_t* kr = proj + (size_t)(tb + tk) * INC + h * HD + c.lane;
            const float z = wave_sum(q * bf2f(kr[C_KB]));
            const float sp = fmaxf(z, 0.f) + log1pf(__expf(-fabsf(z)));
            const float a = __expf(z - sp + run);
            o += a * bf2f(kr[C_VB]);
            run -= sp;
        }
        OB[(size_t)tok * 512 + h * HD + c.lane] = f2bf(o);
    }
}
__device__ __forceinline__ void p_attn_mem_naive(const Ctx& c, const bf16_t* qm, const bf16_t* kvm, bf16_t* om) {
    const float sc = 0.08838834764831845f;
    for (int it = c.gw; it < T * 4; it += c.ngw) {
        const int h = it & 3, tok = it >> 2, b = tok >> 11;
        const float q0 = bf2f(qm[(size_t)tok * MEMW + h * 128 + c.lane]) * sc, q1 = bf2f(qm[(size_t)tok * MEMW + h * 128 + 64 + c.lane]) * sc;
        float m = -INFINITY, l = 0.f, o0 = 0.f, o1 = 0.f;
        for (int j = 0; j < NMEM; ++j) {
            const bf16_t* kr = kvm + (size_t)(b * NMEM + j) * 1024 + h * 128 + c.lane;
            const float s = wave_sum(q0 * bf2f(kr[0]) + q1 * bf2f(kr[64]));
            const float mn = fmaxf(m, s), scl = __expf(m - mn), p = __expf(s - mn);
            l = l * scl + p; o0 = o0 * scl + p * bf2f(kr[512]); o1 = o1 * scl + p * bf2f(kr[512 + 64]); m = mn;
        }
        om[(size_t)tok * MEMW + h * 128 + c.lane] = f2bf(o0 / l); om[(size_t)tok * MEMW + h * 128 + 64 + c.lane] = f2bf(o1 / l);
    }
}
__device__ __forceinline__ void p_final(const Ctx& c, float* out, const float* ss, const float* g) {
    for (int r = c.gw; r < T; r += c.ngw) {
        const float rs = rstd_of(ss, r);
        f32x4* xr = (f32x4*)(out + (size_t)r * DM) + c.lane;
#pragma unroll
        for (int j = 0; j < 4; ++j) { const f32x4 gg = ((const f32x4*)g)[c.lane + 64 * j]; f32x4 v = xr[64 * j]; v = v * rs * gg; xr[64 * j] = v; }
    }
}

__device__ __forceinline__ bool sync_if(bool doit, cg::grid_group& grid) { if (doit) grid.sync(); asm volatile("" ::: "memory"); return true; }
constexpr int NPHASE = 13;
#ifndef ONLY
#define ONLY -1
#endif
#define PHASE(k) if ((ONLY < 0 || ONLY == (k)) && ph_lo <= (k) && (k) < ph_hi) if (sync_if((k) > ph_lo, grid))
__global__ __launch_bounds__(512, 2) void mega(Params p, int ph_lo, int ph_hi) {
    extern __shared__ __attribute__((aligned(16))) unsigned char shm[];
    LAS unsigned char* lds = (LAS unsigned char*)shm;
    cg::grid_group grid = cg::this_grid();
    Ctx c; c.tid = threadIdx.x; c.lane = c.tid & 63; c.wave = c.tid >> 6; c.gw = blockIdx.x * 8 + c.wave; c.ngw = gridDim.x * 8; c.gt = blockIdx.x * 512 + c.tid; c.ngt = gridDim.x * 512;
    unsigned char* ws = p.ws;
    bf16_t* Wt_in = (bf16_t*)(ws + WS_WIN); bf16_t* Wt_upa = (bf16_t*)(ws + WS_WUPA); bf16_t* Wt_upb = (bf16_t*)(ws + WS_WUPB); bf16_t* Wt_out = (bf16_t*)(ws + WS_WOUT);
    bf16_t* Wt_qm = (bf16_t*)(ws + WS_WQM); bf16_t* Wt_kvm = (bf16_t*)(ws + WS_WKVM); bf16_t* Wt_om = (bf16_t*)(ws + WS_WOM); bf16_t* Wt_gu = (bf16_t*)(ws + WS_WGU); bf16_t* Wt_dn = (bf16_t*)(ws + WS_WDN);
    bf16_t* memn = (bf16_t*)(ws + WS_MEMN); bf16_t* kvm = (bf16_t*)(ws + WS_KVM);
    float* ss1 = (float*)(ws + WS_SS1); float* ss2 = (float*)(ws + WS_SS2); float* ss3 = (float*)(ws + WS_SS3); float* rope = (float*)(ws + WS_ROPE);
    bf16_t* n1 = (bf16_t*)(ws + WS_R1); bf16_t* mixed = (bf16_t*)(ws + WS_R1); bf16_t* h2b = (bf16_t*)(ws + WS_R1);
    bf16_t* proj = (bf16_t*)(ws + WS_PROJ);
    float* h1 = (float*)(ws + WS_H1); bf16_t* h1b = (bf16_t*)(ws + WS_H1B); bf16_t* qm = (bf16_t*)(ws + WS_QM); bf16_t* om = (bf16_t*)(ws + WS_OM);
    float* h2 = (float*)(ws + WS_H2); bf16_t* act = (bf16_t*)(ws + WS_ACT); bf16_t* OA = (bf16_t*)(ws + WS_OA); bf16_t* OB = (bf16_t*)(ws + WS_OB);
    float* m1 = p.out;
    pg8::StaticOrder S;
    {
        PHASE(0) {
            p_transpose(c, p.w_in, Wt_in, DM, INC, nullptr, 0);
            p_transpose(c, p.w_up_a, Wt_upa, 512, DM, nullptr, 0);
            p_transpose(c, p.w_up_b, Wt_upb, 512, DM, nullptr, 0);
            p_transpose(c, p.w_out, Wt_out, DM, DM, nullptr, 0);
            p_transpose(c, p.w_q_mem, Wt_qm, DM, MEMW, p.g_mem_q, 0);
            p_transpose(c, p.w_kv_mem, Wt_kvm, DM, 2 * MEMW, nullptr, 0);
            p_transpose(c, p.w_o_mem, Wt_om, MEMW, DM, nullptr, 0);
            p_transpose(c, p.w_ffn_gate, Wt_gu, DM, DFF, p.g_ffn, 1);
            p_transpose(c, p.w_ffn_up, Wt_gu, DM, DFF, p.g_ffn, 2);
            p_transpose(c, p.w_ffn_down, Wt_dn, DFF, DM, nullptr, 0);
            p_rmsnorm_rows(c, p.x, p.g_mix, n1, T);
            p_rmsnorm_rows(c, p.mem, p.g_mem_kv, memn, BATCH * NMEM);
            p_rope_table(c, p.pos, rope);
        }
        PHASE(1) {
            { Gemm g{n1, Wt_in, T, INC, DM}; EpiBf16 E{proj, INC, nullptr, 12}; S.init(g.M, g.N, gridDim.x, blockIdx.x); pg8::gemm_phase(lds, g, S, E); }
            { Gemm g{memn, Wt_kvm, BATCH * NMEM, 1024, DM}; EpiBf16 E{kvm, 1024, nullptr, 1 << 30}; S.init(g.M, g.N, gridDim.x, blockIdx.x); pg8::gemm_phase(lds, g, S, E); }
        }
        PHASE(2) p_rope_apply(c, proj, rope);
        PHASE(3) { p_attn_a_naive(c, proj, OA); p_attn_b_naive(c, proj, OB); }
        PHASE(4) { Gemm g{OA, Wt_upa, T, DM, 512}; EpiGateA E{m1, proj}; S.init(g.M, g.N, gridDim.x, blockIdx.x); pg8::gemm_phase(lds, g, S, E); }
        PHASE(5) { Gemm g{OB, Wt_upb, T, DM, 512}; EpiGateB E{m1, proj, mixed}; S.init(g.M, g.N, gridDim.x, blockIdx.x); pg8::gemm_phase(lds, g, S, E); }
        PHASE(6) { Gemm g{mixed, Wt_out, T, DM, DM}; EpiRes E{p.x, h1, h1b, ss1}; S.init(g.M, g.N, gridDim.x, blockIdx.x); pg8::gemm_phase(lds, g, S, E); }
        PHASE(7) { Gemm g{h1b, Wt_qm, T, MEMW, DM}; EpiBf16 E{qm, MEMW, ss1, 1 << 30}; S.init(g.M, g.N, gridDim.x, blockIdx.x); pg8::gemm_phase(lds, g, S, E); }
        PHASE(8) p_attn_mem_naive(c, qm, kvm, om);
        PHASE(9) { Gemm g{om, Wt_om, T, DM, MEMW}; EpiRes E{h1, h2, h2b, ss2}; S.init(g.M, g.N, gridDim.x, blockIdx.x); pg8::gemm_phase(lds, g, S, E); }
        PHASE(10) { Gemm g{h2b, Wt_gu, T, 2 * DFF, DM}; EpiSwiGLU E{act, ss2}; S.init(g.M, g.N, gridDim.x, blockIdx.x); pg8::gemm_phase(lds, g, S, E); }
        PHASE(11) { Gemm g{act, Wt_dn, T, DM, DFF}; EpiRes E{h2, p.out, nullptr, ss3}; S.init(g.M, g.N, gridDim.x, blockIdx.x); pg8::gemm_phase(lds, g, S, E); }
        PHASE(12) p_final(c, p.out, ss3, p.g_final);
    }
}

constexpr int LDS_BYTES = pg8::STAGE_BYTES;
#ifndef ONE_LAUNCH
#define ONE_LAUNCH 1
#endif
extern "C" void kernel_launch(void* const* d_in, const int* in_sizes, int n_in, void* d_out, int out_size, void* d_ws, size_t ws_size, hipStream_t stream) {
    static int grid = 0;
    if (grid == 0) {
        if (n_in != 18 || out_size != T * DM || ws_size < WS_END) { fprintf(stderr, "kernel_launch: unexpected shapes (n_in %d out %d ws %zu)\n", n_in, out_size, ws_size); grid = -1; return; }
        int dev = 0, cus = 0, per_cu = 0;
        (void)hipGetDevice(&dev); (void)hipDeviceGetAttribute(&cus, hipDeviceAttributeMultiprocessorCount, dev);
        if (hipFuncSetAttribute((const void*)mega, hipFuncAttributeMaxDynamicSharedMemorySize, LDS_BYTES) != hipSuccess) { fprintf(stderr, "hipFuncSetAttribute failed\n"); grid = -1; return; }
        if (hipOccupancyMaxActiveBlocksPerMultiprocessor(&per_cu, (const void*)mega, 512, LDS_BYTES) != hipSuccess || per_cu < 1) { fprintf(stderr, "occupancy query: %d\n", per_cu); per_cu = 1; }
        (void)hipGetLastError();
        grid = cus * 1;
    }
    if (grid < 0) return;
    Params p{};
    p.x = (const float*)d_in[0]; p.mem = (const float*)d_in[1]; p.pos = (const int*)d_in[2]; p.g_mix = (const float*)d_in[3]; p.w_in = (const float*)d_in[4];
    p.w_up_a = (const float*)d_in[5]; p.w_up_b = (const float*)d_in[6]; p.w_out = (const float*)d_in[7]; p.g_mem_q = (const float*)d_in[8]; p.g_mem_kv = (const float*)d_in[9];
    p.w_q_mem = (const float*)d_in[10]; p.w_kv_mem = (const float*)d_in[11]; p.w_o_mem = (const float*)d_in[12]; p.g_ffn = (const float*)d_in[13];
    p.w_ffn_gate = (const float*)d_in[14]; p.w_ffn_up = (const float*)d_in[15]; p.w_ffn_down = (const float*)d_in[16]; p.g_final = (const float*)d_in[17];
    p.out = (float*)d_out; p.ws = (unsigned char*)d_ws;
#if ONE_LAUNCH
    int lo = 0, hi = NPHASE;
    void* args[] = {&p, &lo, &hi};
    hipError_t e = hipLaunchCooperativeKernel((const void*)mega, dim3(grid), dim3(512), args, LDS_BYTES, stream);
    if (e != hipSuccess) fprintf(stderr, "cooperative launch failed: %s\n", hipGetErrorString(e));
#else
    for (int ph = 0; ph < NPHASE; ++ph) hipLaunchKernelGGL(mega, dim3(grid), dim3(512), LDS_BYTES, stream, p, ph, ph + 1);
#endif
}
```

```cpp
#include <hip/hip_runtime.h>
#include <hip/hip_cooperative_groups.h>
#include <cstdio>
namespace cg = cooperative_groups;

#define LAS __attribute__((address_space(3)))
typedef unsigned short bf16_t;
typedef short bf16x8 __attribute__((ext_vector_type(8)));
typedef float f32x4 __attribute__((ext_vector_type(4)));
typedef unsigned u32x4 __attribute__((ext_vector_type(4)));
typedef unsigned u32x2 __attribute__((ext_vector_type(2)));

constexpr int BATCH = 16, SEQ = 2048, DM = 1024, T = BATCH * SEQ;
constexpr int HD = 64, NHA = 8, NHB = 8;
constexpr int INC = 5120;
constexpr int C_QA = 0, C_KA = 512, C_VA = 1024, C_QB = 1536, C_KB = 2048, C_VB = 2560, C_GA = 3072, C_GB = 4096;
constexpr int NMEM = 256, MEMW = 512, DFF = 2816;
constexpr float EPS = 1e-6f;

constexpr size_t MiB = 1ull << 20;
constexpr size_t WS_WIN = 0, WS_WUPA = 10 * MiB, WS_WUPB = 11 * MiB, WS_WOUT = 12 * MiB, WS_WQM = 14 * MiB, WS_WKVM = 15 * MiB,
                 WS_WOM = 17 * MiB, WS_WGU = 18 * MiB, WS_WDN = 29 * MiB, WS_MEMN = 36 * MiB, WS_KVM = 44 * MiB,
                 WS_SS1 = 52 * MiB, WS_SS2 = 54 * MiB, WS_SS3 = 56 * MiB, WS_ROPE = 58 * MiB;
constexpr size_t WS_R1 = 64 * MiB;
constexpr size_t WS_PROJ = 128 * MiB;
constexpr size_t WS_H1 = 128 * MiB, WS_H1B = 256 * MiB, WS_QM = 320 * MiB, WS_OM = 352 * MiB, WS_H2 = 384 * MiB, WS_ACT = 128 * MiB;
constexpr size_t WS_OA = 448 * MiB, WS_OB = 480 * MiB;
constexpr size_t WS_END = 512 * MiB;

struct Params {
    const float* x; const float* mem; const int* pos; const float* g_mix; const float* w_in; const float* w_up_a; const float* w_up_b; const float* w_out;
    const float* g_mem_q; const float* g_mem_kv; const float* w_q_mem; const float* w_kv_mem; const float* w_o_mem; const float* g_ffn;
    const float* w_ffn_gate; const float* w_ffn_up; const float* w_ffn_down; const float* g_final;
    float* out; unsigned char* ws;
};

typedef float f32x2 __attribute__((ext_vector_type(2)));
typedef __bf16 bf16v2 __attribute__((ext_vector_type(2)));
__device__ __forceinline__ unsigned pk_bf16(float lo, float hi) { f32x2 v = {lo, hi}; bf16v2 r = __builtin_convertvector(v, bf16v2); return __builtin_bit_cast(unsigned, r); }
__device__ __forceinline__ bf16_t f2bf(float f) { return (bf16_t)(pk_bf16(f, 0.f) & 0xffffu); }
__device__ __forceinline__ float bf2f(bf16_t b) { return __uint_as_float(((unsigned)b) << 16); }
__device__ __forceinline__ float bflo(unsigned u) { return __uint_as_float(u << 16); }
__device__ __forceinline__ float bfhi(unsigned u) { return __uint_as_float(u & 0xffff0000u); }
__device__ __forceinline__ float wave_sum(float v) {
#pragma unroll
    for (int o = 1; o < 64; o <<= 1) v += __shfl_xor(v, o);
    return v;
}
__device__ __forceinline__ float sigmoidf_(float x) { return 1.f / (1.f + __expf(-x)); }
__device__ __forceinline__ float rstd_of(const float* ss, int row) {
    const f32x4* p = (const f32x4*)(ss + (size_t)row * 16);
    f32x4 a = p[0], b = p[1], c = p[2], d = p[3];
    float s = ((a[0] + a[1]) + (a[2] + a[3])) + ((b[0] + b[1]) + (b[2] + b[3])) + ((c[0] + c[1]) + (c[2] + c[3])) + ((d[0] + d[1]) + (d[2] + d[3]));
    return rsqrtf(s * (1.f / DM) + EPS);
}

namespace pg8 {
constexpr int BM = 256, BK = 64, HALF = 128, HTB = HALF * BK * 2, STAGE_BYTES = 8 * HTB, NXCD = 8, WGM = 8;
__host__ __device__ __forceinline__ int lds_byte(int r, int c) { const int st = (r >> 4) * 2 + (c >> 5), rr = r & 15, cc = c & 31, ob = rr * 64 + cc * 2; return st * 1024 + (ob ^ (((ob >> 9) & 1) << 5)); }
__host__ __device__ __forceinline__ void stage_rc(int b, int& R, int& C) { const int st = b / 1024, sb = b % 1024, swz = sb ^ (((sb >> 9) & 1) << 5); R = (st >> 1) * 16 + swz / 64; C = (st & 1) * 32 + (swz % 64) / 2; }
__host__ __device__ __forceinline__ int perm32(int rho) { const int n = rho >> 4, i = rho & 15; return 8 * (i >> 2) + 4 * n + (i & 3); }
struct Unit { int pm, pn; };
struct Gemm { const bf16_t* A; const bf16_t* Bt; int M, N, K; };
struct StaticOrder {
    int nM, nN, nwg, G, c;
    __host__ __device__ void init(int M, int N, int G_, int c_) { nM = M / BM; nN = N / BM; nwg = nM * nN; G = G_; c = c_; }
    __host__ __device__ bool next(int i, Unit& u) const {
        const long L = (long)i * G + c; if (L >= nwg) return false;
        int wgid = (int)L; { const int q = nwg / NXCD, r = nwg % NXCD, xcd = wgid % NXCD, off = wgid / NXCD; wgid = (xcd < r ? xcd * (q + 1) : r * (q + 1) + (xcd - r) * q) + off; }
        const int nig = WGM * nN, gid = wgid / nig, fm = gid * WGM, gsz = (nM - fm) < WGM ? (nM - fm) : WGM;
        u.pm = fm + ((wgid % nig) % gsz); u.pn = (wgid % nig) / gsz; return true;
    }
};

template <class Epi>
__device__ __forceinline__ void gemm_phase(LAS unsigned char* lds, const Gemm g, const StaticOrder& S, const Epi& E) {
    int tid = threadIdx.x; asm volatile("" : "+v"(tid));
    const int wid = __builtin_amdgcn_readfirstlane(tid >> 6), lane = tid & 63, wr = wid >> 2, wc = wid & 3, fr = lane & 15, fq = lane >> 4;
    const int K = g.K, nt = K / BK;
    unsigned voffA[2], voffB[2];
#pragma unroll
    for (int i = 0; i < 2; ++i) { int R, C; stage_rc(tid * 16 + i * 8192, R, C); const int Rb = Epi::PERM ? ((R & ~31) + perm32(R & 31)) : R;
        voffA[i] = (unsigned)(R * K + C) * 2u; voffB[i] = (unsigned)(Rb * K + C) * 2u; }
    const size_t kstep = (size_t)(BK * 2);
    const size_t hstep = (size_t)HALF * K * 2;
    const size_t tstep = 2 * hstep;
    const unsigned ldsw = (unsigned)wid * 1024u;
    const int aoff = lds_byte(wr * 64 + fr, fq * 8), boff = lds_byte(wc * 32 + fr, fq * 8);
#define PG8_SA(b, h) (((b) * 2 + (h)) * HTB)
#define PG8_SB(b, h) ((4 + (b) * 2 + (h)) * HTB)
#define PG8_STAGE(bufoff, gbase, voff) do { _Pragma("unroll") for (int _i = 0; _i < 2; ++_i) \
        __builtin_amdgcn_global_load_lds((const unsigned*)((const char*)(gbase) + (voff)[_i]), (LAS unsigned*)(lds + (bufoff) + ldsw + _i * 8192), 16, 0, 0); } while (0)
#define PG8_LDA(dst, b, h) do { _Pragma("unroll") for (int m = 0; m < 4; ++m) _Pragma("unroll") for (int k = 0; k < 2; ++k) dst[m][k] = *(const LAS bf16x8*)(lds + PG8_SA(b, h) + aoff + m * 2048 + k * 1024); } while (0)
#define PG8_LDB(dst, b, h) do { _Pragma("unroll") for (int n = 0; n < 2; ++n) _Pragma("unroll") for (int k = 0; k < 2; ++k) dst[n][k] = *(const LAS bf16x8*)(lds + PG8_SB(b, h) + boff + n * 2048 + k * 1024); } while (0)
#define PG8_MMA(ai, bj, At, Bt) do { __builtin_amdgcn_s_setprio(1); _Pragma("unroll") for (int m = 0; m < 4; ++m) _Pragma("unroll") for (int n = 0; n < 2; ++n) _Pragma("unroll") for (int k = 0; k < 2; ++k) \
        acc[ai][bj][m][n] = __builtin_amdgcn_mfma_f32_16x16x32_bf16(Bt[n][k], At[m][k], acc[ai][bj][m][n], 0, 0, 0); __builtin_amdgcn_s_setprio(0); } while (0)
#define PG8_WAIT_V(n) asm volatile("s_waitcnt vmcnt(" #n ")" ::: "memory")
#define PG8_WAIT_L(n) asm volatile("s_waitcnt lgkmcnt(" #n ")" ::: "memory")
#define PG8_BAR __builtin_amdgcn_s_barrier()
#define PG8_SCHED __builtin_amdgcn_sched_barrier(0)
    Unit cur, nxt; int ui = 0;
    if (!S.next(0, cur)) return;
    f32x4 acc[2][2][4][2];
#pragma unroll
    for (int a = 0; a < 2; ++a)
#pragma unroll
        for (int b = 0; b < 2; ++b)
#pragma unroll
            for (int m = 0; m < 4; ++m)
#pragma unroll
                for (int n = 0; n < 2; ++n) acc[a][b][m][n] = (f32x4){0.f, 0.f, 0.f, 0.f};
    bf16x8 At[4][2], B0[2][2], B1[2][2];
    const char* cA = (const char*)g.A + (size_t)cur.pm * tstep; const char* cB = (const char*)g.Bt + (size_t)cur.pn * tstep;
    PG8_STAGE(PG8_SB(0, 0), cB, voffB); PG8_STAGE(PG8_SA(0, 0), cA, voffA); PG8_STAGE(PG8_SB(0, 1), cB + hstep, voffB); PG8_STAGE(PG8_SA(0, 1), cA + hstep, voffA);
    if (wr == 1) PG8_BAR;
    PG8_WAIT_V(4); PG8_BAR;
    PG8_STAGE(PG8_SB(1, 0), cB + kstep, voffB); PG8_STAGE(PG8_SA(1, 0), cA + kstep, voffA); PG8_STAGE(PG8_SB(1, 1), cB + hstep + kstep, voffB);
    PG8_WAIT_V(6); PG8_BAR;
    for (;;) {
        const bool has_next = S.next(ui + 1, nxt);
        const char* nA = has_next ? (const char*)g.A + (size_t)nxt.pm * tstep : cA; const char* nB = has_next ? (const char*)g.Bt + (size_t)nxt.pn * tstep : cB;
        for (int t = 0; t < nt; t += 2) {
            const bool last = (t == nt - 2);
            const char* a1 = cA + (size_t)(t + 1) * kstep;
            const char* a2 = last ? nA : cA + (size_t)(t + 2) * kstep; const char* b2 = last ? nB : cB + (size_t)(t + 2) * kstep;
            const char* a3 = a2 + kstep; const char* b3 = b2 + kstep;
            PG8_LDB(B0, 0, 0); PG8_SCHED; PG8_LDA(At, 0, 0); PG8_STAGE(PG8_SA(1, 1), a1 + hstep, voffA);
            PG8_WAIT_L(8); PG8_BAR; PG8_WAIT_L(0); PG8_MMA(0, 0, At, B0); PG8_BAR; PG8_SCHED;
            PG8_LDB(B1, 0, 1); PG8_STAGE(PG8_SB(0, 0), b2, voffB);
            PG8_BAR; PG8_WAIT_L(0); PG8_MMA(0, 1, At, B1); PG8_BAR;
            PG8_LDA(At, 0, 1); PG8_STAGE(PG8_SA(0, 0), a2, voffA);
            PG8_BAR; PG8_WAIT_L(0); PG8_MMA(1, 0, At, B0); PG8_BAR; PG8_SCHED;
            PG8_STAGE(PG8_SB(0, 1), b2 + hstep, voffB);
            PG8_WAIT_V(6); PG8_BAR; PG8_MMA(1, 1, At, B1); PG8_BAR;
            PG8_LDB(B0, 1, 0); PG8_SCHED; PG8_LDA(At, 1, 0); PG8_STAGE(PG8_SA(0, 1), a2 + hstep, voffA);
            PG8_WAIT_L(8); PG8_BAR; PG8_WAIT_L(0); PG8_MMA(0, 0, At, B0); PG8_BAR; PG8_SCHED;
            PG8_LDB(B1, 1, 1); PG8_STAGE(PG8_SB(1, 0), b3, voffB);
            PG8_BAR; PG8_WAIT_L(0); PG8_MMA(0, 1, At, B1); PG8_BAR;
            PG8_LDA(At, 1, 1); PG8_STAGE(PG8_SA(1, 0), a3, voffA);
            PG8_BAR; PG8_WAIT_L(0); PG8_MMA(1, 0, At, B0); PG8_BAR; PG8_SCHED;
            PG8_STAGE(PG8_SB(1, 1), b3 + hstep, voffB);
            PG8_WAIT_V(6); PG8_BAR; PG8_MMA(1, 1, At, B1); PG8_BAR;
        }
        E(acc, cur, wr, wc, fr, fq);
        if (!has_next) break;
#pragma unroll
        for (int a = 0; a < 2; ++a)
#pragma unroll
            for (int b = 0; b < 2; ++b)
#pragma unroll
                for (int m = 0; m < 4; ++m)
#pragma unroll
                    for (int n = 0; n < 2; ++n) acc[a][b][m][n] = (f32x4){0.f, 0.f, 0.f, 0.f};
        cur = nxt; cA = nA; cB = nB; ++ui;
    }
    PG8_WAIT_V(0);
    if (wr == 0) PG8_BAR;
    PG8_BAR;
#undef PG8_SA
#undef PG8_SB
#undef PG8_STAGE
#undef PG8_LDA
#undef PG8_LDB
#undef PG8_MMA
#undef PG8_WAIT_V
#undef PG8_WAIT_L
#undef PG8_BAR
#undef PG8_SCHED
}
}
using pg8::Unit; using pg8::Gemm;

struct EpiBf16 {
    static constexpr bool PERM = true;
    bf16_t* O; int ldc; const float* ss; int sig_from;
    __device__ __forceinline__ void operator()(const f32x4 (&acc)[2][2][4][2], const Unit& u, int wr, int wc, int fr, int fq) const {
        const int row0 = u.pm * 256 + wr * 64 + fr, col0 = u.pn * 256 + wc * 32 + 8 * fq;
        const bool sig = u.pn >= sig_from;
#pragma unroll
        for (int ai = 0; ai < 2; ++ai)
#pragma unroll
            for (int m = 0; m < 4; ++m) {
                const int row = row0 + ai * 128 + m * 16;
                const float rs = ss ? rstd_of(ss, row) : 1.f;
#pragma unroll
                for (int bj = 0; bj < 2; ++bj) {
                    f32x4 v0 = acc[ai][bj][m][0] * rs, v1 = acc[ai][bj][m][1] * rs;
                    if (sig) {
#pragma unroll
                        for (int j = 0; j < 4; ++j) { v0[j] = sigmoidf_(v0[j]); v1[j] = sigmoidf_(v1[j]); }
                    }
                    u32x4 o; o[0] = pk_bf16(v0[0], v0[1]); o[1] = pk_bf16(v0[2], v0[3]); o[2] = pk_bf16(v1[0], v1[1]); o[3] = pk_bf16(v1[2], v1[3]);
                    *(u32x4*)(O + (size_t)row * ldc + col0 + bj * 128) = o;
                }
            }
    }
};
struct EpiGateA {
    static constexpr bool PERM = false;
    float* M1; const bf16_t* proj;
    __device__ __forceinline__ void operator()(const f32x4 (&acc)[2][2][4][2], const Unit& u, int wr, int wc, int fr, int fq) const {
        const int row0 = u.pm * 256 + wr * 64 + fr, col0 = u.pn * 256 + wc * 32 + 4 * fq;
#pragma unroll
        for (int ai = 0; ai < 2; ++ai)
#pragma unroll
            for (int m = 0; m < 4; ++m) {
                const int row = row0 + ai * 128 + m * 16;
#pragma unroll
                for (int bj = 0; bj < 2; ++bj)
#pragma unroll
                    for (int n = 0; n < 2; ++n) {
                        const int col = col0 + bj * 128 + n * 16;
                        const u32x2 gq = *(const u32x2*)(proj + (size_t)row * INC + C_GA + col);
                        f32x4 a = acc[ai][bj][m][n], o;
                        o[0] = a[0] * bflo(gq[0]); o[1] = a[1] * bfhi(gq[0]); o[2] = a[2] * bflo(gq[1]); o[3] = a[3] * bfhi(gq[1]);
                        *(f32x4*)(M1 + (size_t)row * DM + col) = o;
                    }
            }
    }
};
struct EpiGateB {
    static constexpr bool PERM = true;
    const float* M1; const bf16_t* proj; bf16_t* O;
    __device__ __forceinline__ void operator()(const f32x4 (&acc)[2][2][4][2], const Unit& u, int wr, int wc, int fr, int fq) const {
        const int row0 = u.pm * 256 + wr * 64 + fr, col0 = u.pn * 256 + wc * 32 + 8 * fq;
#pragma unroll
        for (int ai = 0; ai < 2; ++ai)
#pragma unroll
            for (int m = 0; m < 4; ++m) {
                const int row = row0 + ai * 128 + m * 16;
#pragma unroll
                for (int bj = 0; bj < 2; ++bj) {
                    const int col = col0 + bj * 128;
                    const u32x4 gq = *(const u32x4*)(proj + (size_t)row * INC + C_GB + col);
                    const f32x4 m0 = *(const f32x4*)(M1 + (size_t)row * DM + col), m1 = *(const f32x4*)(M1 + (size_t)row * DM + col + 4);
                    const f32x4 a0 = acc[ai][bj][m][0], a1 = acc[ai][bj][m][1];
                    u32x4 o;
                    o[0] = pk_bf16(m0[0] + a0[0] * bflo(gq[0]), m0[1] + a0[1] * bfhi(gq[0]));
                    o[1] = pk_bf16(m0[2] + a0[2] * bflo(gq[1]), m0[3] + a0[3] * bfhi(gq[1]));
                    o[2] = pk_bf16(m1[0] + a1[0] * bflo(gq[2]), m1[1] + a1[1] * bfhi(gq[2]));
                    o[3] = pk_bf16(m1[2] + a1[2] * bflo(gq[3]), m1[3] + a1[3] * bfhi(gq[3]));
                    *(u32x4*)(O + (size_t)row * DM + col) = o;
                }
            }
    }
};
struct EpiRes {
    static constexpr bool PERM = false;
    const float* R; float* H; bf16_t* Hb; float* SS;
    __device__ __forceinline__ void operator()(const f32x4 (&acc)[2][2][4][2], const Unit& u, int wr, int wc, int fr, int fq) const {
        const int row0 = u.pm * 256 + wr * 64 + fr, col0 = u.pn * 256 + wc * 32 + 4 * fq;
#pragma unroll
        for (int ai = 0; ai < 2; ++ai)
#pragma unroll
            for (int m = 0; m < 4; ++m) {
                const int row = row0 + ai * 128 + m * 16;
                float s = 0.f;
#pragma unroll
                for (int bj = 0; bj < 2; ++bj)
#pragma unroll
                    for (int n = 0; n < 2; ++n) {
                        const int col = col0 + bj * 128 + n * 16;
                        const f32x4 h = *(const f32x4*)(R + (size_t)row * DM + col) + acc[ai][bj][m][n];
                        *(f32x4*)(H + (size_t)row * DM + col) = h;
                        if (Hb) { u32x2 o; o[0] = pk_bf16(h[0], h[1]); o[1] = pk_bf16(h[2], h[3]); *(u32x2*)(Hb + (size_t)row * DM + col) = o; }
                        s += (h[0] * h[0] + h[1] * h[1]) + (h[2] * h[2] + h[3] * h[3]);
                    }
                s += __shfl_xor(s, 16); s += __shfl_xor(s, 32);
                if (fq == 0) SS[(size_t)row * 16 + u.pn * 4 + wc] = s;
            }
    }
};
struct EpiSwiGLU {
    static constexpr bool PERM = true;
    bf16_t* O; const float* ss;
    __device__ __forceinline__ void operator()(const f32x4 (&acc)[2][2][4][2], const Unit& u, int wr, int wc, int fr, int fq) const {
        const int row0 = u.pm * 256 + wr * 64 + fr, col0 = u.pn * 128 + wc * 32 + 8 * fq;
#pragma unroll
        for (int ai = 0; ai < 2; ++ai)
#pragma unroll
            for (int m = 0; m < 4; ++m) {
                const int row = row0 + ai * 128 + m * 16;
                const float rs = rstd_of(ss, row);
                float r[8];
#pragma unroll
                for (int n = 0; n < 2; ++n)
#pragma unroll
                    for (int j = 0; j < 4; ++j) { const float gg = acc[ai][0][m][n][j] * rs, uu = acc[ai][1][m][n][j] * rs; r[n * 4 + j] = gg * sigmoidf_(gg) * uu; }
                u32x4 o; o[0] = pk_bf16(r[0], r[1]); o[1] = pk_bf16(r[2], r[3]); o[2] = pk_bf16(r[4], r[5]); o[3] = pk_bf16(r[6], r[7]);
                *(u32x4*)(O + (size_t)row * DFF + col0) = o;
            }
    }
};

struct Ctx { int tid, lane, wave, gw, ngw, gt, ngt; };

__device__ __forceinline__ void p_transpose(const Ctx& c, const float* W, bf16_t* Wt, int K, int N, const float* g, int mode) {
    const size_t total = (size_t)K * N;
    for (size_t i = c.gt; i < total; i += c.ngt) {
        const int k = (int)(i / N), n = (int)(i % N);
        float v = W[i]; if (g) v *= g[k];
        const int row = mode == 0 ? n : (256 * (n >> 7) + (n & 127) + (mode == 2 ? 128 : 0));
        Wt[(size_t)row * K + k] = f2bf(v);
    }
}
__device__ __forceinline__ void p_rmsnorm_rows(const Ctx& c, const float* x, const float* g, bf16_t* out, int rows) {
    for (int r = c.gw; r < rows; r += c.ngw) {
        const f32x4* xr = (const f32x4*)(x + (size_t)r * DM) + c.lane;
        f32x4 v[4]; float s = 0.f;
#pragma unroll
        for (int j = 0; j < 4; ++j) { v[j] = xr[64 * j]; s += (v[j][0] * v[j][0] + v[j][1] * v[j][1]) + (v[j][2] * v[j][2] + v[j][3] * v[j][3]); }
        const float rs = rsqrtf(wave_sum(s) * (1.f / DM) + EPS);
#pragma unroll
        for (int j = 0; j < 4; ++j) {
            const f32x4 gg = ((const f32x4*)g)[c.lane + 64 * j];
            u32x2 o; o[0] = pk_bf16(v[j][0] * rs * gg[0], v[j][1] * rs * gg[1]); o[1] = pk_bf16(v[j][2] * rs * gg[2], v[j][3] * rs * gg[3]);
            ((u32x2*)(out + (size_t)r * DM))[c.lane + 64 * j] = o;
        }
    }
}
__device__ __forceinline__ void p_rope_table(const Ctx& c, const int* pos, float* tab) {
    for (int i = c.gt; i < T * 8; i += c.ngt) {
        const int tok = i >> 3, f = i & 7;
        const double inv = exp2(-(double)f * (18.931568569324174 / 8.0));
        const double ang = (double)pos[tok] * inv;
        const double rev = ang * 0.15915494309189535;
        const float fr = (float)(rev - rint(rev));
        tab[(size_t)tok * 16 + f] = __builtin_amdgcn_cosf(fr);
        tab[(size_t)tok * 16 + 8 + f] = __builtin_amdgcn_sinf(fr);
    }
}
__device__ __forceinline__ void p_rope_apply(const Ctx& c, bf16_t* proj, const float* tab) {
    for (int i = c.gt; i < T * 2 * NHA * 8; i += c.ngt) {
        const int f = i & 7, h = (i >> 3) & 7, which = (i >> 6) & 1, tok = i >> 7;
        bf16_t* p = proj + (size_t)tok * INC + (which ? C_KA : C_QA) + h * HD + f;
        const float x1 = bf2f(p[0]), x2 = bf2f(p[8]), cs = tab[(size_t)tok * 16 + f], sn = tab[(size_t)tok * 16 + 8 + f];
        p[0] = f2bf(x1 * cs - x2 * sn); p[8] = f2bf(x2 * cs + x1 * sn);
    }
}
__device__ __forceinline__ void p_attn_a_naive(const Ctx& c, const bf16_t* proj, bf16_t* OA) {
    for (int it = c.gw; it < T * NHA; it += c.ngw) {
        const int h = it & 7, tok = it >> 3, t = tok & (SEQ - 1), tb = tok - t;
        const float q = bf2f(proj[(size_t)tok * INC + C_QA + h * HD + c.lane]) * 0.125f;
        float og[3], lse[3];
#pragma unroll
        for (int gi = 0; gi < 3; ++gi) {
            const int d = gi == 0 ? 1 : (gi == 1 ? 4 : 16);
            float m = -INFINITY, l = 0.f, o = 0.f;
            for (int j = 0; j <= 128; ++j) {
                const int tk = t - j * d; if (tk < 0) break;
                const bf16_t* kr = proj + (size_t)(tb + tk) * INC + h * HD + c.lane;
                const float s = wave_sum(q * bf2f(kr[C_KA]));
                const float mn = fmaxf(m, s), sc = __expf(m - mn), p = __expf(s - mn);
                l = l * sc + p; o = o * sc + p * bf2f(kr[C_VA]); m = mn;
            }
            og[gi] = o / l; lse[gi] = m + __logf(l);
        }
        const float M = fmaxf(lse[0], fmaxf(lse[1], lse[2]));
        const float w0 = __expf(lse[0] - M), w1 = __expf(lse[1] - M), w2 = __expf(lse[2] - M);
        OA[(size_t)tok * 512 + h * HD + c.lane] = f2bf((w0 * og[0] + w1 * og[1] + w2 * og[2]) / (w0 + w1 + w2));
    }
}
__device__ __forceinline__ void p_attn_b_naive(const Ctx& c, const bf16_t* proj, bf16_t* OB) {
    for (int it = c.gw; it < T * NHB; it += c.ngw) {
        const int h = it & 7, tok = it >> 3, t = tok & (SEQ - 1), tb = tok - t;
        const float q = bf2f(proj[(size_t)tok * INC + C_QB + h * HD + c.lane]) * 0.125f;
        float run = 0.f, o = 0.f;
        for (int tk = t - 1; tk >= 0; --tk) {
            const bf16_t* kr = proj + (size_t)(tb + tk) * INC + h * HD + c.lane;
            const float z = wave_sum(q * bf2f(kr[C_KB]));
            const float sp = fmaxf(z, 0.f) + log1pf(__expf(-fabsf(z)));
            const float a = __expf(z - sp + run);
            o += a * bf2f(kr[C_VB]);
            run -= sp;
        }
        OB[(size_t)tok * 512 + h * HD + c.lane] = f2bf(o);
    }
}
__device__ __forceinline__ void p_attn_mem_naive(const Ctx& c, const bf16_t* qm, const bf16_t* kvm, bf16_t* om) {
    const float sc = 0.08838834764831845f;
    for (int it = c.gw; it < T * 4; it += c.ngw) {
        const int h = it & 3, tok = it >> 2, b = tok >> 11;
        const float q0 = bf2f(qm[(size_t)tok * MEMW + h * 128 + c.lane]) * sc, q1 = bf2f(qm[(size_t)tok * MEMW + h * 128 + 64 + c.lane]) * sc;
        float m = -INFINITY, l = 0.f, o0 = 0.f, o1 = 0.f;
        for (int j = 0; j < NMEM; ++j) {
            const bf16_t* kr = kvm + (size_t)(b * NMEM + j) * 1024 + h * 128 + c.lane;
            const float s = wave_sum(q0 * bf2f(kr[0]) + q1 * bf2f(kr[64]));
            const float mn = fmaxf(m, s), scl = __expf(m - mn), p = __expf(s - mn);
            l = l * scl + p; o0 = o0 * scl + p * bf2f(kr[512]); o1 = o1 * scl + p * bf2f(kr[512 + 64]); m = mn;
        }
        om[(size_t)tok * MEMW + h * 128 + c.lane] = f2bf(o0 / l); om[(size_t)tok * MEMW + h * 128 + 64 + c.lane] = f2bf(o1 / l);
    }
}
__device__ __forceinline__ void p_final(const Ctx& c, float* out, const float* ss, const float* g) {
    for (int r = c.gw; r < T; r += c.ngw) {
        const float rs = rstd_of(ss, r);
        f32x4* xr = (f32x4*)(out + (size_t)r * DM) + c.lane;
#pragma unroll
        for (int j = 0; j < 4; ++j) { const f32x4 gg = ((const f32x4*)g)[c.lane + 64 * j]; f32x4 v = xr[64 * j]; v = v * rs * gg; xr[64 * j] = v; }
    }
}


typedef float f32x16 __attribute__((ext_vector_type(16)));
typedef short s16x4 __attribute__((ext_vector_type(4)));
#define MFMA32(a, b, c) __builtin_amdgcn_mfma_f32_32x32x16_bf16((a), (b), (c), 0, 0, 0)
constexpr int ATT_FLAG_OFF = 40960;
template <int MODE, int HDIM>
__device__ __forceinline__ void attn_item(LAS unsigned char* lds, const bf16_t* Qp, int ldq, const bf16_t* Kp, const bf16_t* Vp, int ldkv, bf16_t* Op, int ldo, int q0, int nkeys) {
    constexpr int KS = HDIM / 16, DD = HDIM / 32, KROW = HDIM * 2 + 16, VROW = 64 * 2 + 8, NCH = HDIM / 8, PER = 64 * NCH / 512;
    int tid = threadIdx.x; asm volatile("" : "+v"(tid));
    const int lane = tid & 63, w = __builtin_amdgcn_readfirstlane(tid >> 6), r = lane & 31, hh = lane >> 5;
    const int tq0 = q0 + 32 * w, tq = tq0 + r;
    LAS unsigned char* Ks = lds; LAS unsigned char* Vt = lds + 64 * KROW;
    LAS unsigned* flags = (LAS unsigned*)(lds + ATT_FLAG_OFF);
    bf16x8 Qf[KS];
#pragma unroll
    for (int ks = 0; ks < KS; ++ks) Qf[ks] = *(const bf16x8*)(Qp + (size_t)tq * ldq + 16 * ks + 8 * hh);
    f32x16 Oacc[DD];
#pragma unroll
    for (int dd = 0; dd < DD; ++dd)
#pragma unroll
        for (int i = 0; i < 16; ++i) Oacc[dd][i] = 0.f;
    float m = -INFINITY, l = 0.f, run = 0.f; unsigned done_w = 0u;
    const int kt_hi = (MODE == 2) ? (nkeys / 64 - 1) : ((q0 + 255) >> 6);
    u32x4 kreg[PER], vreg[PER];
#define ATT_GLOAD(kt) do { _Pragma("unroll") for (int p_ = 0; p_ < PER; ++p_) { const int idx_ = tid + 512 * p_, key_ = idx_ / NCH, ch_ = idx_ % NCH; \
        kreg[p_] = *(const u32x4*)(Kp + (size_t)(64 * (kt) + key_) * ldkv + ch_ * 8); vreg[p_] = *(const u32x4*)(Vp + (size_t)(64 * (kt) + key_) * ldkv + ch_ * 8); } } while (0)
    ATT_GLOAD(kt_hi);
    for (int kt = kt_hi; kt >= 0; --kt) {
        if (MODE == 1 && lane == 0) flags[w] = done_w;
        __syncthreads();
#pragma unroll
        for (int p_ = 0; p_ < PER; ++p_) { const int idx_ = tid + 512 * p_, key_ = idx_ / NCH, ch_ = idx_ % NCH;
            *(LAS u32x4*)(Ks + key_ * KROW + ch_ * 16) = kreg[p_];
#pragma unroll
            for (int j = 0; j < 8; ++j) *(LAS bf16_t*)(Vt + (ch_ * 8 + j) * VROW + key_ * 2) = (bf16_t)((vreg[p_][j >> 1] >> (16 * (j & 1))) & 0xffffu);
        }
        bool alldone = false;
        if (MODE == 1) { unsigned a = 1u;
#pragma unroll
            for (int i = 0; i < 8; ++i) a &= flags[i];
            alldone = a != 0u; }
        __syncthreads();
        if (MODE == 1 && alldone) break;
        if (kt > 0) ATT_GLOAD(kt - 1);
#pragma unroll
        for (int sub = 1; sub >= 0; --sub) {
            const int tk0 = 64 * kt + 32 * sub;
            if (MODE != 2 && tk0 > tq0 + 31) continue;
            if (MODE == 1 && done_w) continue;
            f32x16 S;
#pragma unroll
            for (int i = 0; i < 16; ++i) S[i] = 0.f;
#pragma unroll
            for (int ks = 0; ks < KS; ++ks) { const bf16x8 kf = *(const LAS bf16x8*)(Ks + (32 * sub + r) * KROW + (16 * ks + 8 * hh) * 2); S = MFMA32(kf, Qf[ks], S); }
            const int dbase = tq - tk0 - 4 * hh;
            if (MODE == 0 || MODE == 2) {
                const float C = (MODE == 0 ? 0.125f : 0.08838834764831845f) * 1.4426950408889634f;
                float fm[16]; float mx = -INFINITY;
#pragma unroll
                for (int i = 0; i < 16; ++i) {
                    float v = S[i] * C;
                    if (MODE == 0) { const int d = dbase - ((i & 3) + 8 * (i >> 2));
                        int mult = (d <= 128 ? 1 : 0) + ((((d & 3) == 0) && d <= 512) ? 1 : 0) + (((d & 15) == 0) ? 1 : 0);
                        mult = d >= 0 ? mult : 0; fm[i] = (float)mult; v = mult > 0 ? v : -INFINITY; }
                    else fm[i] = 1.f;
                    S[i] = v; mx = fmaxf(mx, v);
                }
                mx = fmaxf(mx, __shfl_xor(mx, 32));
                const float mn = fmaxf(m, mx), ms = (mn == -INFINITY) ? 0.f : mn;
                const float alpha = __builtin_amdgcn_exp2f(m - ms);
                float ls = 0.f;
#pragma unroll
                for (int i = 0; i < 16; ++i) { const float p = fm[i] * __builtin_amdgcn_exp2f(S[i] - ms); S[i] = p; ls += p; }
                l = l * alpha + ls; m = mn;
#pragma unroll
                for (int dd = 0; dd < DD; ++dd) Oacc[dd] = Oacc[dd] * alpha;
            } else {
                float sp[16], ex[16], G[4], PG[4];
#pragma unroll
                for (int i = 0; i < 16; ++i) { const int d = dbase - ((i & 3) + 8 * (i >> 2)); const bool valid = d > 0;
                    const float z = S[i] * 0.125f; const float e = __expf(-fabsf(z)); const float spv = fmaxf(z, 0.f) + __logf(1.f + e);
                    sp[i] = valid ? spv : 0.f; S[i] = valid ? (z - spv) : -INFINITY; }
#pragma unroll
                for (int g = 0; g < 4; ++g) { ex[4 * g + 3] = 0.f; ex[4 * g + 2] = sp[4 * g + 3]; ex[4 * g + 1] = ex[4 * g + 2] + sp[4 * g + 2]; ex[4 * g] = ex[4 * g + 1] + sp[4 * g + 1]; G[g] = ex[4 * g] + sp[4 * g]; }
#pragma unroll
                for (int g = 0; g < 4; ++g) PG[g] = __shfl_xor(G[g], 32);
                float later[4]; float suf = 0.f;
#pragma unroll
                for (int g = 3; g >= 0; --g) { later[g] = suf + (hh == 0 ? PG[g] : 0.f); suf += G[g] + PG[g]; }
#pragma unroll
                for (int i = 0; i < 16; ++i) S[i] = __expf(S[i] - (run + later[i >> 2] + ex[i]));
                run += suf;
                done_w = __all(run > 104.f) ? 1u : 0u;
            }
            u32x4 pp0, pp1;
#pragma unroll
            for (int j = 0; j < 4; ++j) { pp0[j] = pk_bf16(S[2 * j], S[2 * j + 1]); pp1[j] = pk_bf16(S[8 + 2 * j], S[8 + 2 * j + 1]); }
            const bf16x8 P0 = __builtin_bit_cast(bf16x8, pp0), P1 = __builtin_bit_cast(bf16x8, pp1);
#pragma unroll
            for (int dd = 0; dd < DD; ++dd)
#pragma unroll
                for (int s2 = 0; s2 < 2; ++s2) {
                    const LAS unsigned char* vp = Vt + (32 * dd + r) * VROW + (32 * sub + 16 * s2 + 4 * hh) * 2;
                    const s16x4 lo = *(const LAS s16x4*)vp, hi = *(const LAS s16x4*)(vp + 16);
                    const bf16x8 vf = __builtin_shufflevector(lo, hi, 0, 1, 2, 3, 4, 5, 6, 7);
                    Oacc[dd] = MFMA32(vf, s2 ? P1 : P0, Oacc[dd]);
                }
        }
    }
#undef ATT_GLOAD
    float inv = 1.f;
    if (MODE != 1) { const float lt = l + __shfl_xor(l, 32); inv = 1.f / lt; }
#pragma unroll
    for (int dd = 0; dd < DD; ++dd)
#pragma unroll
        for (int g = 0; g < 4; ++g) {
            u32x2 o; o[0] = pk_bf16(Oacc[dd][4 * g] * inv, Oacc[dd][4 * g + 1] * inv); o[1] = pk_bf16(Oacc[dd][4 * g + 2] * inv, Oacc[dd][4 * g + 3] * inv);
            *(u32x2*)(Op + (size_t)tq * ldo + 32 * dd + 8 * g + 4 * hh) = o;
        }
}
__device__ __forceinline__ void p_attn_ab(LAS unsigned char* lds, const bf16_t* proj, bf16_t* OA, bf16_t* OB) {
    for (int v = blockIdx.x; v < 256; v += gridDim.x) {
        const int bh = v >> 1, b = bh >> 3, h = bh & 7, par = v & 1;
        const bf16_t* base = proj + (size_t)b * SEQ * INC + h * HD;
        for (int k = 0; k < 4; ++k) { const int qb = (k == 0) ? 7 - par : (k == 1) ? par : (k == 2) ? 5 - par : 2 + par;
            attn_item<0, 64>(lds, base + C_QA, INC, base + C_KA, base + C_VA, INC, OA + (size_t)b * SEQ * 512 + h * HD, 512, qb * 256, SEQ); }
        for (int k = 0; k < 4; ++k) { const int qb = (k == 0) ? 7 - par : (k == 1) ? par : (k == 2) ? 5 - par : 2 + par;
            attn_item<1, 64>(lds, base + C_QB, INC, base + C_KB, base + C_VB, INC, OB + (size_t)b * SEQ * 512 + h * HD, 512, qb * 256, SEQ); }
    }
}
__device__ __forceinline__ void p_attn_mem(LAS unsigned char* lds, const bf16_t* qm, const bf16_t* kvm, bf16_t* om) {
    for (int it = blockIdx.x; it < BATCH * 4 * 8; it += gridDim.x) {
        const int qb = it & 7, h = (it >> 3) & 3, b = it >> 5;
        attn_item<2, 128>(lds, qm + (size_t)b * SEQ * MEMW + h * 128, MEMW, kvm + (size_t)b * NMEM * 1024 + h * 128, kvm + (size_t)b * NMEM * 1024 + 512 + h * 128, 1024,
                          om + (size_t)b * SEQ * MEMW + h * 128, MEMW, qb * 256, NMEM);
    }
}

__device__ __forceinline__ bool sync_if(bool doit, cg::grid_group& grid) { if (doit) grid.sync(); asm volatile("" ::: "memory"); return true; }
constexpr int NPHASE = 13;
#ifndef NAIVE_AB
#define NAIVE_AB 0
#endif
#ifndef NAIVE_MEM
#define NAIVE_MEM 0
#endif
#ifndef ONLY
#define ONLY -1
#endif
#define PHASE(k) if ((ONLY < 0 || ONLY == (k)) && ph_lo <= (k) && (k) < ph_hi) if (sync_if((k) > ph_lo, grid))
__global__ __launch_bounds__(512, 2) void mega(Params p, int ph_lo, int ph_hi) {
    extern __shared__ __attribute__((aligned(16))) unsigned char shm[];
    LAS unsigned char* lds = (LAS unsigned char*)shm;
    cg::grid_group grid = cg::this_grid();
    Ctx c; c.tid = threadIdx.x; c.lane = c.tid & 63; c.wave = c.tid >> 6; c.gw = blockIdx.x * 8 + c.wave; c.ngw = gridDim.x * 8; c.gt = blockIdx.x * 512 + c.tid; c.ngt = gridDim.x * 512;
    unsigned char* ws = p.ws;
    bf16_t* Wt_in = (bf16_t*)(ws + WS_WIN); bf16_t* Wt_upa = (bf16_t*)(ws + WS_WUPA); bf16_t* Wt_upb = (bf16_t*)(ws + WS_WUPB); bf16_t* Wt_out = (bf16_t*)(ws + WS_WOUT);
    bf16_t* Wt_qm = (bf16_t*)(ws + WS_WQM); bf16_t* Wt_kvm = (bf16_t*)(ws + WS_WKVM); bf16_t* Wt_om = (bf16_t*)(ws + WS_WOM); bf16_t* Wt_gu = (bf16_t*)(ws + WS_WGU); bf16_t* Wt_dn = (bf16_t*)(ws + WS_WDN);
    bf16_t* memn = (bf16_t*)(ws + WS_MEMN); bf16_t* kvm = (bf16_t*)(ws + WS_KVM);
    float* ss1 = (float*)(ws + WS_SS1); float* ss2 = (float*)(ws + WS_SS2); float* ss3 = (float*)(ws + WS_SS3); float* rope = (float*)(ws + WS_ROPE);
    bf16_t* n1 = (bf16_t*)(ws + WS_R1); bf16_t* mixed = (bf16_t*)(ws + WS_R1); bf16_t* h2b = (bf16_t*)(ws + WS_R1);
    bf16_t* proj = (bf16_t*)(ws + WS_PROJ);
    float* h1 = (float*)(ws + WS_H1); bf16_t* h1b = (bf16_t*)(ws + WS_H1B); bf16_t* qm = (bf16_t*)(ws + WS_QM); bf16_t* om = (bf16_t*)(ws + WS_OM);
    float* h2 = (float*)(ws + WS_H2); bf16_t* act = (bf16_t*)(ws + WS_ACT); bf16_t* OA = (bf16_t*)(ws + WS_OA); bf16_t* OB = (bf16_t*)(ws + WS_OB);
    float* m1 = p.out;
    pg8::StaticOrder S;
    {
        PHASE(0) {
            p_transpose(c, p.w_in, Wt_in, DM, INC, nullptr, 0);
            p_transpose(c, p.w_up_a, Wt_upa, 512, DM, nullptr, 0);
            p_transpose(c, p.w_up_b, Wt_upb, 512, DM, nullptr, 0);
            p_transpose(c, p.w_out, Wt_out, DM, DM, nullptr, 0);
            p_transpose(c, p.w_q_mem, Wt_qm, DM, MEMW, p.g_mem_q, 0);
            p_transpose(c, p.w_kv_mem, Wt_kvm, DM, 2 * MEMW, nullptr, 0);
            p_transpose(c, p.w_o_mem, Wt_om, MEMW, DM, nullptr, 0);
            p_transpose(c, p.w_ffn_gate, Wt_gu, DM, DFF, p.g_ffn, 1);
            p_transpose(c, p.w_ffn_up, Wt_gu, DM, DFF, p.g_ffn, 2);
            p_transpose(c, p.w_ffn_down, Wt_dn, DFF, DM, nullptr, 0);
            p_rmsnorm_rows(c, p.x, p.g_mix, n1, T);
            p_rmsnorm_rows(c, p.mem, p.g_mem_kv, memn, BATCH * NMEM);
            p_rope_table(c, p.pos, rope);
        }
        PHASE(1) {
            { Gemm g{n1, Wt_in, T, INC, DM}; EpiBf16 E{proj, INC, nullptr, 12}; S.init(g.M, g.N, gridDim.x, blockIdx.x); pg8::gemm_phase(lds, g, S, E); }
            { Gemm g{memn, Wt_kvm, BATCH * NMEM, 1024, DM}; EpiBf16 E{kvm, 1024, nullptr, 1 << 30}; S.init(g.M, g.N, gridDim.x, blockIdx.x); pg8::gemm_phase(lds, g, S, E); }
        }
        PHASE(2) p_rope_apply(c, proj, rope);
        PHASE(3) {
#if NAIVE_AB
            p_attn_a_naive(c, proj, OA); p_attn_b_naive(c, proj, OB);
#else
            p_attn_ab(lds, proj, OA, OB);
#endif
        }
        PHASE(4) { Gemm g{OA, Wt_upa, T, DM, 512}; EpiGateA E{m1, proj}; S.init(g.M, g.N, gridDim.x, blockIdx.x); pg8::gemm_phase(lds, g, S, E); }
        PHASE(5) { Gemm g{OB, Wt_upb, T, DM, 512}; EpiGateB E{m1, proj, mixed}; S.init(g.M, g.N, gridDim.x, blockIdx.x); pg8::gemm_phase(lds, g, S, E); }
        PHASE(6) { Gemm g{mixed, Wt_out, T, DM, DM}; EpiRes E{p.x, h1, h1b, ss1}; S.init(g.M, g.N, gridDim.x, blockIdx.x); pg8::gemm_phase(lds, g, S, E); }
        PHASE(7) { Gemm g{h1b, Wt_qm, T, MEMW, DM}; EpiBf16 E{qm, MEMW, ss1, 1 << 30}; S.init(g.M, g.N, gridDim.x, blockIdx.x); pg8::gemm_phase(lds, g, S, E); }
        PHASE(8) {
#if NAIVE_MEM
            p_attn_mem_naive(c, qm, kvm, om);
#else
            p_attn_mem(lds, qm, kvm, om);
#endif
        }
        PHASE(9) { Gemm g{om, Wt_om, T, DM, MEMW}; EpiRes E{h1, h2, h2b, ss2}; S.init(g.M, g.N, gridDim.x, blockIdx.x); pg8::gemm_phase(lds, g, S, E); }
        PHASE(10) { Gemm g{h2b, Wt_gu, T, 2 * DFF, DM}; EpiSwiGLU E{act, ss2}; S.init(g.M, g.N, gridDim.x, blockIdx.x); pg8::gemm_phase(lds, g, S, E); }
        PHASE(11) { Gemm g{act, Wt_dn, T, DM, DFF}; EpiRes E{h2, p.out, nullptr, ss3}; S.init(g.M, g.N, gridDim.x, blockIdx.x); pg8::gemm_phase(lds, g, S, E); }
        PHASE(12) p_final(c, p.out, ss3, p.g_final);
    }
}

constexpr int LDS_BYTES = pg8::STAGE_BYTES;
#ifndef ONE_LAUNCH
#define ONE_LAUNCH 1
#endif
extern "C" void kernel_launch(void* const* d_in, const int* in_sizes, int n_in, void* d_out, int out_size, void* d_ws, size_t ws_size, hipStream_t stream) {
    static int grid = 0;
    if (grid == 0) {
        if (n_in != 18 || out_size != T * DM || ws_size < WS_END) { fprintf(stderr, "kernel_launch: unexpected shapes (n_in %d out %d ws %zu)\n", n_in, out_size, ws_size); grid = -1; return; }
        int dev = 0, cus = 0, per_cu = 0;
        (void)hipGetDevice(&dev); (void)hipDeviceGetAttribute(&cus, hipDeviceAttributeMultiprocessorCount, dev);
        if (hipFuncSetAttribute((const void*)mega, hipFuncAttributeMaxDynamicSharedMemorySize, LDS_BYTES) != hipSuccess) { fprintf(stderr, "hipFuncSetAttribute failed\n"); grid = -1; return; }
        if (hipOccupancyMaxActiveBlocksPerMultiprocessor(&per_cu, (const void*)mega, 512, LDS_BYTES) != hipSuccess || per_cu < 1) { fprintf(stderr, "occupancy query: %d\n", per_cu); per_cu = 1; }
        (void)hipGetLastError();
        grid = cus * 1;
    }
    if (grid < 0) return;
    Params p{};
    p.x = (const float*)d_in[0]; p.mem = (const float*)d_in[1]; p.pos = (const int*)d_in[2]; p.g_mix = (const float*)d_in[3]; p.w_in = (const float*)d_in[4];
    p.w_up_a = (const float*)d_in[5]; p.w_up_b = (const float*)d_in[6]; p.w_out = (const float*)d_in[7]; p.g_mem_q = (const float*)d_in[8]; p.g_mem_kv = (const float*)d_in[9];
    p.w_q_mem = (const float*)d_in[10]; p.w_kv_mem = (const float*)d_in[11]; p.w_o_mem = (const float*)d_in[12]; p.g_ffn = (const float*)d_in[13];
    p.w_ffn_gate = (const float*)d_in[14]; p.w_ffn_up = (const float*)d_in[15]; p.w_ffn_down = (const float*)d_in[16]; p.g_final = (const float*)d_in[17];
    p.out = (float*)d_out; p.ws = (unsigned char*)d_ws;
#if ONE_LAUNCH
    int lo = 0, hi = NPHASE;
    void* args[] = {&p, &lo, &hi};
    hipError_t e = hipLaunchCooperativeKernel((const void*)mega, dim3(grid), dim3(512), args, LDS_BYTES, stream);
    if (e != hipSuccess) fprintf(stderr, "cooperative launch failed: %s\n", hipGetErrorString(e));
#else
    for (int ph = 0; ph < NPHASE; ++ph) hipLaunchKernelGGL(mega, dim3(grid), dim3(512), LDS_BYTES, stream, p, ph, ph + 1);
#endif
}
```

```cpp
#include <hip/hip_runtime.h>
#include <hip/hip_cooperative_groups.h>
#include <cstdio>
namespace cg = cooperative_groups;

#define LAS __attribute__((address_space(3)))
typedef unsigned short bf16_t;
typedef short bf16x8 __attribute__((ext_vector_type(8)));
typedef float f32x4 __attribute__((ext_vector_type(4)));
typedef unsigned u32x4 __attribute__((ext_vector_type(4)));
typedef unsigned u32x2 __attribute__((ext_vector_type(2)));

constexpr int BATCH = 16, SEQ = 2048, DM = 1024, T = BATCH * SEQ;
constexpr int HD = 64, NHA = 8, NHB = 8;
constexpr int INC = 5120;
constexpr int C_QA = 0, C_KA = 512, C_VA = 1024, C_QB = 1536, C_KB = 2048, C_VB = 2560, C_GA = 3072, C_GB = 4096;
constexpr int NMEM = 256, MEMW = 512, DFF = 2816;
constexpr float EPS = 1e-6f;

constexpr size_t MiB = 1ull << 20;
constexpr size_t WS_WIN = 0, WS_WUPA = 10 * MiB, WS_WUPB = 11 * MiB, WS_WOUT = 12 * MiB, WS_WQM = 14 * MiB, WS_WKVM = 15 * MiB,
                 WS_WOM = 17 * MiB, WS_WGU = 18 * MiB, WS_WDN = 29 * MiB, WS_MEMN = 36 * MiB, WS_KVM = 44 * MiB,
                 WS_SS1 = 52 * MiB, WS_SS2 = 54 * MiB, WS_SS3 = 56 * MiB, WS_ROPE = 58 * MiB, WS_BAR = 60 * MiB;
constexpr size_t WS_R1 = 64 * MiB;
constexpr size_t WS_PROJ = 128 * MiB;
constexpr size_t WS_H1 = 128 * MiB, WS_H1B = 256 * MiB, WS_QM = 320 * MiB, WS_OM = 352 * MiB, WS_H2 = 384 * MiB, WS_ACT = 128 * MiB;
constexpr size_t WS_OA = 448 * MiB, WS_OB = 480 * MiB;
constexpr size_t WS_END = 512 * MiB;

struct Params {
    const float* x; const float* mem; const int* pos; const float* g_mix; const float* w_in; const float* w_up_a; const float* w_up_b; const float* w_out;
    const float* g_mem_q; const float* g_mem_kv; const float* w_q_mem; const float* w_kv_mem; const float* w_o_mem; const float* g_ffn;
    const float* w_ffn_gate; const float* w_ffn_up; const float* w_ffn_down; const float* g_final;
    float* out; unsigned char* ws;
};

typedef float f32x2 __attribute__((ext_vector_type(2)));
typedef __bf16 bf16v2 __attribute__((ext_vector_type(2)));
__device__ __forceinline__ unsigned pk_bf16(float lo, float hi) { f32x2 v = {lo, hi}; bf16v2 r = __builtin_convertvector(v, bf16v2); return __builtin_bit_cast(unsigned, r); }
__device__ __forceinline__ bf16_t f2bf(float f) { return (bf16_t)(pk_bf16(f, 0.f) & 0xffffu); }
__device__ __forceinline__ float bf2f(bf16_t b) { return __uint_as_float(((unsigned)b) << 16); }
__device__ __forceinline__ float bflo(unsigned u) { return __uint_as_float(u << 16); }
__device__ __forceinline__ float bfhi(unsigned u) { return __uint_as_float(u & 0xffff0000u); }
__device__ __forceinline__ float wave_sum(float v) {
#pragma unroll
    for (int o = 1; o < 64; o <<= 1) v += __shfl_xor(v, o);
    return v;
}
__device__ __forceinline__ float sigmoidf_(float x) { return 1.f / (1.f + __expf(-x)); }
__device__ __forceinline__ float rstd_of(const float* ss, int row) {
    const f32x4* p = (const f32x4*)(ss + (size_t)row * 16);
    f32x4 a = p[0], b = p[1], c = p[2], d = p[3];
    float s = ((a[0] + a[1]) + (a[2] + a[3])) + ((b[0] + b[1]) + (b[2] + b[3])) + ((c[0] + c[1]) + (c[2] + c[3])) + ((d[0] + d[1]) + (d[2] + d[3]));
    return rsqrtf(s * (1.f / DM) + EPS);
}


#define XB_TMO      128
#define XB_XCNT(j)  (256  + 64 * (j))
#define XB_XSUB(j)  (1280 + 64 * (j))
#define XB_XGEN(j)  (2304 + 64 * (j))
#define XB_TOP      3328
#define XB_TOPGEN   3392
#define XCD_BAR_WORDS 3456
#define XB_SPIN_CAP (1u << 18)
__device__ __forceinline__ unsigned xb_ld(unsigned* p)              { return __hip_atomic_load(p, __ATOMIC_RELAXED, __HIP_MEMORY_SCOPE_AGENT); }
__device__ __forceinline__ unsigned xb_add(unsigned* p, unsigned v) { return __hip_atomic_fetch_add(p, v, __ATOMIC_RELAXED, __HIP_MEMORY_SCOPE_AGENT); }
__device__ __forceinline__ unsigned xb_xcc_id() { return (unsigned)__builtin_amdgcn_s_getreg((3 << 11) | 20) & 0xFu; }
#define XB_SPIN(cond, bar) do { unsigned _sp = 0; while (cond) { __builtin_amdgcn_s_sleep(1); \
    if ((++_sp & 255u) == 0u) { if (xb_ld(&(bar)[XB_TMO])) break; if (_sp > XB_SPIN_CAP) { atomicAdd(&(bar)[XB_TMO], 1u); break; } } } } while (0)
struct XcdBarrier { unsigned* bar; unsigned x; volatile LAS unsigned* st; };
__device__ __forceinline__ XcdBarrier xcd_barrier_post(unsigned* bar, volatile LAS unsigned* st) {
    XcdBarrier b; b.bar = bar; b.x = xb_xcc_id(); b.st = st;
    if (threadIdx.x == 0) (void)xb_add(&bar[XB_XCNT(b.x)], 1u);
    return b;
}
__device__ __forceinline__ void xcd_barrier_complete(unsigned* bar, unsigned x, unsigned& nloc, unsigned& nx) {
    const unsigned G = gridDim.x * gridDim.y * gridDim.z;
    unsigned sum, cnt, mine, sp = 0u;
    for (;;) {
        sum = 0u; cnt = 0u; mine = 0u;
#pragma unroll
        for (unsigned j = 0; j < 16; ++j) { const unsigned c = xb_ld(&bar[XB_XCNT(j)]); sum += c; cnt += (c > 0u) ? 1u : 0u; mine = (j == x) ? c : mine; }
        if (sum == G) break;
        __builtin_amdgcn_s_sleep(1);
        if ((++sp & 255u) == 0u) { if (xb_ld(&bar[XB_TMO])) break; if (sp > XB_SPIN_CAP) { atomicAdd(&bar[XB_TMO], 1u); break; } }
    }
    nloc = mine > 0u ? mine : 1u; nx = cnt > 0u ? cnt : 1u;
}
__device__ __forceinline__ void xcd_barrier(const XcdBarrier& b) {
    asm volatile("s_waitcnt vmcnt(0)" ::: "memory");
    __syncthreads();
    if (threadIdx.x == 0) {
        unsigned* bar = b.bar;
        __builtin_amdgcn_s_waitcnt(0);
        unsigned nloc = b.st[0], nx = b.st[1];
        if (nloc == 0u) { xcd_barrier_complete(bar, b.x, nloc, nx); b.st[0] = nloc; b.st[1] = nx; }
        const unsigned old = xb_add(&bar[XB_XSUB(b.x)], 1u);
        const unsigned gen = old / nloc;
        if (old + 1u == (gen + 1u) * nloc) {
            __builtin_amdgcn_fence(__ATOMIC_RELEASE, "agent");
            asm volatile("s_waitcnt vmcnt(0)" ::: "memory");
            const unsigned og = xb_add(&bar[XB_TOP], 1u);
            const unsigned tg = og / nx;
            if (og + 1u == (tg + 1u) * nx) xb_add(&bar[XB_TOPGEN], 1u);
            else XB_SPIN(xb_ld(&bar[XB_TOPGEN]) == tg, bar);
            __builtin_amdgcn_fence(__ATOMIC_ACQUIRE, "agent");
            xb_add(&bar[XB_XGEN(b.x)], 1u);
            asm volatile("s_waitcnt vmcnt(0)" ::: "memory");
        } else {
            XB_SPIN(xb_ld(&bar[XB_XGEN(b.x)]) == gen, bar);
            __builtin_amdgcn_fence(__ATOMIC_ACQUIRE, "agent");
            asm volatile("s_waitcnt vmcnt(0)" ::: "memory");
        }
    }
    __syncthreads();
}

namespace pg8 {
constexpr int BM = 256, BK = 64, HALF = 128, HTB = HALF * BK * 2, STAGE_BYTES = 8 * HTB, NXCD = 8, WGM = 8;
__host__ __device__ __forceinline__ int lds_byte(int r, int c) { const int st = (r >> 4) * 2 + (c >> 5), rr = r & 15, cc = c & 31, ob = rr * 64 + cc * 2; return st * 1024 + (ob ^ (((ob >> 9) & 1) << 5)); }
__host__ __device__ __forceinline__ void stage_rc(int b, int& R, int& C) { const int st = b / 1024, sb = b % 1024, swz = sb ^ (((sb >> 9) & 1) << 5); R = (st >> 1) * 16 + swz / 64; C = (st & 1) * 32 + (swz % 64) / 2; }
__host__ __device__ __forceinline__ int perm32(int rho) { const int n = rho >> 4, i = rho & 15; return 8 * (i >> 2) + 4 * n + (i & 3); }
struct Unit { int pm, pn; };
struct Gemm { const bf16_t* A; const bf16_t* Bt; int M, N, K; };
struct StaticOrder {
    int nM, nN, nwg, G, c;
    __host__ __device__ void init(int M, int N, int G_, int c_) { nM = M / BM; nN = N / BM; nwg = nM * nN; G = G_; c = c_; }
    __host__ __device__ bool next(int i, Unit& u) const {
        const long L = (long)i * G + c; if (L >= nwg) return false;
        int wgid = (int)L; { const int q = nwg / NXCD, r = nwg % NXCD, xcd = wgid % NXCD, off = wgid / NXCD; wgid = (xcd < r ? xcd * (q + 1) : r * (q + 1) + (xcd - r) * q) + off; }
        const int nig = WGM * nN, gid = wgid / nig, fm = gid * WGM, gsz = (nM - fm) < WGM ? (nM - fm) : WGM;
        u.pm = fm + ((wgid % nig) % gsz); u.pn = (wgid % nig) / gsz; return true;
    }
};

template <class Epi>
__device__ __forceinline__ void gemm_phase(LAS unsigned char* lds, const Gemm g, const StaticOrder& S, const Epi& E) {
    int tid = threadIdx.x; asm volatile("" : "+v"(tid));
    const int wid = __builtin_amdgcn_readfirstlane(tid >> 6), lane = tid & 63, wr = wid >> 2, wc = wid & 3, fr = lane & 15, fq = lane >> 4;
    const int K = g.K, nt = K / BK;
    unsigned voffA[2], voffB[2];
#pragma unroll
    for (int i = 0; i < 2; ++i) { int R, C; stage_rc(tid * 16 + i * 8192, R, C); const int Rb = Epi::PERM ? ((R & ~31) + perm32(R & 31)) : R;
        voffA[i] = (unsigned)(R * K + C) * 2u; voffB[i] = (unsigned)(Rb * K + C) * 2u; }
    const size_t kstep = (size_t)(BK * 2);
    const size_t hstep = (size_t)HALF * K * 2;
    const size_t tstep = 2 * hstep;
    const unsigned ldsw = (unsigned)wid * 1024u;
    const int aoff = lds_byte(wr * 64 + fr, fq * 8), boff = lds_byte(wc * 32 + fr, fq * 8);
#define PG8_SA(b, h) (((b) * 2 + (h)) * HTB)
#define PG8_SB(b, h) ((4 + (b) * 2 + (h)) * HTB)
#define PG8_STAGE(bufoff, gbase, voff) do { _Pragma("unroll") for (int _i = 0; _i < 2; ++_i) \
        __builtin_amdgcn_global_load_lds((const unsigned*)((const char*)(gbase) + (voff)[_i]), (LAS unsigned*)(lds + (bufoff) + ldsw + _i * 8192), 16, 0, 0); } while (0)
#define PG8_LDA(dst, b, h) do { _Pragma("unroll") for (int m = 0; m < 4; ++m) _Pragma("unroll") for (int k = 0; k < 2; ++k) dst[m][k] = *(const LAS bf16x8*)(lds + PG8_SA(b, h) + aoff + m * 2048 + k * 1024); } while (0)
#define PG8_LDB(dst, b, h) do { _Pragma("unroll") for (int n = 0; n < 2; ++n) _Pragma("unroll") for (int k = 0; k < 2; ++k) dst[n][k] = *(const LAS bf16x8*)(lds + PG8_SB(b, h) + boff + n * 2048 + k * 1024); } while (0)
#define PG8_MMA(ai, bj, At, Bt) do { __builtin_amdgcn_s_setprio(1); _Pragma("unroll") for (int m = 0; m < 4; ++m) _Pragma("unroll") for (int n = 0; n < 2; ++n) _Pragma("unroll") for (int k = 0; k < 2; ++k) \
        acc[ai][bj][m][n] = __builtin_amdgcn_mfma_f32_16x16x32_bf16(Bt[n][k], At[m][k], acc[ai][bj][m][n], 0, 0, 0); __builtin_amdgcn_s_setprio(0); } while (0)
#define PG8_WAIT_V(n) asm volatile("s_waitcnt vmcnt(" #n ")" ::: "memory")
#define PG8_WAIT_L(n) asm volatile("s_waitcnt lgkmcnt(" #n ")" ::: "memory")
#define PG8_BAR __builtin_amdgcn_s_barrier()
#define PG8_SCHED __builtin_amdgcn_sched_barrier(0)
    Unit cur, nxt; int ui = 0;
    if (!S.next(0, cur)) return;
    f32x4 acc[2][2][4][2];
#pragma unroll
    for (int a = 0; a < 2; ++a)
#pragma unroll
        for (int b = 0; b < 2; ++b)
#pragma unroll
            for (int m = 0; m < 4; ++m)
#pragma unroll
                for (int n = 0; n < 2; ++n) acc[a][b][m][n] = (f32x4){0.f, 0.f, 0.f, 0.f};
    bf16x8 At[4][2], B0[2][2], B1[2][2];
    const char* cA = (const char*)g.A + (size_t)cur.pm * tstep; const char* cB = (const char*)g.Bt + (size_t)cur.pn * tstep;
    PG8_STAGE(PG8_SB(0, 0), cB, voffB); PG8_STAGE(PG8_SA(0, 0), cA, voffA); PG8_STAGE(PG8_SB(0, 1), cB + hstep, voffB); PG8_STAGE(PG8_SA(0, 1), cA + hstep, voffA);
    if (wr == 1) PG8_BAR;
    PG8_WAIT_V(4); PG8_BAR;
    PG8_STAGE(PG8_SB(1, 0), cB + kstep, voffB); PG8_STAGE(PG8_SA(1, 0), cA + kstep, voffA); PG8_STAGE(PG8_SB(1, 1), cB + hstep + kstep, voffB);
    PG8_WAIT_V(6); PG8_BAR;
    for (;;) {
        const bool has_next = S.next(ui + 1, nxt);
        const char* nA = has_next ? (const char*)g.A + (size_t)nxt.pm * tstep : cA; const char* nB = has_next ? (const char*)g.Bt + (size_t)nxt.pn * tstep : cB;
        for (int t = 0; t < nt; t += 2) {
            const bool last = (t == nt - 2);
            const char* a1 = cA + (size_t)(t + 1) * kstep;
            const char* a2 = last ? nA : cA + (size_t)(t + 2) * kstep; const char* b2 = last ? nB : cB + (size_t)(t + 2) * kstep;
            const char* a3 = a2 + kstep; const char* b3 = b2 + kstep;
            PG8_LDB(B0, 0, 0); PG8_SCHED; PG8_LDA(At, 0, 0); PG8_STAGE(PG8_SA(1, 1), a1 + hstep, voffA);
            PG8_WAIT_L(8); PG8_BAR; PG8_WAIT_L(0); PG8_MMA(0, 0, At, B0); PG8_BAR; PG8_SCHED;
            PG8_LDB(B1, 0, 1); PG8_STAGE(PG8_SB(0, 0), b2, voffB);
            PG8_BAR; PG8_WAIT_L(0); PG8_MMA(0, 1, At, B1); PG8_BAR;
            PG8_LDA(At, 0, 1); PG8_STAGE(PG8_SA(0, 0), a2, voffA);
            PG8_BAR; PG8_WAIT_L(0); PG8_MMA(1, 0, At, B0); PG8_BAR; PG8_SCHED;
            PG8_STAGE(PG8_SB(0, 1), b2 + hstep, voffB);
            PG8_WAIT_V(6); PG8_BAR; PG8_MMA(1, 1, At, B1); PG8_BAR;
            PG8_LDB(B0, 1, 0); PG8_SCHED; PG8_LDA(At, 1, 0); PG8_STAGE(PG8_SA(0, 1), a2 + hstep, voffA);
            PG8_WAIT_L(8); PG8_BAR; PG8_WAIT_L(0); PG8_MMA(0, 0, At, B0); PG8_BAR; PG8_SCHED;
            PG8_LDB(B1, 1, 1); PG8_STAGE(PG8_SB(1, 0), b3, voffB);
            PG8_BAR; PG8_WAIT_L(0); PG8_MMA(0, 1, At, B1); PG8_BAR;
            PG8_LDA(At, 1, 1); PG8_STAGE(PG8_SA(1, 0), a3, voffA);
            PG8_BAR; PG8_WAIT_L(0); PG8_MMA(1, 0, At, B0); PG8_BAR; PG8_SCHED;
            PG8_STAGE(PG8_SB(1, 1), b3 + hstep, voffB);
            PG8_WAIT_V(6); PG8_BAR; PG8_MMA(1, 1, At, B1); PG8_BAR;
        }
        E(acc, cur, wr, wc, fr, fq);
        if (!has_next) break;
#pragma unroll
        for (int a = 0; a < 2; ++a)
#pragma unroll
            for (int b = 0; b < 2; ++b)
#pragma unroll
                for (int m = 0; m < 4; ++m)
#pragma unroll
                    for (int n = 0; n < 2; ++n) acc[a][b][m][n] = (f32x4){0.f, 0.f, 0.f, 0.f};
        cur = nxt; cA = nA; cB = nB; ++ui;
    }
    PG8_WAIT_V(0);
    if (wr == 0) PG8_BAR;
    PG8_BAR;
#undef PG8_SA
#undef PG8_SB
#undef PG8_STAGE
#undef PG8_LDA
#undef PG8_LDB
#undef PG8_MMA
#undef PG8_WAIT_V
#undef PG8_WAIT_L
#undef PG8_BAR
#undef PG8_SCHED
}
}
using pg8::Unit; using pg8::Gemm;

struct EpiBf16 {
    static constexpr bool PERM = true;
    bf16_t* O; int ldc; const float* ss; int sig_from; const float* rope; int rope_below;
    __device__ __forceinline__ void operator()(const f32x4 (&acc)[2][2][4][2], const Unit& u, int wr, int wc, int fr, int fq) const {
        const int row0 = u.pm * 256 + wr * 64 + fr, col0 = u.pn * 256 + wc * 32 + 8 * fq;
        const bool sig = u.pn >= sig_from;
#pragma unroll
        for (int ai = 0; ai < 2; ++ai)
#pragma unroll
            for (int m = 0; m < 4; ++m) {
                const int row = row0 + ai * 128 + m * 16;
                const float rs = ss ? rstd_of(ss, row) : 1.f;
#pragma unroll
                for (int bj = 0; bj < 2; ++bj) {
                    f32x4 v0 = acc[ai][bj][m][0] * rs, v1 = acc[ai][bj][m][1] * rs;
                    if (sig) {
#pragma unroll
                        for (int j = 0; j < 4; ++j) { v0[j] = sigmoidf_(v0[j]); v1[j] = sigmoidf_(v1[j]); }
                    }
                    if (u.pn < rope_below && (wc & 1) == 0) {
                        f32x4 p0, p1;
#pragma unroll
                        for (int j = 0; j < 4; ++j) { p0[j] = __shfl_xor(v0[j], 16); p1[j] = __shfl_xor(v1[j], 16); }
                        if (fq < 2) {
                            const f32x4 c0 = *(const f32x4*)(rope + (size_t)row * 16), c1 = *(const f32x4*)(rope + (size_t)row * 16 + 4);
                            f32x4 s0 = *(const f32x4*)(rope + (size_t)row * 16 + 8), s1 = *(const f32x4*)(rope + (size_t)row * 16 + 12);
                            if (fq == 0) { s0 = -s0; s1 = -s1; }
                            v0 = v0 * c0 + p0 * s0; v1 = v1 * c1 + p1 * s1;
                        }
                    }
                    u32x4 o; o[0] = pk_bf16(v0[0], v0[1]); o[1] = pk_bf16(v0[2], v0[3]); o[2] = pk_bf16(v1[0], v1[1]); o[3] = pk_bf16(v1[2], v1[3]);
                    *(u32x4*)(O + (size_t)row * ldc + col0 + bj * 128) = o;
                }
            }
    }
};
struct EpiGateA {
    static constexpr bool PERM = false;
    float* M1; const bf16_t* proj;
    __device__ __forceinline__ void operator()(const f32x4 (&acc)[2][2][4][2], const Unit& u, int wr, int wc, int fr, int fq) const {
        const int row0 = u.pm * 256 + wr * 64 + fr, col0 = u.pn * 256 + wc * 32 + 4 * fq;
#pragma unroll
        for (int ai = 0; ai < 2; ++ai)
#pragma unroll
            for (int m = 0; m < 4; ++m) {
                const int row = row0 + ai * 128 + m * 16;
#pragma unroll
                for (int bj = 0; bj < 2; ++bj)
#pragma unroll
                    for (int n = 0; n < 2; ++n) {
                        const int col = col0 + bj * 128 + n * 16;
                        const u32x2 gq = *(const u32x2*)(proj + (size_t)row * INC + C_GA + col);
                        f32x4 a = acc[ai][bj][m][n], o;
                        o[0] = a[0] * bflo(gq[0]); o[1] = a[1] * bfhi(gq[0]); o[2] = a[2] * bflo(gq[1]); o[3] = a[3] * bfhi(gq[1]);
                        *(f32x4*)(M1 + (size_t)row * DM + col) = o;
                    }
            }
    }
};
struct EpiGateB {
    static constexpr bool PERM = true;
    const float* M1; const bf16_t* proj; bf16_t* O;
    __device__ __forceinline__ void operator()(const f32x4 (&acc)[2][2][4][2], const Unit& u, int wr, int wc, int fr, int fq) const {
        const int row0 = u.pm * 256 + wr * 64 + fr, col0 = u.pn * 256 + wc * 32 + 8 * fq;
#pragma unroll
        for (int ai = 0; ai < 2; ++ai)
#pragma unroll
            for (int m = 0; m < 4; ++m) {
                const int row = row0 + ai * 128 + m * 16;
#pragma unroll
                for (int bj = 0; bj < 2; ++bj) {
                    const int col = col0 + bj * 128;
                    const u32x4 gq = *(const u32x4*)(proj + (size_t)row * INC + C_GB + col);
                    const f32x4 m0 = *(const f32x4*)(M1 + (size_t)row * DM + col), m1 = *(const f32x4*)(M1 + (size_t)row * DM + col + 4);
                    const f32x4 a0 = acc[ai][bj][m][0], a1 = acc[ai][bj][m][1];
                    u32x4 o;
                    o[0] = pk_bf16(m0[0] + a0[0] * bflo(gq[0]), m0[1] + a0[1] * bfhi(gq[0]));
                    o[1] = pk_bf16(m0[2] + a0[2] * bflo(gq[1]), m0[3] + a0[3] * bfhi(gq[1]));
                    o[2] = pk_bf16(m1[0] + a1[0] * bflo(gq[2]), m1[1] + a1[1] * bfhi(gq[2]));
                    o[3] = pk_bf16(m1[2] + a1[2] * bflo(gq[3]), m1[3] + a1[3] * bfhi(gq[3]));
                    *(u32x4*)(O + (size_t)row * DM + col) = o;
                }
            }
    }
};
struct EpiRes {
    static constexpr bool PERM = false;
    const float* R; float* H; bf16_t* Hb; float* SS;
    __device__ __forceinline__ void operator()(const f32x4 (&acc)[2][2][4][2], const Unit& u, int wr, int wc, int fr, int fq) const {
        const int row0 = u.pm * 256 + wr * 64 + fr, col0 = u.pn * 256 + wc * 32 + 4 * fq;
#pragma unroll
        for (int ai = 0; ai < 2; ++ai)
#pragma unroll
            for (int m = 0; m < 4; ++m) {
                const int row = row0 + ai * 128 + m * 16;
                float s = 0.f;
#pragma unroll
                for (int bj = 0; bj < 2; ++bj)
#pragma unroll
                    for (int n = 0; n < 2; ++n) {
                        const int col = col0 + bj * 128 + n * 16;
                        const f32x4 h = *(const f32x4*)(R + (size_t)row * DM + col) + acc[ai][bj][m][n];
                        *(f32x4*)(H + (size_t)row * DM + col) = h;
                        if (Hb) { u32x2 o; o[0] = pk_bf16(h[0], h[1]); o[1] = pk_bf16(h[2], h[3]); *(u32x2*)(Hb + (size_t)row * DM + col) = o; }
                        s += (h[0] * h[0] + h[1] * h[1]) + (h[2] * h[2] + h[3] * h[3]);
                    }
                s += __shfl_xor(s, 16); s += __shfl_xor(s, 32);
                if (fq == 0) SS[(size_t)row * 16 + u.pn * 4 + wc] = s;
            }
    }
};
struct EpiSwiGLU {
    static constexpr bool PERM = true;
    bf16_t* O; const float* ss;
    __device__ __forceinline__ void operator()(const f32x4 (&acc)[2][2][4][2], const Unit& u, int wr, int wc, int fr, int fq) const {
        const int row0 = u.pm * 256 + wr * 64 + fr, col0 = u.pn * 128 + wc * 32 + 8 * fq;
#pragma unroll
        for (int ai = 0; ai < 2; ++ai)
#pragma unroll
            for (int m = 0; m < 4; ++m) {
                const int row = row0 + ai * 128 + m * 16;
                const float rs = rstd_of(ss, row);
                float r[8];
#pragma unroll
                for (int n = 0; n < 2; ++n)
#pragma unroll
                    for (int j = 0; j < 4; ++j) { const float gg = acc[ai][0][m][n][j] * rs, uu = acc[ai][1][m][n][j] * rs; r[n * 4 + j] = gg * sigmoidf_(gg) * uu; }
                u32x4 o; o[0] = pk_bf16(r[0], r[1]); o[1] = pk_bf16(r[2], r[3]); o[2] = pk_bf16(r[4], r[5]); o[3] = pk_bf16(r[6], r[7]);
                *(u32x4*)(O + (size_t)row * DFF + col0) = o;
            }
    }
};

struct Ctx { int tid, lane, wave, gw, ngw, gt, ngt; };

__device__ __forceinline__ void p_transpose(const Ctx& c, LAS unsigned char* lds, const float* W, bf16_t* Wt, int K, int N, const float* g, int mode, int& cursor) {
    LAS float* scr = (LAS float*)(lds + c.wave * 8704);
    const int nblk = N / 32, nitems = (K / 64) * nblk, lane = c.lane;
    int first = (c.gw - cursor % c.ngw + c.ngw) % c.ngw;
    for (int it = first; it < nitems; it += c.ngw) {
        const int kb = it / nblk, nb = it % nblk, k0 = 64 * kb, n0 = 32 * nb;
#pragma unroll 8
        for (int i = 0; i < 32; ++i) { const int kk = 2 * i + (lane >> 5); float v = W[(size_t)(k0 + kk) * N + n0 + (lane & 31)]; if (g) v *= g[k0 + kk]; scr[kk * 33 + (lane & 31)] = v; }
        asm volatile("s_waitcnt lgkmcnt(0)" ::: "memory");
        const int ch = lane & 7;
#pragma unroll
        for (int j = 0; j < 4; ++j) { const int n = (lane >> 3) + 8 * j; const LAS float* sp = scr + (8 * ch) * 33 + n;
            u32x4 o; o[0] = pk_bf16(sp[0], sp[33]); o[1] = pk_bf16(sp[2 * 33], sp[3 * 33]); o[2] = pk_bf16(sp[4 * 33], sp[5 * 33]); o[3] = pk_bf16(sp[6 * 33], sp[7 * 33]);
            const int nn = n0 + n, row = mode == 0 ? nn : (256 * (nn >> 7) + (nn & 127) + (mode == 2 ? 128 : 0));
            *(u32x4*)(Wt + (size_t)row * K + k0 + 8 * ch) = o; }
        asm volatile("s_waitcnt lgkmcnt(0)" ::: "memory");
    }
    cursor += nitems;
}
__device__ __forceinline__ void p_rmsnorm_rows(const Ctx& c, const float* x, const float* g, bf16_t* out, int rows) {
    for (int r = c.gw; r < rows; r += c.ngw) {
        const f32x4* xr = (const f32x4*)(x + (size_t)r * DM) + c.lane;
        f32x4 v[4]; float s = 0.f;
#pragma unroll
        for (int j = 0; j < 4; ++j) { v[j] = xr[64 * j]; s += (v[j][0] * v[j][0] + v[j][1] * v[j][1]) + (v[j][2] * v[j][2] + v[j][3] * v[j][3]); }
        const float rs = rsqrtf(wave_sum(s) * (1.f / DM) + EPS);
#pragma unroll
        for (int j = 0; j < 4; ++j) {
            const f32x4 gg = ((const f32x4*)g)[c.lane + 64 * j];
            u32x2 o; o[0] = pk_bf16(v[j][0] * rs * gg[0], v[j][1] * rs * gg[1]); o[1] = pk_bf16(v[j][2] * rs * gg[2], v[j][3] * rs * gg[3]);
            ((u32x2*)(out + (size_t)r * DM))[c.lane + 64 * j] = o;
        }
    }
}
__device__ __forceinline__ void p_rope_table(const Ctx& c, const int* pos, float* tab) {
    for (int i = c.gt; i < T * 8; i += c.ngt) {
        const int tok = i >> 3, f = i & 7;
        const double inv = f == 0 ? 1.0 : f == 1 ? 0.19392274474868576 : f == 2 ? 0.03760603093086393 : f == 3 ? 0.007292664737217109 : f == 4 ? 0.001414213562373095 :
                           f == 5 ? 0.0002742481756762073 : f == 6 ? 5.318295896944988e-05 : 1.031338537721246e-05;
        const double rev = (double)pos[tok] * inv * 0.15915494309189535;
        const float fr = (float)(rev - rint(rev));
        tab[(size_t)tok * 16 + f] = __builtin_amdgcn_cosf(fr);
        tab[(size_t)tok * 16 + 8 + f] = __builtin_amdgcn_sinf(fr);
    }
}
__device__ __forceinline__ void p_rope_apply(const Ctx& c, bf16_t* proj, const float* tab) {
    for (int i = c.gt; i < T * 2 * NHA * 8; i += c.ngt) {
        const int f = i & 7, h = (i >> 3) & 7, which = (i >> 6) & 1, tok = i >> 7;
        bf16_t* p = proj + (size_t)tok * INC + (which ? C_KA : C_QA) + h * HD + f;
        const float x1 = bf2f(p[0]), x2 = bf2f(p[8]), cs = tab[(size_t)tok * 16 + f], sn = tab[(size_t)tok * 16 + 8 + f];
        p[0] = f2bf(x1 * cs - x2 * sn); p[8] = f2bf(x2 * cs + x1 * sn);
    }
}
__device__ __forceinline__ void p_attn_a_naive(const Ctx& c, const bf16_t* proj, bf16_t* OA) {
    for (int it = c.gw; it < T * NHA; it += c.ngw) {
        const int h = it & 7, tok = it >> 3, t = tok & (SEQ - 1), tb = tok - t;
        const float q = bf2f(proj[(size_t)tok * INC + C_QA + h * HD + c.lane]) * 0.125f;
        float og[3], lse[3];
#pragma unroll
        for (int gi = 0; gi < 3; ++gi) {
            const int d = gi == 0 ? 1 : (gi == 1 ? 4 : 16);
            float m = -INFINITY, l = 0.f, o = 0.f;
            for (int j = 0; j <= 128; ++j) {
                const int tk = t - j * d; if (tk < 0) break;
                const bf16_t* kr = proj + (size_t)(tb + tk) * INC + h * HD + c.lane;
                const float s = wave_sum(q * bf2f(kr[C_KA]));
                const float mn = fmaxf(m, s), sc = __expf(m - mn), p = __expf(s - mn);
                l = l * sc + p; o = o * sc + p * bf2f(kr[C_VA]); m = mn;
            }
            og[gi] = o / l; lse[gi] = m + __logf(l);
        }
        const float M = fmaxf(lse[0], fmaxf(lse[1], lse[2]));
        const float w0 = __expf(lse[0] - M), w1 = __expf(lse[1] - M), w2 = __expf(lse[2] - M);
        OA[(size_t)tok * 512 + h * HD + c.lane] = f2bf((w0 * og[0] + w1 * og[1] + w2 * og[2]) / (w0 + w1 + w2));
    }
}
__device__ __forceinline__ void p_attn_b_naive(const Ctx& c, const bf16_t* proj, bf16_t* OB) {
    for (int it = c.gw; it < T * NHB; it += c.ngw) {
        const int h = it & 7, tok = it >> 3, t = tok & (SEQ - 1), tb = tok - t;
        const float q = bf2f(proj[(size_t)tok * INC + C_QB + h * HD + c.lane]) * 0.125f;
        float run = 0.f, o = 0.f;
        for (int tk = t - 1; tk >= 0; --tk) {
            const bf16_t* kr = proj + (size_t)(tb + tk) * INC + h * HD + c.lane;
            const float z = wave_sum(q * bf2f(kr[C_KB]));
            const float sp = fmaxf(z, 0.f) + log1pf(__expf(-fabsf(z)));
            const float a = __expf(z - sp + run);
            o += a * bf2f(kr[C_VB]);
            run -= sp;
        }
        OB[(size_t)tok * 512 + h * HD + c.lane] = f2bf(o);
    }
}
__device__ __forceinline__ void p_attn_mem_naive(const Ctx& c, const bf16_t* qm, const bf16_t* kvm, bf16_t* om) {
    const float sc = 0.08838834764831845f;
    for (int it = c.gw; it < T * 4; it += c.ngw) {
        const int h = it & 3, tok = it >> 2, b = tok >> 11;
        const float q0 = bf2f(qm[(size_t)tok * MEMW + h * 128 + c.lane]) * sc, q1 = bf2f(qm[(size_t)tok * MEMW + h * 128 + 64 + c.lane]) * sc;
        float m = -INFINITY, l = 0.f, o0 = 0.f, o1 = 0.f;
        for (int j = 0; j < NMEM; ++j) {
            const bf16_t* kr = kvm + (size_t)(b * NMEM + j) * 1024 + h * 128 + c.lane;
            const float s = wave_sum(q0 * bf2f(kr[0]) + q1 * bf2f(kr[64]));
            const float mn = fmaxf(m, s), scl = __expf(m - mn), p = __expf(s - mn);
            l = l * scl + p; o0 = o0 * scl + p * bf2f(kr[512]); o1 = o1 * scl + p * bf2f(kr[512 + 64]); m = mn;
        }
        om[(size_t)tok * MEMW + h * 128 + c.lane] = f2bf(o0 / l); om[(size_t)tok * MEMW + h * 128 + 64 + c.lane] = f2bf(o1 / l);
    }
}
__device__ __forceinline__ void p_final(const Ctx& c, float* out, const float* ss, const float* g) {
    for (int r = c.gw; r < T; r += c.ngw) {
        const float rs = rstd_of(ss, r);
        f32x4* xr = (f32x4*)(out + (size_t)r * DM) + c.lane;
#pragma unroll
        for (int j = 0; j < 4; ++j) { const f32x4 gg = ((const f32x4*)g)[c.lane + 64 * j]; f32x4 v = xr[64 * j]; v = v * rs * gg; xr[64 * j] = v; }
    }
}


typedef float f32x16 __attribute__((ext_vector_type(16)));
typedef short s16x4 __attribute__((ext_vector_type(4)));
#define MFMA32(a, b, c) __builtin_amdgcn_mfma_f32_32x32x16_bf16((a), (b), (c), 0, 0, 0)
constexpr int ATT_FLAG_OFF = 40960;
template <int MODE, int HDIM>
__device__ __forceinline__ void attn_item(LAS unsigned char* lds, const bf16_t* Qp, int ldq, const bf16_t* Kp, const bf16_t* Vp, int ldkv, bf16_t* Op, int ldo, int q0, int nkeys) {
    constexpr int KS = HDIM / 16, DD = HDIM / 32, KROW = HDIM * 2 + 16, VROW = 64 * 2 + 8, NCH = HDIM / 8, PER = 64 * NCH / 512;
    int tid = threadIdx.x; asm volatile("" : "+v"(tid));
    const int lane = tid & 63, w = __builtin_amdgcn_readfirstlane(tid >> 6), r = lane & 31, hh = lane >> 5;
    const int tq0 = q0 + 32 * w, tq = tq0 + r;
    LAS unsigned char* Ks = lds; LAS unsigned char* Vt = lds + 64 * KROW;
    LAS unsigned* flags = (LAS unsigned*)(lds + ATT_FLAG_OFF);
    bf16x8 Qf[KS];
#pragma unroll
    for (int ks = 0; ks < KS; ++ks) Qf[ks] = *(const bf16x8*)(Qp + (size_t)tq * ldq + 16 * ks + 8 * hh);
    f32x16 Oacc[DD];
#pragma unroll
    for (int dd = 0; dd < DD; ++dd)
#pragma unroll
        for (int i = 0; i < 16; ++i) Oacc[dd][i] = 0.f;
    float m = -INFINITY, l = 0.f, run = 0.f; unsigned done_w = 0u;
    const int kt_hi = (MODE == 2) ? (nkeys / 64 - 1) : ((q0 + 255) >> 6);
    u32x4 kreg[PER], vreg[PER];
#define ATT_GLOAD(kt) do { _Pragma("unroll") for (int p_ = 0; p_ < PER; ++p_) { const int idx_ = tid + 512 * p_, key_ = idx_ / NCH, ch_ = idx_ % NCH; \
        kreg[p_] = *(const u32x4*)(Kp + (size_t)(64 * (kt) + key_) * ldkv + ch_ * 8); vreg[p_] = *(const u32x4*)(Vp + (size_t)(64 * (kt) + key_) * ldkv + ch_ * 8); } } while (0)
    ATT_GLOAD(kt_hi);
    for (int kt = kt_hi; kt >= 0; --kt) {
        if (MODE == 1 && lane == 0) flags[w] = done_w;
        __syncthreads();
#pragma unroll
        for (int p_ = 0; p_ < PER; ++p_) { const int idx_ = tid + 512 * p_, key_ = idx_ / NCH, ch_ = idx_ % NCH;
            *(LAS u32x4*)(Ks + key_ * KROW + ch_ * 16) = kreg[p_];
#pragma unroll
            for (int j = 0; j < 8; ++j) *(LAS bf16_t*)(Vt + (ch_ * 8 + j) * VROW + key_ * 2) = (bf16_t)((vreg[p_][j >> 1] >> (16 * (j & 1))) & 0xffffu);
        }
        bool alldone = false;
        if (MODE == 1) { unsigned a = 1u;
#pragma unroll
            for (int i = 0; i < 8; ++i) a &= flags[i];
            alldone = a != 0u; }
        __syncthreads();
        if (MODE == 1 && alldone) break;
        if (kt > 0) ATT_GLOAD(kt - 1);
#pragma unroll
        for (int sub = 1; sub >= 0; --sub) {
            const int tk0 = 64 * kt + 32 * sub;
            if (MODE != 2 && tk0 > tq0 + 31) continue;
            if (MODE == 1 && done_w) continue;
            f32x16 S;
#pragma unroll
            for (int i = 0; i < 16; ++i) S[i] = 0.f;
#pragma unroll
            for (int ks = 0; ks < KS; ++ks) { const bf16x8 kf = *(const LAS bf16x8*)(Ks + (32 * sub + r) * KROW + (16 * ks + 8 * hh) * 2); S = MFMA32(kf, Qf[ks], S); }
            const int dbase = tq - tk0 - 4 * hh;
            if (MODE == 0 || MODE == 2) {
                const float C = (MODE == 0 ? 0.125f : 0.08838834764831845f) * 1.4426950408889634f;
                float fm[16]; float mx = -INFINITY;
#pragma unroll
                for (int i = 0; i < 16; ++i) {
                    float v = S[i] * C;
                    if (MODE == 0) { const int d = dbase - ((i & 3) + 8 * (i >> 2));
                        int mult = (d <= 128 ? 1 : 0) + ((((d & 3) == 0) && d <= 512) ? 1 : 0) + (((d & 15) == 0) ? 1 : 0);
                        mult = d >= 0 ? mult : 0; fm[i] = (float)mult; v = mult > 0 ? v : -INFINITY; }
                    else fm[i] = 1.f;
                    S[i] = v; mx = fmaxf(mx, v);
                }
                mx = fmaxf(mx, __shfl_xor(mx, 32));
                const float mn = fmaxf(m, mx), ms = (mn == -INFINITY) ? 0.f : mn;
                const float alpha = __builtin_amdgcn_exp2f(m - ms);
                float ls = 0.f;
#pragma unroll
                for (int i = 0; i < 16; ++i) { const float p = fm[i] * __builtin_amdgcn_exp2f(S[i] - ms); S[i] = p; ls += p; }
                l = l * alpha + ls; m = mn;
#pragma unroll
                for (int dd = 0; dd < DD; ++dd) Oacc[dd] = Oacc[dd] * alpha;
            } else {
                float sp[16], ex[16], G[4], PG[4];
#pragma unroll
                for (int i = 0; i < 16; ++i) { const int d = dbase - ((i & 3) + 8 * (i >> 2)); const bool valid = d > 0;
                    const float z = S[i] * 0.125f; const float e = __expf(-fabsf(z)); const float spv = fmaxf(z, 0.f) + __logf(1.f + e);
                    sp[i] = valid ? spv : 0.f; S[i] = valid ? (z - spv) : -INFINITY; }
#pragma unroll
                for (int g = 0; g < 4; ++g) { ex[4 * g + 3] = 0.f; ex[4 * g + 2] = sp[4 * g + 3]; ex[4 * g + 1] = ex[4 * g + 2] + sp[4 * g + 2]; ex[4 * g] = ex[4 * g + 1] + sp[4 * g + 1]; G[g] = ex[4 * g] + sp[4 * g]; }
#pragma unroll
                for (int g = 0; g < 4; ++g) PG[g] = __shfl_xor(G[g], 32);
                float later[4]; float suf = 0.f;
#pragma unroll
                for (int g = 3; g >= 0; --g) { later[g] = suf + (hh == 0 ? PG[g] : 0.f); suf += G[g] + PG[g]; }
#pragma unroll
                for (int i = 0; i < 16; ++i) S[i] = __expf(S[i] - (run + later[i >> 2] + ex[i]));
                run += suf;
                done_w = __all(run > 104.f) ? 1u : 0u;
            }
            u32x4 pp0, pp1;
#pragma unroll
            for (int j = 0; j < 4; ++j) { pp0[j] = pk_bf16(S[2 * j], S[2 * j + 1]); pp1[j] = pk_bf16(S[8 + 2 * j], S[8 + 2 * j + 1]); }
            const bf16x8 P0 = __builtin_bit_cast(bf16x8, pp0), P1 = __builtin_bit_cast(bf16x8, pp1);
#pragma unroll
            for (int dd = 0; dd < DD; ++dd)
#pragma unroll
                for (int s2 = 0; s2 < 2; ++s2) {
                    const LAS unsigned char* vp = Vt + (32 * dd + r) * VROW + (32 * sub + 16 * s2 + 4 * hh) * 2;
                    const s16x4 lo = *(const LAS s16x4*)vp, hi = *(const LAS s16x4*)(vp + 16);
                    const bf16x8 vf = __builtin_shufflevector(lo, hi, 0, 1, 2, 3, 4, 5, 6, 7);
                    Oacc[dd] = MFMA32(vf, s2 ? P1 : P0, Oacc[dd]);
                }
        }
    }
#undef ATT_GLOAD
    float inv = 1.f;
    if (MODE != 1) { const float lt = l + __shfl_xor(l, 32); inv = 1.f / lt; }
#pragma unroll
    for (int dd = 0; dd < DD; ++dd)
#pragma unroll
        for (int g = 0; g < 4; ++g) {
            u32x2 o; o[0] = pk_bf16(Oacc[dd][4 * g] * inv, Oacc[dd][4 * g + 1] * inv); o[1] = pk_bf16(Oacc[dd][4 * g + 2] * inv, Oacc[dd][4 * g + 3] * inv);
            *(u32x2*)(Op + (size_t)tq * ldo + 32 * dd + 8 * g + 4 * hh) = o;
        }
}
__device__ __forceinline__ void p_attn_ab(LAS unsigned char* lds, const bf16_t* proj, bf16_t* OA, bf16_t* OB) {
    for (int v = blockIdx.x; v < 256; v += gridDim.x) {
        const int bh = v >> 1, b = bh >> 3, h = bh & 7, par = v & 1;
        const bf16_t* base = proj + (size_t)b * SEQ * INC + h * HD;
        for (int k = 0; k < 4; ++k) { const int qb = (k == 0) ? 7 - par : (k == 1) ? par : (k == 2) ? 5 - par : 2 + par;
            attn_item<0, 64>(lds, base + C_QA, INC, base + C_KA, base + C_VA, INC, OA + (size_t)b * SEQ * 512 + h * HD, 512, qb * 256, SEQ); }
        for (int k = 0; k < 4; ++k) { const int qb = (k == 0) ? 7 - par : (k == 1) ? par : (k == 2) ? 5 - par : 2 + par;
            attn_item<1, 64>(lds, base + C_QB, INC, base + C_KB, base + C_VB, INC, OB + (size_t)b * SEQ * 512 + h * HD, 512, qb * 256, SEQ); }
    }
}
__device__ __forceinline__ void p_attn_mem(LAS unsigned char* lds, const bf16_t* qm, const bf16_t* kvm, bf16_t* om) {
    for (int it = blockIdx.x; it < BATCH * 4 * 8; it += gridDim.x) {
        const int qb = it & 7, h = (it >> 3) & 3, b = it >> 5;
        attn_item<2, 128>(lds, qm + (size_t)b * SEQ * MEMW + h * 128, MEMW, kvm + (size_t)b * NMEM * 1024 + h * 128, kvm + (size_t)b * NMEM * 1024 + 512 + h * 128, 1024,
                          om + (size_t)b * SEQ * MEMW + h * 128, MEMW, qb * 256, NMEM);
    }
}

__device__ __forceinline__ bool sync_if(int k, cg::grid_group& grid, XcdBarrier& xb) {
    if (k == 1) { grid.sync(); xb = xcd_barrier_post(xb.bar, xb.st); }
    else if (k > 1) xcd_barrier(xb);
    asm volatile("" ::: "memory"); return true; }
constexpr int NPHASE = 13;
#ifndef NAIVE_AB
#define NAIVE_AB 0
#endif
#ifndef NAIVE_MEM
#define NAIVE_MEM 0
#endif
#ifndef ONLY
#define ONLY -1
#endif
#ifndef DUP_MASK
#define DUP_MASK 0
#endif
#define PHASE(k) if ((ONLY < 0 || ONLY == (k)) && ph_lo <= (k) && (k) < ph_hi) if (sync_if((k), grid, xb)) for (int rep_ = 0; rep_ < (((DUP_MASK >> (k)) & 1) ? 2 : 1); ++rep_)
__global__ __launch_bounds__(512, 2) void mega(Params p, int ph_lo, int ph_hi) {
    extern __shared__ __attribute__((aligned(16))) unsigned char shm[];
    LAS unsigned char* lds = (LAS unsigned char*)shm;
    cg::grid_group grid = cg::this_grid();
    Ctx c; c.tid = threadIdx.x; c.lane = c.tid & 63; c.wave = c.tid >> 6; c.gw = blockIdx.x * 8 + c.wave; c.ngw = gridDim.x * 8; c.gt = blockIdx.x * 512 + c.tid; c.ngt = gridDim.x * 512;
    unsigned char* ws = p.ws;
    bf16_t* Wt_in = (bf16_t*)(ws + WS_WIN); bf16_t* Wt_upa = (bf16_t*)(ws + WS_WUPA); bf16_t* Wt_upb = (bf16_t*)(ws + WS_WUPB); bf16_t* Wt_out = (bf16_t*)(ws + WS_WOUT);
    bf16_t* Wt_qm = (bf16_t*)(ws + WS_WQM); bf16_t* Wt_kvm = (bf16_t*)(ws + WS_WKVM); bf16_t* Wt_om = (bf16_t*)(ws + WS_WOM); bf16_t* Wt_gu = (bf16_t*)(ws + WS_WGU); bf16_t* Wt_dn = (bf16_t*)(ws + WS_WDN);
    bf16_t* memn = (bf16_t*)(ws + WS_MEMN); bf16_t* kvm = (bf16_t*)(ws + WS_KVM);
    float* ss1 = (float*)(ws + WS_SS1); float* ss2 = (float*)(ws + WS_SS2); float* ss3 = (float*)(ws + WS_SS3); float* rope = (float*)(ws + WS_ROPE);
    bf16_t* n1 = (bf16_t*)(ws + WS_R1); bf16_t* mixed = (bf16_t*)(ws + WS_R1); bf16_t* h2b = (bf16_t*)(ws + WS_R1);
    bf16_t* proj = (bf16_t*)(ws + WS_PROJ);
    float* h1 = (float*)(ws + WS_H1); bf16_t* h1b = (bf16_t*)(ws + WS_H1B); bf16_t* qm = (bf16_t*)(ws + WS_QM); bf16_t* om = (bf16_t*)(ws + WS_OM);
    float* h2 = (float*)(ws + WS_H2); bf16_t* act = (bf16_t*)(ws + WS_ACT); bf16_t* OA = (bf16_t*)(ws + WS_OA); bf16_t* OB = (bf16_t*)(ws + WS_OB);
    float* m1 = p.out; unsigned* bar = (unsigned*)(ws + WS_BAR);
    volatile LAS unsigned* xst = (volatile LAS unsigned*)(lds + pg8::STAGE_BYTES);
    if (c.tid == 0) { xst[0] = 0u; xst[1] = 0u; }
    __syncthreads();
    XcdBarrier xb; xb.bar = bar; xb.x = 0u; xb.st = xst;
    pg8::StaticOrder S;
    {
        PHASE(0) {
            int cur = 0;
            p_transpose(c, lds, p.w_in, Wt_in, DM, INC, nullptr, 0, cur);
            p_transpose(c, lds, p.w_ffn_gate, Wt_gu, DM, DFF, p.g_ffn, 1, cur);
            p_transpose(c, lds, p.w_ffn_up, Wt_gu, DM, DFF, p.g_ffn, 2, cur);
            p_transpose(c, lds, p.w_ffn_down, Wt_dn, DFF, DM, nullptr, 0, cur);
            p_transpose(c, lds, p.w_up_a, Wt_upa, 512, DM, nullptr, 0, cur);
            p_transpose(c, lds, p.w_up_b, Wt_upb, 512, DM, nullptr, 0, cur);
            p_transpose(c, lds, p.w_out, Wt_out, DM, DM, nullptr, 0, cur);
            p_transpose(c, lds, p.w_q_mem, Wt_qm, DM, MEMW, p.g_mem_q, 0, cur);
            p_transpose(c, lds, p.w_kv_mem, Wt_kvm, DM, 2 * MEMW, nullptr, 0, cur);
            p_transpose(c, lds, p.w_o_mem, Wt_om, MEMW, DM, nullptr, 0, cur);
            p_rmsnorm_rows(c, p.x, p.g_mix, n1, T);
            p_rmsnorm_rows(c, p.mem, p.g_mem_kv, memn, BATCH * NMEM);
            p_rope_table(c, p.pos, rope);
            if (blockIdx.x == 0) for (int i = c.tid; i < XCD_BAR_WORDS; i += 512) bar[i] = 0u;
        }
        PHASE(1) {
            { Gemm g{n1, Wt_in, T, INC, DM}; EpiBf16 E{proj, INC, nullptr, 12, rope, 4}; S.init(g.M, g.N, gridDim.x, blockIdx.x); pg8::gemm_phase(lds, g, S, E); }
            { Gemm g{memn, Wt_kvm, BATCH * NMEM, 1024, DM}; EpiBf16 E{kvm, 1024, nullptr, 1 << 30, nullptr, 0}; S.init(g.M, g.N, gridDim.x, blockIdx.x); pg8::gemm_phase(lds, g, S, E); }
        }
        PHASE(3) {
#if NAIVE_AB
            p_attn_a_naive(c, proj, OA); p_attn_b_naive(c, proj, OB);
#else
            p_attn_ab(lds, proj, OA, OB);
#endif
        }
        PHASE(4) { Gemm g{OA, Wt_upa, T, DM, 512}; EpiGateA E{m1, proj}; S.init(g.M, g.N, gridDim.x, blockIdx.x); pg8::gemm_phase(lds, g, S, E); }
        PHASE(5) { Gemm g{OB, Wt_upb, T, DM, 512}; EpiGateB E{m1, proj, mixed}; S.init(g.M, g.N, gridDim.x, blockIdx.x); pg8::gemm_phase(lds, g, S, E); }
        PHASE(6) { Gemm g{mixed, Wt_out, T, DM, DM}; EpiRes E{p.x, h1, h1b, ss1}; S.init(g.M, g.N, gridDim.x, blockIdx.x); pg8::gemm_phase(lds, g, S, E); }
        PHASE(7) { Gemm g{h1b, Wt_qm, T, MEMW, DM}; EpiBf16 E{qm, MEMW, ss1, 1 << 30, nullptr, 0}; S.init(g.M, g.N, gridDim.x, blockIdx.x); pg8::gemm_phase(lds, g, S, E); }
        PHASE(8) {
#if NAIVE_MEM
            p_attn_mem_naive(c, qm, kvm, om);
#else
            p_attn_mem(lds, qm, kvm, om);
#endif
        }
        PHASE(9) { Gemm g{om, Wt_om, T, DM, MEMW}; EpiRes E{h1, h2, h2b, ss2}; S.init(g.M, g.N, gridDim.x, blockIdx.x); pg8::gemm_phase(lds, g, S, E); }
        PHASE(10) { Gemm g{h2b, Wt_gu, T, 2 * DFF, DM}; EpiSwiGLU E{act, ss2}; S.init(g.M, g.N, gridDim.x, blockIdx.x); pg8::gemm_phase(lds, g, S, E); }
        PHASE(11) { Gemm g{act, Wt_dn, T, DM, DFF}; EpiRes E{h2, p.out, nullptr, ss3}; S.init(g.M, g.N, gridDim.x, blockIdx.x); pg8::gemm_phase(lds, g, S, E); }
        PHASE(12) p_final(c, p.out, ss3, p.g_final);
    }
}

constexpr int LDS_BYTES = pg8::STAGE_BYTES + 16;
#ifndef ONE_LAUNCH
#define ONE_LAUNCH 1
#endif
extern "C" void kernel_launch(void* const* d_in, const int* in_sizes, int n_in, void* d_out, int out_size, void* d_ws, size_t ws_size, hipStream_t stream) {
    static int grid = 0;
    if (grid == 0) {
        if (n_in != 18 || out_size != T * DM || ws_size < WS_END) { fprintf(stderr, "kernel_launch: unexpected shapes (n_in %d out %d ws %zu)\n", n_in, out_size, ws_size); grid = -1; return; }
        int dev = 0, cus = 0, per_cu = 0;
        (void)hipGetDevice(&dev); (void)hipDeviceGetAttribute(&cus, hipDeviceAttributeMultiprocessorCount, dev);
        if (hipFuncSetAttribute((const void*)mega, hipFuncAttributeMaxDynamicSharedMemorySize, LDS_BYTES) != hipSuccess) { fprintf(stderr, "hipFuncSetAttribute failed\n"); grid = -1; return; }
        if (hipOccupancyMaxActiveBlocksPerMultiprocessor(&per_cu, (const void*)mega, 512, LDS_BYTES) != hipSuccess || per_cu < 1) { fprintf(stderr, "occupancy query: %d\n", per_cu); per_cu = 1; }
        (void)hipGetLastError();
        grid = cus * 1;
    }
    if (grid < 0) return;
    Params p{};
    p.x = (const float*)d_in[0]; p.mem = (const float*)d_in[1]; p.pos = (const int*)d_in[2]; p.g_mix = (const float*)d_in[3]; p.w_in = (const float*)d_in[4];
    p.w_up_a = (const float*)d_in[5]; p.w_up_b = (const float*)d_in[6]; p.w_out = (const float*)d_in[7]; p.g_mem_q = (const float*)d_in[8]; p.g_mem_kv = (const float*)d_in[9];
    p.w_q_mem = (const float*)d_in[10]; p.w_kv_mem = (const float*)d_in[11]; p.w_o_mem = (const float*)d_in[12]; p.g_ffn = (const float*)d_in[13];
    p.w_ffn_gate = (const float*)d_in[14]; p.w_ffn_up = (const float*)d_in[15]; p.w_ffn_down = (const float*)d_in[16]; p.g_final = (const float*)d_in[17];
    p.out = (float*)d_out; p.ws = (unsigned char*)d_ws;
#if ONE_LAUNCH
    int lo = 0, hi = NPHASE;
    void* args[] = {&p, &lo, &hi};
    hipError_t e = hipLaunchCooperativeKernel((const void*)mega, dim3(grid), dim3(512), args, LDS_BYTES, stream);
    if (e != hipSuccess) fprintf(stderr, "cooperative launch failed: %s\n", hipGetErrorString(e));
#else
    for (int ph = 0; ph < NPHASE; ++ph) hipLaunchKernelGGL(mega, dim3(grid), dim3(512), LDS_BYTES, stream, p, ph, ph + 1);
#endif
}
```

```cpp
#include <hip/hip_runtime.h>
#include <hip/hip_cooperative_groups.h>
#include <cstdio>
namespace cg = cooperative_groups;

#define LAS __attribute__((address_space(3)))
typedef unsigned short bf16_t;
typedef short bf16x8 __attribute__((ext_vector_type(8)));
typedef float f32x4 __attribute__((ext_vector_type(4)));
typedef unsigned u32x4 __attribute__((ext_vector_type(4)));
typedef unsigned u32x2 __attribute__((ext_vector_type(2)));

constexpr int BATCH = 16, SEQ = 2048, DM = 1024, T = BATCH * SEQ;
constexpr int HD = 64, NHA = 8, NHB = 8;
constexpr int INC = 5120;
constexpr int C_QA = 0, C_KA = 512, C_VA = 1024, C_QB = 1536, C_KB = 2048, C_VB = 2560, C_GA = 3072, C_GB = 4096;
constexpr int NMEM = 256, MEMW = 512, DFF = 2816;
constexpr float EPS = 1e-6f;

constexpr size_t MiB = 1ull << 20;
constexpr size_t WS_WIN = 0, WS_WUPA = 10 * MiB, WS_WUPB = 11 * MiB, WS_WOUT = 12 * MiB, WS_WQM = 14 * MiB, WS_WKVM = 15 * MiB,
                 WS_WOM = 17 * MiB, WS_WGU = 18 * MiB, WS_WDN = 29 * MiB, WS_MEMN = 36 * MiB, WS_KVM = 44 * MiB,
                 WS_SS1 = 52 * MiB, WS_SS2 = 54 * MiB, WS_SS3 = 56 * MiB, WS_ROPE = 58 * MiB, WS_BAR = 60 * MiB;
constexpr size_t WS_R1 = 64 * MiB;
constexpr size_t WS_PROJ = 128 * MiB;
constexpr size_t WS_H1 = 128 * MiB, WS_H1B = 256 * MiB, WS_QM = 320 * MiB, WS_OM = 352 * MiB, WS_H2 = 384 * MiB, WS_ACT = 128 * MiB;
constexpr size_t WS_OA = 448 * MiB, WS_OB = 480 * MiB;
constexpr size_t WS_END = 512 * MiB;

struct Params {
    const float* x; const float* mem; const int* pos; const float* g_mix; const float* w_in; const float* w_up_a; const float* w_up_b; const float* w_out;
    const float* g_mem_q; const float* g_mem_kv; const float* w_q_mem; const float* w_kv_mem; const float* w_o_mem; const float* g_ffn;
    const float* w_ffn_gate; const float* w_ffn_up; const float* w_ffn_down; const float* g_final;
    float* out; unsigned char* ws;
};

typedef float f32x2 __attribute__((ext_vector_type(2)));
typedef __bf16 bf16v2 __attribute__((ext_vector_type(2)));
__device__ __forceinline__ unsigned pk_bf16(float lo, float hi) { f32x2 v = {lo, hi}; bf16v2 r = __builtin_convertvector(v, bf16v2); return __builtin_bit_cast(unsigned, r); }
__device__ __forceinline__ bf16_t f2bf(float f) { return (bf16_t)(pk_bf16(f, 0.f) & 0xffffu); }
__device__ __forceinline__ float bf2f(bf16_t b) { return __uint_as_float(((unsigned)b) << 16); }
__device__ __forceinline__ float bflo(unsigned u) { return __uint_as_float(u << 16); }
__device__ __forceinline__ float bfhi(unsigned u) { return __uint_as_float(u & 0xffff0000u); }
__device__ __forceinline__ float wave_sum(float v) {
#pragma unroll
    for (int o = 1; o < 64; o <<= 1) v += __shfl_xor(v, o);
    return v;
}
__device__ __forceinline__ float sigmoidf_(float x) { return 1.f / (1.f + __expf(-x)); }
__device__ __forceinline__ float rstd_of(const float* ss, int row) {
    const f32x4* p = (const f32x4*)(ss + (size_t)row * 16);
    f32x4 a = p[0], b = p[1], c = p[2], d = p[3];
    float s = ((a[0] + a[1]) + (a[2] + a[3])) + ((b[0] + b[1]) + (b[2] + b[3])) + ((c[0] + c[1]) + (c[2] + c[3])) + ((d[0] + d[1]) + (d[2] + d[3]));
    return rsqrtf(s * (1.f / DM) + EPS);
}


#define XB_TMO      128
#define XB_XCNT(j)  (256  + 64 * (j))
#define XB_XSUB(j)  (1280 + 64 * (j))
#define XB_XGEN(j)  (2304 + 64 * (j))
#define XB_TOP      3328
#define XB_TOPGEN   3392
#define XCD_BAR_WORDS 3456
#define XB_SPIN_CAP (1u << 18)
__device__ __forceinline__ unsigned xb_ld(unsigned* p)              { return __hip_atomic_load(p, __ATOMIC_RELAXED, __HIP_MEMORY_SCOPE_AGENT); }
__device__ __forceinline__ unsigned xb_add(unsigned* p, unsigned v) { return __hip_atomic_fetch_add(p, v, __ATOMIC_RELAXED, __HIP_MEMORY_SCOPE_AGENT); }
__device__ __forceinline__ unsigned xb_xcc_id() { return (unsigned)__builtin_amdgcn_s_getreg((3 << 11) | 20) & 0xFu; }
#define XB_SPIN(cond, bar) do { unsigned _sp = 0; while (cond) { __builtin_amdgcn_s_sleep(1); \
    if ((++_sp & 255u) == 0u) { if (xb_ld(&(bar)[XB_TMO])) break; if (_sp > XB_SPIN_CAP) { atomicAdd(&(bar)[XB_TMO], 1u); break; } } } } while (0)
struct XcdBarrier { unsigned* bar; unsigned x; volatile LAS unsigned* st; };
__device__ __forceinline__ XcdBarrier xcd_barrier_post(unsigned* bar, volatile LAS unsigned* st) {
    XcdBarrier b; b.bar = bar; b.x = xb_xcc_id(); b.st = st;
    if (threadIdx.x == 0) (void)xb_add(&bar[XB_XCNT(b.x)], 1u);
    return b;
}
__device__ __forceinline__ void xcd_barrier_complete(unsigned* bar, unsigned x, unsigned& nloc, unsigned& nx) {
    const unsigned G = gridDim.x * gridDim.y * gridDim.z;
    unsigned sum, cnt, mine, sp = 0u;
    for (;;) {
        sum = 0u; cnt = 0u; mine = 0u;
#pragma unroll
        for (unsigned j = 0; j < 16; ++j) { const unsigned c = xb_ld(&bar[XB_XCNT(j)]); sum += c; cnt += (c > 0u) ? 1u : 0u; mine = (j == x) ? c : mine; }
        if (sum == G) break;
        __builtin_amdgcn_s_sleep(1);
        if ((++sp & 255u) == 0u) { if (xb_ld(&bar[XB_TMO])) break; if (sp > XB_SPIN_CAP) { atomicAdd(&bar[XB_TMO], 1u); break; } }
    }
    nloc = mine > 0u ? mine : 1u; nx = cnt > 0u ? cnt : 1u;
}
__device__ __forceinline__ void xcd_barrier(const XcdBarrier& b) {
    asm volatile("s_waitcnt vmcnt(0)" ::: "memory");
    __syncthreads();
    if (threadIdx.x == 0) {
        unsigned* bar = b.bar;
        __builtin_amdgcn_s_waitcnt(0);
        unsigned nloc = b.st[0], nx = b.st[1];
        if (nloc == 0u) { xcd_barrier_complete(bar, b.x, nloc, nx); b.st[0] = nloc; b.st[1] = nx; }
        const unsigned old = xb_add(&bar[XB_XSUB(b.x)], 1u);
        const unsigned gen = old / nloc;
        if (old + 1u == (gen + 1u) * nloc) {
            __builtin_amdgcn_fence(__ATOMIC_RELEASE, "agent");
            asm volatile("s_waitcnt vmcnt(0)" ::: "memory");
            const unsigned og = xb_add(&bar[XB_TOP], 1u);
            const unsigned tg = og / nx;
            if (og + 1u == (tg + 1u) * nx) xb_add(&bar[XB_TOPGEN], 1u);
            else XB_SPIN(xb_ld(&bar[XB_TOPGEN]) == tg, bar);
            __builtin_amdgcn_fence(__ATOMIC_ACQUIRE, "agent");
            xb_add(&bar[XB_XGEN(b.x)], 1u);
            asm volatile("s_waitcnt vmcnt(0)" ::: "memory");
        } else {
            XB_SPIN(xb_ld(&bar[XB_XGEN(b.x)]) == gen, bar);
            __builtin_amdgcn_fence(__ATOMIC_ACQUIRE, "agent");
            asm volatile("s_waitcnt vmcnt(0)" ::: "memory");
        }
    }
    __syncthreads();
}

namespace pg8 {
constexpr int BM = 256, BK = 64, HALF = 128, HTB = HALF * BK * 2, STAGE_BYTES = 8 * HTB, NXCD = 8, WGM = 8;
__host__ __device__ __forceinline__ int lds_byte(int r, int c) { const int st = (r >> 4) * 2 + (c >> 5), rr = r & 15, cc = c & 31, ob = rr * 64 + cc * 2; return st * 1024 + (ob ^ (((ob >> 9) & 1) << 5)); }
__host__ __device__ __forceinline__ void stage_rc(int b, int& R, int& C) { const int st = b / 1024, sb = b % 1024, swz = sb ^ (((sb >> 9) & 1) << 5); R = (st >> 1) * 16 + swz / 64; C = (st & 1) * 32 + (swz % 64) / 2; }
__host__ __device__ __forceinline__ int perm32(int rho) { const int n = rho >> 4, i = rho & 15; return 8 * (i >> 2) + 4 * n + (i & 3); }
struct Unit { int pm, pn; };
struct Gemm { const bf16_t* A; const bf16_t* Bt; int M, N, K; };
struct StaticOrder {
    int nM, nN, nwg, G, c;
    __host__ __device__ void init(int M, int N, int G_, int c_) { nM = M / BM; nN = N / BM; nwg = nM * nN; G = G_; c = c_; }
    __host__ __device__ bool next(int i, Unit& u) const {
        const long L = (long)i * G + c; if (L >= nwg) return false;
        int wgid = (int)L; { const int q = nwg / NXCD, r = nwg % NXCD, xcd = wgid % NXCD, off = wgid / NXCD; wgid = (xcd < r ? xcd * (q + 1) : r * (q + 1) + (xcd - r) * q) + off; }
        const int nig = WGM * nN, gid = wgid / nig, fm = gid * WGM, gsz = (nM - fm) < WGM ? (nM - fm) : WGM;
        u.pm = fm + ((wgid % nig) % gsz); u.pn = (wgid % nig) / gsz; return true;
    }
};

template <class Epi>
__device__ __forceinline__ void gemm_phase(LAS unsigned char* lds, const Gemm g, const StaticOrder& S, const Epi& E) {
    int tid = threadIdx.x; asm volatile("" : "+v"(tid));
    const int wid = __builtin_amdgcn_readfirstlane(tid >> 6), lane = tid & 63, wr = wid >> 2, wc = wid & 3, fr = lane & 15, fq = lane >> 4;
    const int K = g.K, nt = K / BK;
    unsigned voffA[2], voffB[2];
#pragma unroll
    for (int i = 0; i < 2; ++i) { int R, C; stage_rc(tid * 16 + i * 8192, R, C); const int Rb = Epi::PERM ? ((R & ~31) + perm32(R & 31)) : R;
        voffA[i] = (unsigned)(R * K + C) * 2u; voffB[i] = (unsigned)(Rb * K + C) * 2u; }
    const size_t kstep = (size_t)(BK * 2);
    const size_t hstep = (size_t)HALF * K * 2;
    const size_t tstep = 2 * hstep;
    const unsigned ldsw = (unsigned)wid * 1024u;
    const int aoff = lds_byte(wr * 64 + fr, fq * 8), boff = lds_byte(wc * 32 + fr, fq * 8);
#define PG8_SA(b, h) (((b) * 2 + (h)) * HTB)
#define PG8_SB(b, h) ((4 + (b) * 2 + (h)) * HTB)
#define PG8_STAGE(bufoff, gbase, voff) do { _Pragma("unroll") for (int _i = 0; _i < 2; ++_i) \
        __builtin_amdgcn_global_load_lds((const unsigned*)((const char*)(gbase) + (voff)[_i]), (LAS unsigned*)(lds + (bufoff) + ldsw + _i * 8192), 16, 0, 0); } while (0)
#define PG8_LDA(dst, b, h) do { _Pragma("unroll") for (int m = 0; m < 4; ++m) _Pragma("unroll") for (int k = 0; k < 2; ++k) dst[m][k] = *(const LAS bf16x8*)(lds + PG8_SA(b, h) + aoff + m * 2048 + k * 1024); } while (0)
#define PG8_LDB(dst, b, h) do { _Pragma("unroll") for (int n = 0; n < 2; ++n) _Pragma("unroll") for (int k = 0; k < 2; ++k) dst[n][k] = *(const LAS bf16x8*)(lds + PG8_SB(b, h) + boff + n * 2048 + k * 1024); } while (0)
#define PG8_MMA(ai, bj, At, Bt) do { __builtin_amdgcn_s_setprio(1); _Pragma("unroll") for (int m = 0; m < 4; ++m) _Pragma("unroll") for (int n = 0; n < 2; ++n) _Pragma("unroll") for (int k = 0; k < 2; ++k) \
        acc[ai][bj][m][n] = __builtin_amdgcn_mfma_f32_16x16x32_bf16(Bt[n][k], At[m][k], acc[ai][bj][m][n], 0, 0, 0); __builtin_amdgcn_s_setprio(0); } while (0)
#define PG8_WAIT_V(n) asm volatile("s_waitcnt vmcnt(" #n ")" ::: "memory")
#define PG8_WAIT_L(n) asm volatile("s_waitcnt lgkmcnt(" #n ")" ::: "memory")
#define PG8_BAR __builtin_amdgcn_s_barrier()
#define PG8_SCHED __builtin_amdgcn_sched_barrier(0)
    Unit cur, nxt; int ui = 0;
    if (!S.next(0, cur)) return;
    f32x4 acc[2][2][4][2];
#pragma unroll
    for (int a = 0; a < 2; ++a)
#pragma unroll
        for (int b = 0; b < 2; ++b)
#pragma unroll
            for (int m = 0; m < 4; ++m)
#pragma unroll
                for (int n = 0; n < 2; ++n) acc[a][b][m][n] = (f32x4){0.f, 0.f, 0.f, 0.f};
    bf16x8 At[4][2], B0[2][2], B1[2][2];
    const char* cA = (const char*)g.A + (size_t)cur.pm * tstep; const char* cB = (const char*)g.Bt + (size_t)cur.pn * tstep;
    PG8_STAGE(PG8_SB(0, 0), cB, voffB); PG8_STAGE(PG8_SA(0, 0), cA, voffA); PG8_STAGE(PG8_SB(0, 1), cB + hstep, voffB); PG8_STAGE(PG8_SA(0, 1), cA + hstep, voffA);
    if (wr == 1) PG8_BAR;
    PG8_WAIT_V(4); PG8_BAR;
    PG8_STAGE(PG8_SB(1, 0), cB + kstep, voffB); PG8_STAGE(PG8_SA(1, 0), cA + kstep, voffA); PG8_STAGE(PG8_SB(1, 1), cB + hstep + kstep, voffB);
    PG8_WAIT_V(6); PG8_BAR;
    for (;;) {
        const bool has_next = S.next(ui + 1, nxt);
        const char* nA = has_next ? (const char*)g.A + (size_t)nxt.pm * tstep : cA; const char* nB = has_next ? (const char*)g.Bt + (size_t)nxt.pn * tstep : cB;
        for (int t = 0; t < nt; t += 2) {
            const bool last = (t == nt - 2);
            const char* a1 = cA + (size_t)(t + 1) * kstep;
            const char* a2 = last ? nA : cA + (size_t)(t + 2) * kstep; const char* b2 = last ? nB : cB + (size_t)(t + 2) * kstep;
            const char* a3 = a2 + kstep; const char* b3 = b2 + kstep;
            if constexpr (Epi::HAS_MID) { if (t == nt / 2) E.mid(acc, cur, wr, wc, fr, fq); }
            PG8_LDB(B0, 0, 0); PG8_SCHED; PG8_LDA(At, 0, 0); PG8_STAGE(PG8_SA(1, 1), a1 + hstep, voffA);
            PG8_WAIT_L(8); PG8_BAR; PG8_WAIT_L(0); PG8_MMA(0, 0, At, B0); PG8_BAR; PG8_SCHED;
            PG8_LDB(B1, 0, 1); PG8_STAGE(PG8_SB(0, 0), b2, voffB);
            PG8_BAR; PG8_WAIT_L(0); PG8_MMA(0, 1, At, B1); PG8_BAR;
            PG8_LDA(At, 0, 1); PG8_STAGE(PG8_SA(0, 0), a2, voffA);
            PG8_BAR; PG8_WAIT_L(0); PG8_MMA(1, 0, At, B0); PG8_BAR; PG8_SCHED;
            PG8_STAGE(PG8_SB(0, 1), b2 + hstep, voffB);
            PG8_WAIT_V(6); PG8_BAR; PG8_MMA(1, 1, At, B1); PG8_BAR;
            PG8_LDB(B0, 1, 0); PG8_SCHED; PG8_LDA(At, 1, 0); PG8_STAGE(PG8_SA(0, 1), a2 + hstep, voffA);
            PG8_WAIT_L(8); PG8_BAR; PG8_WAIT_L(0); PG8_MMA(0, 0, At, B0); PG8_BAR; PG8_SCHED;
            PG8_LDB(B1, 1, 1); PG8_STAGE(PG8_SB(1, 0), b3, voffB);
            PG8_BAR; PG8_WAIT_L(0); PG8_MMA(0, 1, At, B1); PG8_BAR;
            PG8_LDA(At, 1, 1); PG8_STAGE(PG8_SA(1, 0), a3, voffA);
            PG8_BAR; PG8_WAIT_L(0); PG8_MMA(1, 0, At, B0); PG8_BAR; PG8_SCHED;
            PG8_STAGE(PG8_SB(1, 1), b3 + hstep, voffB);
            PG8_WAIT_V(6); PG8_BAR; PG8_MMA(1, 1, At, B1); PG8_BAR;
        }
        E(acc, cur, wr, wc, fr, fq);
        if (!has_next) break;
#pragma unroll
        for (int a = 0; a < 2; ++a)
#pragma unroll
            for (int b = 0; b < 2; ++b)
#pragma unroll
                for (int m = 0; m < 4; ++m)
#pragma unroll
                    for (int n = 0; n < 2; ++n) acc[a][b][m][n] = (f32x4){0.f, 0.f, 0.f, 0.f};
        cur = nxt; cA = nA; cB = nB; ++ui;
    }
    PG8_WAIT_V(0);
    if (wr == 0) PG8_BAR;
    PG8_BAR;
#undef PG8_SA
#undef PG8_SB
#undef PG8_STAGE
#undef PG8_LDA
#undef PG8_LDB
#undef PG8_MMA
#undef PG8_WAIT_V
#undef PG8_WAIT_L
#undef PG8_BAR
#undef PG8_SCHED
}
}
using pg8::Unit; using pg8::Gemm;

struct EpiBf16 {
    static constexpr bool PERM = true, HAS_MID = false;
    bf16_t* O; int ldc; const float* ss; int sig_from; const float* rope; int rope_below;
    __device__ __forceinline__ void operator()(const f32x4 (&acc)[2][2][4][2], const Unit& u, int wr, int wc, int fr, int fq) const {
        const int row0 = u.pm * 256 + wr * 64 + fr, col0 = u.pn * 256 + wc * 32 + 8 * fq;
        const bool sig = u.pn >= sig_from;
#pragma unroll
        for (int ai = 0; ai < 2; ++ai)
#pragma unroll
            for (int m = 0; m < 4; ++m) {
                const int row = row0 + ai * 128 + m * 16;
                const float rs = ss ? rstd_of(ss, row) : 1.f;
#pragma unroll
                for (int bj = 0; bj < 2; ++bj) {
                    f32x4 v0 = acc[ai][bj][m][0] * rs, v1 = acc[ai][bj][m][1] * rs;
                    if (sig) {
#pragma unroll
                        for (int j = 0; j < 4; ++j) { v0[j] = sigmoidf_(v0[j]); v1[j] = sigmoidf_(v1[j]); }
                    }
                    if (u.pn < rope_below && (wc & 1) == 0) {
                        f32x4 p0, p1;
#pragma unroll
                        for (int j = 0; j < 4; ++j) { p0[j] = __shfl_xor(v0[j], 16); p1[j] = __shfl_xor(v1[j], 16); }
                        if (fq < 2) {
                            const f32x4 c0 = *(const f32x4*)(rope + (size_t)row * 16), c1 = *(const f32x4*)(rope + (size_t)row * 16 + 4);
                            f32x4 s0 = *(const f32x4*)(rope + (size_t)row * 16 + 8), s1 = *(const f32x4*)(rope + (size_t)row * 16 + 12);
                            if (fq == 0) { s0 = -s0; s1 = -s1; }
                            v0 = v0 * c0 + p0 * s0; v1 = v1 * c1 + p1 * s1;
                        }
                    }
                    u32x4 o; o[0] = pk_bf16(v0[0], v0[1]); o[1] = pk_bf16(v0[2], v0[3]); o[2] = pk_bf16(v1[0], v1[1]); o[3] = pk_bf16(v1[2], v1[3]);
                    *(u32x4*)(O + (size_t)row * ldc + col0 + bj * 128) = o;
                }
            }
    }
};
struct EpiGate {
    static constexpr bool PERM = true, HAS_MID = true;
    const bf16_t* proj; bf16_t* O;
    __device__ __forceinline__ void mid(f32x4 (&acc)[2][2][4][2], const Unit& u, int wr, int wc, int fr, int fq) const {
        int row0 = u.pm * 256 + wr * 64 + fr, col0 = u.pn * 256 + wc * 32 + 8 * fq;
        asm volatile("" : "+v"(row0), "+v"(col0));
#pragma unroll
        for (int ai = 0; ai < 2; ++ai)
#pragma unroll
            for (int m = 0; m < 4; ++m) {
                const int row = row0 + ai * 128 + m * 16;
#pragma unroll
                for (int bj = 0; bj < 2; ++bj) {
                    const int col = col0 + bj * 128;
                    const u32x4 ga = *(const u32x4*)(proj + (size_t)row * INC + C_GA + col), gb = *(const u32x4*)(proj + (size_t)row * INC + C_GB + col);
#pragma unroll
                    for (int q = 0; q < 4; ++q) {
                        const float a0 = bflo(ga[q]), a1 = bfhi(ga[q]), b0 = fmaxf(bflo(gb[q]), -60.f), b1 = fmaxf(bfhi(gb[q]), -60.f);
                        const float r0 = (1.f + __expf(-b0)) * __builtin_amdgcn_rcpf(1.f + __expf(-a0)), r1 = (1.f + __expf(-b1)) * __builtin_amdgcn_rcpf(1.f + __expf(-a1));
                        acc[ai][bj][m][q >> 1][(q & 1) * 2] *= r0; acc[ai][bj][m][q >> 1][(q & 1) * 2 + 1] *= r1;
                    }
                }
                __builtin_amdgcn_sched_barrier(0);
            }
    }
    __device__ __forceinline__ void operator()(const f32x4 (&acc)[2][2][4][2], const Unit& u, int wr, int wc, int fr, int fq) const {
        const int row0 = u.pm * 256 + wr * 64 + fr, col0 = u.pn * 256 + wc * 32 + 8 * fq;
#pragma unroll
        for (int ai = 0; ai < 2; ++ai)
#pragma unroll
            for (int m = 0; m < 4; ++m) {
                const int row = row0 + ai * 128 + m * 16;
#pragma unroll
                for (int bj = 0; bj < 2; ++bj) {
                    const int col = col0 + bj * 128;
                    const u32x4 gb = *(const u32x4*)(proj + (size_t)row * INC + C_GB + col);
                    float r[8];
#pragma unroll
                    for (int q = 0; q < 4; ++q) {
                        const float b0 = fmaxf(bflo(gb[q]), -60.f), b1 = fmaxf(bfhi(gb[q]), -60.f);
                        r[2 * q] = acc[ai][bj][m][q >> 1][(q & 1) * 2] * __builtin_amdgcn_rcpf(1.f + __expf(-b0));
                        r[2 * q + 1] = acc[ai][bj][m][q >> 1][(q & 1) * 2 + 1] * __builtin_amdgcn_rcpf(1.f + __expf(-b1));
                    }
                    u32x4 o; o[0] = pk_bf16(r[0], r[1]); o[1] = pk_bf16(r[2], r[3]); o[2] = pk_bf16(r[4], r[5]); o[3] = pk_bf16(r[6], r[7]);
                    *(u32x4*)(O + (size_t)row * DM + col) = o;
                }
            }
    }
};
struct EpiRes {
    static constexpr bool PERM = false, HAS_MID = false;
    const float* R; const bf16_t* Rb; float* H; bf16_t* Hb; float* SS;
    __device__ __forceinline__ void operator()(const f32x4 (&acc)[2][2][4][2], const Unit& u, int wr, int wc, int fr, int fq) const {
        const int row0 = u.pm * 256 + wr * 64 + fr, col0 = u.pn * 256 + wc * 32 + 4 * fq;
#pragma unroll
        for (int ai = 0; ai < 2; ++ai)
#pragma unroll
            for (int m = 0; m < 4; ++m) {
                const int row = row0 + ai * 128 + m * 16;
                float s = 0.f;
#pragma unroll
                for (int bj = 0; bj < 2; ++bj)
#pragma unroll
                    for (int n = 0; n < 2; ++n) {
                        const int col = col0 + bj * 128 + n * 16;
                        f32x4 rr;
                        if (R) rr = *(const f32x4*)(R + (size_t)row * DM + col);
                        else { const u32x2 rb = *(const u32x2*)(Rb + (size_t)row * DM + col); rr[0] = bflo(rb[0]); rr[1] = bfhi(rb[0]); rr[2] = bflo(rb[1]); rr[3] = bfhi(rb[1]); }
                        const f32x4 h = rr + acc[ai][bj][m][n];
                        if (H) *(f32x4*)(H + (size_t)row * DM + col) = h;
                        if (Hb) { u32x2 o; o[0] = pk_bf16(h[0], h[1]); o[1] = pk_bf16(h[2], h[3]); *(u32x2*)(Hb + (size_t)row * DM + col) = o; }
                        s += (h[0] * h[0] + h[1] * h[1]) + (h[2] * h[2] + h[3] * h[3]);
                    }
                s += __shfl_xor(s, 16); s += __shfl_xor(s, 32);
                if (fq == 0) SS[(size_t)row * 16 + u.pn * 4 + wc] = s;
            }
    }
};
struct EpiSwiGLU {
    static constexpr bool PERM = true, HAS_MID = false;
    bf16_t* O; const float* ss;
    __device__ __forceinline__ void operator()(const f32x4 (&acc)[2][2][4][2], const Unit& u, int wr, int wc, int fr, int fq) const {
        const int row0 = u.pm * 256 + wr * 64 + fr, col0 = u.pn * 128 + wc * 32 + 8 * fq;
#pragma unroll
        for (int ai = 0; ai < 2; ++ai)
#pragma unroll
            for (int m = 0; m < 4; ++m) {
                const int row = row0 + ai * 128 + m * 16;
                const float rs = rstd_of(ss, row);
                float r[8];
#pragma unroll
                for (int n = 0; n < 2; ++n)
#pragma unroll
                    for (int j = 0; j < 4; ++j) { const float gg = acc[ai][0][m][n][j] * rs, uu = acc[ai][1][m][n][j] * rs; r[n * 4 + j] = gg * sigmoidf_(gg) * uu; }
                u32x4 o; o[0] = pk_bf16(r[0], r[1]); o[1] = pk_bf16(r[2], r[3]); o[2] = pk_bf16(r[4], r[5]); o[3] = pk_bf16(r[6], r[7]);
                *(u32x4*)(O + (size_t)row * DFF + col0) = o;
            }
    }
};

struct Ctx { int tid, lane, wave, gw, ngw, gt, ngt; };

__device__ __forceinline__ void p_transpose(const Ctx& c, LAS unsigned char* lds, const float* W, bf16_t* Wt, int K, int N, const float* g, int mode, int& cursor, int ldw = 0, int koff = 0) {
    if (ldw == 0) ldw = K;
    LAS float* scr = (LAS float*)(lds + c.wave * 8704);
    const int nblk = N / 32, nitems = (K / 64) * nblk, lane = c.lane;
    int first = (c.gw - cursor % c.ngw + c.ngw) % c.ngw;
    for (int it = first; it < nitems; it += c.ngw) {
        const int kb = it / nblk, nb = it % nblk, k0 = 64 * kb, n0 = 32 * nb;
#pragma unroll 8
        for (int i = 0; i < 32; ++i) { const int kk = 2 * i + (lane >> 5); float v = W[(size_t)(k0 + kk) * N + n0 + (lane & 31)]; if (g) v *= g[k0 + kk]; scr[kk * 33 + (lane & 31)] = v; }
        asm volatile("s_waitcnt lgkmcnt(0)" ::: "memory");
        const int ch = lane & 7;
#pragma unroll
        for (int j = 0; j < 4; ++j) { const int n = (lane >> 3) + 8 * j; const LAS float* sp = scr + (8 * ch) * 33 + n;
            u32x4 o; o[0] = pk_bf16(sp[0], sp[33]); o[1] = pk_bf16(sp[2 * 33], sp[3 * 33]); o[2] = pk_bf16(sp[4 * 33], sp[5 * 33]); o[3] = pk_bf16(sp[6 * 33], sp[7 * 33]);
            const int nn = n0 + n, row = mode == 0 ? nn : (256 * (nn >> 7) + (nn & 127) + (mode == 2 ? 128 : 0));
            *(u32x4*)(Wt + (size_t)row * ldw + koff + k0 + 8 * ch) = o; }
        asm volatile("s_waitcnt lgkmcnt(0)" ::: "memory");
    }
    cursor += nitems;
}
__device__ __forceinline__ void p_rmsnorm_rows(const Ctx& c, const float* x, const float* g, bf16_t* out, int rows) {
    for (int r = c.gw; r < rows; r += c.ngw) {
        const f32x4* xr = (const f32x4*)(x + (size_t)r * DM) + c.lane;
        f32x4 v[4]; float s = 0.f;
#pragma unroll
        for (int j = 0; j < 4; ++j) { v[j] = xr[64 * j]; s += (v[j][0] * v[j][0] + v[j][1] * v[j][1]) + (v[j][2] * v[j][2] + v[j][3] * v[j][3]); }
        const float rs = rsqrtf(wave_sum(s) * (1.f / DM) + EPS);
#pragma unroll
        for (int j = 0; j < 4; ++j) {
            const f32x4 gg = ((const f32x4*)g)[c.lane + 64 * j];
            u32x2 o; o[0] = pk_bf16(v[j][0] * rs * gg[0], v[j][1] * rs * gg[1]); o[1] = pk_bf16(v[j][2] * rs * gg[2], v[j][3] * rs * gg[3]);
            ((u32x2*)(out + (size_t)r * DM))[c.lane + 64 * j] = o;
        }
    }
}
__device__ __forceinline__ void p_rope_table(const Ctx& c, const int* pos, float* tab) {
    for (int i = c.gt; i < T * 8; i += c.ngt) {
        const int tok = i >> 3, f = i & 7;
        const double inv = f == 0 ? 1.0 : f == 1 ? 0.19392274474868576 : f == 2 ? 0.03760603093086393 : f == 3 ? 0.007292664737217109 : f == 4 ? 0.001414213562373095 :
                           f == 5 ? 0.0002742481756762073 : f == 6 ? 5.318295896944988e-05 : 1.031338537721246e-05;
        const double rev = (double)pos[tok] * inv * 0.15915494309189535;
        const float fr = (float)(rev - rint(rev));
        tab[(size_t)tok * 16 + f] = __builtin_amdgcn_cosf(fr);
        tab[(size_t)tok * 16 + 8 + f] = __builtin_amdgcn_sinf(fr);
    }
}
__device__ __forceinline__ void p_rope_apply(const Ctx& c, bf16_t* proj, const float* tab) {
    for (int i = c.gt; i < T * 2 * NHA * 8; i += c.ngt) {
        const int f = i & 7, h = (i >> 3) & 7, which = (i >> 6) & 1, tok = i >> 7;
        bf16_t* p = proj + (size_t)tok * INC + (which ? C_KA : C_QA) + h * HD + f;
        const float x1 = bf2f(p[0]), x2 = bf2f(p[8]), cs = tab[(size_t)tok * 16 + f], sn = tab[(size_t)tok * 16 + 8 + f];
        p[0] = f2bf(x1 * cs - x2 * sn); p[8] = f2bf(x2 * cs + x1 * sn);
    }
}
__device__ __forceinline__ void p_attn_a_naive(const Ctx& c, const bf16_t* proj, bf16_t* OA) {
    for (int it = c.gw; it < T * NHA; it += c.ngw) {
        const int h = it & 7, tok = it >> 3, t = tok & (SEQ - 1), tb = tok - t;
        const float q = bf2f(proj[(size_t)tok * INC + C_QA + h * HD + c.lane]) * 0.125f;
        float og[3], lse[3];
#pragma unroll
        for (int gi = 0; gi < 3; ++gi) {
            const int d = gi == 0 ? 1 : (gi == 1 ? 4 : 16);
            float m = -INFINITY, l = 0.f, o = 0.f;
            for (int j = 0; j <= 128; ++j) {
                const int tk = t - j * d; if (tk < 0) break;
                const bf16_t* kr = proj + (size_t)(tb + tk) * INC + h * HD + c.lane;
                const float s = wave_sum(q * bf2f(kr[C_KA]));
                const float mn = fmaxf(m, s), sc = __expf(m - mn), p = __expf(s - mn);
                l = l * sc + p; o = o * sc + p * bf2f(kr[C_VA]); m = mn;
            }
            og[gi] = o / l; lse[gi] = m + __logf(l);
        }
        const float M = fmaxf(lse[0], fmaxf(lse[1], lse[2]));
        const float w0 = __expf(lse[0] - M), w1 = __expf(lse[1] - M), w2 = __expf(lse[2] - M);
        OA[(size_t)tok * 1024 + h * HD + c.lane] = f2bf((w0 * og[0] + w1 * og[1] + w2 * og[2]) / (w0 + w1 + w2));
    }
}
__device__ __forceinline__ void p_attn_b_naive(const Ctx& c, const bf16_t* proj, bf16_t* OB) {
    for (int it = c.gw; it < T * NHB; it += c.ngw) {
        const int h = it & 7, tok = it >> 3, t = tok & (SEQ - 1), tb = tok - t;
        const float q = bf2f(proj[(size_t)tok * INC + C_QB + h * HD + c.lane]) * 0.125f;
        float run = 0.f, o = 0.f;
        for (int tk = t - 1; tk >= 0; --tk) {
            const bf16_t* kr = proj + (size_t)(tb + tk) * INC + h * HD + c.lane;
            const float z = wave_sum(q * bf2f(kr[C_KB]));
            const float sp = fmaxf(z, 0.f) + log1pf(__expf(-fabsf(z)));
            const float a = __expf(z - sp + run);
            o += a * bf2f(kr[C_VB]);
            run -= sp;
        }
        OB[(size_t)tok * 1024 + h * HD + c.lane] = f2bf(o);
    }
}
__device__ __forceinline__ void p_attn_mem_naive(const Ctx& c, const bf16_t* qm, const bf16_t* kvm, bf16_t* om) {
    const float sc = 0.08838834764831845f;
    for (int it = c.gw; it < T * 4; it += c.ngw) {
        const int h = it & 3, tok = it >> 2, b = tok >> 11;
        const float q0 = bf2f(qm[(size_t)tok * MEMW + h * 128 + c.lane]) * sc, q1 = bf2f(qm[(size_t)tok * MEMW + h * 128 + 64 + c.lane]) * sc;
        float m = -INFINITY, l = 0.f, o0 = 0.f, o1 = 0.f;
        for (int j = 0; j < NMEM; ++j) {
            const bf16_t* kr = kvm + (size_t)(b * NMEM + j) * 1024 + h * 128 + c.lane;
            const float s = wave_sum(q0 * bf2f(kr[0]) + q1 * bf2f(kr[64]));
            const float mn = fmaxf(m, s), scl = __expf(m - mn), p = __expf(s - mn);
            l = l * scl + p; o0 = o0 * scl + p * bf2f(kr[512]); o1 = o1 * scl + p * bf2f(kr[512 + 64]); m = mn;
        }
        om[(size_t)tok * MEMW + h * 128 + c.lane] = f2bf(o0 / l); om[(size_t)tok * MEMW + h * 128 + 64 + c.lane] = f2bf(o1 / l);
    }
}
__device__ __forceinline__ void p_final(const Ctx& c, float* out, const float* ss, const float* g) {
    for (int r = c.gw; r < T; r += c.ngw) {
        const float rs = rstd_of(ss, r);
        f32x4* xr = (f32x4*)(out + (size_t)r * DM) + c.lane;
#pragma unroll
        for (int j = 0; j < 4; ++j) { const f32x4 gg = ((const f32x4*)g)[c.lane + 64 * j]; f32x4 v = xr[64 * j]; v = v * rs * gg; xr[64 * j] = v; }
    }
}


typedef float f32x16 __attribute__((ext_vector_type(16)));
typedef short s16x4 __attribute__((ext_vector_type(4)));
#define MFMA32(a, b, c) __builtin_amdgcn_mfma_f32_32x32x16_bf16((a), (b), (c), 0, 0, 0)
constexpr int ATT_FLAG_OFF = 40960;
template <int MODE, int HDIM>
__device__ __forceinline__ void attn_item(LAS unsigned char* lds, const bf16_t* Qp, int ldq, const bf16_t* Kp, const bf16_t* Vp, int ldkv, bf16_t* Op, int ldo, int q0, int nkeys) {
    constexpr int KS = HDIM / 16, DD = HDIM / 32, KROW = HDIM * 2 + 16, VROW = 64 * 2 + 8, NCH = HDIM / 8, PER = 64 * NCH / 512;
    int tid = threadIdx.x; asm volatile("" : "+v"(tid));
    const int lane = tid & 63, w = __builtin_amdgcn_readfirstlane(tid >> 6), r = lane & 31, hh = lane >> 5;
    const int tq0 = q0 + 32 * w, tq = tq0 + r;
    LAS unsigned char* Ks = lds; LAS unsigned char* Vt = lds + 64 * KROW;
    LAS unsigned* flags = (LAS unsigned*)(lds + ATT_FLAG_OFF);
    bf16x8 Qf[KS];
#pragma unroll
    for (int ks = 0; ks < KS; ++ks) Qf[ks] = *(const bf16x8*)(Qp + (size_t)tq * ldq + 16 * ks + 8 * hh);
    f32x16 Oacc[DD];
#pragma unroll
    for (int dd = 0; dd < DD; ++dd)
#pragma unroll
        for (int i = 0; i < 16; ++i) Oacc[dd][i] = 0.f;
    float m = -INFINITY, l = 0.f, run = 0.f; unsigned done_w = 0u;
    const int kt_hi = (MODE == 2) ? (nkeys / 64 - 1) : ((q0 + 255) >> 6);
    u32x4 kreg[PER], vreg[PER];
#define ATT_GLOAD(kt) do { _Pragma("unroll") for (int p_ = 0; p_ < PER; ++p_) { const int idx_ = tid + 512 * p_, key_ = idx_ / NCH, ch_ = idx_ % NCH; \
        kreg[p_] = *(const u32x4*)(Kp + (size_t)(64 * (kt) + key_) * ldkv + ch_ * 8); vreg[p_] = *(const u32x4*)(Vp + (size_t)(64 * (kt) + key_) * ldkv + ch_ * 8); } } while (0)
    ATT_GLOAD(kt_hi);
    for (int kt = kt_hi; kt >= 0; --kt) {
        if (MODE == 1 && lane == 0) flags[w] = done_w;
        __syncthreads();
#pragma unroll
        for (int p_ = 0; p_ < PER; ++p_) { const int idx_ = tid + 512 * p_, key_ = idx_ / NCH, ch_ = idx_ % NCH;
            *(LAS u32x4*)(Ks + key_ * KROW + ch_ * 16) = kreg[p_];
#pragma unroll
            for (int j = 0; j < 8; ++j) *(LAS bf16_t*)(Vt + (ch_ * 8 + j) * VROW + key_ * 2) = (bf16_t)((vreg[p_][j >> 1] >> (16 * (j & 1))) & 0xffffu);
        }
        bool alldone = false;
        if (MODE == 1) { unsigned a = 1u;
#pragma unroll
            for (int i = 0; i < 8; ++i) a &= flags[i];
            alldone = a != 0u; }
        __syncthreads();
        if (MODE == 1 && alldone) break;
        if (kt > 0) ATT_GLOAD(kt - 1);
#pragma unroll
        for (int sub = 1; sub >= 0; --sub) {
            const int tk0 = 64 * kt + 32 * sub;
            if (MODE != 2 && tk0 > tq0 + 31) continue;
            if (MODE == 1 && done_w) continue;
            f32x16 S;
#pragma unroll
            for (int i = 0; i < 16; ++i) S[i] = 0.f;
#pragma unroll
            for (int ks = 0; ks < KS; ++ks) { const bf16x8 kf = *(const LAS bf16x8*)(Ks + (32 * sub + r) * KROW + (16 * ks + 8 * hh) * 2); S = MFMA32(kf, Qf[ks], S); }
            const int dbase = tq - tk0 - 4 * hh;
            if (MODE == 0 || MODE == 2) {
                const float C = (MODE == 0 ? 0.125f : 0.08838834764831845f) * 1.4426950408889634f;
                float fm[16]; float mx = -INFINITY;
#pragma unroll
                for (int i = 0; i < 16; ++i) {
                    float v = S[i] * C;
                    if (MODE == 0) { const int d = dbase - ((i & 3) + 8 * (i >> 2));
                        int mult = (d <= 128 ? 1 : 0) + ((((d & 3) == 0) && d <= 512) ? 1 : 0) + (((d & 15) == 0) ? 1 : 0);
                        mult = d >= 0 ? mult : 0; fm[i] = (float)mult; v = mult > 0 ? v : -INFINITY; }
                    else fm[i] = 1.f;
                    S[i] = v; mx = fmaxf(mx, v);
                }
                mx = fmaxf(mx, __shfl_xor(mx, 32));
                const float mn = fmaxf(m, mx), ms = (mn == -INFINITY) ? 0.f : mn;
                const float alpha = __builtin_amdgcn_exp2f(m - ms);
                float ls = 0.f;
#pragma unroll
                for (int i = 0; i < 16; ++i) { const float p = fm[i] * __builtin_amdgcn_exp2f(S[i] - ms); S[i] = p; ls += p; }
                l = l * alpha + ls; m = mn;
#pragma unroll
                for (int dd = 0; dd < DD; ++dd) Oacc[dd] = Oacc[dd] * alpha;
            } else {
                float sp[16], ex[16], G[4], PG[4];
#pragma unroll
                for (int i = 0; i < 16; ++i) { const int d = dbase - ((i & 3) + 8 * (i >> 2)); const bool valid = d > 0;
                    const float z = S[i] * 0.125f; const float e = __expf(-fabsf(z)); const float spv = fmaxf(z, 0.f) + __logf(1.f + e);
                    sp[i] = valid ? spv : 0.f; S[i] = valid ? (z - spv) : -INFINITY; }
#pragma unroll
                for (int g = 0; g < 4; ++g) { ex[4 * g + 3] = 0.f; ex[4 * g + 2] = sp[4 * g + 3]; ex[4 * g + 1] = ex[4 * g + 2] + sp[4 * g + 2]; ex[4 * g] = ex[4 * g + 1] + sp[4 * g + 1]; G[g] = ex[4 * g] + sp[4 * g]; }
#pragma unroll
                for (int g = 0; g < 4; ++g) PG[g] = __shfl_xor(G[g], 32);
                float later[4]; float suf = 0.f;
#pragma unroll
                for (int g = 3; g >= 0; --g) { later[g] = suf + (hh == 0 ? PG[g] : 0.f); suf += G[g] + PG[g]; }
#pragma unroll
                for (int i = 0; i < 16; ++i) S[i] = __expf(S[i] - (run + later[i >> 2] + ex[i]));
                run += suf;
                done_w = __all(run > 104.f) ? 1u : 0u;
            }
            u32x4 pp0, pp1;
#pragma unroll
            for (int j = 0; j < 4; ++j) { pp0[j] = pk_bf16(S[2 * j], S[2 * j + 1]); pp1[j] = pk_bf16(S[8 + 2 * j], S[8 + 2 * j + 1]); }
            const bf16x8 P0 = __builtin_bit_cast(bf16x8, pp0), P1 = __builtin_bit_cast(bf16x8, pp1);
#pragma unroll
            for (int dd = 0; dd < DD; ++dd)
#pragma unroll
                for (int s2 = 0; s2 < 2; ++s2) {
                    const LAS unsigned char* vp = Vt + (32 * dd + r) * VROW + (32 * sub + 16 * s2 + 4 * hh) * 2;
                    const s16x4 lo = *(const LAS s16x4*)vp, hi = *(const LAS s16x4*)(vp + 16);
                    const bf16x8 vf = __builtin_shufflevector(lo, hi, 0, 1, 2, 3, 4, 5, 6, 7);
                    Oacc[dd] = MFMA32(vf, s2 ? P1 : P0, Oacc[dd]);
                }
        }
    }
#undef ATT_GLOAD
    float inv = 1.f;
    if (MODE != 1) { const float lt = l + __shfl_xor(l, 32); inv = 1.f / lt; }
#pragma unroll
    for (int dd = 0; dd < DD; ++dd)
#pragma unroll
        for (int g = 0; g < 4; ++g) {
            u32x2 o; o[0] = pk_bf16(Oacc[dd][4 * g] * inv, Oacc[dd][4 * g + 1] * inv); o[1] = pk_bf16(Oacc[dd][4 * g + 2] * inv, Oacc[dd][4 * g + 3] * inv);
            *(u32x2*)(Op + (size_t)tq * ldo + 32 * dd + 8 * g + 4 * hh) = o;
        }
}
__device__ __forceinline__ void p_attn_ab(LAS unsigned char* lds, const bf16_t* proj, bf16_t* OA, bf16_t* OB) {
    for (int v = blockIdx.x; v < 256; v += gridDim.x) {
        const int bh = v >> 1, b = bh >> 3, h = bh & 7, par = v & 1;
        const bf16_t* base = proj + (size_t)b * SEQ * INC + h * HD;
        for (int k = 0; k < 4; ++k) { const int qb = (k == 0) ? 7 - par : (k == 1) ? par : (k == 2) ? 5 - par : 2 + par;
            attn_item<0, 64>(lds, base + C_QA, INC, base + C_KA, base + C_VA, INC, OA + (size_t)b * SEQ * 1024 + h * HD, 1024, qb * 256, SEQ); }
        for (int k = 0; k < 4; ++k) { const int qb = (k == 0) ? 7 - par : (k == 1) ? par : (k == 2) ? 5 - par : 2 + par;
            attn_item<1, 64>(lds, base + C_QB, INC, base + C_KB, base + C_VB, INC, OB + (size_t)b * SEQ * 1024 + h * HD, 1024, qb * 256, SEQ); }
    }
}
__device__ __forceinline__ void p_attn_mem(LAS unsigned char* lds, const bf16_t* qm, const bf16_t* kvm, bf16_t* om) {
    for (int it = blockIdx.x; it < BATCH * 4 * 8; it += gridDim.x) {
        const int qb = it & 7, h = (it >> 3) & 3, b = it >> 5;
        attn_item<2, 128>(lds, qm + (size_t)b * SEQ * MEMW + h * 128, MEMW, kvm + (size_t)b * NMEM * 1024 + h * 128, kvm + (size_t)b * NMEM * 1024 + 512 + h * 128, 1024,
                          om + (size_t)b * SEQ * MEMW + h * 128, MEMW, qb * 256, NMEM);
    }
}

__device__ __forceinline__ bool sync_if(int k, cg::grid_group& grid, XcdBarrier& xb) {
    if (k == 1) { grid.sync(); xb = xcd_barrier_post(xb.bar, xb.st); }
    else if (k > 1) xcd_barrier(xb);
    asm volatile("" ::: "memory"); return true; }
constexpr int NPHASE = 13;
#ifndef NAIVE_AB
#define NAIVE_AB 0
#endif
#ifndef NAIVE_MEM
#define NAIVE_MEM 0
#endif
#ifndef ONLY
#define ONLY -1
#endif
#ifndef DUP_MASK
#define DUP_MASK 0
#endif
#define PHASE(k) if ((ONLY < 0 || ONLY == (k)) && ph_lo <= (k) && (k) < ph_hi) if (sync_if((k), grid, xb)) for (int rep_ = 0; rep_ < (((DUP_MASK >> (k)) & 1) ? 2 : 1); ++rep_)
__global__ __launch_bounds__(512, 2) void mega(Params p, int ph_lo, int ph_hi) {
    extern __shared__ __attribute__((aligned(16))) unsigned char shm[];
    LAS unsigned char* lds = (LAS unsigned char*)shm;
    cg::grid_group grid = cg::this_grid();
    Ctx c; c.tid = threadIdx.x; c.lane = c.tid & 63; c.wave = c.tid >> 6; c.gw = blockIdx.x * 8 + c.wave; c.ngw = gridDim.x * 8; c.gt = blockIdx.x * 512 + c.tid; c.ngt = gridDim.x * 512;
    unsigned char* ws = p.ws;
    bf16_t* Wt_in = (bf16_t*)(ws + WS_WIN); bf16_t* Wt_upa = (bf16_t*)(ws + WS_WUPA); bf16_t* Wt_upb = (bf16_t*)(ws + WS_WUPB); bf16_t* Wt_out = (bf16_t*)(ws + WS_WOUT);
    bf16_t* Wt_qm = (bf16_t*)(ws + WS_WQM); bf16_t* Wt_kvm = (bf16_t*)(ws + WS_WKVM); bf16_t* Wt_om = (bf16_t*)(ws + WS_WOM); bf16_t* Wt_gu = (bf16_t*)(ws + WS_WGU); bf16_t* Wt_dn = (bf16_t*)(ws + WS_WDN);
    bf16_t* memn = (bf16_t*)(ws + WS_MEMN); bf16_t* kvm = (bf16_t*)(ws + WS_KVM);
    float* ss1 = (float*)(ws + WS_SS1); float* ss2 = (float*)(ws + WS_SS2); float* ss3 = (float*)(ws + WS_SS3); float* rope = (float*)(ws + WS_ROPE);
    bf16_t* n1 = (bf16_t*)(ws + WS_R1); bf16_t* mixed = (bf16_t*)(ws + WS_R1); bf16_t* h2b = (bf16_t*)(ws + WS_R1);
    bf16_t* proj = (bf16_t*)(ws + WS_PROJ);
    float* h1 = (float*)(ws + WS_H1); bf16_t* h1b = (bf16_t*)(ws + WS_H1B); bf16_t* qm = (bf16_t*)(ws + WS_QM); bf16_t* om = (bf16_t*)(ws + WS_OM);
    float* h2 = (float*)(ws + WS_H2); bf16_t* act = (bf16_t*)(ws + WS_ACT); bf16_t* OA = (bf16_t*)(ws + WS_OA); bf16_t* OB = (bf16_t*)(ws + WS_OA) + 512;
    float* m1 = p.out; unsigned* bar = (unsigned*)(ws + WS_BAR);
    volatile LAS unsigned* xst = (volatile LAS unsigned*)(lds + pg8::STAGE_BYTES);
    if (c.tid == 0) { xst[0] = 0u; xst[1] = 0u; }
    __syncthreads();
    XcdBarrier xb; xb.bar = bar; xb.x = 0u; xb.st = xst;
    pg8::StaticOrder S;
    {
        PHASE(0) {
            int cur = 0;
            p_transpose(c, lds, p.w_in, Wt_in, DM, INC, nullptr, 0, cur);
            p_transpose(c, lds, p.w_ffn_gate, Wt_gu, DM, DFF, p.g_ffn, 1, cur);
            p_transpose(c, lds, p.w_ffn_up, Wt_gu, DM, DFF, p.g_ffn, 2, cur);
            p_transpose(c, lds, p.w_ffn_down, Wt_dn, DFF, DM, nullptr, 0, cur);
            p_transpose(c, lds, p.w_up_a, Wt_upa, 512, DM, nullptr, 0, cur, 1024, 0);
            p_transpose(c, lds, p.w_up_b, Wt_upa, 512, DM, nullptr, 0, cur, 1024, 512);
            p_transpose(c, lds, p.w_out, Wt_out, DM, DM, nullptr, 0, cur);
            p_transpose(c, lds, p.w_q_mem, Wt_qm, DM, MEMW, p.g_mem_q, 0, cur);
            p_transpose(c, lds, p.w_kv_mem, Wt_kvm, DM, 2 * MEMW, nullptr, 0, cur);
            p_transpose(c, lds, p.w_o_mem, Wt_om, MEMW, DM, nullptr, 0, cur);
            p_rmsnorm_rows(c, p.x, p.g_mix, n1, T);
            p_rmsnorm_rows(c, p.mem, p.g_mem_kv, memn, BATCH * NMEM);
            p_rope_table(c, p.pos, rope);
            if (blockIdx.x == 0) for (int i = c.tid; i < XCD_BAR_WORDS; i += 512) bar[i] = 0u;
        }
        PHASE(1) {
            { Gemm g{n1, Wt_in, T, INC, DM}; EpiBf16 E{proj, INC, nullptr, 1 << 30, rope, 4};   S.init(g.M, g.N, gridDim.x, blockIdx.x); pg8::gemm_phase(lds, g, S, E); }
            { Gemm g{memn, Wt_kvm, BATCH * NMEM, 1024, DM}; EpiBf16 E{kvm, 1024, nullptr, 1 << 30, nullptr, 0}; S.init(g.M, g.N, gridDim.x, blockIdx.x); pg8::gemm_phase(lds, g, S, E); }
        }
        PHASE(3) {
#if NAIVE_AB
            p_attn_a_naive(c, proj, OA); p_attn_b_naive(c, proj, OB);
#else
            p_attn_ab(lds, proj, OA, OB);
#endif
        }
        PHASE(5) { Gemm g{OA, Wt_upa, T, DM, DM}; EpiGate E{proj, mixed}; S.init(g.M, g.N, gridDim.x, blockIdx.x); pg8::gemm_phase(lds, g, S, E); }
        PHASE(6) { Gemm g{mixed, Wt_out, T, DM, DM}; EpiRes E{p.x, nullptr, nullptr, h1b, ss1}; S.init(g.M, g.N, gridDim.x, blockIdx.x); pg8::gemm_phase(lds, g, S, E); }
        PHASE(7) { Gemm g{h1b, Wt_qm, T, MEMW, DM}; EpiBf16 E{qm, MEMW, ss1, 1 << 30, nullptr, 0}; S.init(g.M, g.N, gridDim.x, blockIdx.x); pg8::gemm_phase(lds, g, S, E); }
        PHASE(8) {
#if NAIVE_MEM
            p_attn_mem_naive(c, qm, kvm, om);
#else
            p_attn_mem(lds, qm, kvm, om);
#endif
        }
        PHASE(9) { Gemm g{om, Wt_om, T, DM, MEMW}; EpiRes E{nullptr, h1b, nullptr, h2b, ss2}; S.init(g.M, g.N, gridDim.x, blockIdx.x); pg8::gemm_phase(lds, g, S, E); }
        PHASE(10) { Gemm g{h2b, Wt_gu, T, 2 * DFF, DM}; EpiSwiGLU E{act, ss2}; S.init(g.M, g.N, gridDim.x, blockIdx.x); pg8::gemm_phase(lds, g, S, E); }
        PHASE(11) { Gemm g{act, Wt_dn, T, DM, DFF}; EpiRes E{nullptr, h2b, p.out, nullptr, ss3}; S.init(g.M, g.N, gridDim.x, blockIdx.x); pg8::gemm_phase(lds, g, S, E); }
        PHASE(12) p_final(c, p.out, ss3, p.g_final);
    }
}

constexpr int LDS_BYTES = pg8::STAGE_BYTES + 16;
#ifndef ONE_LAUNCH
#define ONE_LAUNCH 1
#endif
extern "C" void kernel_launch(void* const* d_in, const int* in_sizes, int n_in, void* d_out, int out_size, void* d_ws, size_t ws_size, hipStream_t stream) {
    static int grid = 0;
    if (grid == 0) {
        if (n_in != 18 || out_size != T * DM || ws_size < WS_END) { fprintf(stderr, "kernel_launch: unexpected shapes (n_in %d out %d ws %zu)\n", n_in, out_size, ws_size); grid = -1; return; }
        int dev = 0, cus = 0, per_cu = 0;
        (void)hipGetDevice(&dev); (void)hipDeviceGetAttribute(&cus, hipDeviceAttributeMultiprocessorCount, dev);
        if (hipFuncSetAttribute((const void*)mega, hipFuncAttributeMaxDynamicSharedMemorySize, LDS_BYTES) != hipSuccess) { fprintf(stderr, "hipFuncSetAttribute failed\n"); grid = -1; return; }
        if (hipOccupancyMaxActiveBlocksPerMultiprocessor(&per_cu, (const void*)mega, 512, LDS_BYTES) != hipSuccess || per_cu < 1) { fprintf(stderr, "occupancy query: %d\n", per_cu); per_cu = 1; }
        (void)hipGetLastError();
        grid = cus * 1;
    }
    if (grid < 0) return;
    Params p{};
    p.x = (const float*)d_in[0]; p.mem = (const float*)d_in[1]; p.pos = (const int*)d_in[2]; p.g_mix = (const float*)d_in[3]; p.w_in = (const float*)d_in[4];
    p.w_up_a = (const float*)d_in[5]; p.w_up_b = (const float*)d_in[6]; p.w_out = (const float*)d_in[7]; p.g_mem_q = (const float*)d_in[8]; p.g_mem_kv = (const float*)d_in[9];
    p.w_q_mem = (const float*)d_in[10]; p.w_kv_mem = (const float*)d_in[11]; p.w_o_mem = (const float*)d_in[12]; p.g_ffn = (const float*)d_in[13];
    p.w_ffn_gate = (const float*)d_in[14]; p.w_ffn_up = (const float*)d_in[15]; p.w_ffn_down = (const float*)d_in[16]; p.g_final = (const float*)d_in[17];
    p.out = (float*)d_out; p.ws = (unsigned char*)d_ws;
#if ONE_LAUNCH
    int lo = 0, hi = NPHASE;
    void* args[] = {&p, &lo, &hi};
    hipError_t e = hipLaunchCooperativeKernel((const void*)mega, dim3(grid), dim3(512), args, LDS_BYTES, stream);
    if (e != hipSuccess) fprintf(stderr, "cooperative launch failed: %s\n", hipGetErrorString(e));
#else
    for (int ph = 0; ph < NPHASE; ++ph) hipLaunchKernelGGL(mega, dim3(grid), dim3(512), LDS_BYTES, stream, p, ph, ph + 1);
#endif
}
```

```cpp
#include <hip/hip_runtime.h>
#include <hip/hip_cooperative_groups.h>
#include <cstdio>
namespace cg = cooperative_groups;

#define LAS __attribute__((address_space(3)))
typedef unsigned short bf16_t;
typedef short bf16x8 __attribute__((ext_vector_type(8)));
typedef float f32x4 __attribute__((ext_vector_type(4)));
typedef unsigned u32x4 __attribute__((ext_vector_type(4)));
typedef unsigned u32x2 __attribute__((ext_vector_type(2)));

constexpr int BATCH = 16, SEQ = 2048, DM = 1024, T = BATCH * SEQ;
constexpr int HD = 64, NHA = 8, NHB = 8;
constexpr int INC = 5120;
constexpr int C_QA = 0, C_KA = 512, C_VA = 1024, C_QB = 1536, C_KB = 2048, C_VB = 2560, C_GA = 3072, C_GB = 4096;
constexpr int NMEM = 256, MEMW = 512, DFF = 2816;
constexpr float EPS = 1e-6f;

constexpr size_t MiB = 1ull << 20;
constexpr size_t WS_WIN = 0, WS_WUPA = 10 * MiB, WS_WUPB = 11 * MiB, WS_WOUT = 12 * MiB, WS_WQM = 14 * MiB, WS_WKVM = 15 * MiB,
                 WS_WOM = 17 * MiB, WS_WGU = 18 * MiB, WS_WDN = 29 * MiB, WS_MEMN = 36 * MiB, WS_KVM = 44 * MiB,
                 WS_SS1 = 52 * MiB, WS_SS2 = 54 * MiB, WS_SS3 = 56 * MiB, WS_ROPE = 58 * MiB, WS_BAR = 60 * MiB;
constexpr size_t WS_R1 = 64 * MiB;
constexpr size_t WS_PROJ = 128 * MiB;
constexpr size_t WS_H1 = 128 * MiB, WS_H1B = 256 * MiB, WS_QM = 320 * MiB, WS_OM = 352 * MiB, WS_H2 = 384 * MiB, WS_ACT = 128 * MiB;
constexpr size_t WS_OA = 448 * MiB, WS_OB = 480 * MiB;
constexpr size_t WS_END = 512 * MiB;

struct Params {
    const float* x; const float* mem; const int* pos; const float* g_mix; const float* w_in; const float* w_up_a; const float* w_up_b; const float* w_out;
    const float* g_mem_q; const float* g_mem_kv; const float* w_q_mem; const float* w_kv_mem; const float* w_o_mem; const float* g_ffn;
    const float* w_ffn_gate; const float* w_ffn_up; const float* w_ffn_down; const float* g_final;
    float* out; unsigned char* ws;
};

typedef float f32x2 __attribute__((ext_vector_type(2)));
typedef __bf16 bf16v2 __attribute__((ext_vector_type(2)));
__device__ __forceinline__ unsigned pk_bf16(float lo, float hi) { f32x2 v = {lo, hi}; bf16v2 r = __builtin_convertvector(v, bf16v2); return __builtin_bit_cast(unsigned, r); }
__device__ __forceinline__ bf16_t f2bf(float f) { return (bf16_t)(pk_bf16(f, 0.f) & 0xffffu); }
__device__ __forceinline__ float bf2f(bf16_t b) { return __uint_as_float(((unsigned)b) << 16); }
__device__ __forceinline__ float bflo(unsigned u) { return __uint_as_float(u << 16); }
__device__ __forceinline__ float bfhi(unsigned u) { return __uint_as_float(u & 0xffff0000u); }
__device__ __forceinline__ float wave_sum(float v) {
#pragma unroll
    for (int o = 1; o < 64; o <<= 1) v += __shfl_xor(v, o);
    return v;
}
__device__ __forceinline__ float sigmoidf_(float x) { return 1.f / (1.f + __expf(-x)); }
__device__ __forceinline__ float rstd_of(const float* ss, int row) {
    const f32x4* p = (const f32x4*)(ss + (size_t)row * 16);
    f32x4 a = p[0], b = p[1], c = p[2], d = p[3];
    float s = ((a[0] + a[1]) + (a[2] + a[3])) + ((b[0] + b[1]) + (b[2] + b[3])) + ((c[0] + c[1]) + (c[2] + c[3])) + ((d[0] + d[1]) + (d[2] + d[3]));
    return rsqrtf(s * (1.f / DM) + EPS);
}


#define XB_TMO      128
#define XB_XCNT(j)  (256  + 64 * (j))
#define XB_XSUB(j)  (1280 + 64 * (j))
#define XB_XGEN(j)  (2304 + 64 * (j))
#define XB_TOP      3328
#define XB_TOPGEN   3392
#define XCD_BAR_WORDS 3456
#define XB_SPIN_CAP (1u << 18)
__device__ __forceinline__ unsigned xb_ld(unsigned* p)              { return __hip_atomic_load(p, __ATOMIC_RELAXED, __HIP_MEMORY_SCOPE_AGENT); }
__device__ __forceinline__ unsigned xb_add(unsigned* p, unsigned v) { return __hip_atomic_fetch_add(p, v, __ATOMIC_RELAXED, __HIP_MEMORY_SCOPE_AGENT); }
__device__ __forceinline__ unsigned xb_xcc_id() { return (unsigned)__builtin_amdgcn_s_getreg((3 << 11) | 20) & 0xFu; }
#define XB_SPIN(cond, bar) do { unsigned _sp = 0; while (cond) { __builtin_amdgcn_s_sleep(1); \
    if ((++_sp & 255u) == 0u) { if (xb_ld(&(bar)[XB_TMO])) break; if (_sp > XB_SPIN_CAP) { atomicAdd(&(bar)[XB_TMO], 1u); break; } } } } while (0)
struct XcdBarrier { unsigned* bar; unsigned x; volatile LAS unsigned* st; };
__device__ __forceinline__ XcdBarrier xcd_barrier_post(unsigned* bar, volatile LAS unsigned* st) {
    XcdBarrier b; b.bar = bar; b.x = xb_xcc_id(); b.st = st;
    if (threadIdx.x == 0) (void)xb_add(&bar[XB_XCNT(b.x)], 1u);
    return b;
}
__device__ __forceinline__ void xcd_barrier_complete(unsigned* bar, unsigned x, unsigned& nloc, unsigned& nx) {
    const unsigned G = gridDim.x * gridDim.y * gridDim.z;
    unsigned sum, cnt, mine, sp = 0u;
    for (;;) {
        sum = 0u; cnt = 0u; mine = 0u;
#pragma unroll
        for (unsigned j = 0; j < 16; ++j) { const unsigned c = xb_ld(&bar[XB_XCNT(j)]); sum += c; cnt += (c > 0u) ? 1u : 0u; mine = (j == x) ? c : mine; }
        if (sum == G) break;
        __builtin_amdgcn_s_sleep(1);
        if ((++sp & 255u) == 0u) { if (xb_ld(&bar[XB_TMO])) break; if (sp > XB_SPIN_CAP) { atomicAdd(&bar[XB_TMO], 1u); break; } }
    }
    nloc = mine > 0u ? mine : 1u; nx = cnt > 0u ? cnt : 1u;
}
__device__ __forceinline__ void xcd_barrier(const XcdBarrier& b) {
    asm volatile("s_waitcnt vmcnt(0)" ::: "memory");
    __syncthreads();
    if (threadIdx.x == 0) {
        unsigned* bar = b.bar;
        __builtin_amdgcn_s_waitcnt(0);
        unsigned nloc = b.st[0], nx = b.st[1];
        if (nloc == 0u) { xcd_barrier_complete(bar, b.x, nloc, nx); b.st[0] = nloc; b.st[1] = nx; }
        const unsigned old = xb_add(&bar[XB_XSUB(b.x)], 1u);
        const unsigned gen = old / nloc;
        if (old + 1u == (gen + 1u) * nloc) {
            __builtin_amdgcn_fence(__ATOMIC_RELEASE, "agent");
            asm volatile("s_waitcnt vmcnt(0)" ::: "memory");
            const unsigned og = xb_add(&bar[XB_TOP], 1u);
            const unsigned tg = og / nx;
            if (og + 1u == (tg + 1u) * nx) xb_add(&bar[XB_TOPGEN], 1u);
            else XB_SPIN(xb_ld(&bar[XB_TOPGEN]) == tg, bar);
            __builtin_amdgcn_fence(__ATOMIC_ACQUIRE, "agent");
            xb_add(&bar[XB_XGEN(b.x)], 1u);
            asm volatile("s_waitcnt vmcnt(0)" ::: "memory");
        } else {
            XB_SPIN(xb_ld(&bar[XB_XGEN(b.x)]) == gen, bar);
            __builtin_amdgcn_fence(__ATOMIC_ACQUIRE, "agent");
            asm volatile("s_waitcnt vmcnt(0)" ::: "memory");
        }
    }
    __syncthreads();
}

namespace pg8 {
constexpr int BM = 256, BK = 64, HALF = 128, HTB = HALF * BK * 2, STAGE_BYTES = 8 * HTB, NXCD = 8, WGM = 8;
__host__ __device__ __forceinline__ int lds_byte(int r, int c) { const int st = (r >> 4) * 2 + (c >> 5), rr = r & 15, cc = c & 31, ob = rr * 64 + cc * 2; return st * 1024 + (ob ^ (((ob >> 9) & 1) << 5)); }
__host__ __device__ __forceinline__ void stage_rc(int b, int& R, int& C) { const int st = b / 1024, sb = b % 1024, swz = sb ^ (((sb >> 9) & 1) << 5); R = (st >> 1) * 16 + swz / 64; C = (st & 1) * 32 + (swz % 64) / 2; }
__host__ __device__ __forceinline__ int perm32(int rho) { const int n = rho >> 4, i = rho & 15; return 8 * (i >> 2) + 4 * n + (i & 3); }
struct Unit { int pm, pn; };
struct Gemm { const bf16_t* A; const bf16_t* Bt; int M, N, K; };
struct StaticOrder {
    int nM, nN, nwg, G, c;
    __host__ __device__ void init(int M, int N, int G_, int c_) { nM = M / BM; nN = N / BM; nwg = nM * nN; G = G_; c = c_; }
    __host__ __device__ bool next(int i, Unit& u) const {
        const long L = (long)i * G + c; if (L >= nwg) return false;
        int wgid = (int)L; { const int q = nwg / NXCD, r = nwg % NXCD, xcd = wgid % NXCD, off = wgid / NXCD; wgid = (xcd < r ? xcd * (q + 1) : r * (q + 1) + (xcd - r) * q) + off; }
        const int nig = WGM * nN, gid = wgid / nig, fm = gid * WGM, gsz = (nM - fm) < WGM ? (nM - fm) : WGM;
        u.pm = fm + ((wgid % nig) % gsz); u.pn = (wgid % nig) / gsz; return true;
    }
};

template <class Epi>
__device__ __forceinline__ void gemm_phase(LAS unsigned char* lds, const Gemm g, const StaticOrder& S, const Epi& E) {
    int tid = threadIdx.x; asm volatile("" : "+v"(tid));
    const int wid = __builtin_amdgcn_readfirstlane(tid >> 6), lane = tid & 63, wr = wid >> 2, wc = wid & 3, fr = lane & 15, fq = lane >> 4;
    const int K = g.K, nt = K / BK;
    unsigned voffA[2], voffB[2];
#pragma unroll
    for (int i = 0; i < 2; ++i) { int R, C; stage_rc(tid * 16 + i * 8192, R, C); const int Rb = Epi::PERM ? ((R & ~31) + perm32(R & 31)) : R;
        voffA[i] = (unsigned)(R * K + C) * 2u; voffB[i] = (unsigned)(Rb * K + C) * 2u; }
    const size_t kstep = (size_t)(BK * 2);
    const size_t hstep = (size_t)HALF * K * 2;
    const size_t tstep = 2 * hstep;
    const unsigned ldsw = (unsigned)wid * 1024u;
    const int aoff = lds_byte(wr * 64 + fr, fq * 8), boff = lds_byte(wc * 32 + fr, fq * 8);
#define PG8_SA(b, h) (((b) * 2 + (h)) * HTB)
#define PG8_SB(b, h) ((4 + (b) * 2 + (h)) * HTB)
#define PG8_STAGE(bufoff, gbase, voff) do { _Pragma("unroll") for (int _i = 0; _i < 2; ++_i) \
        __builtin_amdgcn_global_load_lds((const unsigned*)((const char*)(gbase) + (voff)[_i]), (LAS unsigned*)(lds + (bufoff) + ldsw + _i * 8192), 16, 0, 0); } while (0)
#define PG8_LDA(dst, b, h) do { _Pragma("unroll") for (int m = 0; m < 4; ++m) _Pragma("unroll") for (int k = 0; k < 2; ++k) dst[m][k] = *(const LAS bf16x8*)(lds + PG8_SA(b, h) + aoff + m * 2048 + k * 1024); } while (0)
#define PG8_LDB(dst, b, h) do { _Pragma("unroll") for (int n = 0; n < 2; ++n) _Pragma("unroll") for (int k = 0; k < 2; ++k) dst[n][k] = *(const LAS bf16x8*)(lds + PG8_SB(b, h) + boff + n * 2048 + k * 1024); } while (0)
#define PG8_MMA(ai, bj, At, Bt) do { __builtin_amdgcn_s_setprio(1); _Pragma("unroll") for (int m = 0; m < 4; ++m) _Pragma("unroll") for (int n = 0; n < 2; ++n) _Pragma("unroll") for (int k = 0; k < 2; ++k) \
        acc[ai][bj][m][n] = __builtin_amdgcn_mfma_f32_16x16x32_bf16(Bt[n][k], At[m][k], acc[ai][bj][m][n], 0, 0, 0); __builtin_amdgcn_s_setprio(0); } while (0)
#define PG8_WAIT_V(n) asm volatile("s_waitcnt vmcnt(" #n ")" ::: "memory")
#define PG8_WAIT_L(n) asm volatile("s_waitcnt lgkmcnt(" #n ")" ::: "memory")
#define PG8_BAR __builtin_amdgcn_s_barrier()
#define PG8_SCHED __builtin_amdgcn_sched_barrier(0)
    Unit cur, nxt; int ui = 0;
    if (!S.next(0, cur)) return;
    f32x4 acc[2][2][4][2];
#pragma unroll
    for (int a = 0; a < 2; ++a)
#pragma unroll
        for (int b = 0; b < 2; ++b)
#pragma unroll
            for (int m = 0; m < 4; ++m)
#pragma unroll
                for (int n = 0; n < 2; ++n) acc[a][b][m][n] = (f32x4){0.f, 0.f, 0.f, 0.f};
    bf16x8 At[4][2], B0[2][2], B1[2][2];
    const char* cA = (const char*)g.A + (size_t)cur.pm * tstep; const char* cB = (const char*)g.Bt + (size_t)cur.pn * tstep;
    PG8_STAGE(PG8_SB(0, 0), cB, voffB); PG8_STAGE(PG8_SA(0, 0), cA, voffA); PG8_STAGE(PG8_SB(0, 1), cB + hstep, voffB); PG8_STAGE(PG8_SA(0, 1), cA + hstep, voffA);
    if (wr == 1) PG8_BAR;
    PG8_WAIT_V(4); PG8_BAR;
    PG8_STAGE(PG8_SB(1, 0), cB + kstep, voffB); PG8_STAGE(PG8_SA(1, 0), cA + kstep, voffA); PG8_STAGE(PG8_SB(1, 1), cB + hstep + kstep, voffB);
    PG8_WAIT_V(6); PG8_BAR;
    for (;;) {
        const bool has_next = S.next(ui + 1, nxt);
        const char* nA = has_next ? (const char*)g.A + (size_t)nxt.pm * tstep : cA; const char* nB = has_next ? (const char*)g.Bt + (size_t)nxt.pn * tstep : cB;
        for (int t = 0; t < nt; t += 2) {
            const bool last = (t == nt - 2);
            const char* a1 = cA + (size_t)(t + 1) * kstep;
            const char* a2 = last ? nA : cA + (size_t)(t + 2) * kstep; const char* b2 = last ? nB : cB + (size_t)(t + 2) * kstep;
            const char* a3 = a2 + kstep; const char* b3 = b2 + kstep;
            if constexpr (Epi::HAS_MID) { if (t == nt / 2) E.mid(acc, cur, wr, wc, fr, fq); }
            PG8_LDB(B0, 0, 0); PG8_SCHED; PG8_LDA(At, 0, 0); PG8_STAGE(PG8_SA(1, 1), a1 + hstep, voffA);
            PG8_WAIT_L(8); PG8_BAR; PG8_WAIT_L(0); PG8_MMA(0, 0, At, B0); PG8_BAR; PG8_SCHED;
            PG8_LDB(B1, 0, 1); PG8_STAGE(PG8_SB(0, 0), b2, voffB);
            PG8_BAR; PG8_WAIT_L(0); PG8_MMA(0, 1, At, B1); PG8_BAR;
            PG8_LDA(At, 0, 1); PG8_STAGE(PG8_SA(0, 0), a2, voffA);
            PG8_BAR; PG8_WAIT_L(0); PG8_MMA(1, 0, At, B0); PG8_BAR; PG8_SCHED;
            PG8_STAGE(PG8_SB(0, 1), b2 + hstep, voffB);
            PG8_WAIT_V(6); PG8_BAR; PG8_MMA(1, 1, At, B1); PG8_BAR;
            PG8_LDB(B0, 1, 0); PG8_SCHED; PG8_LDA(At, 1, 0); PG8_STAGE(PG8_SA(0, 1), a2 + hstep, voffA);
            PG8_WAIT_L(8); PG8_BAR; PG8_WAIT_L(0); PG8_MMA(0, 0, At, B0); PG8_BAR; PG8_SCHED;
            PG8_LDB(B1, 1, 1); PG8_STAGE(PG8_SB(1, 0), b3, voffB);
            PG8_BAR; PG8_WAIT_L(0); PG8_MMA(0, 1, At, B1); PG8_BAR;
            PG8_LDA(At, 1, 1); PG8_STAGE(PG8_SA(1, 0), a3, voffA);
            PG8_BAR; PG8_WAIT_L(0); PG8_MMA(1, 0, At, B0); PG8_BAR; PG8_SCHED;
            PG8_STAGE(PG8_SB(1, 1), b3 + hstep, voffB);
            PG8_WAIT_V(6); PG8_BAR; PG8_MMA(1, 1, At, B1); PG8_BAR;
        }
        E(acc, cur, wr, wc, fr, fq);
        if (!has_next) break;
#pragma unroll
        for (int a = 0; a < 2; ++a)
#pragma unroll
            for (int b = 0; b < 2; ++b)
#pragma unroll
                for (int m = 0; m < 4; ++m)
#pragma unroll
                    for (int n = 0; n < 2; ++n) acc[a][b][m][n] = (f32x4){0.f, 0.f, 0.f, 0.f};
        cur = nxt; cA = nA; cB = nB; ++ui;
    }
    PG8_WAIT_V(0);
    if (wr == 0) PG8_BAR;
    PG8_BAR;
#undef PG8_SA
#undef PG8_SB
#undef PG8_STAGE
#undef PG8_LDA
#undef PG8_LDB
#undef PG8_MMA
#undef PG8_WAIT_V
#undef PG8_WAIT_L
#undef PG8_BAR
#undef PG8_SCHED
}
}
using pg8::Unit; using pg8::Gemm;

struct EpiBf16 {
    static constexpr bool PERM = true, HAS_MID = false;
    bf16_t* O; int ldc; const float* ss; int sig_from; const float* rope; int rope_below; int qkv_tiles; bf16_t* gates;
    __device__ __forceinline__ void operator()(const f32x4 (&acc)[2][2][4][2], const Unit& u, int wr, int wc, int fr, int fq) const {
        const int row0 = u.pm * 256 + wr * 64 + fr, col0 = u.pn * 256 + wc * 32 + 8 * fq;
        const bool sig = u.pn >= sig_from;
#pragma unroll
        for (int ai = 0; ai < 2; ++ai)
#pragma unroll
            for (int m = 0; m < 4; ++m) {
                const int row = row0 + ai * 128 + m * 16;
                const float rs = ss ? rstd_of(ss, row) : 1.f;
#pragma unroll
                for (int bj = 0; bj < 2; ++bj) {
                    f32x4 v0 = acc[ai][bj][m][0] * rs, v1 = acc[ai][bj][m][1] * rs;
                    if (sig) {
#pragma unroll
                        for (int j = 0; j < 4; ++j) { v0[j] = sigmoidf_(v0[j]); v1[j] = sigmoidf_(v1[j]); }
                    }
                    if (u.pn < rope_below && (wc & 1) == 0) {
                        f32x4 p0, p1;
#pragma unroll
                        for (int j = 0; j < 4; ++j) { p0[j] = __shfl_xor(v0[j], 16); p1[j] = __shfl_xor(v1[j], 16); }
                        if (fq < 2) {
                            const f32x4 c0 = *(const f32x4*)(rope + (size_t)row * 16), c1 = *(const f32x4*)(rope + (size_t)row * 16 + 4);
                            f32x4 s0 = *(const f32x4*)(rope + (size_t)row * 16 + 8), s1 = *(const f32x4*)(rope + (size_t)row * 16 + 12);
                            if (fq == 0) { s0 = -s0; s1 = -s1; }
                            v0 = v0 * c0 + p0 * s0; v1 = v1 * c1 + p1 * s1;
                        }
                    }
                    u32x4 o; o[0] = pk_bf16(v0[0], v0[1]); o[1] = pk_bf16(v0[2], v0[3]); o[2] = pk_bf16(v1[0], v1[1]); o[3] = pk_bf16(v1[2], v1[3]);
                    if (qkv_tiles > 0) {
                        const int col = col0 + bj * 128;
                        if (u.pn < qkv_tiles) *(u32x4*)(O + (size_t)(col >> 9) * ((size_t)T * 512) + ((size_t)((row >> 11) * 8 + ((col >> 6) & 7)) * SEQ + (row & (SEQ - 1))) * 64 + (col & 63)) = o;
                        else *(u32x4*)(gates + (size_t)row * 2048 + (col - 256 * qkv_tiles)) = o;
                    } else *(u32x4*)(O + (size_t)row * ldc + col0 + bj * 128) = o;
                }
            }
    }
};
struct EpiGate {
    static constexpr bool PERM = true, HAS_MID = true;
    const bf16_t* gates; bf16_t* O;
    __device__ __forceinline__ void mid(f32x4 (&acc)[2][2][4][2], const Unit& u, int wr, int wc, int fr, int fq) const {
        int row0 = u.pm * 256 + wr * 64 + fr, col0 = u.pn * 256 + wc * 32 + 8 * fq;
        asm volatile("" : "+v"(row0), "+v"(col0));
#pragma unroll
        for (int ai = 0; ai < 2; ++ai)
#pragma unroll
            for (int m = 0; m < 4; ++m) {
                const int row = row0 + ai * 128 + m * 16;
#pragma unroll
                for (int bj = 0; bj < 2; ++bj) {
                    const int col = col0 + bj * 128;
                    const u32x4 ga = *(const u32x4*)(gates + (size_t)row * 2048 + col), gb = *(const u32x4*)(gates + (size_t)row * 2048 + 1024 + col);
#pragma unroll
                    for (int q = 0; q < 4; ++q) {
                        const float a0 = bflo(ga[q]), a1 = bfhi(ga[q]), b0 = fmaxf(bflo(gb[q]), -60.f), b1 = fmaxf(bfhi(gb[q]), -60.f);
                        const float r0 = (1.f + __expf(-b0)) * __builtin_amdgcn_rcpf(1.f + __expf(-a0)), r1 = (1.f + __expf(-b1)) * __builtin_amdgcn_rcpf(1.f + __expf(-a1));
                        acc[ai][bj][m][q >> 1][(q & 1) * 2] *= r0; acc[ai][bj][m][q >> 1][(q & 1) * 2 + 1] *= r1;
                    }
                }
                __builtin_amdgcn_sched_barrier(0);
            }
    }
    __device__ __forceinline__ void operator()(const f32x4 (&acc)[2][2][4][2], const Unit& u, int wr, int wc, int fr, int fq) const {
        const int row0 = u.pm * 256 + wr * 64 + fr, col0 = u.pn * 256 + wc * 32 + 8 * fq;
#pragma unroll
        for (int ai = 0; ai < 2; ++ai)
#pragma unroll
            for (int m = 0; m < 4; ++m) {
                const int row = row0 + ai * 128 + m * 16;
#pragma unroll
                for (int bj = 0; bj < 2; ++bj) {
                    const int col = col0 + bj * 128;
                    const u32x4 gb = *(const u32x4*)(gates + (size_t)row * 2048 + 1024 + col);
                    float r[8];
#pragma unroll
                    for (int q = 0; q < 4; ++q) {
                        const float b0 = fmaxf(bflo(gb[q]), -60.f), b1 = fmaxf(bfhi(gb[q]), -60.f);
                        r[2 * q] = acc[ai][bj][m][q >> 1][(q & 1) * 2] * __builtin_amdgcn_rcpf(1.f + __expf(-b0));
                        r[2 * q + 1] = acc[ai][bj][m][q >> 1][(q & 1) * 2 + 1] * __builtin_amdgcn_rcpf(1.f + __expf(-b1));
                    }
                    u32x4 o; o[0] = pk_bf16(r[0], r[1]); o[1] = pk_bf16(r[2], r[3]); o[2] = pk_bf16(r[4], r[5]); o[3] = pk_bf16(r[6], r[7]);
                    *(u32x4*)(O + (size_t)row * DM + col) = o;
                }
            }
    }
};
struct EpiRes {
    static constexpr bool PERM = false, HAS_MID = false;
    const float* R; const bf16_t* Rb; float* H; bf16_t* Hb; float* SS;
    __device__ __forceinline__ void operator()(const f32x4 (&acc)[2][2][4][2], const Unit& u, int wr, int wc, int fr, int fq) const {
        const int row0 = u.pm * 256 + wr * 64 + fr, col0 = u.pn * 256 + wc * 32 + 4 * fq;
#pragma unroll
        for (int ai = 0; ai < 2; ++ai)
#pragma unroll
            for (int m = 0; m < 4; ++m) {
                const int row = row0 + ai * 128 + m * 16;
                float s = 0.f;
#pragma unroll
                for (int bj = 0; bj < 2; ++bj)
#pragma unroll
                    for (int n = 0; n < 2; ++n) {
                        const int col = col0 + bj * 128 + n * 16;
                        f32x4 rr;
                        if (R) rr = *(const f32x4*)(R + (size_t)row * DM + col);
                        else { const u32x2 rb = *(const u32x2*)(Rb + (size_t)row * DM + col); rr[0] = bflo(rb[0]); rr[1] = bfhi(rb[0]); rr[2] = bflo(rb[1]); rr[3] = bfhi(rb[1]); }
                        const f32x4 h = rr + acc[ai][bj][m][n];
                        if (H) *(f32x4*)(H + (size_t)row * DM + col) = h;
                        if (Hb) { u32x2 o; o[0] = pk_bf16(h[0], h[1]); o[1] = pk_bf16(h[2], h[3]); *(u32x2*)(Hb + (size_t)row * DM + col) = o; }
                        s += (h[0] * h[0] + h[1] * h[1]) + (h[2] * h[2] + h[3] * h[3]);
                    }
                s += __shfl_xor(s, 16); s += __shfl_xor(s, 32);
                if (fq == 0) SS[(size_t)row * 16 + u.pn * 4 + wc] = s;
            }
    }
};
struct EpiSwiGLU {
    static constexpr bool PERM = true, HAS_MID = false;
    bf16_t* O; const float* ss;
    __device__ __forceinline__ void operator()(const f32x4 (&acc)[2][2][4][2], const Unit& u, int wr, int wc, int fr, int fq) const {
        const int row0 = u.pm * 256 + wr * 64 + fr, col0 = u.pn * 128 + wc * 32 + 8 * fq;
#pragma unroll
        for (int ai = 0; ai < 2; ++ai)
#pragma unroll
            for (int m = 0; m < 4; ++m) {
                const int row = row0 + ai * 128 + m * 16;
                const float rs = rstd_of(ss, row);
                float r[8];
#pragma unroll
                for (int n = 0; n < 2; ++n)
#pragma unroll
                    for (int j = 0; j < 4; ++j) { const float gg = acc[ai][0][m][n][j] * rs, uu = acc[ai][1][m][n][j] * rs; r[n * 4 + j] = gg * sigmoidf_(gg) * uu; }
                u32x4 o; o[0] = pk_bf16(r[0], r[1]); o[1] = pk_bf16(r[2], r[3]); o[2] = pk_bf16(r[4], r[5]); o[3] = pk_bf16(r[6], r[7]);
                *(u32x4*)(O + (size_t)row * DFF + col0) = o;
            }
    }
};

struct Ctx { int tid, lane, wave, gw, ngw, gt, ngt; };

__device__ __forceinline__ void p_transpose(const Ctx& c, LAS unsigned char* lds, const float* W, bf16_t* Wt, int K, int N, const float* g, int mode, int& cursor, int ldw = 0, int koff = 0) {
    if (ldw == 0) ldw = K;
    LAS float* scr = (LAS float*)(lds + c.wave * 8704);
    const int nblk = N / 32, nitems = (K / 64) * nblk, lane = c.lane;
    int first = (c.gw - cursor % c.ngw + c.ngw) % c.ngw;
    for (int it = first; it < nitems; it += c.ngw) {
        const int kb = it / nblk, nb = it % nblk, k0 = 64 * kb, n0 = 32 * nb;
#pragma unroll 8
        for (int i = 0; i < 32; ++i) { const int kk = 2 * i + (lane >> 5); float v = W[(size_t)(k0 + kk) * N + n0 + (lane & 31)]; if (g) v *= g[k0 + kk]; scr[kk * 33 + (lane & 31)] = v; }
        asm volatile("s_waitcnt lgkmcnt(0)" ::: "memory");
        const int ch = lane & 7;
#pragma unroll
        for (int j = 0; j < 4; ++j) { const int n = (lane >> 3) + 8 * j; const LAS float* sp = scr + (8 * ch) * 33 + n;
            u32x4 o; o[0] = pk_bf16(sp[0], sp[33]); o[1] = pk_bf16(sp[2 * 33], sp[3 * 33]); o[2] = pk_bf16(sp[4 * 33], sp[5 * 33]); o[3] = pk_bf16(sp[6 * 33], sp[7 * 33]);
            const int nn = n0 + n, row = mode == 0 ? nn : (256 * (nn >> 7) + (nn & 127) + (mode == 2 ? 128 : 0));
            *(u32x4*)(Wt + (size_t)row * ldw + koff + k0 + 8 * ch) = o; }
        asm volatile("s_waitcnt lgkmcnt(0)" ::: "memory");
    }
    cursor += nitems;
}
__device__ __forceinline__ void p_rmsnorm_rows(const Ctx& c, const float* x, const float* g, bf16_t* out, int rows) {
    for (int r = c.gw; r < rows; r += c.ngw) {
        const f32x4* xr = (const f32x4*)(x + (size_t)r * DM) + c.lane;
        f32x4 v[4]; float s = 0.f;
#pragma unroll
        for (int j = 0; j < 4; ++j) { v[j] = xr[64 * j]; s += (v[j][0] * v[j][0] + v[j][1] * v[j][1]) + (v[j][2] * v[j][2] + v[j][3] * v[j][3]); }
        const float rs = rsqrtf(wave_sum(s) * (1.f / DM) + EPS);
#pragma unroll
        for (int j = 0; j < 4; ++j) {
            const f32x4 gg = ((const f32x4*)g)[c.lane + 64 * j];
            u32x2 o; o[0] = pk_bf16(v[j][0] * rs * gg[0], v[j][1] * rs * gg[1]); o[1] = pk_bf16(v[j][2] * rs * gg[2], v[j][3] * rs * gg[3]);
            ((u32x2*)(out + (size_t)r * DM))[c.lane + 64 * j] = o;
        }
    }
}
__device__ __forceinline__ void p_rope_table(const Ctx& c, const int* pos, float* tab) {
    for (int i = c.gt; i < T * 8; i += c.ngt) {
        const int tok = i >> 3, f = i & 7;
        const double inv = f == 0 ? 1.0 : f == 1 ? 0.19392274474868576 : f == 2 ? 0.03760603093086393 : f == 3 ? 0.007292664737217109 : f == 4 ? 0.001414213562373095 :
                           f == 5 ? 0.0002742481756762073 : f == 6 ? 5.318295896944988e-05 : 1.031338537721246e-05;
        const double rev = (double)pos[tok] * inv * 0.15915494309189535;
        const float fr = (float)(rev - rint(rev));
        tab[(size_t)tok * 16 + f] = __builtin_amdgcn_cosf(fr);
        tab[(size_t)tok * 16 + 8 + f] = __builtin_amdgcn_sinf(fr);
    }
}
__device__ __forceinline__ void p_final(const Ctx& c, float* out, const float* ss, const float* g) {
    for (int r = c.gw; r < T; r += c.ngw) {
        const float rs = rstd_of(ss, r);
        f32x4* xr = (f32x4*)(out + (size_t)r * DM) + c.lane;
#pragma unroll
        for (int j = 0; j < 4; ++j) { const f32x4 gg = ((const f32x4*)g)[c.lane + 64 * j]; f32x4 v = xr[64 * j]; v = v * rs * gg; xr[64 * j] = v; }
    }
}


typedef float f32x16 __attribute__((ext_vector_type(16)));
typedef short s16x4 __attribute__((ext_vector_type(4)));
#define MFMA32(a, b, c) __builtin_amdgcn_mfma_f32_32x32x16_bf16((a), (b), (c), 0, 0, 0)
constexpr int ATT_FLAG_OFF = 40960;
#ifndef ATT_DUP_A
#define ATT_DUP_A 0
#endif
#ifndef ATT_DUP_B
#define ATT_DUP_B 0
#endif
template <int MODE, int HDIM, int KT>
__device__ __forceinline__ void attn_item(LAS unsigned char* lds, const bf16_t* Qp, int ldq, const bf16_t* Kp, const bf16_t* Vp, int ldkv, bf16_t* Op, int ldo, int q0, int nkeys) {
    constexpr int KS = HDIM / 16, DD = HDIM / 32, KROW = HDIM * 2 + 16, VROW = KT * 2 + 8, NCH = HDIM / 8, PER = KT * NCH / 512, NSUB = KT / 32;
    static_assert(KT * KROW + HDIM * VROW + 128 <= ATT_FLAG_OFF, "attention LDS tiles overlap the flag words");
    int tid = threadIdx.x; asm volatile("" : "+v"(tid));
    const int lane = tid & 63, w = __builtin_amdgcn_readfirstlane(tid >> 6), r = lane & 31, hh = lane >> 5;
    const int tq0 = q0 + 32 * w, tq = tq0 + r;
    LAS unsigned char* Ks = lds; LAS unsigned char* Vt = lds + KT * KROW;
    LAS unsigned* flags = (LAS unsigned*)(lds + ATT_FLAG_OFF);
    bf16x8 Qf[KS];
#pragma unroll
    for (int ks = 0; ks < KS; ++ks) Qf[ks] = *(const bf16x8*)(Qp + (size_t)tq * ldq + 16 * ks + 8 * hh);
    f32x16 Oacc[DD];
#pragma unroll
    for (int dd = 0; dd < DD; ++dd)
#pragma unroll
        for (int i = 0; i < 16; ++i) Oacc[dd][i] = 0.f;
    float m = -INFINITY, l = 0.f, run = 0.f; unsigned done_w = 0u;
    float w8[8], u4[4], fgc[4], fbias = 0.f;
    if (MODE == 0) {
        const int cc = r & 15, e = cc & 3, f = cc >> 3; const bool act = (hh == ((cc >> 2) & 1)); const int c4 = r & 3;
#pragma unroll
        for (int i = 0; i < 8; ++i) { w8[i] = (act && (i & 3) == e && (i >> 2) == f) ? 1.f : 0.f; asm volatile("" : "+v"(w8[i])); }
        fbias = act ? 0.f : -INFINITY; asm volatile("" : "+v"(fbias));
#pragma unroll
        for (int j = 0; j < 4; ++j) { u4[j] = (j == c4) ? 1.f : 0.f; asm volatile("" : "+v"(u4[j])); }
#pragma unroll
        for (int g = 0; g < 4; ++g) { fgc[g] = (((r - 4 * hh - c4 - 8 * g) & 15) == 0) ? 2.f : 1.f; asm volatile("" : "+v"(fgc[g])); }
    }
    const int kt_hi = (MODE == 2) ? (nkeys / KT - 1) : ((q0 + 255) / KT);
    u32x4 kA[PER], vA[PER], kB[PER], vB[PER];
#define ATT_GLOAD(KR, VR, kt) do { _Pragma("unroll") for (int p_ = 0; p_ < PER; ++p_) { const int idx_ = tid + 512 * p_, key_ = idx_ / NCH, ch_ = idx_ % NCH; \
        KR[p_] = *(const u32x4*)(Kp + (size_t)(KT * (kt) + key_) * ldkv + ch_ * 8); VR[p_] = *(const u32x4*)(Vp + (size_t)(KT * (kt) + key_) * ldkv + ch_ * 8); } } while (0)
    auto stage = [&](const u32x4 (&KR)[PER], const u32x4 (&VR)[PER]) -> bool {
        if (MODE == 1 && lane == 0) flags[w] = done_w;
        __syncthreads();
#pragma unroll
        for (int p_ = 0; p_ < PER; ++p_) { const int idx_ = tid + 512 * p_, key_ = idx_ / NCH, ch_ = idx_ % NCH;
            *(LAS u32x4*)(Ks + key_ * KROW + ch_ * 16) = KR[p_];
#pragma unroll
            for (int j = 0; j < 8; ++j) *(LAS bf16_t*)(Vt + (ch_ * 8 + j) * VROW + ch_ * 8 + key_ * 2) = (bf16_t)((VR[p_][j >> 1] >> (16 * (j & 1))) & 0xffffu);
        }
        bool alldone = false;
        if (MODE == 1) { unsigned a = 1u;
#pragma unroll
            for (int i = 0; i < 8; ++i) a &= flags[i];
            alldone = a != 0u; }
        __syncthreads();
        return alldone;
    };
    auto compute = [&](int kt) {
#pragma unroll
        for (int sub = NSUB - 1; sub >= 0; --sub) {
            const int tk0 = KT * kt + 32 * sub;
            if (MODE != 2 && tk0 > tq0 + 31) continue;
            if (MODE == 1 && done_w) continue;
            f32x16 S;
#pragma unroll
            for (int i = 0; i < 16; ++i) S[i] = 0.f;
            bf16x8 kf[KS];
#pragma unroll
            for (int ks = 0; ks < KS; ++ks) kf[ks] = *(const LAS bf16x8*)(Ks + (32 * sub + r) * KROW + (16 * ks + 8 * hh) * 2);
            __builtin_amdgcn_sched_barrier(0);
#pragma unroll
            for (int ks = 0; ks < KS; ++ks) S = MFMA32(kf[ks], Qf[ks], S);
            s16x4 vlo[DD][2], vhi[DD][2];
#pragma unroll
            for (int dd = 0; dd < DD; ++dd)
#pragma unroll
                for (int s2 = 0; s2 < 2; ++s2) {
                    const LAS unsigned char* vp = Vt + (32 * dd + r) * VROW + (4 * dd + (r >> 3)) * 8 + (32 * sub + 16 * s2 + 4 * hh) * 2;
                    vlo[dd][s2] = *(const LAS s16x4*)vp; vhi[dd][s2] = *(const LAS s16x4*)(vp + 16);
                }
            __builtin_amdgcn_sched_barrier(0);
            const int dbase = tq - tk0 - 4 * hh;
            if (MODE == 0 || MODE == 2) {
                const float C = (MODE == 0 ? 0.125f : 0.08838834764831845f) * 1.4426950408889634f;
                const int D = tq0 - tk0;
                float alpha, ls = 0.f, mn;
                if (MODE == 0 && D >= 544) {
                    float s1 = S[0] * w8[0], s2 = S[8] * w8[0];
#pragma unroll
                    for (int i = 1; i < 8; ++i) { s1 = fmaf(S[i], w8[i], s1); s2 = fmaf(S[8 + i], w8[i], s2); }
                    const float v1 = fmaf(s1, C, fbias), v2 = fmaf(s2, C, fbias);
                    float mx = fmaxf(v1, v2); mx = fmaxf(mx, __shfl_xor(mx, 32));
                    mn = fmaxf(m, mx);
                    alpha = __builtin_amdgcn_exp2f(m - mn);
                    const float p1 = __builtin_amdgcn_exp2f(v1 - mn), p2 = __builtin_amdgcn_exp2f(v2 - mn);
                    ls = p1 + p2;
#pragma unroll
                    for (int i = 0; i < 8; ++i) { S[i] = w8[i] * p1; S[8 + i] = w8[i] * p2; }
                } else if (MODE == 0 && D >= 160 && D <= 480) {
                    float vg[4]; float mx = -INFINITY;
#pragma unroll
                    for (int g = 0; g < 4; ++g) { vg[g] = (fmaf(S[4 * g + 3], u4[3], fmaf(S[4 * g + 2], u4[2], fmaf(S[4 * g + 1], u4[1], S[4 * g] * u4[0])))) * C; mx = fmaxf(mx, vg[g]); }
                    mx = fmaxf(mx, __shfl_xor(mx, 32));
                    mn = fmaxf(m, mx);
                    alpha = __builtin_amdgcn_exp2f(m - mn);
#pragma unroll
                    for (int g = 0; g < 4; ++g) { const float pg = fgc[g] * __builtin_amdgcn_exp2f(vg[g] - mn); ls += pg;
#pragma unroll
                        for (int j = 0; j < 4; ++j) S[4 * g + j] = u4[j] * pg; }
                } else {
                    float fm[16]; float mx = -INFINITY;
#pragma unroll
                    for (int i = 0; i < 16; ++i) {
                        float v = S[i] * C;
                        if (MODE == 0) { const int d = dbase - ((i & 3) + 8 * (i >> 2));
                            int mult = (d <= 128 ? 1 : 0) + ((((d & 3) == 0) && d <= 512) ? 1 : 0) + (((d & 15) == 0) ? 1 : 0);
                            mult = d >= 0 ? mult : 0; fm[i] = (float)mult; v = mult > 0 ? v : -INFINITY; }
                        else fm[i] = 1.f;
                        S[i] = v; mx = fmaxf(mx, v);
                    }
                    mx = fmaxf(mx, __shfl_xor(mx, 32));
                    mn = fmaxf(m, mx); const float ms = (mn == -INFINITY) ? 0.f : mn;
                    alpha = __builtin_amdgcn_exp2f(m - ms);
#pragma unroll
                    for (int i = 0; i < 16; ++i) { const float p = fm[i] * __builtin_amdgcn_exp2f(S[i] - ms); S[i] = p; ls += p; }
                }
                l = l * alpha + ls; m = mn;
                if (!__all(alpha == 1.f)) {
#pragma unroll
                    for (int dd = 0; dd < DD; ++dd) Oacc[dd] = Oacc[dd] * alpha;
                }
            } else {
                float sp[16], ex[16], G[4], PG[4];
#pragma unroll
                for (int i = 0; i < 16; ++i) { const int d = dbase - ((i & 3) + 8 * (i >> 2)); const bool valid = d > 0;
                    const float z = S[i] * 0.125f; const float e = __expf(-fabsf(z)); const float spv = fmaxf(z, 0.f) + __logf(1.f + e);
                    sp[i] = valid ? spv : 0.f; S[i] = valid ? (z - spv) : -INFINITY; }
#pragma unroll
                for (int g = 0; g < 4; ++g) { ex[4 * g + 3] = 0.f; ex[4 * g + 2] = sp[4 * g + 3]; ex[4 * g + 1] = ex[4 * g + 2] + sp[4 * g + 2]; ex[4 * g] = ex[4 * g + 1] + sp[4 * g + 1]; G[g] = ex[4 * g] + sp[4 * g]; }
#pragma unroll
                for (int g = 0; g < 4; ++g) PG[g] = __shfl_xor(G[g], 32);
                float later[4]; float suf = 0.f;
#pragma unroll
                for (int g = 3; g >= 0; --g) { later[g] = suf + (hh == 0 ? PG[g] : 0.f); suf += G[g] + PG[g]; }
#pragma unroll
                for (int i = 0; i < 16; ++i) S[i] = __expf(S[i] - (run + later[i >> 2] + ex[i]));
                run += suf;
                done_w = __all(run > 104.f) ? 1u : 0u;
            }
            u32x4 pp0, pp1;
#pragma unroll
            for (int j = 0; j < 4; ++j) { pp0[j] = pk_bf16(S[2 * j], S[2 * j + 1]); pp1[j] = pk_bf16(S[8 + 2 * j], S[8 + 2 * j + 1]); }
            const bf16x8 P0 = __builtin_bit_cast(bf16x8, pp0), P1 = __builtin_bit_cast(bf16x8, pp1);
#pragma unroll
            for (int dd = 0; dd < DD; ++dd)
#pragma unroll
                for (int s2 = 0; s2 < 2; ++s2) {
                    const bf16x8 vf = __builtin_shufflevector(vlo[dd][s2], vhi[dd][s2], 0, 1, 2, 3, 4, 5, 6, 7);
                    Oacc[dd] = MFMA32(vf, s2 ? P1 : P0, Oacc[dd]);
                }
        }
    };
    ATT_GLOAD(kA, vA, kt_hi);
    if constexpr (MODE == 2) {
#pragma unroll 1
        for (int kt = kt_hi; kt >= 0; --kt) {
            stage(kA, vA);
            if (kt >= 1) ATT_GLOAD(kA, vA, kt - 1);
            compute(kt);
        }
    } else {
        if (kt_hi >= 1) ATT_GLOAD(kB, vB, kt_hi - 1);
#pragma unroll 1
        for (int kt = kt_hi; kt >= 0; kt -= 2) {
            if (stage(kA, vA)) break;
            if (kt >= 2) ATT_GLOAD(kA, vA, kt - 2);
            compute(kt);
            if (kt == 0) break;
            if (stage(kB, vB)) break;
            if (kt >= 3) ATT_GLOAD(kB, vB, kt - 3);
            compute(kt - 1);
        }
    }
#undef ATT_GLOAD
    float inv = 1.f;
    if (MODE != 1) { const float lt = l + __shfl_xor(l, 32); inv = 1.f / lt; }
#pragma unroll
    for (int dd = 0; dd < DD; ++dd)
#pragma unroll
        for (int g = 0; g < 4; ++g) {
            u32x2 o; o[0] = pk_bf16(Oacc[dd][4 * g] * inv, Oacc[dd][4 * g + 1] * inv); o[1] = pk_bf16(Oacc[dd][4 * g + 2] * inv, Oacc[dd][4 * g + 3] * inv);
            *(u32x2*)(Op + (size_t)tq * ldo + 32 * dd + 8 * g + 4 * hh) = o;
        }
}
__device__ __forceinline__ void p_attn_ab(LAS unsigned char* lds, const bf16_t* qkv, bf16_t* OA, bf16_t* OB) {
    constexpr size_t TS = (size_t)T * 512;
    for (int v = blockIdx.x; v < 256; v += gridDim.x) {
        const int bh = v >> 1, b = bh >> 3, h = bh & 7, par = v & 1;
        const bf16_t* base = qkv + (size_t)bh * SEQ * 64;
        for (int rep = 0; rep < 1 + ATT_DUP_A; ++rep)
        for (int k = 0; k < 4; ++k) { const int qb = (k == 0) ? 7 - par : (k == 1) ? par : (k == 2) ? 5 - par : 2 + par;
            attn_item<0, 64, 128>(lds, base, 64, base + TS, base + 2 * TS, 64, OA + (size_t)b * SEQ * 1024 + h * HD, 1024, qb * 256, SEQ); }
        for (int rep = 0; rep < 1 + ATT_DUP_B; ++rep)
        for (int k = 0; k < 4; ++k) { const int qb = (k == 0) ? 7 - par : (k == 1) ? par : (k == 2) ? 5 - par : 2 + par;
            attn_item<1, 64, 128>(lds, base + 3 * TS, 64, base + 4 * TS, base + 5 * TS, 64, OB + (size_t)b * SEQ * 1024 + h * HD, 1024, qb * 256, SEQ); }
    }
}
__device__ __forceinline__ void p_attn_mem(LAS unsigned char* lds, const bf16_t* qm, const bf16_t* kvm, bf16_t* om) {
    for (int it = blockIdx.x; it < BATCH * 4 * 8; it += gridDim.x) {
        const int qb = it & 7, h = (it >> 3) & 3, b = it >> 5;
        attn_item<2, 128, 64>(lds, qm + (size_t)b * SEQ * MEMW + h * 128, MEMW, kvm + (size_t)b * NMEM * 1024 + h * 128, kvm + (size_t)b * NMEM * 1024 + 512 + h * 128, 1024,
                          om + (size_t)b * SEQ * MEMW + h * 128, MEMW, qb * 256, NMEM);
    }
}

__device__ __forceinline__ bool sync_if(int k, cg::grid_group& grid, XcdBarrier& xb) {
    if (k == 1) { grid.sync(); xb = xcd_barrier_post(xb.bar, xb.st); }
    else if (k > 1) xcd_barrier(xb);
    asm volatile("" ::: "memory"); return true; }
constexpr int NPHASE = 13;
#ifndef NAIVE_AB
#define NAIVE_AB 0
#endif
#ifndef NAIVE_MEM
#define NAIVE_MEM 0
#endif
#ifndef ONLY
#define ONLY -1
#endif
#ifndef DUP_MASK
#define DUP_MASK 0
#endif
#define PHASE(k) if ((ONLY < 0 || ONLY == (k)) && ph_lo <= (k) && (k) < ph_hi) if (sync_if((k), grid, xb)) for (int rep_ = 0; rep_ < (((DUP_MASK >> (k)) & 1) ? 2 : 1); ++rep_)
__global__ __launch_bounds__(512, 2) void mega(Params p, int ph_lo, int ph_hi) {
    extern __shared__ __attribute__((aligned(16))) unsigned char shm[];
    LAS unsigned char* lds = (LAS unsigned char*)shm;
    cg::grid_group grid = cg::this_grid();
    Ctx c; c.tid = threadIdx.x; c.lane = c.tid & 63; c.wave = c.tid >> 6; c.gw = blockIdx.x * 8 + c.wave; c.ngw = gridDim.x * 8; c.gt = blockIdx.x * 512 + c.tid; c.ngt = gridDim.x * 512;
    unsigned char* ws = p.ws;
    bf16_t* Wt_in = (bf16_t*)(ws + WS_WIN); bf16_t* Wt_upa = (bf16_t*)(ws + WS_WUPA); bf16_t* Wt_upb = (bf16_t*)(ws + WS_WUPB); bf16_t* Wt_out = (bf16_t*)(ws + WS_WOUT);
    bf16_t* Wt_qm = (bf16_t*)(ws + WS_WQM); bf16_t* Wt_kvm = (bf16_t*)(ws + WS_WKVM); bf16_t* Wt_om = (bf16_t*)(ws + WS_WOM); bf16_t* Wt_gu = (bf16_t*)(ws + WS_WGU); bf16_t* Wt_dn = (bf16_t*)(ws + WS_WDN);
    bf16_t* memn = (bf16_t*)(ws + WS_MEMN); bf16_t* kvm = (bf16_t*)(ws + WS_KVM);
    float* ss1 = (float*)(ws + WS_SS1); float* ss2 = (float*)(ws + WS_SS2); float* ss3 = (float*)(ws + WS_SS3); float* rope = (float*)(ws + WS_ROPE);
    bf16_t* n1 = (bf16_t*)(ws + WS_R1); bf16_t* mixed = (bf16_t*)(ws + WS_R1); bf16_t* h2b = (bf16_t*)(ws + WS_R1);
    bf16_t* proj = (bf16_t*)(ws + WS_PROJ); bf16_t* gates = (bf16_t*)(ws + WS_PROJ + 192 * MiB);
    float* h1 = (float*)(ws + WS_H1); bf16_t* h1b = (bf16_t*)(ws + WS_H1B); bf16_t* qm = (bf16_t*)(ws + WS_QM); bf16_t* om = (bf16_t*)(ws + WS_OM);
    float* h2 = (float*)(ws + WS_H2); bf16_t* act = (bf16_t*)(ws + WS_ACT); bf16_t* OA = (bf16_t*)(ws + WS_OA); bf16_t* OB = (bf16_t*)(ws + WS_OA) + 512;
    float* m1 = p.out; unsigned* bar = (unsigned*)(ws + WS_BAR);
    volatile LAS unsigned* xst = (volatile LAS unsigned*)(lds + pg8::STAGE_BYTES);
    if (c.tid == 0) { xst[0] = 0u; xst[1] = 0u; }
    __syncthreads();
    XcdBarrier xb; xb.bar = bar; xb.x = 0u; xb.st = xst;
    pg8::StaticOrder S;
    {
        PHASE(0) {
            int cur = 0;
            p_transpose(c, lds, p.w_in, Wt_in, DM, INC, nullptr, 0, cur);
            p_transpose(c, lds, p.w_ffn_gate, Wt_gu, DM, DFF, p.g_ffn, 1, cur);
            p_transpose(c, lds, p.w_ffn_up, Wt_gu, DM, DFF, p.g_ffn, 2, cur);
            p_transpose(c, lds, p.w_ffn_down, Wt_dn, DFF, DM, nullptr, 0, cur);
            p_transpose(c, lds, p.w_up_a, Wt_upa, 512, DM, nullptr, 0, cur, 1024, 0);
            p_transpose(c, lds, p.w_up_b, Wt_upa, 512, DM, nullptr, 0, cur, 1024, 512);
            p_transpose(c, lds, p.w_out, Wt_out, DM, DM, nullptr, 0, cur);
            p_transpose(c, lds, p.w_q_mem, Wt_qm, DM, MEMW, p.g_mem_q, 0, cur);
            p_transpose(c, lds, p.w_kv_mem, Wt_kvm, DM, 2 * MEMW, nullptr, 0, cur);
            p_transpose(c, lds, p.w_o_mem, Wt_om, MEMW, DM, nullptr, 0, cur);
            p_rmsnorm_rows(c, p.x, p.g_mix, n1, T);
            p_rmsnorm_rows(c, p.mem, p.g_mem_kv, memn, BATCH * NMEM);
            p_rope_table(c, p.pos, rope);
            if (blockIdx.x == 0) for (int i = c.tid; i < XCD_BAR_WORDS; i += 512) bar[i] = 0u;
        }
        PHASE(1) {
            { Gemm g{n1, Wt_in, T, INC, DM}; EpiBf16 E{proj, INC, nullptr, 1 << 30, rope, 4, 12, gates};   S.init(g.M, g.N, gridDim.x, blockIdx.x); pg8::gemm_phase(lds, g, S, E); }
            { Gemm g{memn, Wt_kvm, BATCH * NMEM, 1024, DM}; EpiBf16 E{kvm, 1024, nullptr, 1 << 30, nullptr, 0, 0, nullptr}; S.init(g.M, g.N, gridDim.x, blockIdx.x); pg8::gemm_phase(lds, g, S, E); }
        }
        PHASE(3) {
            p_attn_ab(lds, proj, OA, OB);
        }
        PHASE(5) { Gemm g{OA, Wt_upa, T, DM, DM}; EpiGate E{gates, mixed}; S.init(g.M, g.N, gridDim.x, blockIdx.x); pg8::gemm_phase(lds, g, S, E); }
        PHASE(6) { Gemm g{mixed, Wt_out, T, DM, DM}; EpiRes E{p.x, nullptr, nullptr, h1b, ss1}; S.init(g.M, g.N, gridDim.x, blockIdx.x); pg8::gemm_phase(lds, g, S, E); }
        PHASE(7) { Gemm g{h1b, Wt_qm, T, MEMW, DM}; EpiBf16 E{qm, MEMW, ss1, 1 << 30, nullptr, 0, 0, nullptr}; S.init(g.M, g.N, gridDim.x, blockIdx.x); pg8::gemm_phase(lds, g, S, E); }
        PHASE(8) {
            p_attn_mem(lds, qm, kvm, om);
        }
        PHASE(9) { Gemm g{om, Wt_om, T, DM, MEMW}; EpiRes E{nullptr, h1b, nullptr, h2b, ss2}; S.init(g.M, g.N, gridDim.x, blockIdx.x); pg8::gemm_phase(lds, g, S, E); }
        PHASE(10) { Gemm g{h2b, Wt_gu, T, 2 * DFF, DM}; EpiSwiGLU E{act, ss2}; S.init(g.M, g.N, gridDim.x, blockIdx.x); pg8::gemm_phase(lds, g, S, E); }
        PHASE(11) { Gemm g{act, Wt_dn, T, DM, DFF}; EpiRes E{nullptr, h2b, p.out, nullptr, ss3}; S.init(g.M, g.N, gridDim.x, blockIdx.x); pg8::gemm_phase(lds, g, S, E); }
        PHASE(12) p_final(c, p.out, ss3, p.g_final);
    }
}

constexpr int LDS_BYTES = pg8::STAGE_BYTES + 16;
#ifndef ONE_LAUNCH
#define ONE_LAUNCH 1
#endif
extern "C" void kernel_launch(void* const* d_in, const int* in_sizes, int n_in, void* d_out, int out_size, void* d_ws, size_t ws_size, hipStream_t stream) {
    static int grid = 0;
    if (grid == 0) {
        if (n_in != 18 || out_size != T * DM || ws_size < WS_END) { fprintf(stderr, "kernel_launch: unexpected shapes (n_in %d out %d ws %zu)\n", n_in, out_size, ws_size); grid = -1; return; }
        int dev = 0, cus = 0, per_cu = 0;
        (void)hipGetDevice(&dev); (void)hipDeviceGetAttribute(&cus, hipDeviceAttributeMultiprocessorCount, dev);
        if (hipFuncSetAttribute((const void*)mega, hipFuncAttributeMaxDynamicSharedMemorySize, LDS_BYTES) != hipSuccess) { fprintf(stderr, "hipFuncSetAttribute failed\n"); grid = -1; return; }
        if (hipOccupancyMaxActiveBlocksPerMultiprocessor(&per_cu, (const void*)mega, 512, LDS_BYTES) != hipSuccess || per_cu < 1) { fprintf(stderr, "occupancy query: %d\n", per_cu); per_cu = 1; }
        (void)hipGetLastError();
        grid = cus * 1;
    }
    if (grid < 0) return;
    Params p{};
    p.x = (const float*)d_in[0]; p.mem = (const float*)d_in[1]; p.pos = (const int*)d_in[2]; p.g_mix = (const float*)d_in[3]; p.w_in = (const float*)d_in[4];
    p.w_up_a = (const float*)d_in[5]; p.w_up_b = (const float*)d_in[6]; p.w_out = (const float*)d_in[7]; p.g_mem_q = (const float*)d_in[8]; p.g_mem_kv = (const float*)d_in[9];
    p.w_q_mem = (const float*)d_in[10]; p.w_kv_mem = (const float*)d_in[11]; p.w_o_mem = (const float*)d_in[12]; p.g_ffn = (const float*)d_in[13];
    p.w_ffn_gate = (const float*)d_in[14]; p.w_ffn_up = (const float*)d_in[15]; p.w_ffn_down = (const float*)d_in[16]; p.g_final = (const float*)d_in[17];
    p.out = (float*)d_out; p.ws = (unsigned char*)d_ws;
#if ONE_LAUNCH
    int lo = 0, hi = NPHASE;
    void* args[] = {&p, &lo, &hi};
    hipError_t e = hipLaunchCooperativeKernel((const void*)mega, dim3(grid), dim3(512), args, LDS_BYTES, stream);
    if (e != hipSuccess) fprintf(stderr, "cooperative launch failed: %s\n", hipGetErrorString(e));
#else
    for (int ph = 0; ph < NPHASE; ++ph) hipLaunchKernelGGL(mega, dim3(grid), dim3(512), LDS_BYTES, stream, p, ph, ph + 1);
#endif
}
```

```cpp
#include <hip/hip_runtime.h>
#include <hip/hip_cooperative_groups.h>
#include <cstdio>
namespace cg = cooperative_groups;

#define LAS __attribute__((address_space(3)))
typedef unsigned short bf16_t;
typedef short bf16x8 __attribute__((ext_vector_type(8)));
typedef float f32x4 __attribute__((ext_vector_type(4)));
typedef unsigned u32x4 __attribute__((ext_vector_type(4)));
typedef unsigned u32x2 __attribute__((ext_vector_type(2)));

constexpr int BATCH = 16, SEQ = 2048, DM = 1024, T = BATCH * SEQ;
constexpr int HD = 64, NHA = 8, NHB = 8;
constexpr int INC = 5120;
constexpr int C_QA = 0, C_KA = 512, C_VA = 1024, C_QB = 1536, C_KB = 2048, C_VB = 2560, C_GA = 3072, C_GB = 4096;
constexpr int NMEM = 256, MEMW = 512, DFF = 2816;
constexpr float EPS = 1e-6f;

constexpr size_t MiB = 1ull << 20;
constexpr size_t WS_WIN = 0, WS_WUPA = 10 * MiB, WS_WUPB = 11 * MiB, WS_WOUT = 12 * MiB, WS_WQM = 14 * MiB, WS_WKVM = 15 * MiB,
                 WS_WOM = 17 * MiB, WS_WGU = 18 * MiB, WS_WDN = 29 * MiB, WS_MEMN = 36 * MiB, WS_KVM = 44 * MiB,
                 WS_SS1 = 52 * MiB, WS_SS2 = 54 * MiB, WS_SS3 = 56 * MiB, WS_ROPE = 58 * MiB, WS_BAR = 60 * MiB;
constexpr size_t WS_R1 = 64 * MiB;
constexpr size_t WS_PROJ = 128 * MiB;
constexpr size_t WS_H1 = 128 * MiB, WS_H1B = 256 * MiB, WS_QM = 320 * MiB, WS_OM = 352 * MiB, WS_H2 = 384 * MiB, WS_ACT = 128 * MiB;
constexpr size_t WS_OA = 448 * MiB, WS_OB = 480 * MiB;
constexpr size_t WS_END = 512 * MiB;

struct Params {
    const float* x; const float* mem; const int* pos; const float* g_mix; const float* w_in; const float* w_up_a; const float* w_up_b; const float* w_out;
    const float* g_mem_q; const float* g_mem_kv; const float* w_q_mem; const float* w_kv_mem; const float* w_o_mem; const float* g_ffn;
    const float* w_ffn_gate; const float* w_ffn_up; const float* w_ffn_down; const float* g_final;
    float* out; unsigned char* ws;
};

typedef float f32x2 __attribute__((ext_vector_type(2)));
typedef __bf16 bf16v2 __attribute__((ext_vector_type(2)));
__device__ __forceinline__ unsigned pk_bf16(float lo, float hi) { f32x2 v = {lo, hi}; bf16v2 r = __builtin_convertvector(v, bf16v2); return __builtin_bit_cast(unsigned, r); }
__device__ __forceinline__ bf16_t f2bf(float f) { return (bf16_t)(pk_bf16(f, 0.f) & 0xffffu); }
__device__ __forceinline__ float bf2f(bf16_t b) { return __uint_as_float(((unsigned)b) << 16); }
__device__ __forceinline__ float bflo(unsigned u) { return __uint_as_float(u << 16); }
__device__ __forceinline__ float bfhi(unsigned u) { return __uint_as_float(u & 0xffff0000u); }
__device__ __forceinline__ float wave_sum(float v) {
#pragma unroll
    for (int o = 1; o < 64; o <<= 1) v += __shfl_xor(v, o);
    return v;
}
__device__ __forceinline__ float sigmoidf_(float x) { return 1.f / (1.f + __expf(-x)); }
__device__ __forceinline__ float rstd_of(const float* ss, int row) {
    const f32x4* p = (const f32x4*)(ss + (size_t)row * 16);
    f32x4 a = p[0], b = p[1], c = p[2], d = p[3];
    float s = ((a[0] + a[1]) + (a[2] + a[3])) + ((b[0] + b[1]) + (b[2] + b[3])) + ((c[0] + c[1]) + (c[2] + c[3])) + ((d[0] + d[1]) + (d[2] + d[3]));
    return rsqrtf(s * (1.f / DM) + EPS);
}


#define XB_TMO      128
#define XB_XCNT(j)  (256  + 64 * (j))
#define XB_XSUB(j)  (1280 + 64 * (j))
#define XB_XGEN(j)  (2304 + 64 * (j))
#define XB_TOP      3328
#define XB_TOPGEN   3392
#define XCD_BAR_WORDS 3456
#define XB_SPIN_CAP (1u << 18)
__device__ __forceinline__ unsigned xb_ld(unsigned* p)              { return __hip_atomic_load(p, __ATOMIC_RELAXED, __HIP_MEMORY_SCOPE_AGENT); }
__device__ __forceinline__ unsigned xb_add(unsigned* p, unsigned v) { return __hip_atomic_fetch_add(p, v, __ATOMIC_RELAXED, __HIP_MEMORY_SCOPE_AGENT); }
__device__ __forceinline__ unsigned xb_xcc_id() { return (unsigned)__builtin_amdgcn_s_getreg((3 << 11) | 20) & 0xFu; }
#define XB_SPIN(cond, bar) do { unsigned _sp = 0; while (cond) { __builtin_amdgcn_s_sleep(1); \
    if ((++_sp & 255u) == 0u) { if (xb_ld(&(bar)[XB_TMO])) break; if (_sp > XB_SPIN_CAP) { atomicAdd(&(bar)[XB_TMO], 1u); break; } } } } while (0)
struct XcdBarrier { unsigned* bar; unsigned x; volatile LAS unsigned* st; };
__device__ __forceinline__ XcdBarrier xcd_barrier_post(unsigned* bar, volatile LAS unsigned* st) {
    XcdBarrier b; b.bar = bar; b.x = xb_xcc_id(); b.st = st;
    if (threadIdx.x == 0) (void)xb_add(&bar[XB_XCNT(b.x)], 1u);
    return b;
}
__device__ __forceinline__ void xcd_barrier_complete(unsigned* bar, unsigned x, unsigned& nloc, unsigned& nx) {
    const unsigned G = gridDim.x * gridDim.y * gridDim.z;
    unsigned sum, cnt, mine, sp = 0u;
    for (;;) {
        sum = 0u; cnt = 0u; mine = 0u;
#pragma unroll
        for (unsigned j = 0; j < 16; ++j) { const unsigned c = xb_ld(&bar[XB_XCNT(j)]); sum += c; cnt += (c > 0u) ? 1u : 0u; mine = (j == x) ? c : mine; }
        if (sum == G) break;
        __builtin_amdgcn_s_sleep(1);
        if ((++sp & 255u) == 0u) { if (xb_ld(&bar[XB_TMO])) break; if (sp > XB_SPIN_CAP) { atomicAdd(&bar[XB_TMO], 1u); break; } }
    }
    nloc = mine > 0u ? mine : 1u; nx = cnt > 0u ? cnt : 1u;
}
__device__ __forceinline__ void xcd_barrier(const XcdBarrier& b) {
    asm volatile("s_waitcnt vmcnt(0)" ::: "memory");
    __syncthreads();
    if (threadIdx.x == 0) {
        unsigned* bar = b.bar;
        __builtin_amdgcn_s_waitcnt(0);
        unsigned nloc = b.st[0], nx = b.st[1];
        if (nloc == 0u) { xcd_barrier_complete(bar, b.x, nloc, nx); b.st[0] = nloc; b.st[1] = nx; }
        const unsigned old = xb_add(&bar[XB_XSUB(b.x)], 1u);
        const unsigned gen = old / nloc;
        if (old + 1u == (gen + 1u) * nloc) {
            __builtin_amdgcn_fence(__ATOMIC_RELEASE, "agent");
            asm volatile("s_waitcnt vmcnt(0)" ::: "memory");
            const unsigned og = xb_add(&bar[XB_TOP], 1u);
            const unsigned tg = og / nx;
            if (og + 1u == (tg + 1u) * nx) xb_add(&bar[XB_TOPGEN], 1u);
            else XB_SPIN(xb_ld(&bar[XB_TOPGEN]) == tg, bar);
            __builtin_amdgcn_fence(__ATOMIC_ACQUIRE, "agent");
            xb_add(&bar[XB_XGEN(b.x)], 1u);
            asm volatile("s_waitcnt vmcnt(0)" ::: "memory");
        } else {
            XB_SPIN(xb_ld(&bar[XB_XGEN(b.x)]) == gen, bar);
            __builtin_amdgcn_fence(__ATOMIC_ACQUIRE, "agent");
            asm volatile("s_waitcnt vmcnt(0)" ::: "memory");
        }
    }
    __syncthreads();
}

namespace pg8 {
constexpr int BM = 256, BK = 64, HALF = 128, HTB = HALF * BK * 2, STAGE_BYTES = 8 * HTB, NXCD = 8, WGM = 8;
__host__ __device__ __forceinline__ int lds_byte(int r, int c) { const int st = (r >> 4) * 2 + (c >> 5), rr = r & 15, cc = c & 31, ob = rr * 64 + cc * 2; return st * 1024 + (ob ^ (((ob >> 9) & 1) << 5)); }
__host__ __device__ __forceinline__ void stage_rc(int b, int& R, int& C) { const int st = b / 1024, sb = b % 1024, swz = sb ^ (((sb >> 9) & 1) << 5); R = (st >> 1) * 16 + swz / 64; C = (st & 1) * 32 + (swz % 64) / 2; }
__host__ __device__ __forceinline__ int perm32(int rho) { const int n = rho >> 4, i = rho & 15; return 8 * (i >> 2) + 4 * n + (i & 3); }
struct Unit { int pm, pn; };
struct Gemm { const bf16_t* A; const bf16_t* Bt; int M, N, K; };
struct StaticOrder {
    int nM, nN, nwg, G, c;
    __host__ __device__ void init(int M, int N, int G_, int c_) { nM = M / BM; nN = N / BM; nwg = nM * nN; G = G_; c = c_; }
    __host__ __device__ bool next(int i, Unit& u) const {
        const long L = (long)i * G + c; if (L >= nwg) return false;
        int wgid = (int)L; { const int q = nwg / NXCD, r = nwg % NXCD, xcd = wgid % NXCD, off = wgid / NXCD; wgid = (xcd < r ? xcd * (q + 1) : r * (q + 1) + (xcd - r) * q) + off; }
        const int nig = WGM * nN, gid = wgid / nig, fm = gid * WGM, gsz = (nM - fm) < WGM ? (nM - fm) : WGM;
        u.pm = fm + ((wgid % nig) % gsz); u.pn = (wgid % nig) / gsz; return true;
    }
};

template <class Epi>
__device__ __forceinline__ void gemm_phase(LAS unsigned char* lds, const Gemm g, const StaticOrder& S, const Epi& E) {
    int tid = threadIdx.x; asm volatile("" : "+v"(tid));
    const int wid = __builtin_amdgcn_readfirstlane(tid >> 6), lane = tid & 63, wr = wid >> 2, wc = wid & 3, fr = lane & 15, fq = lane >> 4;
    const int K = g.K, nt = K / BK;
    unsigned voffA[2], voffB[2];
#pragma unroll
    for (int i = 0; i < 2; ++i) { int R, C; stage_rc(tid * 16 + i * 8192, R, C); const int Rb = Epi::PERM ? ((R & ~31) + perm32(R & 31)) : R;
        voffA[i] = (unsigned)(R * K + C) * 2u; voffB[i] = (unsigned)(Rb * K + C) * 2u; }
    const size_t kstep = (size_t)(BK * 2);
    const size_t hstep = (size_t)HALF * K * 2;
    const size_t tstep = 2 * hstep;
    const unsigned ldsw = (unsigned)wid * 1024u;
    const int aoff = lds_byte(wr * 64 + fr, fq * 8), boff = lds_byte(wc * 32 + fr, fq * 8);
#define PG8_SA(b, h) (((b) * 2 + (h)) * HTB)
#define PG8_SB(b, h) ((4 + (b) * 2 + (h)) * HTB)
#define PG8_STAGE(bufoff, gbase, voff) do { _Pragma("unroll") for (int _i = 0; _i < 2; ++_i) \
        __builtin_amdgcn_global_load_lds((const unsigned*)((const char*)(gbase) + (voff)[_i]), (LAS unsigned*)(lds + (bufoff) + ldsw + _i * 8192), 16, 0, 0); } while (0)
#define PG8_LDA(dst, b, h) do { _Pragma("unroll") for (int m = 0; m < 4; ++m) _Pragma("unroll") for (int k = 0; k < 2; ++k) dst[m][k] = *(const LAS bf16x8*)(lds + PG8_SA(b, h) + aoff + m * 2048 + k * 1024); } while (0)
#define PG8_LDB(dst, b, h) do { _Pragma("unroll") for (int n = 0; n < 2; ++n) _Pragma("unroll") for (int k = 0; k < 2; ++k) dst[n][k] = *(const LAS bf16x8*)(lds + PG8_SB(b, h) + boff + n * 2048 + k * 1024); } while (0)
#define PG8_MMA(ai, bj, At, Bt) do { __builtin_amdgcn_s_setprio(1); _Pragma("unroll") for (int m = 0; m < 4; ++m) _Pragma("unroll") for (int n = 0; n < 2; ++n) _Pragma("unroll") for (int k = 0; k < 2; ++k) \
        acc[ai][bj][m][n] = __builtin_amdgcn_mfma_f32_16x16x32_bf16(Bt[n][k], At[m][k], acc[ai][bj][m][n], 0, 0, 0); __builtin_amdgcn_s_setprio(0); } while (0)
#define PG8_WAIT_V(n) asm volatile("s_waitcnt vmcnt(" #n ")" ::: "memory")
#define PG8_WAIT_L(n) asm volatile("s_waitcnt lgkmcnt(" #n ")" ::: "memory")
#define PG8_BAR __builtin_amdgcn_s_barrier()
#define PG8_SCHED __builtin_amdgcn_sched_barrier(0)
    Unit cur, nxt; int ui = 0;
    if (!S.next(0, cur)) return;
    f32x4 acc[2][2][4][2];
#pragma unroll
    for (int a = 0; a < 2; ++a)
#pragma unroll
        for (int b = 0; b < 2; ++b)
#pragma unroll
            for (int m = 0; m < 4; ++m)
#pragma unroll
                for (int n = 0; n < 2; ++n) acc[a][b][m][n] = (f32x4){0.f, 0.f, 0.f, 0.f};
    bf16x8 At[4][2], B0[2][2], B1[2][2];
    const char* cA = (const char*)g.A + (size_t)cur.pm * tstep; const char* cB = (const char*)g.Bt + (size_t)cur.pn * tstep;
    PG8_STAGE(PG8_SB(0, 0), cB, voffB); PG8_STAGE(PG8_SA(0, 0), cA, voffA); PG8_STAGE(PG8_SB(0, 1), cB + hstep, voffB); PG8_STAGE(PG8_SA(0, 1), cA + hstep, voffA);
    if (wr == 1) PG8_BAR;
    PG8_WAIT_V(4); PG8_BAR;
    PG8_STAGE(PG8_SB(1, 0), cB + kstep, voffB); PG8_STAGE(PG8_SA(1, 0), cA + kstep, voffA); PG8_STAGE(PG8_SB(1, 1), cB + hstep + kstep, voffB);
    PG8_WAIT_V(6); PG8_BAR;
    for (;;) {
        const bool has_next = S.next(ui + 1, nxt);
        const char* nA = has_next ? (const char*)g.A + (size_t)nxt.pm * tstep : cA; const char* nB = has_next ? (const char*)g.Bt + (size_t)nxt.pn * tstep : cB;
        for (int t = 0; t < nt; t += 2) {
            const bool last = (t == nt - 2);
            const char* a1 = cA + (size_t)(t + 1) * kstep;
            const char* a2 = last ? nA : cA + (size_t)(t + 2) * kstep; const char* b2 = last ? nB : cB + (size_t)(t + 2) * kstep;
            const char* a3 = a2 + kstep; const char* b3 = b2 + kstep;
            if constexpr (Epi::HAS_MID) { if (t == nt / 2) E.mid(acc, cur, wr, wc, fr, fq); }
            PG8_LDB(B0, 0, 0); PG8_SCHED; PG8_LDA(At, 0, 0); PG8_STAGE(PG8_SA(1, 1), a1 + hstep, voffA);
            PG8_WAIT_L(8); PG8_BAR; PG8_WAIT_L(0); PG8_MMA(0, 0, At, B0); PG8_BAR; PG8_SCHED;
            PG8_LDB(B1, 0, 1); PG8_STAGE(PG8_SB(0, 0), b2, voffB);
            PG8_BAR; PG8_WAIT_L(0); PG8_MMA(0, 1, At, B1); PG8_BAR;
            PG8_LDA(At, 0, 1); PG8_STAGE(PG8_SA(0, 0), a2, voffA);
            PG8_BAR; PG8_WAIT_L(0); PG8_MMA(1, 0, At, B0); PG8_BAR; PG8_SCHED;
            PG8_STAGE(PG8_SB(0, 1), b2 + hstep, voffB);
            PG8_WAIT_V(6); PG8_BAR; PG8_MMA(1, 1, At, B1); PG8_BAR;
            PG8_LDB(B0, 1, 0); PG8_SCHED; PG8_LDA(At, 1, 0); PG8_STAGE(PG8_SA(0, 1), a2 + hstep, voffA);
            PG8_WAIT_L(8); PG8_BAR; PG8_WAIT_L(0); PG8_MMA(0, 0, At, B0); PG8_BAR; PG8_SCHED;
            PG8_LDB(B1, 1, 1); PG8_STAGE(PG8_SB(1, 0), b3, voffB);
            PG8_BAR; PG8_WAIT_L(0); PG8_MMA(0, 1, At, B1); PG8_BAR;
            PG8_LDA(At, 1, 1); PG8_STAGE(PG8_SA(1, 0), a3, voffA);
            PG8_BAR; PG8_WAIT_L(0); PG8_MMA(1, 0, At, B0); PG8_BAR; PG8_SCHED;
            PG8_STAGE(PG8_SB(1, 1), b3 + hstep, voffB);
            PG8_WAIT_V(6); PG8_BAR; PG8_MMA(1, 1, At, B1); PG8_BAR;
        }
        E(acc, cur, wr, wc, fr, fq);
        if (!has_next) break;
#pragma unroll
        for (int a = 0; a < 2; ++a)
#pragma unroll
            for (int b = 0; b < 2; ++b)
#pragma unroll
                for (int m = 0; m < 4; ++m)
#pragma unroll
                    for (int n = 0; n < 2; ++n) acc[a][b][m][n] = (f32x4){0.f, 0.f, 0.f, 0.f};
        cur = nxt; cA = nA; cB = nB; ++ui;
    }
    PG8_WAIT_V(0);
    if (wr == 0) PG8_BAR;
    PG8_BAR;
#undef PG8_SA
#undef PG8_SB
#undef PG8_STAGE
#undef PG8_LDA
#undef PG8_LDB
#undef PG8_MMA
#undef PG8_WAIT_V
#undef PG8_WAIT_L
#undef PG8_BAR
#undef PG8_SCHED
}
}
using pg8::Unit; using pg8::Gemm;

struct EpiBf16 {
    static constexpr bool PERM = true, HAS_MID = false;
    bf16_t* O; int ldc; const float* ss; int sig_from; const float* rope; int rope_below; int qkv_tiles; bf16_t* gates;
    __device__ __forceinline__ void operator()(const f32x4 (&acc)[2][2][4][2], const Unit& u, int wr, int wc, int fr, int fq) const {
        const int row0 = u.pm * 256 + wr * 64 + fr, col0 = u.pn * 256 + wc * 32 + 8 * fq;
        const bool sig = u.pn >= sig_from;
#pragma unroll
        for (int ai = 0; ai < 2; ++ai)
#pragma unroll
            for (int m = 0; m < 4; ++m) {
                const int row = row0 + ai * 128 + m * 16;
                const float rs = ss ? rstd_of(ss, row) : 1.f;
#pragma unroll
                for (int bj = 0; bj < 2; ++bj) {
                    f32x4 v0 = acc[ai][bj][m][0] * rs, v1 = acc[ai][bj][m][1] * rs;
                    if (sig) {
#pragma unroll
                        for (int j = 0; j < 4; ++j) { v0[j] = sigmoidf_(v0[j]); v1[j] = sigmoidf_(v1[j]); }
                    }
                    if (u.pn < rope_below && (wc & 1) == 0) {
                        f32x4 p0, p1;
#pragma unroll
                        for (int j = 0; j < 4; ++j) { p0[j] = __shfl_xor(v0[j], 16); p1[j] = __shfl_xor(v1[j], 16); }
                        if (fq < 2) {
                            const f32x4 c0 = *(const f32x4*)(rope + (size_t)row * 16), c1 = *(const f32x4*)(rope + (size_t)row * 16 + 4);
                            f32x4 s0 = *(const f32x4*)(rope + (size_t)row * 16 + 8), s1 = *(const f32x4*)(rope + (size_t)row * 16 + 12);
                            if (fq == 0) { s0 = -s0; s1 = -s1; }
                            v0 = v0 * c0 + p0 * s0; v1 = v1 * c1 + p1 * s1;
                        }
                    }
                    u32x4 o; o[0] = pk_bf16(v0[0], v0[1]); o[1] = pk_bf16(v0[2], v0[3]); o[2] = pk_bf16(v1[0], v1[1]); o[3] = pk_bf16(v1[2], v1[3]);
                    if (qkv_tiles > 0) {
                        const int col = col0 + bj * 128;
                        if (u.pn < qkv_tiles) *(u32x4*)(O + (size_t)(col >> 9) * ((size_t)T * 512) + ((size_t)((row >> 11) * 8 + ((col >> 6) & 7)) * SEQ + (row & (SEQ - 1))) * 64 + (col & 63)) = o;
                        else *(u32x4*)(gates + (size_t)row * 2048 + (col - 256 * qkv_tiles)) = o;
                    } else *(u32x4*)(O + (size_t)row * ldc + col0 + bj * 128) = o;
                }
            }
    }
};
struct EpiGate {
    static constexpr bool PERM = true, HAS_MID = true;
    const bf16_t* gates; bf16_t* O;
    __device__ __forceinline__ void mid(f32x4 (&acc)[2][2][4][2], const Unit& u, int wr, int wc, int fr, int fq) const {
        int row0 = u.pm * 256 + wr * 64 + fr, col0 = u.pn * 256 + wc * 32 + 8 * fq;
        asm volatile("" : "+v"(row0), "+v"(col0));
#pragma unroll
        for (int ai = 0; ai < 2; ++ai)
#pragma unroll
            for (int m = 0; m < 4; ++m) {
                const int row = row0 + ai * 128 + m * 16;
#pragma unroll
                for (int bj = 0; bj < 2; ++bj) {
                    const int col = col0 + bj * 128;
                    const u32x4 ga = *(const u32x4*)(gates + (size_t)row * 2048 + col), gb = *(const u32x4*)(gates + (size_t)row * 2048 + 1024 + col);
#pragma unroll
                    for (int q = 0; q < 4; ++q) {
                        const float a0 = bflo(ga[q]), a1 = bfhi(ga[q]), b0 = fmaxf(bflo(gb[q]), -60.f), b1 = fmaxf(bfhi(gb[q]), -60.f);
                        const float r0 = (1.f + __expf(-b0)) * __builtin_amdgcn_rcpf(1.f + __expf(-a0)), r1 = (1.f + __expf(-b1)) * __builtin_amdgcn_rcpf(1.f + __expf(-a1));
                        acc[ai][bj][m][q >> 1][(q & 1) * 2] *= r0; acc[ai][bj][m][q >> 1][(q & 1) * 2 + 1] *= r1;
                    }
                }
                __builtin_amdgcn_sched_barrier(0);
            }
    }
    __device__ __forceinline__ void operator()(const f32x4 (&acc)[2][2][4][2], const Unit& u, int wr, int wc, int fr, int fq) const {
        const int row0 = u.pm * 256 + wr * 64 + fr, col0 = u.pn * 256 + wc * 32 + 8 * fq;
#pragma unroll
        for (int ai = 0; ai < 2; ++ai)
#pragma unroll
            for (int m = 0; m < 4; ++m) {
                const int row = row0 + ai * 128 + m * 16;
#pragma unroll
                for (int bj = 0; bj < 2; ++bj) {
                    const int col = col0 + bj * 128;
                    const u32x4 gb = *(const u32x4*)(gates + (size_t)row * 2048 + 1024 + col);
                    float r[8];
#pragma unroll
                    for (int q = 0; q < 4; ++q) {
                        const float b0 = fmaxf(bflo(gb[q]), -60.f), b1 = fmaxf(bfhi(gb[q]), -60.f);
                        r[2 * q] = acc[ai][bj][m][q >> 1][(q & 1) * 2] * __builtin_amdgcn_rcpf(1.f + __expf(-b0));
                        r[2 * q + 1] = acc[ai][bj][m][q >> 1][(q & 1) * 2 + 1] * __builtin_amdgcn_rcpf(1.f + __expf(-b1));
                    }
                    u32x4 o; o[0] = pk_bf16(r[0], r[1]); o[1] = pk_bf16(r[2], r[3]); o[2] = pk_bf16(r[4], r[5]); o[3] = pk_bf16(r[6], r[7]);
                    *(u32x4*)(O + (size_t)row * DM + col) = o;
                }
            }
    }
};
struct EpiRes {
    static constexpr bool PERM = false, HAS_MID = false;
    const float* R; const bf16_t* Rb; float* H; bf16_t* Hb; float* SS;
    __device__ __forceinline__ void operator()(const f32x4 (&acc)[2][2][4][2], const Unit& u, int wr, int wc, int fr, int fq) const {
        const int row0 = u.pm * 256 + wr * 64 + fr, col0 = u.pn * 256 + wc * 32 + 4 * fq;
#pragma unroll
        for (int ai = 0; ai < 2; ++ai)
#pragma unroll
            for (int m = 0; m < 4; ++m) {
                const int row = row0 + ai * 128 + m * 16;
                float s = 0.f;
#pragma unroll
                for (int bj = 0; bj < 2; ++bj)
#pragma unroll
                    for (int n = 0; n < 2; ++n) {
                        const int col = col0 + bj * 128 + n * 16;
                        f32x4 rr;
                        if (R) rr = *(const f32x4*)(R + (size_t)row * DM + col);
                        else { const u32x2 rb = *(const u32x2*)(Rb + (size_t)row * DM + col); rr[0] = bflo(rb[0]); rr[1] = bfhi(rb[0]); rr[2] = bflo(rb[1]); rr[3] = bfhi(rb[1]); }
                        const f32x4 h = rr + acc[ai][bj][m][n];
                        if (H) *(f32x4*)(H + (size_t)row * DM + col) = h;
                        if (Hb) { u32x2 o; o[0] = pk_bf16(h[0], h[1]); o[1] = pk_bf16(h[2], h[3]); *(u32x2*)(Hb + (size_t)row * DM + col) = o; }
                        s += (h[0] * h[0] + h[1] * h[1]) + (h[2] * h[2] + h[3] * h[3]);
                    }
                s += __shfl_xor(s, 16); s += __shfl_xor(s, 32);
                if (fq == 0) SS[(size_t)row * 16 + u.pn * 4 + wc] = s;
            }
    }
};
struct EpiSwiGLU {
    static constexpr bool PERM = true, HAS_MID = false;
    bf16_t* O; const float* ss;
    __device__ __forceinline__ void operator()(const f32x4 (&acc)[2][2][4][2], const Unit& u, int wr, int wc, int fr, int fq) const {
        const int row0 = u.pm * 256 + wr * 64 + fr, col0 = u.pn * 128 + wc * 32 + 8 * fq;
#pragma unroll
        for (int ai = 0; ai < 2; ++ai)
#pragma unroll
            for (int m = 0; m < 4; ++m) {
                const int row = row0 + ai * 128 + m * 16;
                const float rs = rstd_of(ss, row);
                float r[8];
#pragma unroll
                for (int n = 0; n < 2; ++n)
#pragma unroll
                    for (int j = 0; j < 4; ++j) { const float gg = acc[ai][0][m][n][j] * rs, uu = acc[ai][1][m][n][j] * rs; r[n * 4 + j] = gg * sigmoidf_(gg) * uu; }
                u32x4 o; o[0] = pk_bf16(r[0], r[1]); o[1] = pk_bf16(r[2], r[3]); o[2] = pk_bf16(r[4], r[5]); o[3] = pk_bf16(r[6], r[7]);
                *(u32x4*)(O + (size_t)row * DFF + col0) = o;
            }
    }
};

struct Ctx { int tid, lane, wave, gw, ngw, gt, ngt; };

__device__ __forceinline__ void p_transpose(const Ctx& c, LAS unsigned char* lds, const float* W, bf16_t* Wt, int K, int N, const float* g, int mode, int& cursor, int ldw = 0, int koff = 0) {
    if (ldw == 0) ldw = K;
    LAS float* scr = (LAS float*)(lds + c.wave * 8704);
    const int nblk = N / 32, nitems = (K / 64) * nblk, lane = c.lane;
    int first = (c.gw - cursor % c.ngw + c.ngw) % c.ngw;
    for (int it = first; it < nitems; it += c.ngw) {
        const int kb = it / nblk, nb = it % nblk, k0 = 64 * kb, n0 = 32 * nb;
#pragma unroll 8
        for (int i = 0; i < 32; ++i) { const int kk = 2 * i + (lane >> 5); float v = W[(size_t)(k0 + kk) * N + n0 + (lane & 31)]; if (g) v *= g[k0 + kk]; scr[kk * 33 + (lane & 31)] = v; }
        asm volatile("s_waitcnt lgkmcnt(0)" ::: "memory");
        const int ch = lane & 7;
#pragma unroll
        for (int j = 0; j < 4; ++j) { const int n = (lane >> 3) + 8 * j; const LAS float* sp = scr + (8 * ch) * 33 + n;
            u32x4 o; o[0] = pk_bf16(sp[0], sp[33]); o[1] = pk_bf16(sp[2 * 33], sp[3 * 33]); o[2] = pk_bf16(sp[4 * 33], sp[5 * 33]); o[3] = pk_bf16(sp[6 * 33], sp[7 * 33]);
            const int nn = n0 + n, row = mode == 0 ? nn : (256 * (nn >> 7) + (nn & 127) + (mode == 2 ? 128 : 0));
            *(u32x4*)(Wt + (size_t)row * ldw + koff + k0 + 8 * ch) = o; }
        asm volatile("s_waitcnt lgkmcnt(0)" ::: "memory");
    }
    cursor += nitems;
}
__device__ __forceinline__ void p_rmsnorm_rows(const Ctx& c, const float* x, const float* g, bf16_t* out, int rows) {
    f32x4 gg[4];
#pragma unroll
    for (int j = 0; j < 4; ++j) gg[j] = ((const f32x4*)g)[c.lane + 64 * j];
    for (int r0 = c.gw; r0 < rows; r0 += 2 * c.ngw) {
        const int r1 = r0 + c.ngw; const bool has1 = r1 < rows; const int r1c = has1 ? r1 : r0;
        const f32x4* xa = (const f32x4*)(x + (size_t)r0 * DM) + c.lane; const f32x4* xb = (const f32x4*)(x + (size_t)r1c * DM) + c.lane;
        f32x4 va[4], vb[4]; float sa = 0.f, sb = 0.f;
#pragma unroll
        for (int j = 0; j < 4; ++j) { va[j] = xa[64 * j]; vb[j] = xb[64 * j]; }
#pragma unroll
        for (int j = 0; j < 4; ++j) { sa += (va[j][0] * va[j][0] + va[j][1] * va[j][1]) + (va[j][2] * va[j][2] + va[j][3] * va[j][3]); sb += (vb[j][0] * vb[j][0] + vb[j][1] * vb[j][1]) + (vb[j][2] * vb[j][2] + vb[j][3] * vb[j][3]); }
        const float ra = rsqrtf(wave_sum(sa) * (1.f / DM) + EPS), rb = rsqrtf(wave_sum(sb) * (1.f / DM) + EPS);
#pragma unroll
        for (int j = 0; j < 4; ++j) {
            u32x2 o; o[0] = pk_bf16(va[j][0] * ra * gg[j][0], va[j][1] * ra * gg[j][1]); o[1] = pk_bf16(va[j][2] * ra * gg[j][2], va[j][3] * ra * gg[j][3]);
            ((u32x2*)(out + (size_t)r0 * DM))[c.lane + 64 * j] = o;
            if (has1) { u32x2 q; q[0] = pk_bf16(vb[j][0] * rb * gg[j][0], vb[j][1] * rb * gg[j][1]); q[1] = pk_bf16(vb[j][2] * rb * gg[j][2], vb[j][3] * rb * gg[j][3]);
                ((u32x2*)(out + (size_t)r1 * DM))[c.lane + 64 * j] = q; }
        }
    }
}
__device__ __forceinline__ void p_rope_table(const Ctx& c, const int* pos, float* tab) {
    for (int i = c.gt; i < T * 8; i += c.ngt) {
        const int tok = i >> 3, f = i & 7;
        const double inv = f == 0 ? 1.0 : f == 1 ? 0.19392274474868576 : f == 2 ? 0.03760603093086393 : f == 3 ? 0.007292664737217109 : f == 4 ? 0.001414213562373095 :
                           f == 5 ? 0.0002742481756762073 : f == 6 ? 5.318295896944988e-05 : 1.031338537721246e-05;
        const double rev = (double)pos[tok] * inv * 0.15915494309189535;
        const float fr = (float)(rev - rint(rev));
        tab[(size_t)tok * 16 + f] = __builtin_amdgcn_cosf(fr);
        tab[(size_t)tok * 16 + 8 + f] = __builtin_amdgcn_sinf(fr);
    }
}
__device__ __forceinline__ void p_final(const Ctx& c, float* out, const float* ss, const float* g) {
    f32x4 gg[4];
#pragma unroll
    for (int j = 0; j < 4; ++j) gg[j] = ((const f32x4*)g)[c.lane + 64 * j];
    for (int r0 = c.gw; r0 < T; r0 += 2 * c.ngw) {
        const int r1 = r0 + c.ngw; const bool has1 = r1 < T; const int r1c = has1 ? r1 : r0;
        f32x4* xa = (f32x4*)(out + (size_t)r0 * DM) + c.lane; f32x4* xb = (f32x4*)(out + (size_t)r1c * DM) + c.lane;
        f32x4 va[4], vb[4];
#pragma unroll
        for (int j = 0; j < 4; ++j) { va[j] = xa[64 * j]; vb[j] = xb[64 * j]; }
        const float ra = rstd_of(ss, r0), rb = rstd_of(ss, r1c);
#pragma unroll
        for (int j = 0; j < 4; ++j) { xa[64 * j] = va[j] * ra * gg[j]; if (has1) xb[64 * j] = vb[j] * rb * gg[j]; }
    }
}

typedef float f32x16 __attribute__((ext_vector_type(16)));
typedef short s16x4 __attribute__((ext_vector_type(4)));
#define MFMA32(a, b, c) __builtin_amdgcn_mfma_f32_32x32x16_bf16((a), (b), (c), 0, 0, 0)
constexpr int ATT_FLAG_OFF = 40960;
#ifndef ATT_DUP_A
#define ATT_DUP_A 0
#endif
#ifndef ATT_DUP_B
#define ATT_DUP_B 0
#endif
template <int MODE, int HDIM, int KT>
__device__ __forceinline__ void attn_item(LAS unsigned char* lds, const bf16_t* Qp, int ldq, const bf16_t* Kp, const bf16_t* Vp, int ldkv, bf16_t* Op, int ldo, int q0, int nkeys) {
    constexpr int KS = HDIM / 16, DD = HDIM / 32, KROW = HDIM * 2 + 16, VROW = KT * 2 + 8, NCH = HDIM / 8, PER = KT * NCH / 512, NSUB = KT / 32;
    static_assert(KT * KROW + HDIM * VROW + 128 <= ATT_FLAG_OFF, "attention LDS tiles overlap the flag words");
    int tid = threadIdx.x; asm volatile("" : "+v"(tid));
    const int lane = tid & 63, w = __builtin_amdgcn_readfirstlane(tid >> 6), r = lane & 31, hh = lane >> 5;
    const int tq0 = q0 + 32 * w, tq = tq0 + r;
    LAS unsigned char* Ks = lds; LAS unsigned char* Vt = lds + KT * KROW;
    LAS unsigned* flags = (LAS unsigned*)(lds + ATT_FLAG_OFF);
    bf16x8 Qf[KS];
#pragma unroll
    for (int ks = 0; ks < KS; ++ks) Qf[ks] = *(const bf16x8*)(Qp + (size_t)tq * ldq + 16 * ks + 8 * hh);
    f32x16 Oacc[DD];
#pragma unroll
    for (int dd = 0; dd < DD; ++dd)
#pragma unroll
        for (int i = 0; i < 16; ++i) Oacc[dd][i] = 0.f;
    float m = -INFINITY, l = 0.f, run = (MODE == 1) ? 1.f : 0.f; unsigned done_w = 0u;
    float w8[8], u4[4], fgc[4], fmn[16], fbias = 0.f;
    if (MODE == 0) {
        const int cc = r & 15, e = cc & 3, f = cc >> 3; const bool act = (hh == ((cc >> 2) & 1)); const int c4 = r & 3;
#pragma unroll
        for (int i = 0; i < 8; ++i) { w8[i] = (act && (i & 3) == e && (i >> 2) == f) ? 1.f : 0.f; asm volatile("" : "+v"(w8[i])); }
        fbias = act ? 0.f : -INFINITY; asm volatile("" : "+v"(fbias));
#pragma unroll
        for (int j = 0; j < 4; ++j) { u4[j] = (j == c4) ? 1.f : 0.f; asm volatile("" : "+v"(u4[j])); }
#pragma unroll
        for (int g = 0; g < 4; ++g) { fgc[g] = (((r - 4 * hh - c4 - 8 * g) & 15) == 0) ? 2.f : 1.f; asm volatile("" : "+v"(fgc[g])); }
#pragma unroll
        for (int i = 0; i < 16; ++i) { const int dm = (r - 4 * hh - ((i & 3) + 8 * (i >> 2))) & 15; fmn[i] = 1.f + ((dm & 3) == 0 ? 1.f : 0.f) + (dm == 0 ? 1.f : 0.f); asm volatile("" : "+v"(fmn[i])); }
    }
    const int kt_hi = (MODE == 2) ? (nkeys / KT - 1) : ((q0 + 255) / KT);
    u32x4 kA[PER], vA[PER], kB[PER], vB[PER];
#define ATT_GLOAD(KR, VR, kt) do { _Pragma("unroll") for (int p_ = 0; p_ < PER; ++p_) { const int idx_ = tid + 512 * p_, key_ = idx_ / NCH, ch_ = idx_ % NCH; \
        KR[p_] = *(const u32x4*)(Kp + (size_t)(KT * (kt) + key_) * ldkv + ch_ * 8); VR[p_] = *(const u32x4*)(Vp + (size_t)(KT * (kt) + key_) * ldkv + ch_ * 8); } } while (0)
    auto stage = [&](const u32x4 (&KR)[PER], const u32x4 (&VR)[PER]) -> bool {
        if (MODE == 1 && lane == 0) flags[w] = done_w;
        __syncthreads();
#pragma unroll
        for (int p_ = 0; p_ < PER; ++p_) { const int idx_ = tid + 512 * p_, key_ = idx_ / NCH, ch_ = idx_ % NCH;
            *(LAS u32x4*)(Ks + key_ * KROW + ch_ * 16) = KR[p_];
#pragma unroll
            for (int j = 0; j < 8; ++j) *(LAS bf16_t*)(Vt + (ch_ * 8 + j) * VROW + ch_ * 8 + key_ * 2) = (bf16_t)((VR[p_][j >> 1] >> (16 * (j & 1))) & 0xffffu);
        }
        bool alldone = false;
        if (MODE == 1) { unsigned a = 1u;
#pragma unroll
            for (int i = 0; i < 8; ++i) a &= flags[i];
            alldone = a != 0u; }
        __syncthreads();
        return alldone;
    };
    auto compute = [&](int kt) {
#pragma unroll
        for (int sub = NSUB - 1; sub >= 0; --sub) {
            const int tk0 = KT * kt + 32 * sub;
            if (MODE != 2 && tk0 > tq0 + 31) continue;
            if (MODE == 1 && done_w) continue;
            f32x16 S;
#pragma unroll
            for (int i = 0; i < 16; ++i) S[i] = 0.f;
            bf16x8 kf[KS];
#pragma unroll
            for (int ks = 0; ks < KS; ++ks) kf[ks] = *(const LAS bf16x8*)(Ks + (32 * sub + r) * KROW + (16 * ks + 8 * hh) * 2);
            __builtin_amdgcn_sched_barrier(0);
#pragma unroll
            for (int ks = 0; ks < KS; ++ks) S = MFMA32(kf[ks], Qf[ks], S);
            s16x4 vlo[DD][2], vhi[DD][2];
#pragma unroll
            for (int dd = 0; dd < DD; ++dd)
#pragma unroll
                for (int s2 = 0; s2 < 2; ++s2) {
                    const LAS unsigned char* vp = Vt + (32 * dd + r) * VROW + (4 * dd + (r >> 3)) * 8 + (32 * sub + 16 * s2 + 4 * hh) * 2;
                    vlo[dd][s2] = *(const LAS s16x4*)vp; vhi[dd][s2] = *(const LAS s16x4*)(vp + 16);
                }
            __builtin_amdgcn_sched_barrier(0);
            const int dbase = tq - tk0 - 4 * hh;
            const int D = tq0 - tk0;
            if (MODE == 0 || MODE == 2) {
                const float C = (MODE == 0 ? 0.125f : 0.08838834764831845f) * 1.4426950408889634f;
                float alpha, ls = 0.f, mn;
                if (MODE == 0 && D >= 544) {
                    float s1 = S[0] * w8[0], s2 = S[8] * w8[0];
#pragma unroll
                    for (int i = 1; i < 8; ++i) { s1 = fmaf(S[i], w8[i], s1); s2 = fmaf(S[8 + i], w8[i], s2); }
                    const float v1 = fmaf(s1, C, fbias), v2 = fmaf(s2, C, fbias);
                    float mx = fmaxf(v1, v2); mx = fmaxf(mx, __shfl_xor(mx, 32));
                    mn = fmaxf(m, mx);
                    alpha = __builtin_amdgcn_exp2f(m - mn);
                    const float p1 = __builtin_amdgcn_exp2f(v1 - mn), p2 = __builtin_amdgcn_exp2f(v2 - mn);
                    ls = p1 + p2;
#pragma unroll
                    for (int i = 0; i < 8; ++i) { S[i] = w8[i] * p1; S[8 + i] = w8[i] * p2; }
                } else if (MODE == 0 && D >= 160 && D <= 480) {
                    float vg[4]; float mx = -INFINITY;
#pragma unroll
                    for (int g = 0; g < 4; ++g) { vg[g] = (fmaf(S[4 * g + 3], u4[3], fmaf(S[4 * g + 2], u4[2], fmaf(S[4 * g + 1], u4[1], S[4 * g] * u4[0])))) * C; mx = fmaxf(mx, vg[g]); }
                    mx = fmaxf(mx, __shfl_xor(mx, 32));
                    mn = fmaxf(m, mx);
                    alpha = __builtin_amdgcn_exp2f(m - mn);
#pragma unroll
                    for (int g = 0; g < 4; ++g) { const float pg = fgc[g] * __builtin_amdgcn_exp2f(vg[g] - mn); ls += pg;
#pragma unroll
                        for (int j = 0; j < 4; ++j) S[4 * g + j] = u4[j] * pg; }
                } else if (MODE == 0 && D >= 32 && D <= 96) {
                    float mx = -INFINITY;
#pragma unroll
                    for (int i = 0; i < 16; ++i) { S[i] = S[i] * C; mx = fmaxf(mx, S[i]); }
                    mx = fmaxf(mx, __shfl_xor(mx, 32));
                    mn = fmaxf(m, mx);
                    alpha = __builtin_amdgcn_exp2f(m - mn);
#pragma unroll
                    for (int i = 0; i < 16; ++i) { const float p = fmn[i] * __builtin_amdgcn_exp2f(S[i] - mn); S[i] = p; ls += p; }
                } else {
                    float fm[16]; float mx = -INFINITY;
#pragma unroll
                    for (int i = 0; i < 16; ++i) {
                        float v = S[i] * C;
                        if (MODE == 0) { const int d = dbase - ((i & 3) + 8 * (i >> 2));
                            int mult = (d <= 128 ? 1 : 0) + ((((d & 3) == 0) && d <= 512) ? 1 : 0) + (((d & 15) == 0) ? 1 : 0);
                            mult = d >= 0 ? mult : 0; fm[i] = (float)mult; v = mult > 0 ? v : -INFINITY; }
                        else fm[i] = 1.f;
                        S[i] = v; mx = fmaxf(mx, v);
                    }
                    mx = fmaxf(mx, __shfl_xor(mx, 32));
                    mn = fmaxf(m, mx); const float ms = (mn == -INFINITY) ? 0.f : mn;
                    alpha = __builtin_amdgcn_exp2f(m - ms);
#pragma unroll
                    for (int i = 0; i < 16; ++i) { const float p = fm[i] * __builtin_amdgcn_exp2f(S[i] - ms); S[i] = p; ls += p; }
                }
                l = l * alpha + ls; m = mn;
                if (!__all(alpha == 1.f)) {
#pragma unroll
                    for (int dd = 0; dd < DD; ++dd) Oacc[dd] = Oacc[dd] * alpha;
                }
            } else {
                float om[16], ex[16], G[4], PG[4];
                if (D < 32) {
#pragma unroll
                    for (int i = 0; i < 16; ++i) { const int d = dbase - ((i & 3) + 8 * (i >> 2)); const bool valid = d > 0;
                        const float x = fminf(fmaxf(S[i] * (0.125f * 1.4426950408889634f), -115.f), 115.f); const float e = __builtin_amdgcn_exp2f(x); const float o1 = __builtin_amdgcn_rcpf(1.f + e);
                        om[i] = valid ? o1 : 1.f; S[i] = valid ? e * o1 : 0.f; }
                } else {
#pragma unroll
                    for (int i = 0; i < 16; ++i) {
                        const float x = fminf(fmaxf(S[i] * (0.125f * 1.4426950408889634f), -115.f), 115.f); const float e = __builtin_amdgcn_exp2f(x); const float o1 = __builtin_amdgcn_rcpf(1.f + e);
                        om[i] = o1; S[i] = e * o1; }
                }
#pragma unroll
                for (int g = 0; g < 4; ++g) { ex[4 * g + 3] = 1.f; ex[4 * g + 2] = om[4 * g + 3]; ex[4 * g + 1] = ex[4 * g + 2] * om[4 * g + 2]; ex[4 * g] = ex[4 * g + 1] * om[4 * g + 1]; G[g] = ex[4 * g] * om[4 * g]; }
#pragma unroll
                for (int g = 0; g < 4; ++g) PG[g] = __shfl_xor(G[g], 32);
                float suf = run;
#pragma unroll
                for (int g = 3; g >= 0; --g) { const float lat = suf * (hh == 0 ? PG[g] : 1.f);
                    S[4 * g + 3] = S[4 * g + 3] * lat; S[4 * g + 2] = S[4 * g + 2] * (lat * ex[4 * g + 2]); S[4 * g + 1] = S[4 * g + 1] * (lat * ex[4 * g + 1]); S[4 * g] = S[4 * g] * (lat * ex[4 * g]);
                    suf *= G[g] * PG[g]; }
                run = suf;
                done_w = __all(run < 1e-30f) ? 1u : 0u;
            }
            u32x4 pp0, pp1;
#pragma unroll
            for (int j = 0; j < 4; ++j) { pp0[j] = pk_bf16(S[2 * j], S[2 * j + 1]); pp1[j] = pk_bf16(S[8 + 2 * j], S[8 + 2 * j + 1]); }
            const bf16x8 P0 = __builtin_bit_cast(bf16x8, pp0), P1 = __builtin_bit_cast(bf16x8, pp1);
#pragma unroll
            for (int dd = 0; dd < DD; ++dd)
#pragma unroll
                for (int s2 = 0; s2 < 2; ++s2) {
                    const bf16x8 vf = __builtin_shufflevector(vlo[dd][s2], vhi[dd][s2], 0, 1, 2, 3, 4, 5, 6, 7);
                    Oacc[dd] = MFMA32(vf, s2 ? P1 : P0, Oacc[dd]);
                }
        }
    };
    ATT_GLOAD(kA, vA, kt_hi);
    if constexpr (MODE == 2) {
#pragma unroll 1
        for (int kt = kt_hi; kt >= 0; --kt) {
            stage(kA, vA);
            if (kt >= 1) ATT_GLOAD(kA, vA, kt - 1);
            compute(kt);
        }
    } else {
        if (kt_hi >= 1) ATT_GLOAD(kB, vB, kt_hi - 1);
#pragma unroll 1
        for (int kt = kt_hi; kt >= 0; kt -= 2) {
            if (stage(kA, vA)) break;
            if (kt >= 2) ATT_GLOAD(kA, vA, kt - 2);
            compute(kt);
            if (kt == 0) break;
            if (stage(kB, vB)) break;
            if (kt >= 3) ATT_GLOAD(kB, vB, kt - 3);
            compute(kt - 1);
        }
    }
#undef ATT_GLOAD
    float inv = 1.f;
    if (MODE != 1) { const float lt = l + __shfl_xor(l, 32); inv = 1.f / lt; }
#pragma unroll
    for (int dd = 0; dd < DD; ++dd)
#pragma unroll
        for (int g = 0; g < 4; ++g) {
            u32x2 o; o[0] = pk_bf16(Oacc[dd][4 * g] * inv, Oacc[dd][4 * g + 1] * inv); o[1] = pk_bf16(Oacc[dd][4 * g + 2] * inv, Oacc[dd][4 * g + 3] * inv);
            *(u32x2*)(Op + (size_t)tq * ldo + 32 * dd + 8 * g + 4 * hh) = o;
        }
}
__device__ __forceinline__ void p_attn_ab(LAS unsigned char* lds, const bf16_t* qkv, bf16_t* OA, bf16_t* OB) {
    constexpr size_t TS = (size_t)T * 512;
    for (int v = blockIdx.x; v < 256; v += gridDim.x) {
        const int bh = v >> 1, b = bh >> 3, h = bh & 7, par = v & 1;
        const bf16_t* base = qkv + (size_t)bh * SEQ * 64;
        for (int rep = 0; rep < 1 + ATT_DUP_A; ++rep)
        for (int k = 0; k < 4; ++k) { const int qb = (k == 0) ? 7 - par : (k == 1) ? par : (k == 2) ? 5 - par : 2 + par;
            attn_item<0, 64, 128>(lds, base, 64, base + TS, base + 2 * TS, 64, OA + (size_t)b * SEQ * 1024 + h * HD, 1024, qb * 256, SEQ); }
        for (int rep = 0; rep < 1 + ATT_DUP_B; ++rep)
        for (int k = 0; k < 4; ++k) { const int qb = (k == 0) ? 7 - par : (k == 1) ? par : (k == 2) ? 5 - par : 2 + par;
            attn_item<1, 64, 128>(lds, base + 3 * TS, 64, base + 4 * TS, base + 5 * TS, 64, OB + (size_t)b * SEQ * 1024 + h * HD, 1024, qb * 256, SEQ); }
    }
}
__device__ __forceinline__ void p_attn_mem(LAS unsigned char* lds, const bf16_t* qm, const bf16_t* kvm, bf16_t* om) {
    for (int it = blockIdx.x; it < BATCH * 4 * 8; it += gridDim.x) {
        const int qb = it & 7, h = (it >> 3) & 3, b = it >> 5;
        attn_item<2, 128, 64>(lds, qm + (size_t)b * SEQ * MEMW + h * 128, MEMW, kvm + (size_t)b * NMEM * 1024 + h * 128, kvm + (size_t)b * NMEM * 1024 + 512 + h * 128, 1024,
                          om + (size_t)b * SEQ * MEMW + h * 128, MEMW, qb * 256, NMEM);
    }
}

__device__ __forceinline__ bool sync_if(int k, cg::grid_group& grid, XcdBarrier& xb) {
    if (k == 1) { grid.sync(); xb = xcd_barrier_post(xb.bar, xb.st); }
    else if (k > 1) xcd_barrier(xb);
    asm volatile("" ::: "memory"); return true; }
constexpr int NPHASE = 13;
#ifndef NAIVE_AB
#define NAIVE_AB 0
#endif
#ifndef NAIVE_MEM
#define NAIVE_MEM 0
#endif
#ifndef ONLY
#define ONLY -1
#endif
#ifndef DUP_MASK
#define DUP_MASK 0
#endif
#define PHASE(k) if ((ONLY < 0 || ONLY == (k)) && ph_lo <= (k) && (k) < ph_hi) if (sync_if((k), grid, xb)) for (int rep_ = 0; rep_ < (((DUP_MASK >> (k)) & 1) ? 2 : 1); ++rep_)
__global__ __launch_bounds__(512, 2) void mega(Params p, int ph_lo, int ph_hi) {
    extern __shared__ __attribute__((aligned(16))) unsigned char shm[];
    LAS unsigned char* lds = (LAS unsigned char*)shm;
    cg::grid_group grid = cg::this_grid();
    Ctx c; c.tid = threadIdx.x; c.lane = c.tid & 63; c.wave = c.tid >> 6; c.gw = blockIdx.x * 8 + c.wave; c.ngw = gridDim.x * 8; c.gt = blockIdx.x * 512 + c.tid; c.ngt = gridDim.x * 512;
    unsigned char* ws = p.ws;
    bf16_t* Wt_in = (bf16_t*)(ws + WS_WIN); bf16_t* Wt_upa = (bf16_t*)(ws + WS_WUPA); bf16_t* Wt_upb = (bf16_t*)(ws + WS_WUPB); bf16_t* Wt_out = (bf16_t*)(ws + WS_WOUT);
    bf16_t* Wt_qm = (bf16_t*)(ws + WS_WQM); bf16_t* Wt_kvm = (bf16_t*)(ws + WS_WKVM); bf16_t* Wt_om = (bf16_t*)(ws + WS_WOM); bf16_t* Wt_gu = (bf16_t*)(ws + WS_WGU); bf16_t* Wt_dn = (bf16_t*)(ws + WS_WDN);
    bf16_t* memn = (bf16_t*)(ws + WS_MEMN); bf16_t* kvm = (bf16_t*)(ws + WS_KVM);
    float* ss1 = (float*)(ws + WS_SS1); float* ss2 = (float*)(ws + WS_SS2); float* ss3 = (float*)(ws + WS_SS3); float* rope = (float*)(ws + WS_ROPE);
    bf16_t* n1 = (bf16_t*)(ws + WS_R1); bf16_t* mixed = (bf16_t*)(ws + WS_R1); bf16_t* h2b = (bf16_t*)(ws + WS_R1);
    bf16_t* proj = (bf16_t*)(ws + WS_PROJ); bf16_t* gates = (bf16_t*)(ws + WS_PROJ + 192 * MiB);
    float* h1 = (float*)(ws + WS_H1); bf16_t* h1b = (bf16_t*)(ws + WS_H1B); bf16_t* qm = (bf16_t*)(ws + WS_QM); bf16_t* om = (bf16_t*)(ws + WS_OM);
    float* h2 = (float*)(ws + WS_H2); bf16_t* act = (bf16_t*)(ws + WS_ACT); bf16_t* OA = (bf16_t*)(ws + WS_OA); bf16_t* OB = (bf16_t*)(ws + WS_OA) + 512;
    float* m1 = p.out; unsigned* bar = (unsigned*)(ws + WS_BAR);
    volatile LAS unsigned* xst = (volatile LAS unsigned*)(lds + pg8::STAGE_BYTES);
    if (c.tid == 0) { xst[0] = 0u; xst[1] = 0u; }
    __syncthreads();
    XcdBarrier xb; xb.bar = bar; xb.x = 0u; xb.st = xst;
    pg8::StaticOrder S;
    {
        PHASE(0) {
            int cur = 0;
            p_transpose(c, lds, p.w_in, Wt_in, DM, INC, nullptr, 0, cur);
            p_transpose(c, lds, p.w_ffn_gate, Wt_gu, DM, DFF, p.g_ffn, 1, cur);
            p_transpose(c, lds, p.w_ffn_up, Wt_gu, DM, DFF, p.g_ffn, 2, cur);
            p_transpose(c, lds, p.w_ffn_down, Wt_dn, DFF, DM, nullptr, 0, cur);
            p_transpose(c, lds, p.w_up_a, Wt_upa, 512, DM, nullptr, 0, cur, 1024, 0);
            p_transpose(c, lds, p.w_up_b, Wt_upa, 512, DM, nullptr, 0, cur, 1024, 512);
            p_transpose(c, lds, p.w_out, Wt_out, DM, DM, nullptr, 0, cur);
            p_transpose(c, lds, p.w_q_mem, Wt_qm, DM, MEMW, p.g_mem_q, 0, cur);
            p_transpose(c, lds, p.w_kv_mem, Wt_kvm, DM, 2 * MEMW, nullptr, 0, cur);
            p_transpose(c, lds, p.w_o_mem, Wt_om, MEMW, DM, nullptr, 0, cur);
            p_rmsnorm_rows(c, p.x, p.g_mix, n1, T);
            p_rmsnorm_rows(c, p.mem, p.g_mem_kv, memn, BATCH * NMEM);
            p_rope_table(c, p.pos, rope);
            if (blockIdx.x == 0) for (int i = c.tid; i < XCD_BAR_WORDS; i += 512) bar[i] = 0u;
        }
        PHASE(1) {
            { Gemm g{n1, Wt_in, T, INC, DM}; EpiBf16 E{proj, INC, nullptr, 1 << 30, rope, 4, 12, gates};   S.init(g.M, g.N, gridDim.x, blockIdx.x); pg8::gemm_phase(lds, g, S, E); }
            { Gemm g{memn, Wt_kvm, BATCH * NMEM, 1024, DM}; EpiBf16 E{kvm, 1024, nullptr, 1 << 30, nullptr, 0, 0, nullptr}; S.init(g.M, g.N, gridDim.x, blockIdx.x); pg8::gemm_phase(lds, g, S, E); }
        }
        PHASE(3) {
            p_attn_ab(lds, proj, OA, OB);
        }
        PHASE(5) { Gemm g{OA, Wt_upa, T, DM, DM}; EpiGate E{gates, mixed}; S.init(g.M, g.N, gridDim.x, blockIdx.x); pg8::gemm_phase(lds, g, S, E); }
        PHASE(6) { Gemm g{mixed, Wt_out, T, DM, DM}; EpiRes E{p.x, nullptr, nullptr, h1b, ss1}; S.init(g.M, g.N, gridDim.x, blockIdx.x); pg8::gemm_phase(lds, g, S, E); }
        PHASE(7) { Gemm g{h1b, Wt_qm, T, MEMW, DM}; EpiBf16 E{qm, MEMW, ss1, 1 << 30, nullptr, 0, 0, nullptr}; S.init(g.M, g.N, gridDim.x, blockIdx.x); pg8::gemm_phase(lds, g, S, E); }
        PHASE(8) {
            p_attn_mem(lds, qm, kvm, om);
        }
        PHASE(9) { Gemm g{om, Wt_om, T, DM, MEMW}; EpiRes E{nullptr, h1b, nullptr, h2b, ss2}; S.init(g.M, g.N, gridDim.x, blockIdx.x); pg8::gemm_phase(lds, g, S, E); }
        PHASE(10) { Gemm g{h2b, Wt_gu, T, 2 * DFF, DM}; EpiSwiGLU E{act, ss2}; S.init(g.M, g.N, gridDim.x, blockIdx.x); pg8::gemm_phase(lds, g, S, E); }
        PHASE(11) { Gemm g{act, Wt_dn, T, DM, DFF}; EpiRes E{nullptr, h2b, p.out, nullptr, ss3}; S.init(g.M, g.N, gridDim.x, blockIdx.x); pg8::gemm_phase(lds, g, S, E); }
        PHASE(12) p_final(c, p.out, ss3, p.g_final);
    }
}

constexpr int LDS_BYTES = pg8::STAGE_BYTES + 16;
#ifndef ONE_LAUNCH
#define ONE_LAUNCH 1
#endif
extern "C" void kernel_launch(void* const* d_in, const int* in_sizes, int n_in, void* d_out, int out_size, void* d_ws, size_t ws_size, hipStream_t stream) {
    static int grid = 0;
    if (grid == 0) {
        if (n_in != 18 || out_size != T * DM || ws_size < WS_END) { fprintf(stderr, "kernel_launch: unexpected shapes (n_in %d out %d ws %zu)\n", n_in, out_size, ws_size); grid = -1; return; }
        int dev = 0, cus = 0, per_cu = 0;
        (void)hipGetDevice(&dev); (void)hipDeviceGetAttribute(&cus, hipDeviceAttributeMultiprocessorCount, dev);
        if (hipFuncSetAttribute((const void*)mega, hipFuncAttributeMaxDynamicSharedMemorySize, LDS_BYTES) != hipSuccess) { fprintf(stderr, "hipFuncSetAttribute failed\n"); grid = -1; return; }
        if (hipOccupancyMaxActiveBlocksPerMultiprocessor(&per_cu, (const void*)mega, 512, LDS_BYTES) != hipSuccess || per_cu < 1) { fprintf(stderr, "occupancy query: %d\n", per_cu); per_cu = 1; }
        (void)hipGetLastError();
        grid = cus * 1;
    }
    if (grid < 0) return;
    Params p{};
    p.x = (const float*)d_in[0]; p.mem = (const float*)d_in[1]; p.pos = (const int*)d_in[2]; p.g_mix = (const float*)d_in[3]; p.w_in = (const float*)d_in[4];
    p.w_up_a = (const float*)d_in[5]; p.w_up_b = (const float*)d_in[6]; p.w_out = (const float*)d_in[7]; p.g_mem_q = (const float*)d_in[8]; p.g_mem_kv = (const float*)d_in[9];
    p.w_q_mem = (const float*)d_in[10]; p.w_kv_mem = (const float*)d_in[11]; p.w_o_mem = (const float*)d_in[12]; p.g_ffn = (const float*)d_in[13];
    p.w_ffn_gate = (const float*)d_in[14]; p.w_ffn_up = (const float*)d_in[15]; p.w_ffn_down = (const float*)d_in[16]; p.g_final = (const float*)d_in[17];
    p.out = (float*)d_out; p.ws = (unsigned char*)d_ws;
#if ONE_LAUNCH
    int lo = 0, hi = NPHASE;
    void* args[] = {&p, &lo, &hi};
    hipError_t e = hipLaunchCooperativeKernel((const void*)mega, dim3(grid), dim3(512), args, LDS_BYTES, stream);
    if (e != hipSuccess) fprintf(stderr, "cooperative launch failed: %s\n", hipGetErrorString(e));
#else
    for (int ph = 0; ph < NPHASE; ++ph) hipLaunchKernelGGL(mega, dim3(grid), dim3(512), LDS_BYTES, stream, p, ph, ph + 1);
#endif
}
```

```cpp
#include <hip/hip_runtime.h>
#include <hip/hip_cooperative_groups.h>
#include <cstdio>
namespace cg = cooperative_groups;

#define LAS __attribute__((address_space(3)))
typedef unsigned short bf16_t;
typedef short bf16x8 __attribute__((ext_vector_type(8)));
typedef float f32x4 __attribute__((ext_vector_type(4)));
typedef unsigned u32x4 __attribute__((ext_vector_type(4)));
typedef unsigned u32x2 __attribute__((ext_vector_type(2)));

constexpr int BATCH = 16, SEQ = 2048, DM = 1024, T = BATCH * SEQ;
constexpr int HD = 64, NHA = 8, NHB = 8;
constexpr int INC = 5120;
constexpr int C_QA = 0, C_KA = 512, C_VA = 1024, C_QB = 1536, C_KB = 2048, C_VB = 2560, C_GA = 3072, C_GB = 4096;
constexpr int NMEM = 256, MEMW = 512, DFF = 2816;
constexpr float EPS = 1e-6f;

constexpr size_t MiB = 1ull << 20;
constexpr size_t WS_WIN = 0, WS_WUPA = 10 * MiB, WS_WUPB = 11 * MiB, WS_WOUT = 12 * MiB, WS_WQM = 14 * MiB, WS_WKVM = 15 * MiB,
                 WS_WOM = 17 * MiB, WS_WGU = 18 * MiB, WS_WDN = 29 * MiB, WS_MEMN = 36 * MiB, WS_KVM = 44 * MiB,
                 WS_SS1 = 52 * MiB, WS_SS2 = 54 * MiB, WS_SS3 = 56 * MiB, WS_ROPE = 58 * MiB, WS_BAR = 60 * MiB;
constexpr size_t WS_R1 = 64 * MiB;
constexpr size_t WS_PROJ = 128 * MiB;
constexpr size_t WS_H1 = 128 * MiB, WS_H1B = 256 * MiB, WS_QM = 320 * MiB, WS_OM = 352 * MiB, WS_H2 = 384 * MiB, WS_ACT = 128 * MiB;
constexpr size_t WS_OA = 448 * MiB, WS_OB = 480 * MiB;
constexpr size_t WS_END = 512 * MiB;

struct Params {
    const float* x; const float* mem; const int* pos; const float* g_mix; const float* w_in; const float* w_up_a; const float* w_up_b; const float* w_out;
    const float* g_mem_q; const float* g_mem_kv; const float* w_q_mem; const float* w_kv_mem; const float* w_o_mem; const float* g_ffn;
    const float* w_ffn_gate; const float* w_ffn_up; const float* w_ffn_down; const float* g_final;
    float* out; unsigned char* ws;
};

typedef float f32x2 __attribute__((ext_vector_type(2)));
typedef __bf16 bf16v2 __attribute__((ext_vector_type(2)));
__device__ __forceinline__ unsigned pk_bf16(float lo, float hi) { f32x2 v = {lo, hi}; bf16v2 r = __builtin_convertvector(v, bf16v2); return __builtin_bit_cast(unsigned, r); }
__device__ __forceinline__ bf16_t f2bf(float f) { return (bf16_t)(pk_bf16(f, 0.f) & 0xffffu); }
__device__ __forceinline__ float bf2f(bf16_t b) { return __uint_as_float(((unsigned)b) << 16); }
__device__ __forceinline__ float bflo(unsigned u) { return __uint_as_float(u << 16); }
__device__ __forceinline__ float bfhi(unsigned u) { return __uint_as_float(u & 0xffff0000u); }
__device__ __forceinline__ float wave_sum(float v) {
#pragma unroll
    for (int o = 1; o < 64; o <<= 1) v += __shfl_xor(v, o);
    return v;
}
__device__ __forceinline__ float sigmoidf_(float x) { return 1.f / (1.f + __expf(-x)); }
__device__ __forceinline__ float rstd_of(const float* ss, int row) {
    const f32x4* p = (const f32x4*)(ss + (size_t)row * 16);
    f32x4 a = p[0], b = p[1], c = p[2], d = p[3];
    float s = ((a[0] + a[1]) + (a[2] + a[3])) + ((b[0] + b[1]) + (b[2] + b[3])) + ((c[0] + c[1]) + (c[2] + c[3])) + ((d[0] + d[1]) + (d[2] + d[3]));
    return rsqrtf(s * (1.f / DM) + EPS);
}


#define XB_TMO      128
#define XB_XCNT(j)  (256  + 64 * (j))
#define XB_XSUB(j)  (1280 + 64 * (j))
#define XB_XGEN(j)  (2304 + 64 * (j))
#define XB_TOP      3328
#define XB_TOPGEN   3392
#define XCD_BAR_WORDS 3456
#define XB_SPIN_CAP (1u << 18)
__device__ __forceinline__ unsigned xb_ld(unsigned* p)              { return __hip_atomic_load(p, __ATOMIC_RELAXED, __HIP_MEMORY_SCOPE_AGENT); }
__device__ __forceinline__ unsigned xb_add(unsigned* p, unsigned v) { return __hip_atomic_fetch_add(p, v, __ATOMIC_RELAXED, __HIP_MEMORY_SCOPE_AGENT); }
__device__ __forceinline__ unsigned xb_xcc_id() { return (unsigned)__builtin_amdgcn_s_getreg((3 << 11) | 20) & 0xFu; }
#define XB_SPIN(cond, bar) do { unsigned _sp = 0; while (cond) { __builtin_amdgcn_s_sleep(1); \
    if ((++_sp & 255u) == 0u) { if (xb_ld(&(bar)[XB_TMO])) break; if (_sp > XB_SPIN_CAP) { atomicAdd(&(bar)[XB_TMO], 1u); break; } } } } while (0)
struct XcdBarrier { unsigned* bar; unsigned x; volatile LAS unsigned* st; };
__device__ __forceinline__ XcdBarrier xcd_barrier_post(unsigned* bar, volatile LAS unsigned* st) {
    XcdBarrier b; b.bar = bar; b.x = xb_xcc_id(); b.st = st;
    if (threadIdx.x == 0) (void)xb_add(&bar[XB_XCNT(b.x)], 1u);
    return b;
}
__device__ __forceinline__ void xcd_barrier_complete(unsigned* bar, unsigned x, unsigned& nloc, unsigned& nx) {
    const unsigned G = gridDim.x * gridDim.y * gridDim.z;
    unsigned sum, cnt, mine, sp = 0u;
    for (;;) {
        sum = 0u; cnt = 0u; mine = 0u;
#pragma unroll
        for (unsigned j = 0; j < 16; ++j) { const unsigned c = xb_ld(&bar[XB_XCNT(j)]); sum += c; cnt += (c > 0u) ? 1u : 0u; mine = (j == x) ? c : mine; }
        if (sum == G) break;
        __builtin_amdgcn_s_sleep(1);
        if ((++sp & 255u) == 0u) { if (xb_ld(&bar[XB_TMO])) break; if (sp > XB_SPIN_CAP) { atomicAdd(&bar[XB_TMO], 1u); break; } }
    }
    nloc = mine > 0u ? mine : 1u; nx = cnt > 0u ? cnt : 1u;
}
__device__ __forceinline__ void xcd_barrier(const XcdBarrier& b) {
    asm volatile("s_waitcnt vmcnt(0)" ::: "memory");
    __syncthreads();
    if (threadIdx.x == 0) {
        unsigned* bar = b.bar;
        __builtin_amdgcn_s_waitcnt(0);
        unsigned nloc = b.st[0], nx = b.st[1];
        if (nloc == 0u) { xcd_barrier_complete(bar, b.x, nloc, nx); b.st[0] = nloc; b.st[1] = nx; }
        const unsigned old = xb_add(&bar[XB_XSUB(b.x)], 1u);
        const unsigned gen = old / nloc;
        if (old + 1u == (gen + 1u) * nloc) {
            __builtin_amdgcn_fence(__ATOMIC_RELEASE, "agent");
            asm volatile("s_waitcnt vmcnt(0)" ::: "memory");
            const unsigned og = xb_add(&bar[XB_TOP], 1u);
            const unsigned tg = og / nx;
            if (og + 1u == (tg + 1u) * nx) xb_add(&bar[XB_TOPGEN], 1u);
            else XB_SPIN(xb_ld(&bar[XB_TOPGEN]) == tg, bar);
            __builtin_amdgcn_fence(__ATOMIC_ACQUIRE, "agent");
            xb_add(&bar[XB_XGEN(b.x)], 1u);
            asm volatile("s_waitcnt vmcnt(0)" ::: "memory");
        } else {
            XB_SPIN(xb_ld(&bar[XB_XGEN(b.x)]) == gen, bar);
            __builtin_amdgcn_fence(__ATOMIC_ACQUIRE, "agent");
            asm volatile("s_waitcnt vmcnt(0)" ::: "memory");
        }
    }
    __syncthreads();
}

namespace pg8 {
constexpr int BM = 256, BK = 64, HALF = 128, HTB = HALF * BK * 2, STAGE_BYTES = 8 * HTB, NXCD = 8, WGM = 8;
__host__ __device__ __forceinline__ int lds_byte(int r, int c) { const int st = (r >> 4) * 2 + (c >> 5), rr = r & 15, cc = c & 31, ob = rr * 64 + cc * 2; return st * 1024 + (ob ^ (((ob >> 9) & 1) << 5)); }
__host__ __device__ __forceinline__ void stage_rc(int b, int& R, int& C) { const int st = b / 1024, sb = b % 1024, swz = sb ^ (((sb >> 9) & 1) << 5); R = (st >> 1) * 16 + swz / 64; C = (st & 1) * 32 + (swz % 64) / 2; }
__host__ __device__ __forceinline__ int perm32(int rho) { const int n = rho >> 4, i = rho & 15; return 8 * (i >> 2) + 4 * n + (i & 3); }
struct Unit { int pm, pn; };
struct Gemm { const bf16_t* A; const bf16_t* Bt; int M, N, K; };
struct StaticOrder {
    int nM, nN, nwg, G, c;
    __host__ __device__ void init(int M, int N, int G_, int c_) { nM = M / BM; nN = N / BM; nwg = nM * nN; G = G_; c = c_; }
    __host__ __device__ bool next(int i, Unit& u) const {
        const long L = (long)i * G + c; if (L >= nwg) return false;
        int wgid = (int)L; { const int q = nwg / NXCD, r = nwg % NXCD, xcd = wgid % NXCD, off = wgid / NXCD; wgid = (xcd < r ? xcd * (q + 1) : r * (q + 1) + (xcd - r) * q) + off; }
        const int nig = WGM * nN, gid = wgid / nig, fm = gid * WGM, gsz = (nM - fm) < WGM ? (nM - fm) : WGM;
        u.pm = fm + ((wgid % nig) % gsz); u.pn = (wgid % nig) / gsz; return true;
    }
};

template <class Epi>
__device__ __forceinline__ void gemm_phase(LAS unsigned char* lds, const Gemm g, const StaticOrder& S, const Epi& E) {
    int tid = threadIdx.x; asm volatile("" : "+v"(tid));
    const int wid = __builtin_amdgcn_readfirstlane(tid >> 6), lane = tid & 63, wr = wid >> 2, wc = wid & 3, fr = lane & 15, fq = lane >> 4;
    const int K = g.K, nt = K / BK;
    unsigned voffA[2], voffB[2];
#pragma unroll
    for (int i = 0; i < 2; ++i) { int R, C; stage_rc(tid * 16 + i * 8192, R, C); const int Rb = Epi::PERM ? ((R & ~31) + perm32(R & 31)) : R;
        voffA[i] = (unsigned)(R * K + C) * 2u; voffB[i] = (unsigned)(Rb * K + C) * 2u; }
    const size_t kstep = (size_t)(BK * 2);
    const size_t hstep = (size_t)HALF * K * 2;
    const size_t tstep = 2 * hstep;
    const unsigned ldsw = (unsigned)wid * 1024u;
    const int aoff = lds_byte(wr * 64 + fr, fq * 8), boff = lds_byte(wc * 32 + fr, fq * 8);
#define PG8_SA(b, h) (((b) * 2 + (h)) * HTB)
#define PG8_SB(b, h) ((4 + (b) * 2 + (h)) * HTB)
#define PG8_STAGE(bufoff, gbase, voff) do { _Pragma("unroll") for (int _i = 0; _i < 2; ++_i) \
        __builtin_amdgcn_global_load_lds((const unsigned*)((const char*)(gbase) + (voff)[_i]), (LAS unsigned*)(lds + (bufoff) + ldsw + _i * 8192), 16, 0, 0); } while (0)
#define PG8_LDA(dst, b, h) do { _Pragma("unroll") for (int m = 0; m < 4; ++m) _Pragma("unroll") for (int k = 0; k < 2; ++k) dst[m][k] = *(const LAS bf16x8*)(lds + PG8_SA(b, h) + aoff + m * 2048 + k * 1024); } while (0)
#define PG8_LDB(dst, b, h) do { _Pragma("unroll") for (int n = 0; n < 2; ++n) _Pragma("unroll") for (int k = 0; k < 2; ++k) dst[n][k] = *(const LAS bf16x8*)(lds + PG8_SB(b, h) + boff + n * 2048 + k * 1024); } while (0)
#define PG8_MMA(ai, bj, At, Bt) do { __builtin_amdgcn_s_setprio(1); _Pragma("unroll") for (int m = 0; m < 4; ++m) _Pragma("unroll") for (int n = 0; n < 2; ++n) _Pragma("unroll") for (int k = 0; k < 2; ++k) \
        acc[ai][bj][m][n] = __builtin_amdgcn_mfma_f32_16x16x32_bf16(Bt[n][k], At[m][k], acc[ai][bj][m][n], 0, 0, 0); __builtin_amdgcn_s_setprio(0); } while (0)
#define PG8_WAIT_V(n) asm volatile("s_waitcnt vmcnt(" #n ")" ::: "memory")
#define PG8_WAIT_L(n) asm volatile("s_waitcnt lgkmcnt(" #n ")" ::: "memory")
#define PG8_BAR __builtin_amdgcn_s_barrier()
#define PG8_SCHED __builtin_amdgcn_sched_barrier(0)
    Unit cur, nxt; int ui = 0;
    if (!S.next(0, cur)) return;
    f32x4 acc[2][2][4][2];
#pragma unroll
    for (int a = 0; a < 2; ++a)
#pragma unroll
        for (int b = 0; b < 2; ++b)
#pragma unroll
            for (int m = 0; m < 4; ++m)
#pragma unroll
                for (int n = 0; n < 2; ++n) acc[a][b][m][n] = (f32x4){0.f, 0.f, 0.f, 0.f};
    bf16x8 At[4][2], B0[2][2], B1[2][2];
    const char* cA = (const char*)g.A + (size_t)cur.pm * tstep; const char* cB = (const char*)g.Bt + (size_t)cur.pn * tstep;
    PG8_STAGE(PG8_SB(0, 0), cB, voffB); PG8_STAGE(PG8_SA(0, 0), cA, voffA); PG8_STAGE(PG8_SB(0, 1), cB + hstep, voffB); PG8_STAGE(PG8_SA(0, 1), cA + hstep, voffA);
    if (wr == 1) PG8_BAR;
    PG8_WAIT_V(4); PG8_BAR;
    PG8_STAGE(PG8_SB(1, 0), cB + kstep, voffB); PG8_STAGE(PG8_SA(1, 0), cA + kstep, voffA); PG8_STAGE(PG8_SB(1, 1), cB + hstep + kstep, voffB);
    PG8_WAIT_V(6); PG8_BAR;
    for (;;) {
        const bool has_next = S.next(ui + 1, nxt);
        const char* nA = has_next ? (const char*)g.A + (size_t)nxt.pm * tstep : cA; const char* nB = has_next ? (const char*)g.Bt + (size_t)nxt.pn * tstep : cB;
        for (int t = 0; t < nt; t += 2) {
            const bool last = (t == nt - 2);
            const char* a1 = cA + (size_t)(t + 1) * kstep;
            const char* a2 = last ? nA : cA + (size_t)(t + 2) * kstep; const char* b2 = last ? nB : cB + (size_t)(t + 2) * kstep;
            const char* a3 = a2 + kstep; const char* b3 = b2 + kstep;
            if constexpr (Epi::HAS_MID) { if (t == nt / 2) E.mid(acc, cur, wr, wc, fr, fq); }
            PG8_LDB(B0, 0, 0); PG8_SCHED; PG8_LDA(At, 0, 0); PG8_STAGE(PG8_SA(1, 1), a1 + hstep, voffA);
            PG8_WAIT_L(8); PG8_BAR; PG8_WAIT_L(0); PG8_MMA(0, 0, At, B0); PG8_BAR; PG8_SCHED;
            PG8_LDB(B1, 0, 1); PG8_STAGE(PG8_SB(0, 0), b2, voffB);
            PG8_BAR; PG8_WAIT_L(0); PG8_MMA(0, 1, At, B1); PG8_BAR;
            PG8_LDA(At, 0, 1); PG8_STAGE(PG8_SA(0, 0), a2, voffA);
            PG8_BAR; PG8_WAIT_L(0); PG8_MMA(1, 0, At, B0); PG8_BAR; PG8_SCHED;
            PG8_STAGE(PG8_SB(0, 1), b2 + hstep, voffB);
            PG8_WAIT_V(6); PG8_BAR; PG8_MMA(1, 1, At, B1); PG8_BAR;
            PG8_LDB(B0, 1, 0); PG8_SCHED; PG8_LDA(At, 1, 0); PG8_STAGE(PG8_SA(0, 1), a2 + hstep, voffA);
            PG8_WAIT_L(8); PG8_BAR; PG8_WAIT_L(0); PG8_MMA(0, 0, At, B0); PG8_BAR; PG8_SCHED;
            PG8_LDB(B1, 1, 1); PG8_STAGE(PG8_SB(1, 0), b3, voffB);
            PG8_BAR; PG8_WAIT_L(0); PG8_MMA(0, 1, At, B1); PG8_BAR;
            PG8_LDA(At, 1, 1); PG8_STAGE(PG8_SA(1, 0), a3, voffA);
            PG8_BAR; PG8_WAIT_L(0); PG8_MMA(1, 0, At, B0); PG8_BAR; PG8_SCHED;
            PG8_STAGE(PG8_SB(1, 1), b3 + hstep, voffB);
            PG8_WAIT_V(6); PG8_BAR; PG8_MMA(1, 1, At, B1); PG8_BAR;
        }
        E(acc, cur, wr, wc, fr, fq);
        if (!has_next) break;
#pragma unroll
        for (int a = 0; a < 2; ++a)
#pragma unroll
            for (int b = 0; b < 2; ++b)
#pragma unroll
                for (int m = 0; m < 4; ++m)
#pragma unroll
                    for (int n = 0; n < 2; ++n) acc[a][b][m][n] = (f32x4){0.f, 0.f, 0.f, 0.f};
        cur = nxt; cA = nA; cB = nB; ++ui;
    }
    PG8_WAIT_V(0);
    if (wr == 0) PG8_BAR;
    PG8_BAR;
#undef PG8_SA
#undef PG8_SB
#undef PG8_STAGE
#undef PG8_LDA
#undef PG8_LDB
#undef PG8_MMA
#undef PG8_WAIT_V
#undef PG8_WAIT_L
#undef PG8_BAR
#undef PG8_SCHED
}
}
using pg8::Unit; using pg8::Gemm;

struct EpiBf16 {
    static constexpr bool PERM = true, HAS_MID = false;
    bf16_t* O; int ldc; const float* ss; int sig_from; const float* rope; int rope_below; int qkv_tiles; bf16_t* gates;
    __device__ __forceinline__ void operator()(const f32x4 (&acc)[2][2][4][2], const Unit& u, int wr, int wc, int fr, int fq) const {
        const int row0 = u.pm * 256 + wr * 64 + fr, col0 = u.pn * 256 + wc * 32 + 8 * fq;
        const bool sig = u.pn >= sig_from;
#pragma unroll
        for (int ai = 0; ai < 2; ++ai)
#pragma unroll
            for (int m = 0; m < 4; ++m) {
                const int row = row0 + ai * 128 + m * 16;
                const float rs = ss ? rstd_of(ss, row) : 1.f;
#pragma unroll
                for (int bj = 0; bj < 2; ++bj) {
                    f32x4 v0 = acc[ai][bj][m][0] * rs, v1 = acc[ai][bj][m][1] * rs;
                    if (sig) {
#pragma unroll
                        for (int j = 0; j < 4; ++j) { v0[j] = sigmoidf_(v0[j]); v1[j] = sigmoidf_(v1[j]); }
                    }
                    if (u.pn < rope_below && (wc & 1) == 0) {
                        f32x4 p0, p1;
#pragma unroll
                        for (int j = 0; j < 4; ++j) { p0[j] = __shfl_xor(v0[j], 16); p1[j] = __shfl_xor(v1[j], 16); }
                        if (fq < 2) {
                            const f32x4 c0 = *(const f32x4*)(rope + (size_t)row * 16), c1 = *(const f32x4*)(rope + (size_t)row * 16 + 4);
                            f32x4 s0 = *(const f32x4*)(rope + (size_t)row * 16 + 8), s1 = *(const f32x4*)(rope + (size_t)row * 16 + 12);
                            if (fq == 0) { s0 = -s0; s1 = -s1; }
                            v0 = v0 * c0 + p0 * s0; v1 = v1 * c1 + p1 * s1;
                        }
                    }
                    u32x4 o; o[0] = pk_bf16(v0[0], v0[1]); o[1] = pk_bf16(v0[2], v0[3]); o[2] = pk_bf16(v1[0], v1[1]); o[3] = pk_bf16(v1[2], v1[3]);
                    if (qkv_tiles > 0) {
                        const int col = col0 + bj * 128;
                        if (u.pn < qkv_tiles) *(u32x4*)(O + (size_t)(col >> 9) * ((size_t)T * 512) + ((size_t)((row >> 11) * 8 + ((col >> 6) & 7)) * SEQ + (row & (SEQ - 1))) * 64 + (col & 63)) = o;
                        else *(u32x4*)(gates + (size_t)row * 2048 + (col - 256 * qkv_tiles)) = o;
                    } else *(u32x4*)(O + (size_t)row * ldc + col0 + bj * 128) = o;
                }
            }
    }
};
struct EpiGate {
    static constexpr bool PERM = true, HAS_MID = true;
    const bf16_t* gates; bf16_t* O;
    __device__ __forceinline__ void mid(f32x4 (&acc)[2][2][4][2], const Unit& u, int wr, int wc, int fr, int fq) const {
        int row0 = u.pm * 256 + wr * 64 + fr, col0 = u.pn * 256 + wc * 32 + 8 * fq;
        asm volatile("" : "+v"(row0), "+v"(col0));
#pragma unroll
        for (int ai = 0; ai < 2; ++ai)
#pragma unroll
            for (int m = 0; m < 4; ++m) {
                const int row = row0 + ai * 128 + m * 16;
#pragma unroll
                for (int bj = 0; bj < 2; ++bj) {
                    const int col = col0 + bj * 128;
                    const u32x4 ga = *(const u32x4*)(gates + (size_t)row * 2048 + col), gb = *(const u32x4*)(gates + (size_t)row * 2048 + 1024 + col);
#pragma unroll
                    for (int q = 0; q < 4; ++q) {
                        const float a0 = bflo(ga[q]), a1 = bfhi(ga[q]), b0 = fmaxf(bflo(gb[q]), -60.f), b1 = fmaxf(bfhi(gb[q]), -60.f);
                        const float r0 = (1.f + __expf(-b0)) * __builtin_amdgcn_rcpf(1.f + __expf(-a0)), r1 = (1.f + __expf(-b1)) * __builtin_amdgcn_rcpf(1.f + __expf(-a1));
                        acc[ai][bj][m][q >> 1][(q & 1) * 2] *= r0; acc[ai][bj][m][q >> 1][(q & 1) * 2 + 1] *= r1;
                    }
                }
                __builtin_amdgcn_sched_barrier(0);
            }
    }
    __device__ __forceinline__ void operator()(const f32x4 (&acc)[2][2][4][2], const Unit& u, int wr, int wc, int fr, int fq) const {
        const int row0 = u.pm * 256 + wr * 64 + fr, col0 = u.pn * 256 + wc * 32 + 8 * fq;
#pragma unroll
        for (int ai = 0; ai < 2; ++ai)
#pragma unroll
            for (int m = 0; m < 4; ++m) {
                const int row = row0 + ai * 128 + m * 16;
#pragma unroll
                for (int bj = 0; bj < 2; ++bj) {
                    const int col = col0 + bj * 128;
                    const u32x4 gb = *(const u32x4*)(gates + (size_t)row * 2048 + 1024 + col);
                    float r[8];
#pragma unroll
                    for (int q = 0; q < 4; ++q) {
                        const float b0 = fmaxf(bflo(gb[q]), -60.f), b1 = fmaxf(bfhi(gb[q]), -60.f);
                        r[2 * q] = acc[ai][bj][m][q >> 1][(q & 1) * 2] * __builtin_amdgcn_rcpf(1.f + __expf(-b0));
                        r[2 * q + 1] = acc[ai][bj][m][q >> 1][(q & 1) * 2 + 1] * __builtin_amdgcn_rcpf(1.f + __expf(-b1));
                    }
                    u32x4 o; o[0] = pk_bf16(r[0], r[1]); o[1] = pk_bf16(r[2], r[3]); o[2] = pk_bf16(r[4], r[5]); o[3] = pk_bf16(r[6], r[7]);
                    *(u32x4*)(O + (size_t)row * DM + col) = o;
                }
            }
    }
};
struct EpiRes {
    static constexpr bool PERM = false, HAS_MID = false;
    const float* R; const bf16_t* Rb; float* H; bf16_t* Hb; float* SS;
    __device__ __forceinline__ void operator()(const f32x4 (&acc)[2][2][4][2], const Unit& u, int wr, int wc, int fr, int fq) const {
        const int row0 = u.pm * 256 + wr * 64 + fr, col0 = u.pn * 256 + wc * 32 + 4 * fq;
#pragma unroll
        for (int ai = 0; ai < 2; ++ai)
#pragma unroll
            for (int m = 0; m < 4; ++m) {
                const int row = row0 + ai * 128 + m * 16;
                float s = 0.f;
#pragma unroll
                for (int bj = 0; bj < 2; ++bj)
#pragma unroll
                    for (int n = 0; n < 2; ++n) {
                        const int col = col0 + bj * 128 + n * 16;
                        f32x4 rr;
                        if (R) rr = *(const f32x4*)(R + (size_t)row * DM + col);
                        else { const u32x2 rb = *(const u32x2*)(Rb + (size_t)row * DM + col); rr[0] = bflo(rb[0]); rr[1] = bfhi(rb[0]); rr[2] = bflo(rb[1]); rr[3] = bfhi(rb[1]); }
                        const f32x4 h = rr + acc[ai][bj][m][n];
                        if (H) *(f32x4*)(H + (size_t)row * DM + col) = h;
                        if (Hb) { u32x2 o; o[0] = pk_bf16(h[0], h[1]); o[1] = pk_bf16(h[2], h[3]); *(u32x2*)(Hb + (size_t)row * DM + col) = o; }
                        s += (h[0] * h[0] + h[1] * h[1]) + (h[2] * h[2] + h[3] * h[3]);
                    }
                s += __shfl_xor(s, 16); s += __shfl_xor(s, 32);
                if (fq == 0) SS[(size_t)row * 16 + u.pn * 4 + wc] = s;
            }
    }
};
struct EpiSwiGLU {
    static constexpr bool PERM = true, HAS_MID = false;
    bf16_t* O; const float* ss;
    __device__ __forceinline__ void operator()(const f32x4 (&acc)[2][2][4][2], const Unit& u, int wr, int wc, int fr, int fq) const {
        const int row0 = u.pm * 256 + wr * 64 + fr, col0 = u.pn * 128 + wc * 32 + 8 * fq;
#pragma unroll
        for (int ai = 0; ai < 2; ++ai)
#pragma unroll
            for (int m = 0; m < 4; ++m) {
                const int row = row0 + ai * 128 + m * 16;
                const float rs = rstd_of(ss, row);
                float r[8];
#pragma unroll
                for (int n = 0; n < 2; ++n)
#pragma unroll
                    for (int j = 0; j < 4; ++j) { const float gg = acc[ai][0][m][n][j] * rs, uu = acc[ai][1][m][n][j] * rs; r[n * 4 + j] = gg * sigmoidf_(gg) * uu; }
                u32x4 o; o[0] = pk_bf16(r[0], r[1]); o[1] = pk_bf16(r[2], r[3]); o[2] = pk_bf16(r[4], r[5]); o[3] = pk_bf16(r[6], r[7]);
                *(u32x4*)(O + (size_t)row * DFF + col0) = o;
            }
    }
};

struct Ctx { int tid, lane, wave, gw, ngw, gt, ngt; };

__device__ __forceinline__ void p_transpose(const Ctx& c, LAS unsigned char* lds, const float* W, bf16_t* Wt, int K, int N, const float* g, int mode, int& cursor, int ldw = 0, int koff = 0) {
    if (ldw == 0) ldw = K;
    LAS float* scr = (LAS float*)(lds + c.wave * 8704);
    const int nblk = N / 32, nitems = (K / 64) * nblk, lane = c.lane;
    int first = (c.gw - cursor % c.ngw + c.ngw) % c.ngw;
    for (int it = first; it < nitems; it += c.ngw) {
        const int kb = it / nblk, nb = it % nblk, k0 = 64 * kb, n0 = 32 * nb;
#pragma unroll 8
        for (int i = 0; i < 32; ++i) { const int kk = 2 * i + (lane >> 5); float v = W[(size_t)(k0 + kk) * N + n0 + (lane & 31)]; if (g) v *= g[k0 + kk]; scr[kk * 33 + (lane & 31)] = v; }
        asm volatile("s_waitcnt lgkmcnt(0)" ::: "memory");
        const int ch = lane & 7;
#pragma unroll
        for (int j = 0; j < 4; ++j) { const int n = (lane >> 3) + 8 * j; const LAS float* sp = scr + (8 * ch) * 33 + n;
            u32x4 o; o[0] = pk_bf16(sp[0], sp[33]); o[1] = pk_bf16(sp[2 * 33], sp[3 * 33]); o[2] = pk_bf16(sp[4 * 33], sp[5 * 33]); o[3] = pk_bf16(sp[6 * 33], sp[7 * 33]);
            const int nn = n0 + n, row = mode == 0 ? nn : (256 * (nn >> 7) + (nn & 127) + (mode == 2 ? 128 : 0));
            *(u32x4*)(Wt + (size_t)row * ldw + koff + k0 + 8 * ch) = o; }
        asm volatile("s_waitcnt lgkmcnt(0)" ::: "memory");
    }
    cursor += nitems;
}
__device__ __forceinline__ void p_rmsnorm_rows(const Ctx& c, const float* x, const float* g, bf16_t* out, int rows) {
    f32x4 gg[4];
#pragma unroll
    for (int j = 0; j < 4; ++j) gg[j] = ((const f32x4*)g)[c.lane + 64 * j];
    for (int r0 = c.gw; r0 < rows; r0 += 2 * c.ngw) {
        const int r1 = r0 + c.ngw; const bool has1 = r1 < rows; const int r1c = has1 ? r1 : r0;
        const f32x4* xa = (const f32x4*)(x + (size_t)r0 * DM) + c.lane; const f32x4* xb = (const f32x4*)(x + (size_t)r1c * DM) + c.lane;
        f32x4 va[4], vb[4]; float sa = 0.f, sb = 0.f;
#pragma unroll
        for (int j = 0; j < 4; ++j) { va[j] = xa[64 * j]; vb[j] = xb[64 * j]; }
#pragma unroll
        for (int j = 0; j < 4; ++j) { sa += (va[j][0] * va[j][0] + va[j][1] * va[j][1]) + (va[j][2] * va[j][2] + va[j][3] * va[j][3]); sb += (vb[j][0] * vb[j][0] + vb[j][1] * vb[j][1]) + (vb[j][2] * vb[j][2] + vb[j][3] * vb[j][3]); }
        const float ra = rsqrtf(wave_sum(sa) * (1.f / DM) + EPS), rb = rsqrtf(wave_sum(sb) * (1.f / DM) + EPS);
#pragma unroll
        for (int j = 0; j < 4; ++j) {
            u32x2 o; o[0] = pk_bf16(va[j][0] * ra * gg[j][0], va[j][1] * ra * gg[j][1]); o[1] = pk_bf16(va[j][2] * ra * gg[j][2], va[j][3] * ra * gg[j][3]);
            ((u32x2*)(out + (size_t)r0 * DM))[c.lane + 64 * j] = o;
            if (has1) { u32x2 q; q[0] = pk_bf16(vb[j][0] * rb * gg[j][0], vb[j][1] * rb * gg[j][1]); q[1] = pk_bf16(vb[j][2] * rb * gg[j][2], vb[j][3] * rb * gg[j][3]);
                ((u32x2*)(out + (size_t)r1 * DM))[c.lane + 64 * j] = q; }
        }
    }
}
__device__ __forceinline__ void p_rope_table(const Ctx& c, const int* pos, float* tab) {
    for (int i = c.gt; i < T * 8; i += c.ngt) {
        const int tok = i >> 3, f = i & 7;
        const double inv = f == 0 ? 1.0 : f == 1 ? 0.19392274474868576 : f == 2 ? 0.03760603093086393 : f == 3 ? 0.007292664737217109 : f == 4 ? 0.001414213562373095 :
                           f == 5 ? 0.0002742481756762073 : f == 6 ? 5.318295896944988e-05 : 1.031338537721246e-05;
        const double rev = (double)pos[tok] * inv * 0.15915494309189535;
        const float fr = (float)(rev - rint(rev));
        tab[(size_t)tok * 16 + f] = __builtin_amdgcn_cosf(fr);
        tab[(size_t)tok * 16 + 8 + f] = __builtin_amdgcn_sinf(fr);
    }
}
__device__ __forceinline__ void p_final(const Ctx& c, float* out, const float* ss, const float* g) {
    f32x4 gg[4];
#pragma unroll
    for (int j = 0; j < 4; ++j) gg[j] = ((const f32x4*)g)[c.lane + 64 * j];
    for (int r0 = c.gw; r0 < T; r0 += 2 * c.ngw) {
        const int r1 = r0 + c.ngw; const bool has1 = r1 < T; const int r1c = has1 ? r1 : r0;
        f32x4* xa = (f32x4*)(out + (size_t)r0 * DM) + c.lane; f32x4* xb = (f32x4*)(out + (size_t)r1c * DM) + c.lane;
        f32x4 va[4], vb[4];
#pragma unroll
        for (int j = 0; j < 4; ++j) { va[j] = xa[64 * j]; vb[j] = xb[64 * j]; }
        const float ra = rstd_of(ss, r0), rb = rstd_of(ss, r1c);
#pragma unroll
        for (int j = 0; j < 4; ++j) { xa[64 * j] = va[j] * ra * gg[j]; if (has1) xb[64 * j] = vb[j] * rb * gg[j]; }
    }
}

typedef float f32x16 __attribute__((ext_vector_type(16)));
typedef short s16x4 __attribute__((ext_vector_type(4)));
#define MFMA32(a, b, c) __builtin_amdgcn_mfma_f32_32x32x16_bf16((a), (b), (c), 0, 0, 0)
constexpr int ATT_FLAG_OFF = 40960;
#ifndef ATT_DUP_A
#define ATT_DUP_A 0
#endif
#ifndef ATT_DUP_B
#define ATT_DUP_B 0
#endif
template <int MODE, int HDIM, int KT>
__device__ __forceinline__ void attn_item(LAS unsigned char* lds, const bf16_t* Qp, int ldq, const bf16_t* Kp, const bf16_t* Vp, int ldkv, bf16_t* Op, int ldo, int q0, int nkeys) {
    constexpr int KS = HDIM / 16, DD = HDIM / 32, KROW = HDIM * 2 + 16, VROW = KT * 2 + 8, NCH = HDIM / 8, PER = KT * NCH / 512, NSUB = KT / 32;
    static_assert(KT * KROW + HDIM * VROW + 128 <= ATT_FLAG_OFF, "attention LDS tiles overlap the flag words");
    int tid = threadIdx.x; asm volatile("" : "+v"(tid));
    const int lane = tid & 63, w = __builtin_amdgcn_readfirstlane(tid >> 6), r = lane & 31, hh = lane >> 5;
    const int tq0 = q0 + 32 * w, tq = tq0 + r;
    LAS unsigned char* Ks = lds; LAS unsigned char* Vt = lds + KT * KROW;
    LAS unsigned* flags = (LAS unsigned*)(lds + ATT_FLAG_OFF);
    bf16x8 Qf[KS];
#pragma unroll
    for (int ks = 0; ks < KS; ++ks) Qf[ks] = *(const bf16x8*)(Qp + (size_t)tq * ldq + 16 * ks + 8 * hh);
    f32x16 Oacc[DD];
#pragma unroll
    for (int dd = 0; dd < DD; ++dd)
#pragma unroll
        for (int i = 0; i < 16; ++i) Oacc[dd][i] = 0.f;
    float m = -INFINITY, l = 0.f, run = (MODE == 1) ? 1.f : 0.f; unsigned done_w = 0u;
    float w8[8], u4[4], fgc[4], fmn[16], fbias = 0.f;
    if (MODE == 0) {
        const int cc = r & 15, e = cc & 3, f = cc >> 3; const bool act = (hh == ((cc >> 2) & 1)); const int c4 = r & 3;
#pragma unroll
        for (int i = 0; i < 8; ++i) { w8[i] = (act && (i & 3) == e && (i >> 2) == f) ? 1.f : 0.f; asm volatile("" : "+v"(w8[i])); }
        fbias = act ? 0.f : -INFINITY; asm volatile("" : "+v"(fbias));
#pragma unroll
        for (int j = 0; j < 4; ++j) { u4[j] = (j == c4) ? 1.f : 0.f; asm volatile("" : "+v"(u4[j])); }
#pragma unroll
        for (int g = 0; g < 4; ++g) { fgc[g] = (((r - 4 * hh - c4 - 8 * g) & 15) == 0) ? 2.f : 1.f; asm volatile("" : "+v"(fgc[g])); }
#pragma unroll
        for (int i = 0; i < 16; ++i) { const int dm = (r - 4 * hh - ((i & 3) + 8 * (i >> 2))) & 15; fmn[i] = 1.f + ((dm & 3) == 0 ? 1.f : 0.f) + (dm == 0 ? 1.f : 0.f); asm volatile("" : "+v"(fmn[i])); }
    }
    const int kt_hi = (MODE == 2) ? (nkeys / KT - 1) : ((q0 + 255) / KT);
    u32x4 kA[PER], vA[PER], kB[PER], vB[PER];
#define ATT_GLOAD(KR, VR, kt) do { _Pragma("unroll") for (int p_ = 0; p_ < PER; ++p_) { const int idx_ = tid + 512 * p_, key_ = idx_ / NCH, ch_ = idx_ % NCH; \
        KR[p_] = *(const u32x4*)(Kp + (size_t)(KT * (kt) + key_) * ldkv + ch_ * 8); VR[p_] = *(const u32x4*)(Vp + (size_t)(KT * (kt) + key_) * ldkv + ch_ * 8); } } while (0)
    auto stage = [&](const u32x4 (&KR)[PER], const u32x4 (&VR)[PER]) -> bool {
        if (MODE == 1 && lane == 0) flags[w] = done_w;
        __syncthreads();
#pragma unroll
        for (int p_ = 0; p_ < PER; ++p_) { const int idx_ = tid + 512 * p_, key_ = idx_ / NCH, ch_ = idx_ % NCH;
            *(LAS u32x4*)(Ks + key_ * KROW + ch_ * 16) = KR[p_];
#pragma unroll
            for (int j = 0; j < 8; ++j) *(LAS bf16_t*)(Vt + (ch_ * 8 + j) * VROW + ch_ * 8 + key_ * 2) = (bf16_t)((VR[p_][j >> 1] >> (16 * (j & 1))) & 0xffffu);
        }
        bool alldone = false;
        if (MODE == 1) { unsigned a = 1u;
#pragma unroll
            for (int i = 0; i < 8; ++i) a &= flags[i];
            alldone = a != 0u; }
        __syncthreads();
        return alldone;
    };
    auto qk = [&](int sub, f32x16& S) {
        bf16x8 kf[KS];
#pragma unroll
        for (int ks = 0; ks < KS; ++ks) kf[ks] = *(const LAS bf16x8*)(Ks + (32 * sub + r) * KROW + (16 * ks + 8 * hh) * 2);
#pragma unroll
        for (int i = 0; i < 16; ++i) S[i] = 0.f;
        __builtin_amdgcn_sched_barrier(0);
#pragma unroll
        for (int ks = 0; ks < KS; ++ks) S = MFMA32(kf[ks], Qf[ks], S);
    };
    auto compute = [&](int kt) {
        f32x16 Sn; bool an;
        { const int tkn = KT * kt + 32 * (NSUB - 1); an = !((MODE != 2 && tkn > tq0 + 31) || (MODE == 1 && done_w)); if (an) qk(NSUB - 1, Sn); }
#pragma unroll
        for (int sub = NSUB - 1; sub >= 0; --sub) {
            const int tk0 = KT * kt + 32 * sub;
            f32x16 S = Sn; const bool a = an;
            if (sub > 0) { const int tkn = tk0 - 32; an = !((MODE != 2 && tkn > tq0 + 31) || (MODE == 1 && done_w)); if (an) qk(sub - 1, Sn); }
            if (!a) continue;
            s16x4 vlo[DD][2], vhi[DD][2];
#pragma unroll
            for (int dd = 0; dd < DD; ++dd)
#pragma unroll
                for (int s2 = 0; s2 < 2; ++s2) {
                    const LAS unsigned char* vp = Vt + (32 * dd + r) * VROW + (4 * dd + (r >> 3)) * 8 + (32 * sub + 16 * s2 + 4 * hh) * 2;
                    vlo[dd][s2] = *(const LAS s16x4*)vp; vhi[dd][s2] = *(const LAS s16x4*)(vp + 16);
                }
            __builtin_amdgcn_sched_barrier(0);
            const int dbase = tq - tk0 - 4 * hh;
            const int D = tq0 - tk0;
            if (MODE == 0 || MODE == 2) {
                const float C = (MODE == 0 ? 0.125f : 0.08838834764831845f) * 1.4426950408889634f;
                float alpha, ls = 0.f, mn;
                if (MODE == 0 && D >= 544) {
                    float s1 = S[0] * w8[0], s2 = S[8] * w8[0];
#pragma unroll
                    for (int i = 1; i < 8; ++i) { s1 = fmaf(S[i], w8[i], s1); s2 = fmaf(S[8 + i], w8[i], s2); }
                    const float v1 = fmaf(s1, C, fbias), v2 = fmaf(s2, C, fbias);
                    float mx = fmaxf(v1, v2); mx = fmaxf(mx, __shfl_xor(mx, 32));
                    mn = fmaxf(m, mx);
                    alpha = __builtin_amdgcn_exp2f(m - mn);
                    const float p1 = __builtin_amdgcn_exp2f(v1 - mn), p2 = __builtin_amdgcn_exp2f(v2 - mn);
                    ls = p1 + p2;
#pragma unroll
                    for (int i = 0; i < 8; ++i) { S[i] = w8[i] * p1; S[8 + i] = w8[i] * p2; }
                } else if (MODE == 0 && D >= 160 && D <= 480) {
                    float vg[4]; float mx = -INFINITY;
#pragma unroll
                    for (int g = 0; g < 4; ++g) { vg[g] = (fmaf(S[4 * g + 3], u4[3], fmaf(S[4 * g + 2], u4[2], fmaf(S[4 * g + 1], u4[1], S[4 * g] * u4[0])))) * C; mx = fmaxf(mx, vg[g]); }
                    mx = fmaxf(mx, __shfl_xor(mx, 32));
                    mn = fmaxf(m, mx);
                    alpha = __builtin_amdgcn_exp2f(m - mn);
#pragma unroll
                    for (int g = 0; g < 4; ++g) { const float pg = fgc[g] * __builtin_amdgcn_exp2f(vg[g] - mn); ls += pg;
#pragma unroll
                        for (int j = 0; j < 4; ++j) S[4 * g + j] = u4[j] * pg; }
                } else if (MODE == 0 && D >= 32 && D <= 96) {
                    float mx = -INFINITY;
#pragma unroll
                    for (int i = 0; i < 16; ++i) { S[i] = S[i] * C; mx = fmaxf(mx, S[i]); }
                    mx = fmaxf(mx, __shfl_xor(mx, 32));
                    mn = fmaxf(m, mx);
                    alpha = __builtin_amdgcn_exp2f(m - mn);
#pragma unroll
                    for (int i = 0; i < 16; ++i) { const float p = fmn[i] * __builtin_amdgcn_exp2f(S[i] - mn); S[i] = p; ls += p; }
                } else {
                    float fm[16]; float mx = -INFINITY;
#pragma unroll
                    for (int i = 0; i < 16; ++i) {
                        float v = S[i] * C;
                        if (MODE == 0) { const int d = dbase - ((i & 3) + 8 * (i >> 2));
                            int mult = (d <= 128 ? 1 : 0) + ((((d & 3) == 0) && d <= 512) ? 1 : 0) + (((d & 15) == 0) ? 1 : 0);
                            mult = d >= 0 ? mult : 0; fm[i] = (float)mult; v = mult > 0 ? v : -INFINITY; }
                        else fm[i] = 1.f;
                        S[i] = v; mx = fmaxf(mx, v);
                    }
                    mx = fmaxf(mx, __shfl_xor(mx, 32));
                    mn = fmaxf(m, mx); const float ms = (mn == -INFINITY) ? 0.f : mn;
                    alpha = __builtin_amdgcn_exp2f(m - ms);
#pragma unroll
                    for (int i = 0; i < 16; ++i) { const float p = fm[i] * __builtin_amdgcn_exp2f(S[i] - ms); S[i] = p; ls += p; }
                }
                l = l * alpha + ls; m = mn;
                if (!__all(alpha == 1.f)) {
#pragma unroll
                    for (int dd = 0; dd < DD; ++dd) Oacc[dd] = Oacc[dd] * alpha;
                }
            } else {
                float om[16], ex[16], G[4], PG[4];
                if (D < 32) {
#pragma unroll
                    for (int i = 0; i < 16; ++i) { const int d = dbase - ((i & 3) + 8 * (i >> 2)); const bool valid = d > 0;
                        const float x = fminf(fmaxf(S[i] * (0.125f * 1.4426950408889634f), -115.f), 115.f); const float e = __builtin_amdgcn_exp2f(x); const float o1 = __builtin_amdgcn_rcpf(1.f + e);
                        om[i] = valid ? o1 : 1.f; S[i] = valid ? e * o1 : 0.f; }
                } else {
#pragma unroll
                    for (int i = 0; i < 16; ++i) {
                        const float x = fminf(fmaxf(S[i] * (0.125f * 1.4426950408889634f), -115.f), 115.f); const float e = __builtin_amdgcn_exp2f(x); const float o1 = __builtin_amdgcn_rcpf(1.f + e);
                        om[i] = o1; S[i] = e * o1; }
                }
#pragma unroll
                for (int g = 0; g < 4; ++g) { ex[4 * g + 3] = 1.f; ex[4 * g + 2] = om[4 * g + 3]; ex[4 * g + 1] = ex[4 * g + 2] * om[4 * g + 2]; ex[4 * g] = ex[4 * g + 1] * om[4 * g + 1]; G[g] = ex[4 * g] * om[4 * g]; }
#pragma unroll
                for (int g = 0; g < 4; ++g) PG[g] = __shfl_xor(G[g], 32);
                float suf = run;
#pragma unroll
                for (int g = 3; g >= 0; --g) { const float lat = suf * (hh == 0 ? PG[g] : 1.f);
                    S[4 * g + 3] = S[4 * g + 3] * lat; S[4 * g + 2] = S[4 * g + 2] * (lat * ex[4 * g + 2]); S[4 * g + 1] = S[4 * g + 1] * (lat * ex[4 * g + 1]); S[4 * g] = S[4 * g] * (lat * ex[4 * g]);
                    suf *= G[g] * PG[g]; }
                run = suf;
                done_w = __all(run < 1e-30f) ? 1u : 0u;
            }
            u32x4 pp0, pp1;
#pragma unroll
            for (int j = 0; j < 4; ++j) { pp0[j] = pk_bf16(S[2 * j], S[2 * j + 1]); pp1[j] = pk_bf16(S[8 + 2 * j], S[8 + 2 * j + 1]); }
            const bf16x8 P0 = __builtin_bit_cast(bf16x8, pp0), P1 = __builtin_bit_cast(bf16x8, pp1);
#pragma unroll
            for (int dd = 0; dd < DD; ++dd)
#pragma unroll
                for (int s2 = 0; s2 < 2; ++s2) {
                    const bf16x8 vf = __builtin_shufflevector(vlo[dd][s2], vhi[dd][s2], 0, 1, 2, 3, 4, 5, 6, 7);
                    Oacc[dd] = MFMA32(vf, s2 ? P1 : P0, Oacc[dd]);
                }
        }
    };
    ATT_GLOAD(kA, vA, kt_hi);
    if constexpr (MODE == 2) {
#pragma unroll 1
        for (int kt = kt_hi; kt >= 0; --kt) {
            stage(kA, vA);
            if (kt >= 1) ATT_GLOAD(kA, vA, kt - 1);
            compute(kt);
        }
    } else {
        if (kt_hi >= 1) ATT_GLOAD(kB, vB, kt_hi - 1);
#pragma unroll 1
        for (int kt = kt_hi; kt >= 0; kt -= 2) {
            if (stage(kA, vA)) break;
            if (kt >= 2) ATT_GLOAD(kA, vA, kt - 2);
            compute(kt);
            if (kt == 0) break;
            if (stage(kB, vB)) break;
            if (kt >= 3) ATT_GLOAD(kB, vB, kt - 3);
            compute(kt - 1);
        }
    }
#undef ATT_GLOAD
    float inv = 1.f;
    if (MODE != 1) { const float lt = l + __shfl_xor(l, 32); inv = 1.f / lt; }
#pragma unroll
    for (int dd = 0; dd < DD; ++dd)
#pragma unroll
        for (int g = 0; g < 4; ++g) {
            u32x2 o; o[0] = pk_bf16(Oacc[dd][4 * g] * inv, Oacc[dd][4 * g + 1] * inv); o[1] = pk_bf16(Oacc[dd][4 * g + 2] * inv, Oacc[dd][4 * g + 3] * inv);
            *(u32x2*)(Op + (size_t)tq * ldo + 32 * dd + 8 * g + 4 * hh) = o;
        }
}
__device__ __forceinline__ void p_attn_ab(LAS unsigned char* lds, const bf16_t* qkv, bf16_t* OA, bf16_t* OB) {
    constexpr size_t TS = (size_t)T * 512;
    for (int v = blockIdx.x; v < 256; v += gridDim.x) {
        const int bh = v >> 1, b = bh >> 3, h = bh & 7, par = v & 1;
        const bf16_t* base = qkv + (size_t)bh * SEQ * 64;
        for (int rep = 0; rep < 1 + ATT_DUP_A; ++rep)
        for (int k = 0; k < 4; ++k) { const int qb = (k == 0) ? 7 - par : (k == 1) ? par : (k == 2) ? 5 - par : 2 + par;
            attn_item<0, 64, 128>(lds, base, 64, base + TS, base + 2 * TS, 64, OA + (size_t)b * SEQ * 1024 + h * HD, 1024, qb * 256, SEQ); }
        for (int rep = 0; rep < 1 + ATT_DUP_B; ++rep)
        for (int k = 0; k < 4; ++k) { const int qb = (k == 0) ? 7 - par : (k == 1) ? par : (k == 2) ? 5 - par : 2 + par;
            attn_item<1, 64, 128>(lds, base + 3 * TS, 64, base + 4 * TS, base + 5 * TS, 64, OB + (size_t)b * SEQ * 1024 + h * HD, 1024, qb * 256, SEQ); }
    }
}
__device__ __forceinline__ void p_attn_mem(LAS unsigned char* lds, const bf16_t* qm, const bf16_t* kvm, bf16_t* om) {
#pragma unroll 1
    for (int i = 0;; ++i) {
        Unit u; { pg8::StaticOrder S2; S2.init(T, MEMW, (int)gridDim.x, (int)blockIdx.x); if (!S2.next(i, u)) break; }
        const int b = u.pm >> 3, qb = u.pm & 7;
#pragma unroll 1
        for (int hq = 0; hq < 2; ++hq) { const int h = 2 * u.pn + hq;
            attn_item<2, 128, 64>(lds, qm + (size_t)b * SEQ * MEMW + h * 128, MEMW, kvm + (size_t)b * NMEM * 1024 + h * 128, kvm + (size_t)b * NMEM * 1024 + 512 + h * 128, 1024,
                                  om + (size_t)b * SEQ * MEMW + h * 128, MEMW, qb * 256, NMEM); }
    }
}

__device__ __forceinline__ bool sync_if(int k, cg::grid_group& grid, XcdBarrier& xb) {
    if (k == 1) { grid.sync(); xb = xcd_barrier_post(xb.bar, xb.st); }
    else if (k == 8) {
        asm volatile("s_waitcnt vmcnt(0)" ::: "memory");
        __syncthreads();
        if (threadIdx.x == 0) { __builtin_amdgcn_fence(__ATOMIC_ACQUIRE, "agent"); asm volatile("s_waitcnt vmcnt(0)" ::: "memory"); }
        __syncthreads();
    }
    else if (k > 1) xcd_barrier(xb);
    asm volatile("" ::: "memory"); return true; }
constexpr int NPHASE = 13;
#ifndef NAIVE_AB
#define NAIVE_AB 0
#endif
#ifndef NAIVE_MEM
#define NAIVE_MEM 0
#endif
#ifndef ONLY
#define ONLY -1
#endif
#ifndef DUP_MASK
#define DUP_MASK 0
#endif
#define PHASE(k) if ((ONLY < 0 || ONLY == (k)) && ph_lo <= (k) && (k) < ph_hi) if (sync_if((k), grid, xb)) for (int rep_ = 0; rep_ < (((DUP_MASK >> (k)) & 1) ? 2 : 1); ++rep_)
__global__ __launch_bounds__(512, 2) void mega(Params p, int ph_lo, int ph_hi) {
    extern __shared__ __attribute__((aligned(16))) unsigned char shm[];
    LAS unsigned char* lds = (LAS unsigned char*)shm;
    cg::grid_group grid = cg::this_grid();
    Ctx c; c.tid = threadIdx.x; c.lane = c.tid & 63; c.wave = c.tid >> 6; c.gw = blockIdx.x * 8 + c.wave; c.ngw = gridDim.x * 8; c.gt = blockIdx.x * 512 + c.tid; c.ngt = gridDim.x * 512;
    unsigned char* ws = p.ws;
    bf16_t* Wt_in = (bf16_t*)(ws + WS_WIN); bf16_t* Wt_upa = (bf16_t*)(ws + WS_WUPA); bf16_t* Wt_upb = (bf16_t*)(ws + WS_WUPB); bf16_t* Wt_out = (bf16_t*)(ws + WS_WOUT);
    bf16_t* Wt_qm = (bf16_t*)(ws + WS_WQM); bf16_t* Wt_kvm = (bf16_t*)(ws + WS_WKVM); bf16_t* Wt_om = (bf16_t*)(ws + WS_WOM); bf16_t* Wt_gu = (bf16_t*)(ws + WS_WGU); bf16_t* Wt_dn = (bf16_t*)(ws + WS_WDN);
    bf16_t* memn = (bf16_t*)(ws + WS_MEMN); bf16_t* kvm = (bf16_t*)(ws + WS_KVM);
    float* ss1 = (float*)(ws + WS_SS1); float* ss2 = (float*)(ws + WS_SS2); float* ss3 = (float*)(ws + WS_SS3); float* rope = (float*)(ws + WS_ROPE);
    bf16_t* n1 = (bf16_t*)(ws + WS_R1); bf16_t* mixed = (bf16_t*)(ws + WS_R1); bf16_t* h2b = (bf16_t*)(ws + WS_R1);
    bf16_t* proj = (bf16_t*)(ws + WS_PROJ); bf16_t* gates = (bf16_t*)(ws + WS_PROJ + 192 * MiB);
    float* h1 = (float*)(ws + WS_H1); bf16_t* h1b = (bf16_t*)(ws + WS_H1B); bf16_t* qm = (bf16_t*)(ws + WS_QM); bf16_t* om = (bf16_t*)(ws + WS_OM);
    float* h2 = (float*)(ws + WS_H2); bf16_t* act = (bf16_t*)(ws + WS_ACT); bf16_t* OA = (bf16_t*)(ws + WS_OA); bf16_t* OB = (bf16_t*)(ws + WS_OA) + 512;
    float* m1 = p.out; unsigned* bar = (unsigned*)(ws + WS_BAR);
    volatile LAS unsigned* xst = (volatile LAS unsigned*)(lds + pg8::STAGE_BYTES);
    if (c.tid == 0) { xst[0] = 0u; xst[1] = 0u; }
    __syncthreads();
    XcdBarrier xb; xb.bar = bar; xb.x = 0u; xb.st = xst;
    pg8::StaticOrder S;
    {
        PHASE(0) {
            int cur = 0;
            p_transpose(c, lds, p.w_in, Wt_in, DM, INC, nullptr, 0, cur);
            p_transpose(c, lds, p.w_ffn_gate, Wt_gu, DM, DFF, p.g_ffn, 1, cur);
            p_transpose(c, lds, p.w_ffn_up, Wt_gu, DM, DFF, p.g_ffn, 2, cur);
            p_transpose(c, lds, p.w_ffn_down, Wt_dn, DFF, DM, nullptr, 0, cur);
            p_transpose(c, lds, p.w_up_a, Wt_upa, 512, DM, nullptr, 0, cur, 1024, 0);
            p_transpose(c, lds, p.w_up_b, Wt_upa, 512, DM, nullptr, 0, cur, 1024, 512);
            p_transpose(c, lds, p.w_out, Wt_out, DM, DM, nullptr, 0, cur);
            p_transpose(c, lds, p.w_q_mem, Wt_qm, DM, MEMW, p.g_mem_q, 0, cur);
            p_transpose(c, lds, p.w_kv_mem, Wt_kvm, DM, 2 * MEMW, nullptr, 0, cur);
            p_transpose(c, lds, p.w_o_mem, Wt_om, MEMW, DM, nullptr, 0, cur);
            p_rmsnorm_rows(c, p.x, p.g_mix, n1, T);
            p_rmsnorm_rows(c, p.mem, p.g_mem_kv, memn, BATCH * NMEM);
            p_rope_table(c, p.pos, rope);
            if (blockIdx.x == 0) for (int i = c.tid; i < XCD_BAR_WORDS; i += 512) bar[i] = 0u;
        }
        PHASE(1) {
            { Gemm g{n1, Wt_in, T, INC, DM}; EpiBf16 E{proj, INC, nullptr, 1 << 30, rope, 4, 12, gates};   S.init(g.M, g.N, gridDim.x, blockIdx.x); pg8::gemm_phase(lds, g, S, E); }
            { Gemm g{memn, Wt_kvm, BATCH * NMEM, 1024, DM}; EpiBf16 E{kvm, 1024, nullptr, 1 << 30, nullptr, 0, 0, nullptr}; S.init(g.M, g.N, gridDim.x, blockIdx.x); pg8::gemm_phase(lds, g, S, E); }
        }
        PHASE(3) {
            p_attn_ab(lds, proj, OA, OB);
        }
        PHASE(5) { Gemm g{OA, Wt_upa, T, DM, DM}; EpiGate E{gates, mixed}; S.init(g.M, g.N, gridDim.x, blockIdx.x); pg8::gemm_phase(lds, g, S, E); }
        PHASE(6) { Gemm g{mixed, Wt_out, T, DM, DM}; EpiRes E{p.x, nullptr, nullptr, h1b, ss1}; S.init(g.M, g.N, gridDim.x, blockIdx.x); pg8::gemm_phase(lds, g, S, E); }
        PHASE(7) { Gemm g{h1b, Wt_qm, T, MEMW, DM}; EpiBf16 E{qm, MEMW, ss1, 1 << 30, nullptr, 0, 0, nullptr}; S.init(g.M, g.N, gridDim.x, blockIdx.x); pg8::gemm_phase(lds, g, S, E); }
        PHASE(8) {
            p_attn_mem(lds, qm, kvm, om);
        }
        PHASE(9) { Gemm g{om, Wt_om, T, DM, MEMW}; EpiRes E{nullptr, h1b, nullptr, h2b, ss2}; S.init(g.M, g.N, gridDim.x, blockIdx.x); pg8::gemm_phase(lds, g, S, E); }
        PHASE(10) { Gemm g{h2b, Wt_gu, T, 2 * DFF, DM}; EpiSwiGLU E{act, ss2}; S.init(g.M, g.N, gridDim.x, blockIdx.x); pg8::gemm_phase(lds, g, S, E); }
        PHASE(11) { Gemm g{act, Wt_dn, T, DM, DFF}; EpiRes E{nullptr, h2b, p.out, nullptr, ss3}; S.init(g.M, g.N, gridDim.x, blockIdx.x); pg8::gemm_phase(lds, g, S, E); }
        PHASE(12) p_final(c, p.out, ss3, p.g_final);
    }
}

constexpr int LDS_BYTES = pg8::STAGE_BYTES + 16;
#ifndef ONE_LAUNCH
#define ONE_LAUNCH 1
#endif
extern "C" void kernel_launch(void* const* d_in, const int* in_sizes, int n_in, void* d_out, int out_size, void* d_ws, size_t ws_size, hipStream_t stream) {
    static int grid = 0;
    if (grid == 0) {
        if (n_in != 18 || out_size != T * DM || ws_size < WS_END) { fprintf(stderr, "kernel_launch: unexpected shapes (n_in %d out %d ws %zu)\n", n_in, out_size, ws_size); grid = -1; return; }
        int dev = 0, cus = 0, per_cu = 0;
        (void)hipGetDevice(&dev); (void)hipDeviceGetAttribute(&cus, hipDeviceAttributeMultiprocessorCount, dev);
        if (hipFuncSetAttribute((const void*)mega, hipFuncAttributeMaxDynamicSharedMemorySize, LDS_BYTES) != hipSuccess) { fprintf(stderr, "hipFuncSetAttribute failed\n"); grid = -1; return; }
        if (hipOccupancyMaxActiveBlocksPerMultiprocessor(&per_cu, (const void*)mega, 512, LDS_BYTES) != hipSuccess || per_cu < 1) { fprintf(stderr, "occupancy query: %d\n", per_cu); per_cu = 1; }
        (void)hipGetLastError();
        grid = cus * 1;
    }
    if (grid < 0) return;
    Params p{};
    p.x = (const float*)d_in[0]; p.mem = (const float*)d_in[1]; p.pos = (const int*)d_in[2]; p.g_mix = (const float*)d_in[3]; p.w_in = (const float*)d_in[4];
    p.w_up_a = (const float*)d_in[5]; p.w_up_b = (const float*)d_in[6]; p.w_out = (const float*)d_in[7]; p.g_mem_q = (const float*)d_in[8]; p.g_mem_kv = (const float*)d_in[9];
    p.w_q_mem = (const float*)d_in[10]; p.w_kv_mem = (const float*)d_in[11]; p.w_o_mem = (const float*)d_in[12]; p.g_ffn = (const float*)d_in[13];
    p.w_ffn_gate = (const float*)d_in[14]; p.w_ffn_up = (const float*)d_in[15]; p.w_ffn_down = (const float*)d_in[16]; p.g_final = (const float*)d_in[17];
    p.out = (float*)d_out; p.ws = (unsigned char*)d_ws;
#if ONE_LAUNCH
    int lo = 0, hi = NPHASE;
    void* args[] = {&p, &lo, &hi};
    hipError_t e = hipLaunchCooperativeKernel((const void*)mega, dim3(grid), dim3(512), args, LDS_BYTES, stream);
    if (e != hipSuccess) fprintf(stderr, "cooperative launch failed: %s\n", hipGetErrorString(e));
#else
    for (int ph = 0; ph < NPHASE; ++ph) hipLaunchKernelGGL(mega, dim3(grid), dim3(512), LDS_BYTES, stream, p, ph, ph + 1);
#endif
}
```

```cpp
#include <hip/hip_runtime.h>
#include <hip/hip_cooperative_groups.h>
#include <cstdio>
namespace cg = cooperative_groups;

#define LAS __attribute__((address_space(3)))
typedef unsigned short bf16_t;
typedef short bf16x8 __attribute__((ext_vector_type(8)));
typedef float f32x4 __attribute__((ext_vector_type(4)));
typedef unsigned u32x4 __attribute__((ext_vector_type(4)));
typedef unsigned u32x2 __attribute__((ext_vector_type(2)));

constexpr int BATCH = 16, SEQ = 2048, DM = 1024, T = BATCH * SEQ;
constexpr int HD = 64, NHA = 8, NHB = 8;
constexpr int INC = 5120;
constexpr int C_QA = 0, C_KA = 512, C_VA = 1024, C_QB = 1536, C_KB = 2048, C_VB = 2560, C_GA = 3072, C_GB = 4096;
constexpr int NMEM = 256, MEMW = 512, DFF = 2816;
constexpr float EPS = 1e-6f;

constexpr size_t MiB = 1ull << 20;
constexpr size_t WS_WIN = 0, WS_WUPA = 10 * MiB, WS_WUPB = 11 * MiB, WS_WOUT = 12 * MiB, WS_WQM = 14 * MiB, WS_WKVM = 15 * MiB,
                 WS_WOM = 17 * MiB, WS_WGU = 18 * MiB, WS_WDN = 29 * MiB, WS_MEMN = 36 * MiB, WS_KVM = 44 * MiB,
                 WS_SS1 = 52 * MiB, WS_SS2 = 54 * MiB, WS_SS3 = 56 * MiB, WS_ROPE = 58 * MiB, WS_BAR = 60 * MiB;
constexpr size_t WS_R1 = 64 * MiB;
constexpr size_t WS_PROJ = 128 * MiB;
constexpr size_t WS_H1 = 128 * MiB, WS_H1B = 256 * MiB, WS_QM = 320 * MiB, WS_OM = 352 * MiB, WS_H2 = 384 * MiB, WS_ACT = 128 * MiB;
constexpr size_t WS_OA = 448 * MiB, WS_OB = 480 * MiB;
constexpr size_t WS_END = 512 * MiB;

struct Params {
    const float* x; const float* mem; const int* pos; const float* g_mix; const float* w_in; const float* w_up_a; const float* w_up_b; const float* w_out;
    const float* g_mem_q; const float* g_mem_kv; const float* w_q_mem; const float* w_kv_mem; const float* w_o_mem; const float* g_ffn;
    const float* w_ffn_gate; const float* w_ffn_up; const float* w_ffn_down; const float* g_final;
    float* out; unsigned char* ws;
};

typedef float f32x2 __attribute__((ext_vector_type(2)));
typedef __bf16 bf16v2 __attribute__((ext_vector_type(2)));
__device__ __forceinline__ unsigned pk_bf16(float lo, float hi) { f32x2 v = {lo, hi}; bf16v2 r = __builtin_convertvector(v, bf16v2); return __builtin_bit_cast(unsigned, r); }
__device__ __forceinline__ bf16_t f2bf(float f) { return (bf16_t)(pk_bf16(f, 0.f) & 0xffffu); }
__device__ __forceinline__ float bf2f(bf16_t b) { return __uint_as_float(((unsigned)b) << 16); }
__device__ __forceinline__ float bflo(unsigned u) { return __uint_as_float(u << 16); }
__device__ __forceinline__ float bfhi(unsigned u) { return __uint_as_float(u & 0xffff0000u); }
__device__ __forceinline__ float wave_sum(float v) {
#pragma unroll
    for (int o = 1; o < 64; o <<= 1) v += __shfl_xor(v, o);
    return v;
}
__device__ __forceinline__ float sigmoidf_(float x) { return 1.f / (1.f + __expf(-x)); }
__device__ __forceinline__ float rstd_of(const float* ss, int row) {
    const f32x4* p = (const f32x4*)(ss + (size_t)row * 16);
    f32x4 a = p[0], b = p[1], c = p[2], d = p[3];
    float s = ((a[0] + a[1]) + (a[2] + a[3])) + ((b[0] + b[1]) + (b[2] + b[3])) + ((c[0] + c[1]) + (c[2] + c[3])) + ((d[0] + d[1]) + (d[2] + d[3]));
    return rsqrtf(s * (1.f / DM) + EPS);
}


#define XB_TMO      128
#define XB_XCNT(j)  (256  + 64 * (j))
#define XB_XSUB(j)  (1280 + 64 * (j))
#define XB_XGEN(j)  (2304 + 64 * (j))
#define XB_TOP      3328
#define XB_TOPGEN   3392
#define XCD_BAR_WORDS 3456
#define XB_SPIN_CAP (1u << 18)
__device__ __forceinline__ unsigned xb_ld(unsigned* p)              { return __hip_atomic_load(p, __ATOMIC_RELAXED, __HIP_MEMORY_SCOPE_AGENT); }
__device__ __forceinline__ unsigned xb_add(unsigned* p, unsigned v) { return __hip_atomic_fetch_add(p, v, __ATOMIC_RELAXED, __HIP_MEMORY_SCOPE_AGENT); }
__device__ __forceinline__ unsigned xb_xcc_id() { return (unsigned)__builtin_amdgcn_s_getreg((3 << 11) | 20) & 0xFu; }
#define XB_SPIN(cond, bar) do { unsigned _sp = 0; while (cond) { __builtin_amdgcn_s_sleep(1); \
    if ((++_sp & 255u) == 0u) { if (xb_ld(&(bar)[XB_TMO])) break; if (_sp > XB_SPIN_CAP) { atomicAdd(&(bar)[XB_TMO], 1u); break; } } } } while (0)
struct XcdBarrier { unsigned* bar; unsigned x; volatile LAS unsigned* st; };
__device__ __forceinline__ XcdBarrier xcd_barrier_post(unsigned* bar, volatile LAS unsigned* st) {
    XcdBarrier b; b.bar = bar; b.x = xb_xcc_id(); b.st = st;
    if (threadIdx.x == 0) (void)xb_add(&bar[XB_XCNT(b.x)], 1u);
    return b;
}
__device__ __forceinline__ void xcd_barrier_complete(unsigned* bar, unsigned x, unsigned& nloc, unsigned& nx) {
    const unsigned G = gridDim.x * gridDim.y * gridDim.z;
    unsigned sum, cnt, mine, sp = 0u;
    for (;;) {
        sum = 0u; cnt = 0u; mine = 0u;
#pragma unroll
        for (unsigned j = 0; j < 16; ++j) { const unsigned c = xb_ld(&bar[XB_XCNT(j)]); sum += c; cnt += (c > 0u) ? 1u : 0u; mine = (j == x) ? c : mine; }
        if (sum == G) break;
        __builtin_amdgcn_s_sleep(1);
        if ((++sp & 255u) == 0u) { if (xb_ld(&bar[XB_TMO])) break; if (sp > XB_SPIN_CAP) { atomicAdd(&bar[XB_TMO], 1u); break; } }
    }
    nloc = mine > 0u ? mine : 1u; nx = cnt > 0u ? cnt : 1u;
}
__device__ __forceinline__ void xcd_barrier(const XcdBarrier& b) {
    asm volatile("s_waitcnt vmcnt(0)" ::: "memory");
    __syncthreads();
    if (threadIdx.x == 0) {
        unsigned* bar = b.bar;
        __builtin_amdgcn_s_waitcnt(0);
        unsigned nloc = b.st[0], nx = b.st[1];
        if (nloc == 0u) { xcd_barrier_complete(bar, b.x, nloc, nx); b.st[0] = nloc; b.st[1] = nx; }
        const unsigned old = xb_add(&bar[XB_XSUB(b.x)], 1u);
        const unsigned gen = old / nloc;
        if (old + 1u == (gen + 1u) * nloc) {
            __builtin_amdgcn_fence(__ATOMIC_RELEASE, "agent");
            asm volatile("s_waitcnt vmcnt(0)" ::: "memory");
            const unsigned og = xb_add(&bar[XB_TOP], 1u);
            const unsigned tg = og / nx;
            if (og + 1u == (tg + 1u) * nx) xb_add(&bar[XB_TOPGEN], 1u);
            else XB_SPIN(xb_ld(&bar[XB_TOPGEN]) == tg, bar);
            __builtin_amdgcn_fence(__ATOMIC_ACQUIRE, "agent");
            xb_add(&bar[XB_XGEN(b.x)], 1u);
            asm volatile("s_waitcnt vmcnt(0)" ::: "memory");
        } else {
            XB_SPIN(xb_ld(&bar[XB_XGEN(b.x)]) == gen, bar);
            __builtin_amdgcn_fence(__ATOMIC_ACQUIRE, "agent");
            asm volatile("s_waitcnt vmcnt(0)" ::: "memory");
        }
    }
    __syncthreads();
}

namespace pg8 {
constexpr int BM = 256, BK = 64, HALF = 128, HTB = HALF * BK * 2, STAGE_BYTES = 8 * HTB, NXCD = 8, WGM = 8;
__host__ __device__ __forceinline__ int lds_byte(int r, int c) { const int st = (r >> 4) * 2 + (c >> 5), rr = r & 15, cc = c & 31, ob = rr * 64 + cc * 2; return st * 1024 + (ob ^ (((ob >> 9) & 1) << 5)); }
__host__ __device__ __forceinline__ void stage_rc(int b, int& R, int& C) { const int st = b / 1024, sb = b % 1024, swz = sb ^ (((sb >> 9) & 1) << 5); R = (st >> 1) * 16 + swz / 64; C = (st & 1) * 32 + (swz % 64) / 2; }
__host__ __device__ __forceinline__ int perm32(int rho) { const int n = rho >> 4, i = rho & 15; return 8 * (i >> 2) + 4 * n + (i & 3); }
struct Unit { int pm, pn; };
struct Gemm { const bf16_t* A; const bf16_t* Bt; int M, N, K; };
struct StaticOrder {
    int nM, nN, nwg, G, c;
    __host__ __device__ void init(int M, int N, int G_, int c_) { nM = M / BM; nN = N / BM; nwg = nM * nN; G = G_; c = c_; }
    __host__ __device__ bool next(int i, Unit& u) const {
        const long L = (long)i * G + c; if (L >= nwg) return false;
        int wgid = (int)L; { const int q = nwg / NXCD, r = nwg % NXCD, xcd = wgid % NXCD, off = wgid / NXCD; wgid = (xcd < r ? xcd * (q + 1) : r * (q + 1) + (xcd - r) * q) + off; }
        const int nig = WGM * nN, gid = wgid / nig, fm = gid * WGM, gsz = (nM - fm) < WGM ? (nM - fm) : WGM;
        u.pm = fm + ((wgid % nig) % gsz); u.pn = (wgid % nig) / gsz; return true;
    }
};

template <class Epi>
__device__ __forceinline__ void gemm_phase(LAS unsigned char* lds, const Gemm g, const StaticOrder& S, const Epi& E) {
    int tid = threadIdx.x; asm volatile("" : "+v"(tid));
    const int wid = __builtin_amdgcn_readfirstlane(tid >> 6), lane = tid & 63, wr = wid >> 2, wc = wid & 3, fr = lane & 15, fq = lane >> 4;
    const int K = g.K, nt = K / BK;
    unsigned voffA[2], voffB[2];
#pragma unroll
    for (int i = 0; i < 2; ++i) { int R, C; stage_rc(tid * 16 + i * 8192, R, C); const int Rb = Epi::LINE ? ((R >> 5) * 64 + perm32(R & 31)) : (Epi::PERM ? ((R & ~31) + perm32(R & 31)) : R);
        voffA[i] = (unsigned)(R * K + C) * 2u; voffB[i] = (unsigned)(Rb * K + C) * 2u; }
    const size_t kstep = (size_t)(BK * 2);
    const size_t hstep = (size_t)HALF * K * 2;
    const size_t tstep = 2 * hstep;
    const size_t hstepB = Epi::LINE ? (size_t)32 * K * 2 : hstep;
    const unsigned ldsw = (unsigned)wid * 1024u;
    const int aoff = lds_byte(wr * 64 + fr, fq * 8), boff = lds_byte(wc * 32 + fr, fq * 8);
#define PG8_SA(b, h) (((b) * 2 + (h)) * HTB)
#define PG8_SB(b, h) ((4 + (b) * 2 + (h)) * HTB)
#define PG8_STAGE(bufoff, gbase, voff) do { _Pragma("unroll") for (int _i = 0; _i < 2; ++_i) \
        __builtin_amdgcn_global_load_lds((const unsigned*)((const char*)(gbase) + (voff)[_i]), (LAS unsigned*)(lds + (bufoff) + ldsw + _i * 8192), 16, 0, 0); } while (0)
#define PG8_LDA(dst, b, h) do { _Pragma("unroll") for (int m = 0; m < 4; ++m) _Pragma("unroll") for (int k = 0; k < 2; ++k) dst[m][k] = *(const LAS bf16x8*)(lds + PG8_SA(b, h) + aoff + m * 2048 + k * 1024); } while (0)
#define PG8_LDB(dst, b, h) do { _Pragma("unroll") for (int n = 0; n < 2; ++n) _Pragma("unroll") for (int k = 0; k < 2; ++k) dst[n][k] = *(const LAS bf16x8*)(lds + PG8_SB(b, h) + boff + n * 2048 + k * 1024); } while (0)
#define PG8_MMA(ai, bj, At, Bt) do { __builtin_amdgcn_s_setprio(1); _Pragma("unroll") for (int m = 0; m < 4; ++m) _Pragma("unroll") for (int n = 0; n < 2; ++n) _Pragma("unroll") for (int k = 0; k < 2; ++k) \
        acc[ai][bj][m][n] = __builtin_amdgcn_mfma_f32_16x16x32_bf16(Bt[n][k], At[m][k], acc[ai][bj][m][n], 0, 0, 0); __builtin_amdgcn_s_setprio(0); } while (0)
#define PG8_WAIT_V(n) asm volatile("s_waitcnt vmcnt(" #n ")" ::: "memory")
#define PG8_WAIT_L(n) asm volatile("s_waitcnt lgkmcnt(" #n ")" ::: "memory")
#define PG8_BAR __builtin_amdgcn_s_barrier()
#define PG8_SCHED __builtin_amdgcn_sched_barrier(0)
    Unit cur, nxt; int ui = 0;
    if (!S.next(0, cur)) return;
    f32x4 acc[2][2][4][2];
#pragma unroll
    for (int a = 0; a < 2; ++a)
#pragma unroll
        for (int b = 0; b < 2; ++b)
#pragma unroll
            for (int m = 0; m < 4; ++m)
#pragma unroll
                for (int n = 0; n < 2; ++n) acc[a][b][m][n] = (f32x4){0.f, 0.f, 0.f, 0.f};
    bf16x8 At[4][2], B0[2][2], B1[2][2];
    const char* cA = (const char*)g.A + (size_t)cur.pm * tstep; const char* cB = (const char*)g.Bt + (size_t)cur.pn * tstep;
    PG8_STAGE(PG8_SB(0, 0), cB, voffB); PG8_STAGE(PG8_SA(0, 0), cA, voffA); PG8_STAGE(PG8_SB(0, 1), cB + hstepB, voffB); PG8_STAGE(PG8_SA(0, 1), cA + hstep, voffA);
    if (wr == 1) PG8_BAR;
    PG8_WAIT_V(4); PG8_BAR;
    PG8_STAGE(PG8_SB(1, 0), cB + kstep, voffB); PG8_STAGE(PG8_SA(1, 0), cA + kstep, voffA); PG8_STAGE(PG8_SB(1, 1), cB + hstepB + kstep, voffB);
    PG8_WAIT_V(6); PG8_BAR;
    for (;;) {
        const bool has_next = S.next(ui + 1, nxt);
        const char* nA = has_next ? (const char*)g.A + (size_t)nxt.pm * tstep : cA; const char* nB = has_next ? (const char*)g.Bt + (size_t)nxt.pn * tstep : cB;
        for (int t = 0; t < nt; t += 2) {
            const bool last = (t == nt - 2);
            const char* a1 = cA + (size_t)(t + 1) * kstep;
            const char* a2 = last ? nA : cA + (size_t)(t + 2) * kstep; const char* b2 = last ? nB : cB + (size_t)(t + 2) * kstep;
            const char* a3 = a2 + kstep; const char* b3 = b2 + kstep;
            if constexpr (Epi::HAS_MID) { if (t == nt / 2) E.mid(acc, cur, wr, wc, fr, fq); }
            PG8_LDB(B0, 0, 0); PG8_SCHED; PG8_LDA(At, 0, 0); PG8_STAGE(PG8_SA(1, 1), a1 + hstep, voffA);
            PG8_WAIT_L(8); PG8_BAR; PG8_WAIT_L(0); PG8_MMA(0, 0, At, B0); PG8_BAR; PG8_SCHED;
            PG8_LDB(B1, 0, 1); PG8_STAGE(PG8_SB(0, 0), b2, voffB);
            PG8_BAR; PG8_WAIT_L(0); PG8_MMA(0, 1, At, B1); PG8_BAR;
            PG8_LDA(At, 0, 1); PG8_STAGE(PG8_SA(0, 0), a2, voffA);
            PG8_BAR; PG8_WAIT_L(0); PG8_MMA(1, 0, At, B0); PG8_BAR; PG8_SCHED;
            PG8_STAGE(PG8_SB(0, 1), b2 + hstepB, voffB);
            PG8_WAIT_V(6); PG8_BAR; PG8_MMA(1, 1, At, B1); PG8_BAR;
            PG8_LDB(B0, 1, 0); PG8_SCHED; PG8_LDA(At, 1, 0); PG8_STAGE(PG8_SA(0, 1), a2 + hstep, voffA);
            PG8_WAIT_L(8); PG8_BAR; PG8_WAIT_L(0); PG8_MMA(0, 0, At, B0); PG8_BAR; PG8_SCHED;
            PG8_LDB(B1, 1, 1); PG8_STAGE(PG8_SB(1, 0), b3, voffB);
            PG8_BAR; PG8_WAIT_L(0); PG8_MMA(0, 1, At, B1); PG8_BAR;
            PG8_LDA(At, 1, 1); PG8_STAGE(PG8_SA(1, 0), a3, voffA);
            PG8_BAR; PG8_WAIT_L(0); PG8_MMA(1, 0, At, B0); PG8_BAR; PG8_SCHED;
            PG8_STAGE(PG8_SB(1, 1), b3 + hstepB, voffB);
            PG8_WAIT_V(6); PG8_BAR; PG8_MMA(1, 1, At, B1); PG8_BAR;
        }
        E(acc, cur, wr, wc, fr, fq);
        if (!has_next) break;
#pragma unroll
        for (int a = 0; a < 2; ++a)
#pragma unroll
            for (int b = 0; b < 2; ++b)
#pragma unroll
                for (int m = 0; m < 4; ++m)
#pragma unroll
                    for (int n = 0; n < 2; ++n) acc[a][b][m][n] = (f32x4){0.f, 0.f, 0.f, 0.f};
        cur = nxt; cA = nA; cB = nB; ++ui;
    }
    PG8_WAIT_V(0);
    if (wr == 0) PG8_BAR;
    PG8_BAR;
#undef PG8_SA
#undef PG8_SB
#undef PG8_STAGE
#undef PG8_LDA
#undef PG8_LDB
#undef PG8_MMA
#undef PG8_WAIT_V
#undef PG8_WAIT_L
#undef PG8_BAR
#undef PG8_SCHED
}
}
using pg8::Unit; using pg8::Gemm;

__device__ __forceinline__ void line_pair(u32x4& a, u32x4& b, bool lo) {
#pragma unroll
    for (int q = 0; q < 4; ++q) {
        const unsigned send = lo ? b[q] : a[q];
        const unsigned recv = (unsigned)__builtin_amdgcn_update_dpp(0, (int)send, 0x128  , 0xf, 0xf, false);
        if (lo) b[q] = recv; else a[q] = recv;
    }
}
struct EpiBf16 {
    static constexpr bool PERM = true, HAS_MID = false, LINE = true;
    bf16_t* O; int ldc; const float* ss; int sig_from; const float* rope; int rope_below; int qkv_tiles; bf16_t* gates;
    __device__ __forceinline__ bf16_t* addr(int row, int col, int pn) const {
        if (qkv_tiles > 0) {
            if (pn < qkv_tiles) return O + (size_t)(col >> 9) * ((size_t)T * 512) + ((size_t)((row >> 11) * 8 + ((col >> 6) & 7)) * SEQ + (row & (SEQ - 1))) * 64 + (col & 63);
            return gates + (size_t)row * 2048 + (col - 256 * qkv_tiles);
        }
        return O + (size_t)row * ldc + col;
    }
    __device__ __forceinline__ void operator()(const f32x4 (&acc)[2][2][4][2], const Unit& u, int wr, int wc, int fr, int fq) const {
        const int row0 = u.pm * 256 + wr * 64 + fr, col0 = u.pn * 256 + wc * 64 + 8 * fq;
        const bool sig = u.pn >= sig_from, lo = fr < 8;
#pragma unroll
        for (int ai = 0; ai < 2; ++ai)
#pragma unroll
            for (int m = 0; m < 4; ++m) {
                const int row = row0 + ai * 128 + m * 16;
                const float rs = ss ? rstd_of(ss, row) : 1.f;
                u32x4 o[2];
#pragma unroll
                for (int bj = 0; bj < 2; ++bj) {
                    f32x4 v0 = acc[ai][bj][m][0] * rs, v1 = acc[ai][bj][m][1] * rs;
                    if (sig) {
#pragma unroll
                        for (int j = 0; j < 4; ++j) { v0[j] = sigmoidf_(v0[j]); v1[j] = sigmoidf_(v1[j]); }
                    }
                    if (bj == 0 && u.pn < rope_below) {
                        f32x4 p0, p1;
#pragma unroll
                        for (int j = 0; j < 4; ++j) { p0[j] = __shfl_xor(v0[j], 16); p1[j] = __shfl_xor(v1[j], 16); }
                        if (fq < 2) {
                            const f32x4 c0 = *(const f32x4*)(rope + (size_t)row * 16), c1 = *(const f32x4*)(rope + (size_t)row * 16 + 4);
                            f32x4 s0 = *(const f32x4*)(rope + (size_t)row * 16 + 8), s1 = *(const f32x4*)(rope + (size_t)row * 16 + 12);
                            if (fq == 0) { s0 = -s0; s1 = -s1; }
                            v0 = v0 * c0 + p0 * s0; v1 = v1 * c1 + p1 * s1;
                        }
                    }
                    o[bj][0] = pk_bf16(v0[0], v0[1]); o[bj][1] = pk_bf16(v0[2], v0[3]); o[bj][2] = pk_bf16(v1[0], v1[1]); o[bj][3] = pk_bf16(v1[2], v1[3]);
                }
                line_pair(o[0], o[1], lo);
                const int colx = col0 + (lo ? 0 : 32);
                *(u32x4*)addr(lo ? row : row - 8, colx, u.pn) = o[0];
                *(u32x4*)addr(lo ? row + 8 : row, colx, u.pn) = o[1];
            }
    }
};
struct EpiGate {
    static constexpr bool PERM = true, HAS_MID = true, LINE = true;
    const bf16_t* gates; bf16_t* O;
    __device__ __forceinline__ void mid(f32x4 (&acc)[2][2][4][2], const Unit& u, int wr, int wc, int fr, int fq) const {
        int row0 = u.pm * 256 + wr * 64 + fr, col0 = u.pn * 256 + wc * 64 + 8 * fq;
        asm volatile("" : "+v"(row0), "+v"(col0));
#pragma unroll
        for (int ai = 0; ai < 2; ++ai)
#pragma unroll
            for (int m = 0; m < 4; ++m) {
                const int row = row0 + ai * 128 + m * 16;
#pragma unroll
                for (int bj = 0; bj < 2; ++bj) {
                    const int col = col0 + bj * 32;
                    const u32x4 ga = *(const u32x4*)(gates + (size_t)row * 2048 + col), gb = *(const u32x4*)(gates + (size_t)row * 2048 + 1024 + col);
#pragma unroll
                    for (int q = 0; q < 4; ++q) {
                        const float a0 = bflo(ga[q]), a1 = bfhi(ga[q]), b0 = fmaxf(bflo(gb[q]), -60.f), b1 = fmaxf(bfhi(gb[q]), -60.f);
                        const float r0 = (1.f + __expf(-b0)) * __builtin_amdgcn_rcpf(1.f + __expf(-a0)), r1 = (1.f + __expf(-b1)) * __builtin_amdgcn_rcpf(1.f + __expf(-a1));
                        acc[ai][bj][m][q >> 1][(q & 1) * 2] *= r0; acc[ai][bj][m][q >> 1][(q & 1) * 2 + 1] *= r1;
                    }
                }
                __builtin_amdgcn_sched_barrier(0);
            }
    }
    __device__ __forceinline__ void operator()(const f32x4 (&acc)[2][2][4][2], const Unit& u, int wr, int wc, int fr, int fq) const {
        const int row0 = u.pm * 256 + wr * 64 + fr, col0 = u.pn * 256 + wc * 64 + 8 * fq; const bool lo = fr < 8;
#pragma unroll
        for (int ai = 0; ai < 2; ++ai)
#pragma unroll
            for (int m = 0; m < 4; ++m) {
                const int row = row0 + ai * 128 + m * 16;
                u32x4 oo[2];
#pragma unroll
                for (int bj = 0; bj < 2; ++bj) {
                    const int col = col0 + bj * 32;
                    const u32x4 gb = *(const u32x4*)(gates + (size_t)row * 2048 + 1024 + col);
                    float r[8];
#pragma unroll
                    for (int q = 0; q < 4; ++q) {
                        const float b0 = fmaxf(bflo(gb[q]), -60.f), b1 = fmaxf(bfhi(gb[q]), -60.f);
                        r[2 * q] = acc[ai][bj][m][q >> 1][(q & 1) * 2] * __builtin_amdgcn_rcpf(1.f + __expf(-b0));
                        r[2 * q + 1] = acc[ai][bj][m][q >> 1][(q & 1) * 2 + 1] * __builtin_amdgcn_rcpf(1.f + __expf(-b1));
                    }
                    oo[bj][0] = pk_bf16(r[0], r[1]); oo[bj][1] = pk_bf16(r[2], r[3]); oo[bj][2] = pk_bf16(r[4], r[5]); oo[bj][3] = pk_bf16(r[6], r[7]);
                }
                line_pair(oo[0], oo[1], lo);
                const int colx = col0 + (lo ? 0 : 32);
                *(u32x4*)(O + (size_t)(lo ? row : row - 8) * DM + colx) = oo[0];
                *(u32x4*)(O + (size_t)(lo ? row + 8 : row) * DM + colx) = oo[1];
            }
    }
};
struct EpiRes {
    static constexpr bool PERM = true, HAS_MID = false, LINE = true;
    const float* R; const bf16_t* Rb; float* H; bf16_t* Hb; float* SS;
    __device__ __forceinline__ void operator()(const f32x4 (&acc)[2][2][4][2], const Unit& u, int wr, int wc, int fr, int fq) const {
        const int row0 = u.pm * 256 + wr * 64 + fr, col0 = u.pn * 256 + wc * 64 + 8 * fq; const bool lo = fr < 8;
#pragma unroll
        for (int ai = 0; ai < 2; ++ai)
#pragma unroll
            for (int m = 0; m < 4; ++m) {
                const int row = row0 + ai * 128 + m * 16;
                float s = 0.f; u32x4 ob[2];
#pragma unroll
                for (int bj = 0; bj < 2; ++bj) {
                    const int col = col0 + bj * 32;
                    f32x4 r0, r1;
                    if (R) { r0 = *(const f32x4*)(R + (size_t)row * DM + col); r1 = *(const f32x4*)(R + (size_t)row * DM + col + 4); }
                    else { const u32x4 rb = *(const u32x4*)(Rb + (size_t)row * DM + col);
                        r0[0] = bflo(rb[0]); r0[1] = bfhi(rb[0]); r0[2] = bflo(rb[1]); r0[3] = bfhi(rb[1]); r1[0] = bflo(rb[2]); r1[1] = bfhi(rb[2]); r1[2] = bflo(rb[3]); r1[3] = bfhi(rb[3]); }
                    const f32x4 h0 = r0 + acc[ai][bj][m][0], h1 = r1 + acc[ai][bj][m][1];
                    if (H) { *(f32x4*)(H + (size_t)row * DM + col) = h0; *(f32x4*)(H + (size_t)row * DM + col + 4) = h1; }
                    ob[bj][0] = pk_bf16(h0[0], h0[1]); ob[bj][1] = pk_bf16(h0[2], h0[3]); ob[bj][2] = pk_bf16(h1[0], h1[1]); ob[bj][3] = pk_bf16(h1[2], h1[3]);
                    s += ((h0[0] * h0[0] + h0[1] * h0[1]) + (h0[2] * h0[2] + h0[3] * h0[3])) + ((h1[0] * h1[0] + h1[1] * h1[1]) + (h1[2] * h1[2] + h1[3] * h1[3]));
                }
                if (Hb) { line_pair(ob[0], ob[1], lo); const int colx = col0 + (lo ? 0 : 32);
                    *(u32x4*)(Hb + (size_t)(lo ? row : row - 8) * DM + colx) = ob[0]; *(u32x4*)(Hb + (size_t)(lo ? row + 8 : row) * DM + colx) = ob[1]; }
                s += __shfl_xor(s, 16); s += __shfl_xor(s, 32);
                if (fq == 0) SS[(size_t)row * 16 + u.pn * 4 + wc] = s;
            }
    }
};
struct EpiSwiGLU {
    static constexpr bool PERM = true, HAS_MID = false, LINE = false;
    bf16_t* O; const float* ss;
    __device__ __forceinline__ void operator()(const f32x4 (&acc)[2][2][4][2], const Unit& u, int wr, int wc, int fr, int fq) const {
        const int row0 = u.pm * 256 + wr * 64 + fr, col0 = u.pn * 128 + wc * 32 + 8 * fq;
#pragma unroll
        for (int ai = 0; ai < 2; ++ai)
#pragma unroll
            for (int m = 0; m < 4; ++m) {
                const int row = row0 + ai * 128 + m * 16;
                const float rs = rstd_of(ss, row);
                float r[8];
#pragma unroll
                for (int n = 0; n < 2; ++n)
#pragma unroll
                    for (int j = 0; j < 4; ++j) { const float gg = acc[ai][0][m][n][j] * rs, uu = acc[ai][1][m][n][j] * rs; r[n * 4 + j] = gg * sigmoidf_(gg) * uu; }
                u32x4 o; o[0] = pk_bf16(r[0], r[1]); o[1] = pk_bf16(r[2], r[3]); o[2] = pk_bf16(r[4], r[5]); o[3] = pk_bf16(r[6], r[7]);
                *(u32x4*)(O + (size_t)row * DFF + col0) = o;
            }
    }
};

struct Ctx { int tid, lane, wave, gw, ngw, gt, ngt; };

__device__ __forceinline__ void p_transpose(const Ctx& c, LAS unsigned char* lds, const float* W, bf16_t* Wt, int K, int N, const float* g, int mode, int& cursor, int ldw = 0, int koff = 0) {
    if (ldw == 0) ldw = K;
    LAS float* scr = (LAS float*)(lds + c.wave * 8704);
    const int nblk = N / 32, nitems = (K / 64) * nblk, lane = c.lane;
    int first = (c.gw - cursor % c.ngw + c.ngw) % c.ngw;
    for (int it = first; it < nitems; it += c.ngw) {
        const int kb = it / nblk, nb = it % nblk, k0 = 64 * kb, n0 = 32 * nb;
#pragma unroll 8
        for (int i = 0; i < 32; ++i) { const int kk = 2 * i + (lane >> 5); float v = W[(size_t)(k0 + kk) * N + n0 + (lane & 31)]; if (g) v *= g[k0 + kk]; scr[kk * 33 + (lane & 31)] = v; }
        asm volatile("s_waitcnt lgkmcnt(0)" ::: "memory");
        const int ch = lane & 7;
#pragma unroll
        for (int j = 0; j < 4; ++j) { const int n = (lane >> 3) + 8 * j; const LAS float* sp = scr + (8 * ch) * 33 + n;
            u32x4 o; o[0] = pk_bf16(sp[0], sp[33]); o[1] = pk_bf16(sp[2 * 33], sp[3 * 33]); o[2] = pk_bf16(sp[4 * 33], sp[5 * 33]); o[3] = pk_bf16(sp[6 * 33], sp[7 * 33]);
            const int nn = n0 + n, row = mode == 0 ? nn : (256 * (nn >> 7) + (nn & 127) + (mode == 2 ? 128 : 0));
            *(u32x4*)(Wt + (size_t)row * ldw + koff + k0 + 8 * ch) = o; }
        asm volatile("s_waitcnt lgkmcnt(0)" ::: "memory");
    }
    cursor += nitems;
}
__device__ __forceinline__ void p_rmsnorm_rows(const Ctx& c, const float* x, const float* g, bf16_t* out, int rows) {
    f32x4 gg[4];
#pragma unroll
    for (int j = 0; j < 4; ++j) gg[j] = ((const f32x4*)g)[c.lane + 64 * j];
    for (int r0 = c.gw; r0 < rows; r0 += 2 * c.ngw) {
        const int r1 = r0 + c.ngw; const bool has1 = r1 < rows; const int r1c = has1 ? r1 : r0;
        const f32x4* xa = (const f32x4*)(x + (size_t)r0 * DM) + c.lane; const f32x4* xb = (const f32x4*)(x + (size_t)r1c * DM) + c.lane;
        f32x4 va[4], vb[4]; float sa = 0.f, sb = 0.f;
#pragma unroll
        for (int j = 0; j < 4; ++j) { va[j] = xa[64 * j]; vb[j] = xb[64 * j]; }
#pragma unroll
        for (int j = 0; j < 4; ++j) { sa += (va[j][0] * va[j][0] + va[j][1] * va[j][1]) + (va[j][2] * va[j][2] + va[j][3] * va[j][3]); sb += (vb[j][0] * vb[j][0] + vb[j][1] * vb[j][1]) + (vb[j][2] * vb[j][2] + vb[j][3] * vb[j][3]); }
        const float ra = rsqrtf(wave_sum(sa) * (1.f / DM) + EPS), rb = rsqrtf(wave_sum(sb) * (1.f / DM) + EPS);
#pragma unroll
        for (int j = 0; j < 4; ++j) {
            u32x2 o; o[0] = pk_bf16(va[j][0] * ra * gg[j][0], va[j][1] * ra * gg[j][1]); o[1] = pk_bf16(va[j][2] * ra * gg[j][2], va[j][3] * ra * gg[j][3]);
            ((u32x2*)(out + (size_t)r0 * DM))[c.lane + 64 * j] = o;
            if (has1) { u32x2 q; q[0] = pk_bf16(vb[j][0] * rb * gg[j][0], vb[j][1] * rb * gg[j][1]); q[1] = pk_bf16(vb[j][2] * rb * gg[j][2], vb[j][3] * rb * gg[j][3]);
                ((u32x2*)(out + (size_t)r1 * DM))[c.lane + 64 * j] = q; }
        }
    }
}
__device__ __forceinline__ void p_rope_table(const Ctx& c, const int* pos, float* tab) {
    for (int i = c.gt; i < T * 8; i += c.ngt) {
        const int tok = i >> 3, f = i & 7;
        const double inv = f == 0 ? 1.0 : f == 1 ? 0.19392274474868576 : f == 2 ? 0.03760603093086393 : f == 3 ? 0.007292664737217109 : f == 4 ? 0.001414213562373095 :
                           f == 5 ? 0.0002742481756762073 : f == 6 ? 5.318295896944988e-05 : 1.031338537721246e-05;
        const double rev = (double)pos[tok] * inv * 0.15915494309189535;
        const float fr = (float)(rev - rint(rev));
        tab[(size_t)tok * 16 + f] = __builtin_amdgcn_cosf(fr);
        tab[(size_t)tok * 16 + 8 + f] = __builtin_amdgcn_sinf(fr);
    }
}
__device__ __forceinline__ void p_final(const Ctx& c, float* out, const float* ss, const float* g) {
    f32x4 gg[4];
#pragma unroll
    for (int j = 0; j < 4; ++j) gg[j] = ((const f32x4*)g)[c.lane + 64 * j];
    for (int r0 = c.gw; r0 < T; r0 += 2 * c.ngw) {
        const int r1 = r0 + c.ngw; const bool has1 = r1 < T; const int r1c = has1 ? r1 : r0;
        f32x4* xa = (f32x4*)(out + (size_t)r0 * DM) + c.lane; f32x4* xb = (f32x4*)(out + (size_t)r1c * DM) + c.lane;
        f32x4 va[4], vb[4];
#pragma unroll
        for (int j = 0; j < 4; ++j) { va[j] = xa[64 * j]; vb[j] = xb[64 * j]; }
        const float ra = rstd_of(ss, r0), rb = rstd_of(ss, r1c);
#pragma unroll
        for (int j = 0; j < 4; ++j) { xa[64 * j] = va[j] * ra * gg[j]; if (has1) xb[64 * j] = vb[j] * rb * gg[j]; }
    }
}

typedef float f32x16 __attribute__((ext_vector_type(16)));
typedef short s16x4 __attribute__((ext_vector_type(4)));
#define MFMA32(a, b, c) __builtin_amdgcn_mfma_f32_32x32x16_bf16((a), (b), (c), 0, 0, 0)
constexpr int ATT_FLAG_OFF = 40960;
#ifndef ATT_DUP_A
#define ATT_DUP_A 0
#endif
#ifndef ATT_DUP_B
#define ATT_DUP_B 0
#endif
template <int MODE, int HDIM, int KT>
__device__ __forceinline__ void attn_item(LAS unsigned char* lds, const bf16_t* Qp, int ldq, const bf16_t* Kp, const bf16_t* Vp, int ldkv, bf16_t* Op, int ldo, int q0, int nkeys) {
    constexpr int KS = HDIM / 16, DD = HDIM / 32, KROW = HDIM * 2 + 16, VROW = KT * 2 + 8, NCH = HDIM / 8, PER = KT * NCH / 512, NSUB = KT / 32;
    static_assert(KT * KROW + HDIM * VROW + 128 <= ATT_FLAG_OFF, "attention LDS tiles overlap the flag words");
    int tid = threadIdx.x; asm volatile("" : "+v"(tid));
    const int lane = tid & 63, w = __builtin_amdgcn_readfirstlane(tid >> 6), r = lane & 31, hh = lane >> 5;
    const int tq0 = q0 + 32 * w, tq = tq0 + r;
    LAS unsigned char* Ks = lds; LAS unsigned char* Vt = lds + KT * KROW;
    LAS unsigned* flags = (LAS unsigned*)(lds + ATT_FLAG_OFF);
    bf16x8 Qf[KS];
#pragma unroll
    for (int ks = 0; ks < KS; ++ks) Qf[ks] = *(const bf16x8*)(Qp + (size_t)tq * ldq + 16 * ks + 8 * hh);
    f32x16 Oacc[DD];
#pragma unroll
    for (int dd = 0; dd < DD; ++dd)
#pragma unroll
        for (int i = 0; i < 16; ++i) Oacc[dd][i] = 0.f;
    float m = -INFINITY, l = 0.f, run = (MODE == 1) ? 1.f : 0.f; unsigned done_w = 0u;
    float w8[8], u4[4], fgc[4], fmn[16], fbias = 0.f;
    if (MODE == 0) {
        const int cc = r & 15, e = cc & 3, f = cc >> 3; const bool act = (hh == ((cc >> 2) & 1)); const int c4 = r & 3;
#pragma unroll
        for (int i = 0; i < 8; ++i) { w8[i] = (act && (i & 3) == e && (i >> 2) == f) ? 1.f : 0.f; asm volatile("" : "+v"(w8[i])); }
        fbias = act ? 0.f : -INFINITY; asm volatile("" : "+v"(fbias));
#pragma unroll
        for (int j = 0; j < 4; ++j) { u4[j] = (j == c4) ? 1.f : 0.f; asm volatile("" : "+v"(u4[j])); }
#pragma unroll
        for (int g = 0; g < 4; ++g) { fgc[g] = (((r - 4 * hh - c4 - 8 * g) & 15) == 0) ? 2.f : 1.f; asm volatile("" : "+v"(fgc[g])); }
#pragma unroll
        for (int i = 0; i < 16; ++i) { const int dm = (r - 4 * hh - ((i & 3) + 8 * (i >> 2))) & 15; fmn[i] = 1.f + ((dm & 3) == 0 ? 1.f : 0.f) + (dm == 0 ? 1.f : 0.f); asm volatile("" : "+v"(fmn[i])); }
    }
    const int kt_hi = (MODE == 2) ? (nkeys / KT - 1) : ((q0 + 255) / KT);
    u32x4 kA[PER], vA[PER], kB[PER], vB[PER];
#define ATT_GLOAD(KR, VR, kt) do { _Pragma("unroll") for (int p_ = 0; p_ < PER; ++p_) { const int idx_ = tid + 512 * p_, key_ = idx_ / NCH, ch_ = idx_ % NCH; \
        KR[p_] = *(const u32x4*)(Kp + (size_t)(KT * (kt) + key_) * ldkv + ch_ * 8); VR[p_] = *(const u32x4*)(Vp + (size_t)(KT * (kt) + key_) * ldkv + ch_ * 8); } } while (0)
    auto stage = [&](const u32x4 (&KR)[PER], const u32x4 (&VR)[PER]) -> bool {
        if (MODE == 1 && lane == 0) flags[w] = done_w;
        __syncthreads();
#pragma unroll
        for (int p_ = 0; p_ < PER; ++p_) { const int idx_ = tid + 512 * p_, key_ = idx_ / NCH, ch_ = idx_ % NCH;
            *(LAS u32x4*)(Ks + key_ * KROW + ch_ * 16) = KR[p_];
#pragma unroll
            for (int j = 0; j < 8; ++j) *(LAS bf16_t*)(Vt + (ch_ * 8 + j) * VROW + ch_ * 8 + key_ * 2) = (bf16_t)((VR[p_][j >> 1] >> (16 * (j & 1))) & 0xffffu);
        }
        bool alldone = false;
        if (MODE == 1) { unsigned a = 1u;
#pragma unroll
            for (int i = 0; i < 8; ++i) a &= flags[i];
            alldone = a != 0u; }
        __syncthreads();
        return alldone;
    };
    auto qk = [&](int sub, f32x16& S) {
        bf16x8 kf[KS];
#pragma unroll
        for (int ks = 0; ks < KS; ++ks) kf[ks] = *(const LAS bf16x8*)(Ks + (32 * sub + r) * KROW + (16 * ks + 8 * hh) * 2);
#pragma unroll
        for (int i = 0; i < 16; ++i) S[i] = 0.f;
        __builtin_amdgcn_sched_barrier(0);
#pragma unroll
        for (int ks = 0; ks < KS; ++ks) S = MFMA32(kf[ks], Qf[ks], S);
    };
    auto compute = [&](int kt) {
        f32x16 Sn; bool an;
        { const int tkn = KT * kt + 32 * (NSUB - 1); an = !((MODE != 2 && tkn > tq0 + 31) || (MODE == 1 && done_w)); if (an) qk(NSUB - 1, Sn); }
#pragma unroll
        for (int sub = NSUB - 1; sub >= 0; --sub) {
            const int tk0 = KT * kt + 32 * sub;
            f32x16 S = Sn; const bool a = an;
            if (sub > 0) { const int tkn = tk0 - 32; an = !((MODE != 2 && tkn > tq0 + 31) || (MODE == 1 && done_w)); if (an) qk(sub - 1, Sn); }
            if (!a) continue;
            s16x4 vlo[DD][2], vhi[DD][2];
#pragma unroll
            for (int dd = 0; dd < DD; ++dd)
#pragma unroll
                for (int s2 = 0; s2 < 2; ++s2) {
                    const LAS unsigned char* vp = Vt + (32 * dd + r) * VROW + (4 * dd + (r >> 3)) * 8 + (32 * sub + 16 * s2 + 4 * hh) * 2;
                    vlo[dd][s2] = *(const LAS s16x4*)vp; vhi[dd][s2] = *(const LAS s16x4*)(vp + 16);
                }
            __builtin_amdgcn_sched_barrier(0);
            const int dbase = tq - tk0 - 4 * hh;
            const int D = tq0 - tk0;
            if (MODE == 0 || MODE == 2) {
                const float C = (MODE == 0 ? 0.125f : 0.08838834764831845f) * 1.4426950408889634f;
                float alpha, ls = 0.f, mn;
                if (MODE == 0 && D >= 544) {
                    float s1 = S[0] * w8[0], s2 = S[8] * w8[0];
#pragma unroll
                    for (int i = 1; i < 8; ++i) { s1 = fmaf(S[i], w8[i], s1); s2 = fmaf(S[8 + i], w8[i], s2); }
                    const float v1 = fmaf(s1, C, fbias), v2 = fmaf(s2, C, fbias);
                    float mx = fmaxf(v1, v2); mx = fmaxf(mx, __shfl_xor(mx, 32));
                    mn = fmaxf(m, mx);
                    alpha = __builtin_amdgcn_exp2f(m - mn);
                    const float p1 = __builtin_amdgcn_exp2f(v1 - mn), p2 = __builtin_amdgcn_exp2f(v2 - mn);
                    ls = p1 + p2;
#pragma unroll
                    for (int i = 0; i < 8; ++i) { S[i] = w8[i] * p1; S[8 + i] = w8[i] * p2; }
                } else if (MODE == 0 && D >= 160 && D <= 480) {
                    float vg[4]; float mx = -INFINITY;
#pragma unroll
                    for (int g = 0; g < 4; ++g) { vg[g] = (fmaf(S[4 * g + 3], u4[3], fmaf(S[4 * g + 2], u4[2], fmaf(S[4 * g + 1], u4[1], S[4 * g] * u4[0])))) * C; mx = fmaxf(mx, vg[g]); }
                    mx = fmaxf(mx, __shfl_xor(mx, 32));
                    mn = fmaxf(m, mx);
                    alpha = __builtin_amdgcn_exp2f(m - mn);
#pragma unroll
                    for (int g = 0; g < 4; ++g) { const float pg = fgc[g] * __builtin_amdgcn_exp2f(vg[g] - mn); ls += pg;
#pragma unroll
                        for (int j = 0; j < 4; ++j) S[4 * g + j] = u4[j] * pg; }
                } else if (MODE == 0 && D >= 32 && D <= 96) {
                    float mx = -INFINITY;
#pragma unroll
                    for (int i = 0; i < 16; ++i) { S[i] = S[i] * C; mx = fmaxf(mx, S[i]); }
                    mx = fmaxf(mx, __shfl_xor(mx, 32));
                    mn = fmaxf(m, mx);
                    alpha = __builtin_amdgcn_exp2f(m - mn);
#pragma unroll
                    for (int i = 0; i < 16; ++i) { const float p = fmn[i] * __builtin_amdgcn_exp2f(S[i] - mn); S[i] = p; ls += p; }
                } else {
                    float fm[16]; float mx = -INFINITY;
#pragma unroll
                    for (int i = 0; i < 16; ++i) {
                        float v = S[i] * C;
                        if (MODE == 0) { const int d = dbase - ((i & 3) + 8 * (i >> 2));
                            int mult = (d <= 128 ? 1 : 0) + ((((d & 3) == 0) && d <= 512) ? 1 : 0) + (((d & 15) == 0) ? 1 : 0);
                            mult = d >= 0 ? mult : 0; fm[i] = (float)mult; v = mult > 0 ? v : -INFINITY; }
                        else fm[i] = 1.f;
                        S[i] = v; mx = fmaxf(mx, v);
                    }
                    mx = fmaxf(mx, __shfl_xor(mx, 32));
                    mn = fmaxf(m, mx); const float ms = (mn == -INFINITY) ? 0.f : mn;
                    alpha = __builtin_amdgcn_exp2f(m - ms);
#pragma unroll
                    for (int i = 0; i < 16; ++i) { const float p = fm[i] * __builtin_amdgcn_exp2f(S[i] - ms); S[i] = p; ls += p; }
                }
                l = l * alpha + ls; m = mn;
                if (!__all(alpha == 1.f)) {
#pragma unroll
                    for (int dd = 0; dd < DD; ++dd) Oacc[dd] = Oacc[dd] * alpha;
                }
            } else {
                float om[16], ex[16], G[4], PG[4];
                if (D < 32) {
#pragma unroll
                    for (int i = 0; i < 16; ++i) { const int d = dbase - ((i & 3) + 8 * (i >> 2)); const bool valid = d > 0;
                        const float x = fminf(fmaxf(S[i] * (0.125f * 1.4426950408889634f), -115.f), 115.f); const float e = __builtin_amdgcn_exp2f(x); const float o1 = __builtin_amdgcn_rcpf(1.f + e);
                        om[i] = valid ? o1 : 1.f; S[i] = valid ? e * o1 : 0.f; }
                } else {
#pragma unroll
                    for (int i = 0; i < 16; ++i) {
                        const float x = fminf(fmaxf(S[i] * (0.125f * 1.4426950408889634f), -115.f), 115.f); const float e = __builtin_amdgcn_exp2f(x); const float o1 = __builtin_amdgcn_rcpf(1.f + e);
                        om[i] = o1; S[i] = e * o1; }
                }
#pragma unroll
                for (int g = 0; g < 4; ++g) { ex[4 * g + 3] = 1.f; ex[4 * g + 2] = om[4 * g + 3]; ex[4 * g + 1] = ex[4 * g + 2] * om[4 * g + 2]; ex[4 * g] = ex[4 * g + 1] * om[4 * g + 1]; G[g] = ex[4 * g] * om[4 * g]; }
#pragma unroll
                for (int g = 0; g < 4; ++g) PG[g] = __shfl_xor(G[g], 32);
                float suf = run;
#pragma unroll
                for (int g = 3; g >= 0; --g) { const float lat = suf * (hh == 0 ? PG[g] : 1.f);
                    S[4 * g + 3] = S[4 * g + 3] * lat; S[4 * g + 2] = S[4 * g + 2] * (lat * ex[4 * g + 2]); S[4 * g + 1] = S[4 * g + 1] * (lat * ex[4 * g + 1]); S[4 * g] = S[4 * g] * (lat * ex[4 * g]);
                    suf *= G[g] * PG[g]; }
                run = suf;
                done_w = __all(run < 1e-30f) ? 1u : 0u;
            }
            u32x4 pp0, pp1;
#pragma unroll
            for (int j = 0; j < 4; ++j) { pp0[j] = pk_bf16(S[2 * j], S[2 * j + 1]); pp1[j] = pk_bf16(S[8 + 2 * j], S[8 + 2 * j + 1]); }
            const bf16x8 P0 = __builtin_bit_cast(bf16x8, pp0), P1 = __builtin_bit_cast(bf16x8, pp1);
#pragma unroll
            for (int dd = 0; dd < DD; ++dd)
#pragma unroll
                for (int s2 = 0; s2 < 2; ++s2) {
                    const bf16x8 vf = __builtin_shufflevector(vlo[dd][s2], vhi[dd][s2], 0, 1, 2, 3, 4, 5, 6, 7);
                    Oacc[dd] = MFMA32(vf, s2 ? P1 : P0, Oacc[dd]);
                }
        }
    };
    ATT_GLOAD(kA, vA, kt_hi);
    if constexpr (MODE == 2) {
#pragma unroll 1
        for (int kt = kt_hi; kt >= 0; --kt) {
            stage(kA, vA);
            if (kt >= 1) ATT_GLOAD(kA, vA, kt - 1);
            compute(kt);
        }
    } else {
        if (kt_hi >= 1) ATT_GLOAD(kB, vB, kt_hi - 1);
#pragma unroll 1
        for (int kt = kt_hi; kt >= 0; kt -= 2) {
            if (stage(kA, vA)) break;
            if (kt >= 2) ATT_GLOAD(kA, vA, kt - 2);
            compute(kt);
            if (kt == 0) break;
            if (stage(kB, vB)) break;
            if (kt >= 3) ATT_GLOAD(kB, vB, kt - 3);
            compute(kt - 1);
        }
    }
#undef ATT_GLOAD
    float inv = 1.f;
    if (MODE != 1) { const float lt = l + __shfl_xor(l, 32); inv = 1.f / lt; }
#pragma unroll
    for (int dd = 0; dd < DD; ++dd)
#pragma unroll
        for (int g = 0; g < 4; ++g) {
            u32x2 o; o[0] = pk_bf16(Oacc[dd][4 * g] * inv, Oacc[dd][4 * g + 1] * inv); o[1] = pk_bf16(Oacc[dd][4 * g + 2] * inv, Oacc[dd][4 * g + 3] * inv);
            *(u32x2*)(Op + (size_t)tq * ldo + 32 * dd + 8 * g + 4 * hh) = o;
        }
}
__device__ __forceinline__ void p_attn_ab(LAS unsigned char* lds, const bf16_t* qkv, bf16_t* OA, bf16_t* OB) {
    constexpr size_t TS = (size_t)T * 512;
    for (int v = blockIdx.x; v < 256; v += gridDim.x) {
        const int bh = v >> 1, b = bh >> 3, h = bh & 7, par = v & 1;
        const bf16_t* base = qkv + (size_t)bh * SEQ * 64;
        for (int rep = 0; rep < 1 + ATT_DUP_A; ++rep)
        for (int k = 0; k < 4; ++k) { const int qb = (k == 0) ? 7 - par : (k == 1) ? par : (k == 2) ? 5 - par : 2 + par;
            attn_item<0, 64, 128>(lds, base, 64, base + TS, base + 2 * TS, 64, OA + (size_t)b * SEQ * 1024 + h * HD, 1024, qb * 256, SEQ); }
        for (int rep = 0; rep < 1 + ATT_DUP_B; ++rep)
        for (int k = 0; k < 4; ++k) { const int qb = (k == 0) ? 7 - par : (k == 1) ? par : (k == 2) ? 5 - par : 2 + par;
            attn_item<1, 64, 128>(lds, base + 3 * TS, 64, base + 4 * TS, base + 5 * TS, 64, OB + (size_t)b * SEQ * 1024 + h * HD, 1024, qb * 256, SEQ); }
    }
}
__device__ __forceinline__ void p_attn_mem(LAS unsigned char* lds, const bf16_t* qm, const bf16_t* kvm, bf16_t* om) {
#pragma unroll 1
    for (int i = 0;; ++i) {
        Unit u; { pg8::StaticOrder S2; S2.init(T, MEMW, (int)gridDim.x, (int)blockIdx.x); if (!S2.next(i, u)) break; }
        const int b = u.pm >> 3, qb = u.pm & 7;
#pragma unroll 1
        for (int hq = 0; hq < 2; ++hq) { const int h = 2 * u.pn + hq;
            attn_item<2, 128, 64>(lds, qm + (size_t)b * SEQ * MEMW + h * 128, MEMW, kvm + (size_t)b * NMEM * 1024 + h * 128, kvm + (size_t)b * NMEM * 1024 + 512 + h * 128, 1024,
                                  om + (size_t)b * SEQ * MEMW + h * 128, MEMW, qb * 256, NMEM); }
    }
}

__device__ __forceinline__ bool sync_if(int k, cg::grid_group& grid, XcdBarrier& xb) {
    if (k == 1) { grid.sync(); xb = xcd_barrier_post(xb.bar, xb.st); }
    else if (k == 8) {
        asm volatile("s_waitcnt vmcnt(0)" ::: "memory");
        __syncthreads();
        if (threadIdx.x == 0) { __builtin_amdgcn_fence(__ATOMIC_ACQUIRE, "agent"); asm volatile("s_waitcnt vmcnt(0)" ::: "memory"); }
        __syncthreads();
    }
    else if (k > 1) xcd_barrier(xb);
    asm volatile("" ::: "memory"); return true; }
constexpr int NPHASE = 13;
#ifndef NAIVE_AB
#define NAIVE_AB 0
#endif
#ifndef NAIVE_MEM
#define NAIVE_MEM 0
#endif
#ifndef ONLY
#define ONLY -1
#endif
#ifndef DUP_MASK
#define DUP_MASK 0
#endif
#define PHASE(k) if ((ONLY < 0 || ONLY == (k)) && ph_lo <= (k) && (k) < ph_hi) if (sync_if((k), grid, xb)) for (int rep_ = 0; rep_ < (((DUP_MASK >> (k)) & 1) ? 2 : 1); ++rep_)
__global__ __launch_bounds__(512, 2) void mega(Params p, int ph_lo, int ph_hi) {
    extern __shared__ __attribute__((aligned(16))) unsigned char shm[];
    LAS unsigned char* lds = (LAS unsigned char*)shm;
    cg::grid_group grid = cg::this_grid();
    Ctx c; c.tid = threadIdx.x; c.lane = c.tid & 63; c.wave = c.tid >> 6; c.gw = blockIdx.x * 8 + c.wave; c.ngw = gridDim.x * 8; c.gt = blockIdx.x * 512 + c.tid; c.ngt = gridDim.x * 512;
    unsigned char* ws = p.ws;
    bf16_t* Wt_in = (bf16_t*)(ws + WS_WIN); bf16_t* Wt_upa = (bf16_t*)(ws + WS_WUPA); bf16_t* Wt_upb = (bf16_t*)(ws + WS_WUPB); bf16_t* Wt_out = (bf16_t*)(ws + WS_WOUT);
    bf16_t* Wt_qm = (bf16_t*)(ws + WS_WQM); bf16_t* Wt_kvm = (bf16_t*)(ws + WS_WKVM); bf16_t* Wt_om = (bf16_t*)(ws + WS_WOM); bf16_t* Wt_gu = (bf16_t*)(ws + WS_WGU); bf16_t* Wt_dn = (bf16_t*)(ws + WS_WDN);
    bf16_t* memn = (bf16_t*)(ws + WS_MEMN); bf16_t* kvm = (bf16_t*)(ws + WS_KVM);
    float* ss1 = (float*)(ws + WS_SS1); float* ss2 = (float*)(ws + WS_SS2); float* ss3 = (float*)(ws + WS_SS3); float* rope = (float*)(ws + WS_ROPE);
    bf16_t* n1 = (bf16_t*)(ws + WS_R1); bf16_t* mixed = (bf16_t*)(ws + WS_R1); bf16_t* h2b = (bf16_t*)(ws + WS_R1);
    bf16_t* proj = (bf16_t*)(ws + WS_PROJ); bf16_t* gates = (bf16_t*)(ws + WS_PROJ + 192 * MiB);
    float* h1 = (float*)(ws + WS_H1); bf16_t* h1b = (bf16_t*)(ws + WS_H1B); bf16_t* qm = (bf16_t*)(ws + WS_QM); bf16_t* om = (bf16_t*)(ws + WS_OM);
    float* h2 = (float*)(ws + WS_H2); bf16_t* act = (bf16_t*)(ws + WS_ACT); bf16_t* OA = (bf16_t*)(ws + WS_OA); bf16_t* OB = (bf16_t*)(ws + WS_OA) + 512;
    float* m1 = p.out; unsigned* bar = (unsigned*)(ws + WS_BAR);
    volatile LAS unsigned* xst = (volatile LAS unsigned*)(lds + pg8::STAGE_BYTES);
    if (c.tid == 0) { xst[0] = 0u; xst[1] = 0u; }
    __syncthreads();
    XcdBarrier xb; xb.bar = bar; xb.x = 0u; xb.st = xst;
    pg8::StaticOrder S;
    {
        PHASE(0) {
            int cur = 0;
            p_transpose(c, lds, p.w_in, Wt_in, DM, INC, nullptr, 0, cur);
            p_transpose(c, lds, p.w_ffn_gate, Wt_gu, DM, DFF, p.g_ffn, 1, cur);
            p_transpose(c, lds, p.w_ffn_up, Wt_gu, DM, DFF, p.g_ffn, 2, cur);
            p_transpose(c, lds, p.w_ffn_down, Wt_dn, DFF, DM, nullptr, 0, cur);
            p_transpose(c, lds, p.w_up_a, Wt_upa, 512, DM, nullptr, 0, cur, 1024, 0);
            p_transpose(c, lds, p.w_up_b, Wt_upa, 512, DM, nullptr, 0, cur, 1024, 512);
            p_transpose(c, lds, p.w_out, Wt_out, DM, DM, nullptr, 0, cur);
            p_transpose(c, lds, p.w_q_mem, Wt_qm, DM, MEMW, p.g_mem_q, 0, cur);
            p_transpose(c, lds, p.w_kv_mem, Wt_kvm, DM, 2 * MEMW, nullptr, 0, cur);
            p_transpose(c, lds, p.w_o_mem, Wt_om, MEMW, DM, nullptr, 0, cur);
            p_rmsnorm_rows(c, p.x, p.g_mix, n1, T);
            p_rmsnorm_rows(c, p.mem, p.g_mem_kv, memn, BATCH * NMEM);
            p_rope_table(c, p.pos, rope);
            if (blockIdx.x == 0) for (int i = c.tid; i < XCD_BAR_WORDS; i += 512) bar[i] = 0u;
        }
        PHASE(1) {
            { Gemm g{n1, Wt_in, T, INC, DM}; EpiBf16 E{proj, INC, nullptr, 1 << 30, rope, 4, 12, gates};   S.init(g.M, g.N, gridDim.x, blockIdx.x); pg8::gemm_phase(lds, g, S, E); }
            { Gemm g{memn, Wt_kvm, BATCH * NMEM, 1024, DM}; EpiBf16 E{kvm, 1024, nullptr, 1 << 30, nullptr, 0, 0, nullptr}; S.init(g.M, g.N, gridDim.x, blockIdx.x); pg8::gemm_phase(lds, g, S, E); }
        }
        PHASE(3) {
            p_attn_ab(lds, proj, OA, OB);
        }
        PHASE(5) { Gemm g{OA, Wt_upa, T, DM, DM}; EpiGate E{gates, mixed}; S.init(g.M, g.N, gridDim.x, blockIdx.x); pg8::gemm_phase(lds, g, S, E); }
        PHASE(6) { Gemm g{mixed, Wt_out, T, DM, DM}; EpiRes E{p.x, nullptr, nullptr, h1b, ss1}; S.init(g.M, g.N, gridDim.x, blockIdx.x); pg8::gemm_phase(lds, g, S, E); }
        PHASE(7) { Gemm g{h1b, Wt_qm, T, MEMW, DM}; EpiBf16 E{qm, MEMW, ss1, 1 << 30, nullptr, 0, 0, nullptr}; S.init(g.M, g.N, gridDim.x, blockIdx.x); pg8::gemm_phase(lds, g, S, E); }
        PHASE(8) {
            p_attn_mem(lds, qm, kvm, om);
        }
        PHASE(9) { Gemm g{om, Wt_om, T, DM, MEMW}; EpiRes E{nullptr, h1b, nullptr, h2b, ss2}; S.init(g.M, g.N, gridDim.x, blockIdx.x); pg8::gemm_phase(lds, g, S, E); }
        PHASE(10) { Gemm g{h2b, Wt_gu, T, 2 * DFF, DM}; EpiSwiGLU E{act, ss2}; S.init(g.M, g.N, gridDim.x, blockIdx.x); pg8::gemm_phase(lds, g, S, E); }
        PHASE(11) { Gemm g{act, Wt_dn, T, DM, DFF}; EpiRes E{nullptr, h2b, p.out, nullptr, ss3}; S.init(g.M, g.N, gridDim.x, blockIdx.x); pg8::gemm_phase(lds, g, S, E); }
        PHASE(12) p_final(c, p.out, ss3, p.g_final);
    }
}

constexpr int LDS_BYTES = pg8::STAGE_BYTES + 16;
#ifndef ONE_LAUNCH
#define ONE_LAUNCH 1
#endif
extern "C" void kernel_launch(void* const* d_in, const int* in_sizes, int n_in, void* d_out, int out_size, void* d_ws, size_t ws_size, hipStream_t stream) {
    static int grid = 0;
    if (grid == 0) {
        if (n_in != 18 || out_size != T * DM || ws_size < WS_END) { fprintf(stderr, "kernel_launch: unexpected shapes (n_in %d out %d ws %zu)\n", n_in, out_size, ws_size); grid = -1; return; }
        int dev = 0, cus = 0, per_cu = 0;
        (void)hipGetDevice(&dev); (void)hipDeviceGetAttribute(&cus, hipDeviceAttributeMultiprocessorCount, dev);
        if (hipFuncSetAttribute((const void*)mega, hipFuncAttributeMaxDynamicSharedMemorySize, LDS_BYTES) != hipSuccess) { fprintf(stderr, "hipFuncSetAttribute failed\n"); grid = -1; return; }
        if (hipOccupancyMaxActiveBlocksPerMultiprocessor(&per_cu, (const void*)mega, 512, LDS_BYTES) != hipSuccess || per_cu < 1) { fprintf(stderr, "occupancy query: %d\n", per_cu); per_cu = 1; }
        (void)hipGetLastError();
        grid = cus * 1;
    }
    if (grid < 0) return;
    Params p{};
    p.x = (const float*)d_in[0]; p.mem = (const float*)d_in[1]; p.pos = (const int*)d_in[2]; p.g_mix = (const float*)d_in[3]; p.w_in = (const float*)d_in[4];
    p.w_up_a = (const float*)d_in[5]; p.w_up_b = (const float*)d_in[6]; p.w_out = (const float*)d_in[7]; p.g_mem_q = (const float*)d_in[8]; p.g_mem_kv = (const float*)d_in[9];
    p.w_q_mem = (const float*)d_in[10]; p.w_kv_mem = (const float*)d_in[11]; p.w_o_mem = (const float*)d_in[12]; p.g_ffn = (const float*)d_in[13];
    p.w_ffn_gate = (const float*)d_in[14]; p.w_ffn_up = (const float*)d_in[15]; p.w_ffn_down = (const float*)d_in[16]; p.g_final = (const float*)d_in[17];
    p.out = (float*)d_out; p.ws = (unsigned char*)d_ws;
#if ONE_LAUNCH
    int lo = 0, hi = NPHASE;
    void* args[] = {&p, &lo, &hi};
    hipError_t e = hipLaunchCooperativeKernel((const void*)mega, dim3(grid), dim3(512), args, LDS_BYTES, stream);
    if (e != hipSuccess) fprintf(stderr, "cooperative launch failed: %s\n", hipGetErrorString(e));
#else
    for (int ph = 0; ph < NPHASE; ++ph) hipLaunchKernelGGL(mega, dim3(grid), dim3(512), LDS_BYTES, stream, p, ph, ph + 1);
#endif
}
```

```cpp
#include <hip/hip_runtime.h>
#include <hip/hip_cooperative_groups.h>
#include <cstdio>
namespace cg = cooperative_groups;

#define LAS __attribute__((address_space(3)))
typedef unsigned short bf16_t;
typedef short bf16x8 __attribute__((ext_vector_type(8)));
typedef float f32x4 __attribute__((ext_vector_type(4)));
typedef unsigned u32x4 __attribute__((ext_vector_type(4)));
typedef unsigned u32x2 __attribute__((ext_vector_type(2)));

constexpr int BATCH = 16, SEQ = 2048, DM = 1024, T = BATCH * SEQ;
constexpr int HD = 64, NHA = 8, NHB = 8;
constexpr int INC = 5120;
constexpr int C_QA = 0, C_KA = 512, C_VA = 1024, C_QB = 1536, C_KB = 2048, C_VB = 2560, C_GA = 3072, C_GB = 4096;
constexpr int NMEM = 256, MEMW = 512, DFF = 2816;
constexpr float EPS = 1e-6f;

constexpr size_t MiB = 1ull << 20;
constexpr size_t WS_WIN = 0, WS_WUPA = 10 * MiB, WS_WUPB = 11 * MiB, WS_WOUT = 12 * MiB, WS_WQM = 14 * MiB, WS_WKVM = 15 * MiB,
                 WS_WOM = 17 * MiB, WS_WGU = 18 * MiB, WS_WDN = 29 * MiB, WS_MEMN = 36 * MiB, WS_KVM = 44 * MiB,
                 WS_SS1 = 52 * MiB, WS_SS2 = 54 * MiB, WS_SS3 = 56 * MiB, WS_ROPE = 58 * MiB, WS_BAR = 60 * MiB;
constexpr size_t WS_R1 = 64 * MiB;
constexpr size_t WS_PROJ = 128 * MiB;
constexpr size_t WS_H1 = 128 * MiB, WS_H1B = 256 * MiB, WS_QM = 320 * MiB, WS_OM = 352 * MiB, WS_H2 = 384 * MiB, WS_ACT = 128 * MiB;
constexpr size_t WS_OA = 448 * MiB, WS_OB = 480 * MiB;
constexpr size_t WS_END = 512 * MiB;

struct Params {
    const float* x; const float* mem; const int* pos; const float* g_mix; const float* w_in; const float* w_up_a; const float* w_up_b; const float* w_out;
    const float* g_mem_q; const float* g_mem_kv; const float* w_q_mem; const float* w_kv_mem; const float* w_o_mem; const float* g_ffn;
    const float* w_ffn_gate; const float* w_ffn_up; const float* w_ffn_down; const float* g_final;
    float* out; unsigned char* ws;
};

typedef float f32x2 __attribute__((ext_vector_type(2)));
typedef __bf16 bf16v2 __attribute__((ext_vector_type(2)));
__device__ __forceinline__ unsigned pk_bf16(float lo, float hi) { f32x2 v = {lo, hi}; bf16v2 r = __builtin_convertvector(v, bf16v2); return __builtin_bit_cast(unsigned, r); }
__device__ __forceinline__ bf16_t f2bf(float f) { return (bf16_t)(pk_bf16(f, 0.f) & 0xffffu); }
__device__ __forceinline__ float bf2f(bf16_t b) { return __uint_as_float(((unsigned)b) << 16); }
__device__ __forceinline__ float bflo(unsigned u) { return __uint_as_float(u << 16); }
__device__ __forceinline__ float bfhi(unsigned u) { return __uint_as_float(u & 0xffff0000u); }
__device__ __forceinline__ float wave_sum(float v) {
#pragma unroll
    for (int o = 1; o < 64; o <<= 1) v += __shfl_xor(v, o);
    return v;
}
__device__ __forceinline__ float sigmoidf_(float x) { return 1.f / (1.f + __expf(-x)); }
__device__ __forceinline__ float rstd_of(const float* ss, int row) {
    const f32x4* p = (const f32x4*)(ss + (size_t)row * 16);
    f32x4 a = p[0], b = p[1], c = p[2], d = p[3];
    float s = ((a[0] + a[1]) + (a[2] + a[3])) + ((b[0] + b[1]) + (b[2] + b[3])) + ((c[0] + c[1]) + (c[2] + c[3])) + ((d[0] + d[1]) + (d[2] + d[3]));
    return rsqrtf(s * (1.f / DM) + EPS);
}


#define XB_TMO      128
#define XB_XCNT(j)  (256  + 64 * (j))
#define XB_XSUB(j)  (1280 + 64 * (j))
#define XB_XGEN(j)  (2304 + 64 * (j))
#define XB_TOP      3328
#define XB_TOPGEN   3392
#define XCD_BAR_WORDS 3456
#define XB_SPIN_CAP (1u << 18)
__device__ __forceinline__ unsigned xb_ld(unsigned* p)              { return __hip_atomic_load(p, __ATOMIC_RELAXED, __HIP_MEMORY_SCOPE_AGENT); }
__device__ __forceinline__ unsigned xb_add(unsigned* p, unsigned v) { return __hip_atomic_fetch_add(p, v, __ATOMIC_RELAXED, __HIP_MEMORY_SCOPE_AGENT); }
__device__ __forceinline__ unsigned xb_xcc_id() { return (unsigned)__builtin_amdgcn_s_getreg((3 << 11) | 20) & 0xFu; }
#define XB_SPIN(cond, bar) do { unsigned _sp = 0; while (cond) { __builtin_amdgcn_s_sleep(1); \
    if ((++_sp & 255u) == 0u) { if (xb_ld(&(bar)[XB_TMO])) break; if (_sp > XB_SPIN_CAP) { atomicAdd(&(bar)[XB_TMO], 1u); break; } } } } while (0)
struct XcdBarrier { unsigned* bar; unsigned x; volatile LAS unsigned* st; };
__device__ __forceinline__ XcdBarrier xcd_barrier_post(unsigned* bar, volatile LAS unsigned* st) {
    XcdBarrier b; b.bar = bar; b.x = xb_xcc_id(); b.st = st;
    if (threadIdx.x == 0) (void)xb_add(&bar[XB_XCNT(b.x)], 1u);
    return b;
}
__device__ __forceinline__ void xcd_barrier_complete(unsigned* bar, unsigned x, unsigned& nloc, unsigned& nx) {
    const unsigned G = gridDim.x * gridDim.y * gridDim.z;
    unsigned sum, cnt, mine, sp = 0u;
    for (;;) {
        sum = 0u; cnt = 0u; mine = 0u;
#pragma unroll
        for (unsigned j = 0; j < 16; ++j) { const unsigned c = xb_ld(&bar[XB_XCNT(j)]); sum += c; cnt += (c > 0u) ? 1u : 0u; mine = (j == x) ? c : mine; }
        if (sum == G) break;
        __builtin_amdgcn_s_sleep(1);
        if ((++sp & 255u) == 0u) { if (xb_ld(&bar[XB_TMO])) break; if (sp > XB_SPIN_CAP) { atomicAdd(&bar[XB_TMO], 1u); break; } }
    }
    nloc = mine > 0u ? mine : 1u; nx = cnt > 0u ? cnt : 1u;
}
__device__ __forceinline__ void xcd_barrier(const XcdBarrier& b) {
    asm volatile("s_waitcnt vmcnt(0)" ::: "memory");
    __syncthreads();
    if (threadIdx.x == 0) {
        unsigned* bar = b.bar;
        __builtin_amdgcn_s_waitcnt(0);
        unsigned nloc = b.st[0], nx = b.st[1];
        if (nloc == 0u) { xcd_barrier_complete(bar, b.x, nloc, nx); b.st[0] = nloc; b.st[1] = nx; }
        const unsigned old = xb_add(&bar[XB_XSUB(b.x)], 1u);
        const unsigned gen = old / nloc;
        if (old + 1u == (gen + 1u) * nloc) {
            __builtin_amdgcn_fence(__ATOMIC_RELEASE, "agent");
            asm volatile("s_waitcnt vmcnt(0)" ::: "memory");
            const unsigned og = xb_add(&bar[XB_TOP], 1u);
            const unsigned tg = og / nx;
            if (og + 1u == (tg + 1u) * nx) xb_add(&bar[XB_TOPGEN], 1u);
            else XB_SPIN(xb_ld(&bar[XB_TOPGEN]) == tg, bar);
            __builtin_amdgcn_fence(__ATOMIC_ACQUIRE, "agent");
            xb_add(&bar[XB_XGEN(b.x)], 1u);
            asm volatile("s_waitcnt vmcnt(0)" ::: "memory");
        } else {
            XB_SPIN(xb_ld(&bar[XB_XGEN(b.x)]) == gen, bar);
            __builtin_amdgcn_fence(__ATOMIC_ACQUIRE, "agent");
            asm volatile("s_waitcnt vmcnt(0)" ::: "memory");
        }
    }
    __syncthreads();
}

namespace pg8 {
constexpr int BM = 256, BK = 64, HALF = 128, HTB = HALF * BK * 2, STAGE_BYTES = 8 * HTB, NXCD = 8, WGM = 8;
__host__ __device__ __forceinline__ int lds_byte(int r, int c) { const int st = (r >> 4) * 2 + (c >> 5), rr = r & 15, cc = c & 31, ob = rr * 64 + cc * 2; return st * 1024 + (ob ^ (((ob >> 9) & 1) << 5)); }
__host__ __device__ __forceinline__ void stage_rc(int b, int& R, int& C) { const int st = b / 1024, sb = b % 1024, swz = sb ^ (((sb >> 9) & 1) << 5); R = (st >> 1) * 16 + swz / 64; C = (st & 1) * 32 + (swz % 64) / 2; }
__host__ __device__ __forceinline__ int perm32(int rho) { const int n = rho >> 4, i = rho & 15; return 8 * (i >> 2) + 4 * n + (i & 3); }
struct Unit { int pm, pn; };
struct Gemm { const bf16_t* A; const bf16_t* Bt; int M, N, K; };
struct StaticOrder {
    int nM, nN, nwg, G, c;
    __host__ __device__ void init(int M, int N, int G_, int c_) { nM = M / BM; nN = N / BM; nwg = nM * nN; G = G_; c = c_; }
    __host__ __device__ bool next(int i, Unit& u) const {
        const long L = (long)i * G + c; if (L >= nwg) return false;
        int wgid = (int)L; { const int q = nwg / NXCD, r = nwg % NXCD, xcd = wgid % NXCD, off = wgid / NXCD; wgid = (xcd < r ? xcd * (q + 1) : r * (q + 1) + (xcd - r) * q) + off; }
        const int nig = WGM * nN, gid = wgid / nig, fm = gid * WGM, gsz = (nM - fm) < WGM ? (nM - fm) : WGM;
        u.pm = fm + ((wgid % nig) % gsz); u.pn = (wgid % nig) / gsz; return true;
    }
};

template <class Epi>
__device__ __forceinline__ void gemm_phase(LAS unsigned char* lds, const Gemm g, const StaticOrder& S, const Epi& E) {
    int tid = threadIdx.x; asm volatile("" : "+v"(tid));
    const int wid = __builtin_amdgcn_readfirstlane(tid >> 6), lane = tid & 63, wr = wid >> 2, wc = wid & 3, fr = lane & 15, fq = lane >> 4;
    const int K = g.K, nt = K / BK;
    unsigned voffA[2], voffB[2];
#pragma unroll
    for (int i = 0; i < 2; ++i) { int R, C; stage_rc(tid * 16 + i * 8192, R, C); const int Rb = Epi::LINE ? ((R >> 5) * 64 + perm32(R & 31)) : (Epi::PERM ? ((R & ~31) + perm32(R & 31)) : R);
        voffA[i] = (unsigned)(R * K + C) * 2u; voffB[i] = (unsigned)(Rb * K + C) * 2u; }
    const size_t kstep = (size_t)(BK * 2);
    const size_t hstep = (size_t)HALF * K * 2;
    const size_t tstep = 2 * hstep;
    const size_t hstepB = Epi::LINE ? (size_t)32 * K * 2 : hstep;
    const unsigned ldsw = (unsigned)wid * 1024u;
    const int aoff = lds_byte(wr * 64 + fr, fq * 8), boff = lds_byte(wc * 32 + fr, fq * 8);
#define PG8_SA(b, h) (((b) * 2 + (h)) * HTB)
#define PG8_SB(b, h) ((4 + (b) * 2 + (h)) * HTB)
#define PG8_STAGE(bufoff, gbase, voff) do { _Pragma("unroll") for (int _i = 0; _i < 2; ++_i) \
        __builtin_amdgcn_global_load_lds((const unsigned*)((const char*)(gbase) + (voff)[_i]), (LAS unsigned*)(lds + (bufoff) + ldsw + _i * 8192), 16, 0, 0); } while (0)
#define PG8_LDA(dst, b, h) do { _Pragma("unroll") for (int m = 0; m < 4; ++m) _Pragma("unroll") for (int k = 0; k < 2; ++k) dst[m][k] = *(const LAS bf16x8*)(lds + PG8_SA(b, h) + aoff + m * 2048 + k * 1024); } while (0)
#define PG8_LDB(dst, b, h) do { _Pragma("unroll") for (int n = 0; n < 2; ++n) _Pragma("unroll") for (int k = 0; k < 2; ++k) dst[n][k] = *(const LAS bf16x8*)(lds + PG8_SB(b, h) + boff + n * 2048 + k * 1024); } while (0)
#define PG8_MMA(ai, bj, At, Bt) do { __builtin_amdgcn_s_setprio(1); _Pragma("unroll") for (int m = 0; m < 4; ++m) _Pragma("unroll") for (int n = 0; n < 2; ++n) _Pragma("unroll") for (int k = 0; k < 2; ++k) \
        acc[ai][bj][m][n] = __builtin_amdgcn_mfma_f32_16x16x32_bf16(Bt[n][k], At[m][k], acc[ai][bj][m][n], 0, 0, 0); __builtin_amdgcn_s_setprio(0); } while (0)
#define PG8_WAIT_V(n) asm volatile("s_waitcnt vmcnt(" #n ")" ::: "memory")
#define PG8_WAIT_L(n) asm volatile("s_waitcnt lgkmcnt(" #n ")" ::: "memory")
#define PG8_BAR __builtin_amdgcn_s_barrier()
#define PG8_SCHED __builtin_amdgcn_sched_barrier(0)
    Unit cur, nxt; int ui = 0;
    if (!S.next(0, cur)) return;
    f32x4 acc[2][2][4][2];
#pragma unroll
    for (int a = 0; a < 2; ++a)
#pragma unroll
        for (int b = 0; b < 2; ++b)
#pragma unroll
            for (int m = 0; m < 4; ++m)
#pragma unroll
                for (int n = 0; n < 2; ++n) acc[a][b][m][n] = (f32x4){0.f, 0.f, 0.f, 0.f};
    bf16x8 At[4][2], B0[2][2], B1[2][2];
    const char* cA = (const char*)g.A + (size_t)cur.pm * tstep; const char* cB = (const char*)g.Bt + (size_t)cur.pn * tstep;
    PG8_STAGE(PG8_SB(0, 0), cB, voffB); PG8_STAGE(PG8_SA(0, 0), cA, voffA); PG8_STAGE(PG8_SB(0, 1), cB + hstepB, voffB); PG8_STAGE(PG8_SA(0, 1), cA + hstep, voffA);
    if (wr == 1) PG8_BAR;
    PG8_WAIT_V(4); PG8_BAR;
    PG8_STAGE(PG8_SB(1, 0), cB + kstep, voffB); PG8_STAGE(PG8_SA(1, 0), cA + kstep, voffA); PG8_STAGE(PG8_SB(1, 1), cB + hstepB + kstep, voffB);
    PG8_WAIT_V(6); PG8_BAR;
    for (;;) {
        const bool has_next = S.next(ui + 1, nxt);
        const char* nA = has_next ? (const char*)g.A + (size_t)nxt.pm * tstep : cA; const char* nB = has_next ? (const char*)g.Bt + (size_t)nxt.pn * tstep : cB;
        for (int t = 0; t < nt; t += 2) {
            const bool last = (t == nt - 2);
            const char* a1 = cA + (size_t)(t + 1) * kstep;
            const char* a2 = last ? nA : cA + (size_t)(t + 2) * kstep; const char* b2 = last ? nB : cB + (size_t)(t + 2) * kstep;
            const char* a3 = a2 + kstep; const char* b3 = b2 + kstep;
            if constexpr (Epi::HAS_MID) { if (t == nt / 2) E.mid(acc, cur, wr, wc, fr, fq); }
            PG8_LDB(B0, 0, 0); PG8_SCHED; PG8_LDA(At, 0, 0); PG8_STAGE(PG8_SA(1, 1), a1 + hstep, voffA);
            PG8_WAIT_L(8); PG8_BAR; PG8_WAIT_L(0); PG8_MMA(0, 0, At, B0); PG8_BAR; PG8_SCHED;
            PG8_LDB(B1, 0, 1); PG8_STAGE(PG8_SB(0, 0), b2, voffB);
            PG8_BAR; PG8_WAIT_L(0); PG8_MMA(0, 1, At, B1); PG8_BAR;
            PG8_LDA(At, 0, 1); PG8_STAGE(PG8_SA(0, 0), a2, voffA);
            PG8_BAR; PG8_WAIT_L(0); PG8_MMA(1, 0, At, B0); PG8_BAR; PG8_SCHED;
            PG8_STAGE(PG8_SB(0, 1), b2 + hstepB, voffB);
            PG8_WAIT_V(6); PG8_BAR; PG8_MMA(1, 1, At, B1); PG8_BAR;
            PG8_LDB(B0, 1, 0); PG8_SCHED; PG8_LDA(At, 1, 0); PG8_STAGE(PG8_SA(0, 1), a2 + hstep, voffA);
            PG8_WAIT_L(8); PG8_BAR; PG8_WAIT_L(0); PG8_MMA(0, 0, At, B0); PG8_BAR; PG8_SCHED;
            PG8_LDB(B1, 1, 1); PG8_STAGE(PG8_SB(1, 0), b3, voffB);
            PG8_BAR; PG8_WAIT_L(0); PG8_MMA(0, 1, At, B1); PG8_BAR;
            PG8_LDA(At, 1, 1); PG8_STAGE(PG8_SA(1, 0), a3, voffA);
            PG8_BAR; PG8_WAIT_L(0); PG8_MMA(1, 0, At, B0); PG8_BAR; PG8_SCHED;
            PG8_STAGE(PG8_SB(1, 1), b3 + hstepB, voffB);
            PG8_WAIT_V(6); PG8_BAR; PG8_MMA(1, 1, At, B1); PG8_BAR;
        }
        E(acc, cur, wr, wc, fr, fq);
        if (!has_next) break;
#pragma unroll
        for (int a = 0; a < 2; ++a)
#pragma unroll
            for (int b = 0; b < 2; ++b)
#pragma unroll
                for (int m = 0; m < 4; ++m)
#pragma unroll
                    for (int n = 0; n < 2; ++n) acc[a][b][m][n] = (f32x4){0.f, 0.f, 0.f, 0.f};
        cur = nxt; cA = nA; cB = nB; ++ui;
    }
    PG8_WAIT_V(0);
    if (wr == 0) PG8_BAR;
    PG8_BAR;
#undef PG8_SA
#undef PG8_SB
#undef PG8_STAGE
#undef PG8_LDA
#undef PG8_LDB
#undef PG8_MMA
#undef PG8_WAIT_V
#undef PG8_WAIT_L
#undef PG8_BAR
#undef PG8_SCHED
}
}
using pg8::Unit; using pg8::Gemm;

__device__ __forceinline__ void line_pair(u32x4& a, u32x4& b, bool lo) {
#pragma unroll
    for (int q = 0; q < 4; ++q) {
        const unsigned send = lo ? b[q] : a[q];
        const unsigned recv = (unsigned)__builtin_amdgcn_update_dpp(0, (int)send, 0x128  , 0xf, 0xf, false);
        if (lo) b[q] = recv; else a[q] = recv;
    }
}
struct EpiBf16 {
    static constexpr bool PERM = true, HAS_MID = false, LINE = true;
    bf16_t* O; int ldc; const float* ss; int sig_from; const float* rope; int rope_below; int qkv_tiles; bf16_t* gates;
    __device__ __forceinline__ bf16_t* addr(int row, int col, int pn) const {
        if (qkv_tiles > 0) {
            if (pn < qkv_tiles) return O + (size_t)(col >> 9) * ((size_t)T * 512) + ((size_t)((row >> 11) * 8 + ((col >> 6) & 7)) * SEQ + (row & (SEQ - 1))) * 64 + (col & 63);
            return gates + (size_t)row * 2048 + (col - 256 * qkv_tiles);
        }
        return O + (size_t)row * ldc + col;
    }
    __device__ __forceinline__ void operator()(const f32x4 (&acc)[2][2][4][2], const Unit& u, int wr, int wc, int fr, int fq) const {
        const int row0 = u.pm * 256 + wr * 64 + fr, col0 = u.pn * 256 + wc * 64 + 8 * fq;
        const bool sig = u.pn >= sig_from, lo = fr < 8;
#pragma unroll
        for (int ai = 0; ai < 2; ++ai)
#pragma unroll
            for (int m = 0; m < 4; ++m) {
                const int row = row0 + ai * 128 + m * 16;
                const float rs = ss ? rstd_of(ss, row) : 1.f;
                u32x4 o[2];
#pragma unroll
                for (int bj = 0; bj < 2; ++bj) {
                    f32x4 v0 = acc[ai][bj][m][0] * rs, v1 = acc[ai][bj][m][1] * rs;
                    if (sig) {
#pragma unroll
                        for (int j = 0; j < 4; ++j) { v0[j] = sigmoidf_(v0[j]); v1[j] = sigmoidf_(v1[j]); }
                    }
                    if (bj == 0 && u.pn < rope_below) {
                        f32x4 p0, p1;
#pragma unroll
                        for (int j = 0; j < 4; ++j) { p0[j] = __shfl_xor(v0[j], 16); p1[j] = __shfl_xor(v1[j], 16); }
                        if (fq < 2) {
                            const f32x4 c0 = *(const f32x4*)(rope + (size_t)row * 16), c1 = *(const f32x4*)(rope + (size_t)row * 16 + 4);
                            f32x4 s0 = *(const f32x4*)(rope + (size_t)row * 16 + 8), s1 = *(const f32x4*)(rope + (size_t)row * 16 + 12);
                            if (fq == 0) { s0 = -s0; s1 = -s1; }
                            v0 = v0 * c0 + p0 * s0; v1 = v1 * c1 + p1 * s1;
                        }
                    }
                    o[bj][0] = pk_bf16(v0[0], v0[1]); o[bj][1] = pk_bf16(v0[2], v0[3]); o[bj][2] = pk_bf16(v1[0], v1[1]); o[bj][3] = pk_bf16(v1[2], v1[3]);
                }
                line_pair(o[0], o[1], lo);
                const int colx = col0 + (lo ? 0 : 32);
                *(u32x4*)addr(lo ? row : row - 8, colx, u.pn) = o[0];
                *(u32x4*)addr(lo ? row + 8 : row, colx, u.pn) = o[1];
            }
    }
};
struct EpiGate {
    static constexpr bool PERM = true, HAS_MID = true, LINE = true;
    const bf16_t* gates; bf16_t* O;
    __device__ __forceinline__ void mid(f32x4 (&acc)[2][2][4][2], const Unit& u, int wr, int wc, int fr, int fq) const {
        int row0 = u.pm * 256 + wr * 64 + fr, col0 = u.pn * 256 + wc * 64 + 8 * fq;
        asm volatile("" : "+v"(row0), "+v"(col0));
#pragma unroll
        for (int ai = 0; ai < 2; ++ai)
#pragma unroll
            for (int m = 0; m < 4; ++m) {
                const int row = row0 + ai * 128 + m * 16;
#pragma unroll
                for (int bj = 0; bj < 2; ++bj) {
                    const int col = col0 + bj * 32;
                    const u32x4 ga = *(const u32x4*)(gates + (size_t)row * 2048 + col), gb = *(const u32x4*)(gates + (size_t)row * 2048 + 1024 + col);
#pragma unroll
                    for (int q = 0; q < 4; ++q) {
                        const float a0 = bflo(ga[q]), a1 = bfhi(ga[q]), b0 = fmaxf(bflo(gb[q]), -60.f), b1 = fmaxf(bfhi(gb[q]), -60.f);
                        const float r0 = (1.f + __expf(-b0)) * __builtin_amdgcn_rcpf(1.f + __expf(-a0)), r1 = (1.f + __expf(-b1)) * __builtin_amdgcn_rcpf(1.f + __expf(-a1));
                        acc[ai][bj][m][q >> 1][(q & 1) * 2] *= r0; acc[ai][bj][m][q >> 1][(q & 1) * 2 + 1] *= r1;
                    }
                }
                __builtin_amdgcn_sched_barrier(0);
            }
    }
    __device__ __forceinline__ void operator()(const f32x4 (&acc)[2][2][4][2], const Unit& u, int wr, int wc, int fr, int fq) const {
        const int row0 = u.pm * 256 + wr * 64 + fr, col0 = u.pn * 256 + wc * 64 + 8 * fq; const bool lo = fr < 8;
#pragma unroll
        for (int ai = 0; ai < 2; ++ai)
#pragma unroll
            for (int m = 0; m < 4; ++m) {
                const int row = row0 + ai * 128 + m * 16;
                u32x4 oo[2];
#pragma unroll
                for (int bj = 0; bj < 2; ++bj) {
                    const int col = col0 + bj * 32;
                    const u32x4 gb = *(const u32x4*)(gates + (size_t)row * 2048 + 1024 + col);
                    float r[8];
#pragma unroll
                    for (int q = 0; q < 4; ++q) {
                        const float b0 = fmaxf(bflo(gb[q]), -60.f), b1 = fmaxf(bfhi(gb[q]), -60.f);
                        r[2 * q] = acc[ai][bj][m][q >> 1][(q & 1) * 2] * __builtin_amdgcn_rcpf(1.f + __expf(-b0));
                        r[2 * q + 1] = acc[ai][bj][m][q >> 1][(q & 1) * 2 + 1] * __builtin_amdgcn_rcpf(1.f + __expf(-b1));
                    }
                    oo[bj][0] = pk_bf16(r[0], r[1]); oo[bj][1] = pk_bf16(r[2], r[3]); oo[bj][2] = pk_bf16(r[4], r[5]); oo[bj][3] = pk_bf16(r[6], r[7]);
                }
                line_pair(oo[0], oo[1], lo);
                const int colx = col0 + (lo ? 0 : 32);
                *(u32x4*)(O + (size_t)(lo ? row : row - 8) * DM + colx) = oo[0];
                *(u32x4*)(O + (size_t)(lo ? row + 8 : row) * DM + colx) = oo[1];
            }
    }
};
struct EpiRes {
    static constexpr bool PERM = true, HAS_MID = false, LINE = true;
    const float* R; const bf16_t* Rb; float* H; bf16_t* Hb; float* SS;
    __device__ __forceinline__ void operator()(const f32x4 (&acc)[2][2][4][2], const Unit& u, int wr, int wc, int fr, int fq) const {
        const int row0 = u.pm * 256 + wr * 64 + fr, col0 = u.pn * 256 + wc * 64 + 8 * fq; const bool lo = fr < 8;
#pragma unroll
        for (int ai = 0; ai < 2; ++ai)
#pragma unroll
            for (int m = 0; m < 4; ++m) {
                const int row = row0 + ai * 128 + m * 16;
                float s = 0.f; u32x4 ob[2];
#pragma unroll
                for (int bj = 0; bj < 2; ++bj) {
                    const int col = col0 + bj * 32;
                    f32x4 r0, r1;
                    if (R) { r0 = *(const f32x4*)(R + (size_t)row * DM + col); r1 = *(const f32x4*)(R + (size_t)row * DM + col + 4); }
                    else { const u32x4 rb = *(const u32x4*)(Rb + (size_t)row * DM + col);
                        r0[0] = bflo(rb[0]); r0[1] = bfhi(rb[0]); r0[2] = bflo(rb[1]); r0[3] = bfhi(rb[1]); r1[0] = bflo(rb[2]); r1[1] = bfhi(rb[2]); r1[2] = bflo(rb[3]); r1[3] = bfhi(rb[3]); }
                    const f32x4 h0 = r0 + acc[ai][bj][m][0], h1 = r1 + acc[ai][bj][m][1];
                    if (H) { *(f32x4*)(H + (size_t)row * DM + col) = h0; *(f32x4*)(H + (size_t)row * DM + col + 4) = h1; }
                    ob[bj][0] = pk_bf16(h0[0], h0[1]); ob[bj][1] = pk_bf16(h0[2], h0[3]); ob[bj][2] = pk_bf16(h1[0], h1[1]); ob[bj][3] = pk_bf16(h1[2], h1[3]);
                    s += ((h0[0] * h0[0] + h0[1] * h0[1]) + (h0[2] * h0[2] + h0[3] * h0[3])) + ((h1[0] * h1[0] + h1[1] * h1[1]) + (h1[2] * h1[2] + h1[3] * h1[3]));
                }
                if (Hb) { line_pair(ob[0], ob[1], lo); const int colx = col0 + (lo ? 0 : 32);
                    *(u32x4*)(Hb + (size_t)(lo ? row : row - 8) * DM + colx) = ob[0]; *(u32x4*)(Hb + (size_t)(lo ? row + 8 : row) * DM + colx) = ob[1]; }
                s += __shfl_xor(s, 16); s += __shfl_xor(s, 32);
                if (fq == 0) SS[(size_t)row * 16 + u.pn * 4 + wc] = s;
            }
    }
};
struct EpiSwiGLU {
    static constexpr bool PERM = true, HAS_MID = false, LINE = false;
    bf16_t* O; const float* ss;
    __device__ __forceinline__ void operator()(const f32x4 (&acc)[2][2][4][2], const Unit& u, int wr, int wc, int fr, int fq) const {
        const int row0 = u.pm * 256 + wr * 64 + fr, col0 = u.pn * 128 + wc * 32 + 8 * fq;
#pragma unroll
        for (int ai = 0; ai < 2; ++ai)
#pragma unroll
            for (int m = 0; m < 4; ++m) {
                const int row = row0 + ai * 128 + m * 16;
                const float rs = rstd_of(ss, row);
                float r[8];
#pragma unroll
                for (int n = 0; n < 2; ++n)
#pragma unroll
                    for (int j = 0; j < 4; ++j) { const float gg = acc[ai][0][m][n][j] * rs, uu = acc[ai][1][m][n][j] * rs; r[n * 4 + j] = gg * sigmoidf_(gg) * uu; }
                u32x4 o; o[0] = pk_bf16(r[0], r[1]); o[1] = pk_bf16(r[2], r[3]); o[2] = pk_bf16(r[4], r[5]); o[3] = pk_bf16(r[6], r[7]);
                *(u32x4*)(O + (size_t)row * DFF + col0) = o;
            }
    }
};

struct Ctx { int tid, lane, wave, gw, ngw, gt, ngt; };

__device__ __forceinline__ void p_transpose(const Ctx& c, LAS unsigned char* lds, const float* W, bf16_t* Wt, int K, int N, const float* g, int mode, int& cursor, int ldw = 0, int koff = 0) {
    if (ldw == 0) ldw = K;
    LAS float* scr = (LAS float*)(lds + c.wave * 8704);
    const int nblk = N / 32, nitems = (K / 64) * nblk, lane = c.lane;
    int first = (c.gw - cursor % c.ngw + c.ngw) % c.ngw;
    for (int it = first; it < nitems; it += c.ngw) {
        const int kb = it / nblk, nb = it % nblk, k0 = 64 * kb, n0 = 32 * nb;
#pragma unroll 8
        for (int i = 0; i < 32; ++i) { const int kk = 2 * i + (lane >> 5); float v = W[(size_t)(k0 + kk) * N + n0 + (lane & 31)]; if (g) v *= g[k0 + kk]; scr[kk * 33 + (lane & 31)] = v; }
        asm volatile("s_waitcnt lgkmcnt(0)" ::: "memory");
        const int ch = lane & 7;
#pragma unroll
        for (int j = 0; j < 4; ++j) { const int n = (lane >> 3) + 8 * j; const LAS float* sp = scr + (8 * ch) * 33 + n;
            u32x4 o; o[0] = pk_bf16(sp[0], sp[33]); o[1] = pk_bf16(sp[2 * 33], sp[3 * 33]); o[2] = pk_bf16(sp[4 * 33], sp[5 * 33]); o[3] = pk_bf16(sp[6 * 33], sp[7 * 33]);
            const int nn = n0 + n, row = mode == 0 ? nn : (256 * (nn >> 7) + (nn & 127) + (mode == 2 ? 128 : 0));
            *(u32x4*)(Wt + (size_t)row * ldw + koff + k0 + 8 * ch) = o; }
        asm volatile("s_waitcnt lgkmcnt(0)" ::: "memory");
    }
    cursor += nitems;
}
__device__ __forceinline__ void p_rmsnorm_rows(const Ctx& c, const float* x, const float* g, bf16_t* out, int rows) {
    f32x4 gg[4];
#pragma unroll
    for (int j = 0; j < 4; ++j) gg[j] = ((const f32x4*)g)[c.lane + 64 * j];
    for (int r0 = c.gw; r0 < rows; r0 += 2 * c.ngw) {
        const int r1 = r0 + c.ngw; const bool has1 = r1 < rows; const int r1c = has1 ? r1 : r0;
        const f32x4* xa = (const f32x4*)(x + (size_t)r0 * DM) + c.lane; const f32x4* xb = (const f32x4*)(x + (size_t)r1c * DM) + c.lane;
        f32x4 va[4], vb[4]; float sa = 0.f, sb = 0.f;
#pragma unroll
        for (int j = 0; j < 4; ++j) { va[j] = xa[64 * j]; vb[j] = xb[64 * j]; }
#pragma unroll
        for (int j = 0; j < 4; ++j) { sa += (va[j][0] * va[j][0] + va[j][1] * va[j][1]) + (va[j][2] * va[j][2] + va[j][3] * va[j][3]); sb += (vb[j][0] * vb[j][0] + vb[j][1] * vb[j][1]) + (vb[j][2] * vb[j][2] + vb[j][3] * vb[j][3]); }
        const float ra = rsqrtf(wave_sum(sa) * (1.f / DM) + EPS), rb = rsqrtf(wave_sum(sb) * (1.f / DM) + EPS);
#pragma unroll
        for (int j = 0; j < 4; ++j) {
            u32x2 o; o[0] = pk_bf16(va[j][0] * ra * gg[j][0], va[j][1] * ra * gg[j][1]); o[1] = pk_bf16(va[j][2] * ra * gg[j][2], va[j][3] * ra * gg[j][3]);
            ((u32x2*)(out + (size_t)r0 * DM))[c.lane + 64 * j] = o;
            if (has1) { u32x2 q; q[0] = pk_bf16(vb[j][0] * rb * gg[j][0], vb[j][1] * rb * gg[j][1]); q[1] = pk_bf16(vb[j][2] * rb * gg[j][2], vb[j][3] * rb * gg[j][3]);
                ((u32x2*)(out + (size_t)r1 * DM))[c.lane + 64 * j] = q; }
        }
    }
}
__device__ __forceinline__ void p_rope_table(const Ctx& c, const int* pos, float* tab) {
    for (int i = c.gt; i < T * 8; i += c.ngt) {
        const int tok = i >> 3, f = i & 7;
        const double inv = f == 0 ? 1.0 : f == 1 ? 0.19392274474868576 : f == 2 ? 0.03760603093086393 : f == 3 ? 0.007292664737217109 : f == 4 ? 0.001414213562373095 :
                           f == 5 ? 0.0002742481756762073 : f == 6 ? 5.318295896944988e-05 : 1.031338537721246e-05;
        const double rev = (double)pos[tok] * inv * 0.15915494309189535;
        const float fr = (float)(rev - rint(rev));
        tab[(size_t)tok * 16 + f] = __builtin_amdgcn_cosf(fr);
        tab[(size_t)tok * 16 + 8 + f] = __builtin_amdgcn_sinf(fr);
    }
}
__device__ __forceinline__ void p_final(const Ctx& c, float* out, const float* ss, const float* g) {
    f32x4 gg[4];
#pragma unroll
    for (int j = 0; j < 4; ++j) gg[j] = ((const f32x4*)g)[c.lane + 64 * j];
    for (int r0 = c.gw; r0 < T; r0 += 2 * c.ngw) {
        const int r1 = r0 + c.ngw; const bool has1 = r1 < T; const int r1c = has1 ? r1 : r0;
        f32x4* xa = (f32x4*)(out + (size_t)r0 * DM) + c.lane; f32x4* xb = (f32x4*)(out + (size_t)r1c * DM) + c.lane;
        f32x4 va[4], vb[4];
#pragma unroll
        for (int j = 0; j < 4; ++j) { va[j] = xa[64 * j]; vb[j] = xb[64 * j]; }
        const float ra = rstd_of(ss, r0), rb = rstd_of(ss, r1c);
#pragma unroll
        for (int j = 0; j < 4; ++j) { xa[64 * j] = va[j] * ra * gg[j]; if (has1) xb[64 * j] = vb[j] * rb * gg[j]; }
    }
}

typedef float f32x16 __attribute__((ext_vector_type(16)));
typedef short s16x4 __attribute__((ext_vector_type(4)));
#define MFMA32(a, b, c) __builtin_amdgcn_mfma_f32_32x32x16_bf16((a), (b), (c), 0, 0, 0)
constexpr int ATT_FLAG_OFF = 40960;
#ifndef ATT_DUP_A
#define ATT_DUP_A 0
#endif
#ifndef ATT_DUP_B
#define ATT_DUP_B 0
#endif
template <int MODE, int HDIM, int KT>
__device__ __forceinline__ void attn_item(LAS unsigned char* lds, const bf16_t* Qp, int ldq, const bf16_t* Kp, const bf16_t* Vp, int ldkv, bf16_t* Op, int ldo, int q0, int nkeys) {
    constexpr int KS = HDIM / 16, DD = HDIM / 32, KROW = HDIM * 2 + 16, NCH = HDIM / 8, PER = KT * NCH / 512, NSUB = KT / 32;
    static_assert(2 * KT * KROW + 128 <= ATT_FLAG_OFF, "attention LDS tiles overlap the flag words");
    int tid = threadIdx.x; asm volatile("" : "+v"(tid));
    const int lane = tid & 63, w = __builtin_amdgcn_readfirstlane(tid >> 6), r = lane & 31, hh = lane >> 5;
    const int tq0 = q0 + 32 * w, tq = tq0 + r;
    LAS unsigned char* Ks = lds; LAS unsigned char* Vr = lds + KT * KROW;
    const int trq = (r & 15) >> 2, trp = r & 3, trb = r & 16;
    LAS unsigned* flags = (LAS unsigned*)(lds + ATT_FLAG_OFF);
    bf16x8 Qf[KS];
#pragma unroll
    for (int ks = 0; ks < KS; ++ks) Qf[ks] = *(const bf16x8*)(Qp + (size_t)tq * ldq + 16 * ks + 8 * hh);
    f32x16 Oacc[DD];
#pragma unroll
    for (int dd = 0; dd < DD; ++dd)
#pragma unroll
        for (int i = 0; i < 16; ++i) Oacc[dd][i] = 0.f;
    float m = -INFINITY, l = 0.f, run = (MODE == 1) ? 1.f : 0.f; unsigned done_w = 0u;
    float w8[8], u4[4], fgc[4], fmn[16], fbias = 0.f;
    if (MODE == 0) {
        const int cc = r & 15, e = cc & 3, f = cc >> 3; const bool act = (hh == ((cc >> 2) & 1)); const int c4 = r & 3;
#pragma unroll
        for (int i = 0; i < 8; ++i) { w8[i] = (act && (i & 3) == e && (i >> 2) == f) ? 1.f : 0.f; asm volatile("" : "+v"(w8[i])); }
        fbias = act ? 0.f : -INFINITY; asm volatile("" : "+v"(fbias));
#pragma unroll
        for (int j = 0; j < 4; ++j) { u4[j] = (j == c4) ? 1.f : 0.f; asm volatile("" : "+v"(u4[j])); }
#pragma unroll
        for (int g = 0; g < 4; ++g) { fgc[g] = (((r - 4 * hh - c4 - 8 * g) & 15) == 0) ? 2.f : 1.f; asm volatile("" : "+v"(fgc[g])); }
#pragma unroll
        for (int i = 0; i < 16; ++i) { const int dm = (r - 4 * hh - ((i & 3) + 8 * (i >> 2))) & 15; fmn[i] = 1.f + ((dm & 3) == 0 ? 1.f : 0.f) + (dm == 0 ? 1.f : 0.f); asm volatile("" : "+v"(fmn[i])); }
    }
    const int kt_hi = (MODE == 2) ? (nkeys / KT - 1) : ((q0 + 255) / KT);
    u32x4 kA[PER], vA[PER], kB[PER], vB[PER];
#define ATT_GLOAD(KR, VR, kt) do { _Pragma("unroll") for (int p_ = 0; p_ < PER; ++p_) { const int idx_ = tid + 512 * p_, key_ = idx_ / NCH, ch_ = idx_ % NCH; \
        KR[p_] = *(const u32x4*)(Kp + (size_t)(KT * (kt) + key_) * ldkv + ch_ * 8); VR[p_] = *(const u32x4*)(Vp + (size_t)(KT * (kt) + key_) * ldkv + ch_ * 8); } } while (0)
    auto stage = [&](const u32x4 (&KR)[PER], const u32x4 (&VR)[PER]) -> bool {
        if (MODE == 1 && lane == 0) flags[w] = done_w;
        __syncthreads();
#pragma unroll
        for (int p_ = 0; p_ < PER; ++p_) { const int idx_ = tid + 512 * p_, key_ = idx_ / NCH, ch_ = idx_ % NCH;
            *(LAS u32x4*)(Ks + key_ * KROW + ch_ * 16) = KR[p_];
            *(LAS u32x4*)(Vr + key_ * KROW + ch_ * 16) = VR[p_];
        }
        bool alldone = false;
        if (MODE == 1) { unsigned a = 1u;
#pragma unroll
            for (int i = 0; i < 8; ++i) a &= flags[i];
            alldone = a != 0u; }
        __syncthreads();
        return alldone;
    };
    auto qk = [&](int sub, f32x16& S) {
        bf16x8 kf[KS];
#pragma unroll
        for (int ks = 0; ks < KS; ++ks) kf[ks] = *(const LAS bf16x8*)(Ks + (32 * sub + r) * KROW + (16 * ks + 8 * hh) * 2);
#pragma unroll
        for (int i = 0; i < 16; ++i) S[i] = 0.f;
        __builtin_amdgcn_sched_barrier(0);
#pragma unroll
        for (int ks = 0; ks < KS; ++ks) S = MFMA32(kf[ks], Qf[ks], S);
    };
    auto compute = [&](int kt) {
        f32x16 Sn; bool an;
        { const int tkn = KT * kt + 32 * (NSUB - 1); an = !((MODE != 2 && tkn > tq0 + 31) || (MODE == 1 && done_w)); if (an) qk(NSUB - 1, Sn); }
#pragma unroll
        for (int sub = NSUB - 1; sub >= 0; --sub) {
            const int tk0 = KT * kt + 32 * sub;
            f32x16 S = Sn; const bool a = an;
            if (sub > 0) { const int tkn = tk0 - 32; an = !((MODE != 2 && tkn > tq0 + 31) || (MODE == 1 && done_w)); if (an) qk(sub - 1, Sn); }
            if (!a) continue;
            s16x4 vlo[DD][2], vhi[DD][2];
#pragma unroll
            for (int dd = 0; dd < DD; ++dd)
#pragma unroll
                for (int s2 = 0; s2 < 2; ++s2) {
                    LAS unsigned char* vp = Vr + (32 * sub + 16 * s2 + 4 * hh + trq) * KROW + (32 * dd + trb) * 2 + 8 * trp;
                    vlo[dd][s2] = __builtin_amdgcn_ds_read_tr16_b64_v4i16((LAS s16x4*)vp); vhi[dd][s2] = __builtin_amdgcn_ds_read_tr16_b64_v4i16((LAS s16x4*)(vp + 8 * KROW));
                }
            __builtin_amdgcn_sched_barrier(0);
            const int dbase = tq - tk0 - 4 * hh;
            const int D = tq0 - tk0;
            if (MODE == 0 || MODE == 2) {
                const float C = (MODE == 0 ? 0.125f : 0.08838834764831845f) * 1.4426950408889634f;
                float alpha, ls = 0.f, mn;
                if (MODE == 0 && D >= 544) {
                    float s1 = S[0] * w8[0], s2 = S[8] * w8[0];
#pragma unroll
                    for (int i = 1; i < 8; ++i) { s1 = fmaf(S[i], w8[i], s1); s2 = fmaf(S[8 + i], w8[i], s2); }
                    const float v1 = fmaf(s1, C, fbias), v2 = fmaf(s2, C, fbias);
                    float mx = fmaxf(v1, v2); mx = fmaxf(mx, __shfl_xor(mx, 32));
                    mn = fmaxf(m, mx);
                    alpha = __builtin_amdgcn_exp2f(m - mn);
                    const float p1 = __builtin_amdgcn_exp2f(v1 - mn), p2 = __builtin_amdgcn_exp2f(v2 - mn);
                    ls = p1 + p2;
#pragma unroll
                    for (int i = 0; i < 8; ++i) { S[i] = w8[i] * p1; S[8 + i] = w8[i] * p2; }
                } else if (MODE == 0 && D >= 160 && D <= 480) {
                    float vg[4]; float mx = -INFINITY;
#pragma unroll
                    for (int g = 0; g < 4; ++g) { vg[g] = (fmaf(S[4 * g + 3], u4[3], fmaf(S[4 * g + 2], u4[2], fmaf(S[4 * g + 1], u4[1], S[4 * g] * u4[0])))) * C; mx = fmaxf(mx, vg[g]); }
                    mx = fmaxf(mx, __shfl_xor(mx, 32));
                    mn = fmaxf(m, mx);
                    alpha = __builtin_amdgcn_exp2f(m - mn);
#pragma unroll
                    for (int g = 0; g < 4; ++g) { const float pg = fgc[g] * __builtin_amdgcn_exp2f(vg[g] - mn); ls += pg;
#pragma unroll
                        for (int j = 0; j < 4; ++j) S[4 * g + j] = u4[j] * pg; }
                } else if (MODE == 0 && D >= 32 && D <= 96) {
                    float mx = -INFINITY;
#pragma unroll
                    for (int i = 0; i < 16; ++i) { S[i] = S[i] * C; mx = fmaxf(mx, S[i]); }
                    mx = fmaxf(mx, __shfl_xor(mx, 32));
                    mn = fmaxf(m, mx);
                    alpha = __builtin_amdgcn_exp2f(m - mn);
#pragma unroll
                    for (int i = 0; i < 16; ++i) { const float p = fmn[i] * __builtin_amdgcn_exp2f(S[i] - mn); S[i] = p; ls += p; }
                } else {
                    float fm[16]; float mx = -INFINITY;
#pragma unroll
                    for (int i = 0; i < 16; ++i) {
                        float v = S[i] * C;
                        if (MODE == 0) { const int d = dbase - ((i & 3) + 8 * (i >> 2));
                            int mult = (d <= 128 ? 1 : 0) + ((((d & 3) == 0) && d <= 512) ? 1 : 0) + (((d & 15) == 0) ? 1 : 0);
                            mult = d >= 0 ? mult : 0; fm[i] = (float)mult; v = mult > 0 ? v : -INFINITY; }
                        else fm[i] = 1.f;
                        S[i] = v; mx = fmaxf(mx, v);
                    }
                    mx = fmaxf(mx, __shfl_xor(mx, 32));
                    mn = fmaxf(m, mx); const float ms = (mn == -INFINITY) ? 0.f : mn;
                    alpha = __builtin_amdgcn_exp2f(m - ms);
#pragma unroll
                    for (int i = 0; i < 16; ++i) { const float p = fm[i] * __builtin_amdgcn_exp2f(S[i] - ms); S[i] = p; ls += p; }
                }
                l = l * alpha + ls; m = mn;
                if (!__all(alpha == 1.f)) {
#pragma unroll
                    for (int dd = 0; dd < DD; ++dd) Oacc[dd] = Oacc[dd] * alpha;
                }
            } else {
                float om[16], ex[16], G[4], PG[4];
                if (D < 32) {
#pragma unroll
                    for (int i = 0; i < 16; ++i) { const int d = dbase - ((i & 3) + 8 * (i >> 2)); const bool valid = d > 0;
                        const float x = fminf(fmaxf(S[i] * (0.125f * 1.4426950408889634f), -115.f), 115.f); const float e = __builtin_amdgcn_exp2f(x); const float o1 = __builtin_amdgcn_rcpf(1.f + e);
                        om[i] = valid ? o1 : 1.f; S[i] = valid ? e * o1 : 0.f; }
                } else {
#pragma unroll
                    for (int i = 0; i < 16; ++i) {
                        const float x = fminf(fmaxf(S[i] * (0.125f * 1.4426950408889634f), -115.f), 115.f); const float e = __builtin_amdgcn_exp2f(x); const float o1 = __builtin_amdgcn_rcpf(1.f + e);
                        om[i] = o1; S[i] = e * o1; }
                }
#pragma unroll
                for (int g = 0; g < 4; ++g) { ex[4 * g + 3] = 1.f; ex[4 * g + 2] = om[4 * g + 3]; ex[4 * g + 1] = ex[4 * g + 2] * om[4 * g + 2]; ex[4 * g] = ex[4 * g + 1] * om[4 * g + 1]; G[g] = ex[4 * g] * om[4 * g]; }
#pragma unroll
                for (int g = 0; g < 4; ++g) PG[g] = __shfl_xor(G[g], 32);
                float suf = run;
#pragma unroll
                for (int g = 3; g >= 0; --g) { const float lat = suf * (hh == 0 ? PG[g] : 1.f);
                    S[4 * g + 3] = S[4 * g + 3] * lat; S[4 * g + 2] = S[4 * g + 2] * (lat * ex[4 * g + 2]); S[4 * g + 1] = S[4 * g + 1] * (lat * ex[4 * g + 1]); S[4 * g] = S[4 * g] * (lat * ex[4 * g]);
                    suf *= G[g] * PG[g]; }
                run = suf;
                done_w = __all(run < 1e-30f) ? 1u : 0u;
            }
            u32x4 pp0, pp1;
#pragma unroll
            for (int j = 0; j < 4; ++j) { pp0[j] = pk_bf16(S[2 * j], S[2 * j + 1]); pp1[j] = pk_bf16(S[8 + 2 * j], S[8 + 2 * j + 1]); }
            const bf16x8 P0 = __builtin_bit_cast(bf16x8, pp0), P1 = __builtin_bit_cast(bf16x8, pp1);
#pragma unroll
            for (int dd = 0; dd < DD; ++dd)
#pragma unroll
                for (int s2 = 0; s2 < 2; ++s2) {
                    const bf16x8 vf = __builtin_shufflevector(vlo[dd][s2], vhi[dd][s2], 0, 1, 2, 3, 4, 5, 6, 7);
                    Oacc[dd] = MFMA32(vf, s2 ? P1 : P0, Oacc[dd]);
                }
        }
    };
    ATT_GLOAD(kA, vA, kt_hi);
    if constexpr (MODE == 2) {
#pragma unroll 1
        for (int kt = kt_hi; kt >= 0; --kt) {
            stage(kA, vA);
            if (kt >= 1) ATT_GLOAD(kA, vA, kt - 1);
            compute(kt);
        }
    } else {
        if (kt_hi >= 1) ATT_GLOAD(kB, vB, kt_hi - 1);
#pragma unroll 1
        for (int kt = kt_hi; kt >= 0; kt -= 2) {
            if (stage(kA, vA)) break;
            if (kt >= 2) ATT_GLOAD(kA, vA, kt - 2);
            compute(kt);
            if (kt == 0) break;
            if (stage(kB, vB)) break;
            if (kt >= 3) ATT_GLOAD(kB, vB, kt - 3);
            compute(kt - 1);
        }
    }
#undef ATT_GLOAD
    float inv = 1.f;
    if (MODE != 1) { const float lt = l + __shfl_xor(l, 32); inv = 1.f / lt; }
#pragma unroll
    for (int dd = 0; dd < DD; ++dd)
#pragma unroll
        for (int g = 0; g < 4; g += 2) {
            unsigned a0 = pk_bf16(Oacc[dd][4 * g] * inv, Oacc[dd][4 * g + 1] * inv), a1 = pk_bf16(Oacc[dd][4 * g + 2] * inv, Oacc[dd][4 * g + 3] * inv);
            unsigned b0 = pk_bf16(Oacc[dd][4 * g + 4] * inv, Oacc[dd][4 * g + 5] * inv), b1 = pk_bf16(Oacc[dd][4 * g + 6] * inv, Oacc[dd][4 * g + 7] * inv);
            { auto x = __builtin_amdgcn_permlane32_swap(a0, b0, false, false); a0 = x[0]; b0 = x[1]; }
            { auto x = __builtin_amdgcn_permlane32_swap(a1, b1, false, false); a1 = x[0]; b1 = x[1]; }
            u32x4 o; o[0] = a0; o[1] = a1; o[2] = b0; o[3] = b1;
            *(u32x4*)(Op + (size_t)tq * ldo + 32 * dd + 8 * g + 8 * hh) = o;
        }
}
__device__ __forceinline__ void p_attn_ab(LAS unsigned char* lds, const bf16_t* qkv, bf16_t* OA, bf16_t* OB) {
    constexpr size_t TS = (size_t)T * 512;
    for (int v = blockIdx.x; v < 256; v += gridDim.x) {
        const int bh = v >> 1, b = bh >> 3, h = bh & 7, par = v & 1;
        const bf16_t* base = qkv + (size_t)bh * SEQ * 64;
        for (int rep = 0; rep < 1 + ATT_DUP_A; ++rep)
        for (int k = 0; k < 4; ++k) { const int qb = (k == 0) ? 7 - par : (k == 1) ? par : (k == 2) ? 5 - par : 2 + par;
            attn_item<0, 64, 128>(lds, base, 64, base + TS, base + 2 * TS, 64, OA + (size_t)b * SEQ * 1024 + h * HD, 1024, qb * 256, SEQ); }
        for (int rep = 0; rep < 1 + ATT_DUP_B; ++rep)
        for (int k = 0; k < 4; ++k) { const int qb = (k == 0) ? 7 - par : (k == 1) ? par : (k == 2) ? 5 - par : 2 + par;
            attn_item<1, 64, 128>(lds, base + 3 * TS, 64, base + 4 * TS, base + 5 * TS, 64, OB + (size_t)b * SEQ * 1024 + h * HD, 1024, qb * 256, SEQ); }
    }
}
__device__ __forceinline__ void p_attn_mem(LAS unsigned char* lds, const bf16_t* qm, const bf16_t* kvm, bf16_t* om) {
#pragma unroll 1
    for (int i = 0;; ++i) {
        Unit u; { pg8::StaticOrder S2; S2.init(T, MEMW, (int)gridDim.x, (int)blockIdx.x); if (!S2.next(i, u)) break; }
        const int b = u.pm >> 3, qb = u.pm & 7;
#pragma unroll 1
        for (int hq = 0; hq < 2; ++hq) { const int h = 2 * u.pn + hq;
            attn_item<2, 128, 64>(lds, qm + (size_t)b * SEQ * MEMW + h * 128, MEMW, kvm + (size_t)b * NMEM * 1024 + h * 128, kvm + (size_t)b * NMEM * 1024 + 512 + h * 128, 1024,
                                  om + (size_t)b * SEQ * MEMW + h * 128, MEMW, qb * 256, NMEM); }
    }
}

__device__ __forceinline__ bool sync_if(int k, cg::grid_group& grid, XcdBarrier& xb) {
    if (k == 1) { grid.sync(); xb = xcd_barrier_post(xb.bar, xb.st); }
    else if (k == 8) {
        asm volatile("s_waitcnt vmcnt(0)" ::: "memory");
        __syncthreads();
        if (threadIdx.x == 0) { __builtin_amdgcn_fence(__ATOMIC_ACQUIRE, "agent"); asm volatile("s_waitcnt vmcnt(0)" ::: "memory"); }
        __syncthreads();
    }
    else if (k > 1) xcd_barrier(xb);
    asm volatile("" ::: "memory"); return true; }
constexpr int NPHASE = 13;
#ifndef NAIVE_AB
#define NAIVE_AB 0
#endif
#ifndef NAIVE_MEM
#define NAIVE_MEM 0
#endif
#ifndef ONLY
#define ONLY -1
#endif
#ifndef DUP_MASK
#define DUP_MASK 0
#endif
#define PHASE(k) if ((ONLY < 0 || ONLY == (k)) && ph_lo <= (k) && (k) < ph_hi) if (sync_if((k), grid, xb)) for (int rep_ = 0; rep_ < (((DUP_MASK >> (k)) & 1) ? 2 : 1); ++rep_)
__global__ __launch_bounds__(512, 2) void mega(Params p, int ph_lo, int ph_hi) {
    extern __shared__ __attribute__((aligned(16))) unsigned char shm[];
    LAS unsigned char* lds = (LAS unsigned char*)shm;
    cg::grid_group grid = cg::this_grid();
    Ctx c; c.tid = threadIdx.x; c.lane = c.tid & 63; c.wave = c.tid >> 6; c.gw = blockIdx.x * 8 + c.wave; c.ngw = gridDim.x * 8; c.gt = blockIdx.x * 512 + c.tid; c.ngt = gridDim.x * 512;
    unsigned char* ws = p.ws;
    bf16_t* Wt_in = (bf16_t*)(ws + WS_WIN); bf16_t* Wt_upa = (bf16_t*)(ws + WS_WUPA); bf16_t* Wt_upb = (bf16_t*)(ws + WS_WUPB); bf16_t* Wt_out = (bf16_t*)(ws + WS_WOUT);
    bf16_t* Wt_qm = (bf16_t*)(ws + WS_WQM); bf16_t* Wt_kvm = (bf16_t*)(ws + WS_WKVM); bf16_t* Wt_om = (bf16_t*)(ws + WS_WOM); bf16_t* Wt_gu = (bf16_t*)(ws + WS_WGU); bf16_t* Wt_dn = (bf16_t*)(ws + WS_WDN);
    bf16_t* memn = (bf16_t*)(ws + WS_MEMN); bf16_t* kvm = (bf16_t*)(ws + WS_KVM);
    float* ss1 = (float*)(ws + WS_SS1); float* ss2 = (float*)(ws + WS_SS2); float* ss3 = (float*)(ws + WS_SS3); float* rope = (float*)(ws + WS_ROPE);
    bf16_t* n1 = (bf16_t*)(ws + WS_R1); bf16_t* mixed = (bf16_t*)(ws + WS_R1); bf16_t* h2b = (bf16_t*)(ws + WS_R1);
    bf16_t* proj = (bf16_t*)(ws + WS_PROJ); bf16_t* gates = (bf16_t*)(ws + WS_PROJ + 192 * MiB);
    float* h1 = (float*)(ws + WS_H1); bf16_t* h1b = (bf16_t*)(ws + WS_H1B); bf16_t* qm = (bf16_t*)(ws + WS_QM); bf16_t* om = (bf16_t*)(ws + WS_OM);
    float* h2 = (float*)(ws + WS_H2); bf16_t* act = (bf16_t*)(ws + WS_ACT); bf16_t* OA = (bf16_t*)(ws + WS_OA); bf16_t* OB = (bf16_t*)(ws + WS_OA) + 512;
    float* m1 = p.out; unsigned* bar = (unsigned*)(ws + WS_BAR);
    volatile LAS unsigned* xst = (volatile LAS unsigned*)(lds + pg8::STAGE_BYTES);
    if (c.tid == 0) { xst[0] = 0u; xst[1] = 0u; }
    __syncthreads();
    XcdBarrier xb; xb.bar = bar; xb.x = 0u; xb.st = xst;
    pg8::StaticOrder S;
    {
        PHASE(0) {
            int cur = 0;
            p_transpose(c, lds, p.w_in, Wt_in, DM, INC, nullptr, 0, cur);
            p_transpose(c, lds, p.w_ffn_gate, Wt_gu, DM, DFF, p.g_ffn, 1, cur);
            p_transpose(c, lds, p.w_ffn_up, Wt_gu, DM, DFF, p.g_ffn, 2, cur);
            p_transpose(c, lds, p.w_ffn_down, Wt_dn, DFF, DM, nullptr, 0, cur);
            p_transpose(c, lds, p.w_up_a, Wt_upa, 512, DM, nullptr, 0, cur, 1024, 0);
            p_transpose(c, lds, p.w_up_b, Wt_upa, 512, DM, nullptr, 0, cur, 1024, 512);
            p_transpose(c, lds, p.w_out, Wt_out, DM, DM, nullptr, 0, cur);
            p_transpose(c, lds, p.w_q_mem, Wt_qm, DM, MEMW, p.g_mem_q, 0, cur);
            p_transpose(c, lds, p.w_kv_mem, Wt_kvm, DM, 2 * MEMW, nullptr, 0, cur);
            p_transpose(c, lds, p.w_o_mem, Wt_om, MEMW, DM, nullptr, 0, cur);
            p_rmsnorm_rows(c, p.x, p.g_mix, n1, T);
            p_rmsnorm_rows(c, p.mem, p.g_mem_kv, memn, BATCH * NMEM);
            p_rope_table(c, p.pos, rope);
            if (blockIdx.x == 0) for (int i = c.tid; i < XCD_BAR_WORDS; i += 512) bar[i] = 0u;
        }
        PHASE(1) {
            { Gemm g{n1, Wt_in, T, INC, DM}; EpiBf16 E{proj, INC, nullptr, 1 << 30, rope, 4, 12, gates};   S.init(g.M, g.N, gridDim.x, blockIdx.x); pg8::gemm_phase(lds, g, S, E); }
            { Gemm g{memn, Wt_kvm, BATCH * NMEM, 1024, DM}; EpiBf16 E{kvm, 1024, nullptr, 1 << 30, nullptr, 0, 0, nullptr}; S.init(g.M, g.N, gridDim.x, blockIdx.x); pg8::gemm_phase(lds, g, S, E); }
        }
        PHASE(3) {
            p_attn_ab(lds, proj, OA, OB);
        }
        PHASE(5) { Gemm g{OA, Wt_upa, T, DM, DM}; EpiGate E{gates, mixed}; S.init(g.M, g.N, gridDim.x, blockIdx.x); pg8::gemm_phase(lds, g, S, E); }
        PHASE(6) { Gemm g{mixed, Wt_out, T, DM, DM}; EpiRes E{p.x, nullptr, nullptr, h1b, ss1}; S.init(g.M, g.N, gridDim.x, blockIdx.x); pg8::gemm_phase(lds, g, S, E); }
        PHASE(7) { Gemm g{h1b, Wt_qm, T, MEMW, DM}; EpiBf16 E{qm, MEMW, ss1, 1 << 30, nullptr, 0, 0, nullptr}; S.init(g.M, g.N, gridDim.x, blockIdx.x); pg8::gemm_phase(lds, g, S, E); }
        PHASE(8) {
            p_attn_mem(lds, qm, kvm, om);
        }
        PHASE(9) { Gemm g{om, Wt_om, T, DM, MEMW}; EpiRes E{nullptr, h1b, nullptr, h2b, ss2}; S.init(g.M, g.N, gridDim.x, blockIdx.x); pg8::gemm_phase(lds, g, S, E); }
        PHASE(10) { Gemm g{h2b, Wt_gu, T, 2 * DFF, DM}; EpiSwiGLU E{act, ss2}; S.init(g.M, g.N, gridDim.x, blockIdx.x); pg8::gemm_phase(lds, g, S, E); }
        PHASE(11) { Gemm g{act, Wt_dn, T, DM, DFF}; EpiRes E{nullptr, h2b, p.out, nullptr, ss3}; S.init(g.M, g.N, gridDim.x, blockIdx.x); pg8::gemm_phase(lds, g, S, E); }
        PHASE(12) p_final(c, p.out, ss3, p.g_final);
    }
}

constexpr int LDS_BYTES = pg8::STAGE_BYTES + 16;
#ifndef ONE_LAUNCH
#define ONE_LAUNCH 1
#endif
extern "C" void kernel_launch(void* const* d_in, const int* in_sizes, int n_in, void* d_out, int out_size, void* d_ws, size_t ws_size, hipStream_t stream) {
    static int grid = 0;
    if (grid == 0) {
        if (n_in != 18 || out_size != T * DM || ws_size < WS_END) { fprintf(stderr, "kernel_launch: unexpected shapes (n_in %d out %d ws %zu)\n", n_in, out_size, ws_size); grid = -1; return; }
        int dev = 0, cus = 0, per_cu = 0;
        (void)hipGetDevice(&dev); (void)hipDeviceGetAttribute(&cus, hipDeviceAttributeMultiprocessorCount, dev);
        if (hipFuncSetAttribute((const void*)mega, hipFuncAttributeMaxDynamicSharedMemorySize, LDS_BYTES) != hipSuccess) { fprintf(stderr, "hipFuncSetAttribute failed\n"); grid = -1; return; }
        if (hipOccupancyMaxActiveBlocksPerMultiprocessor(&per_cu, (const void*)mega, 512, LDS_BYTES) != hipSuccess || per_cu < 1) { fprintf(stderr, "occupancy query: %d\n", per_cu); per_cu = 1; }
        (void)hipGetLastError();
        grid = cus * 1;
    }
    if (grid < 0) return;
    Params p{};
    p.x = (const float*)d_in[0]; p.mem = (const float*)d_in[1]; p.pos = (const int*)d_in[2]; p.g_mix = (const float*)d_in[3]; p.w_in = (const float*)d_in[4];
    p.w_up_a = (const float*)d_in[5]; p.w_up_b = (const float*)d_in[6]; p.w_out = (const float*)d_in[7]; p.g_mem_q = (const float*)d_in[8]; p.g_mem_kv = (const float*)d_in[9];
    p.w_q_mem = (const float*)d_in[10]; p.w_kv_mem = (const float*)d_in[11]; p.w_o_mem = (const float*)d_in[12]; p.g_ffn = (const float*)d_in[13];
    p.w_ffn_gate = (const float*)d_in[14]; p.w_ffn_up = (const float*)d_in[15]; p.w_ffn_down = (const float*)d_in[16]; p.g_final = (const float*)d_in[17];
    p.out = (float*)d_out; p.ws = (unsigned char*)d_ws;
#if ONE_LAUNCH
    int lo = 0, hi = NPHASE;
    void* args[] = {&p, &lo, &hi};
    hipError_t e = hipLaunchCooperativeKernel((const void*)mega, dim3(grid), dim3(512), args, LDS_BYTES, stream);
    if (e != hipSuccess) fprintf(stderr, "cooperative launch failed: %s\n", hipGetErrorString(e));
#else
    for (int ph = 0; ph < NPHASE; ++ph) hipLaunchKernelGGL(mega, dim3(grid), dim3(512), LDS_BYTES, stream, p, ph, ph + 1);
#endif
}
```

```cpp
#include <hip/hip_runtime.h>
#include <hip/hip_cooperative_groups.h>
#include <cstdio>
namespace cg = cooperative_groups;

#define LAS __attribute__((address_space(3)))
typedef unsigned short bf16_t;
typedef short bf16x8 __attribute__((ext_vector_type(8)));
typedef float f32x4 __attribute__((ext_vector_type(4)));
typedef unsigned u32x4 __attribute__((ext_vector_type(4)));
typedef unsigned u32x2 __attribute__((ext_vector_type(2)));

constexpr int BATCH = 16, SEQ = 2048, DM = 1024, T = BATCH * SEQ;
constexpr int HD = 64, NHA = 8, NHB = 8;
constexpr int INC = 5120;
constexpr int C_QA = 0, C_KA = 512, C_VA = 1024, C_QB = 1536, C_KB = 2048, C_VB = 2560, C_GA = 3072, C_GB = 4096;
constexpr int NMEM = 256, MEMW = 512, DFF = 2816;
constexpr float EPS = 1e-6f;

constexpr size_t MiB = 1ull << 20;
constexpr size_t WS_WIN = 0, WS_WUPA = 10 * MiB, WS_WUPB = 11 * MiB, WS_WOUT = 12 * MiB, WS_WQM = 14 * MiB, WS_WKVM = 15 * MiB,
                 WS_WOM = 17 * MiB, WS_WGU = 18 * MiB, WS_WDN = 29 * MiB, WS_MEMN = 36 * MiB, WS_KVM = 44 * MiB,
                 WS_SS1 = 52 * MiB, WS_SS2 = 54 * MiB, WS_SS3 = 56 * MiB, WS_ROPE = 58 * MiB, WS_BAR = 60 * MiB;
constexpr size_t WS_R1 = 64 * MiB;
constexpr size_t WS_PROJ = 128 * MiB;
constexpr size_t WS_H1 = 128 * MiB, WS_H1B = 256 * MiB, WS_QM = 320 * MiB, WS_OM = 352 * MiB, WS_H2 = 384 * MiB, WS_ACT = 128 * MiB;
constexpr size_t WS_OA = 448 * MiB, WS_OB = 480 * MiB;
constexpr size_t WS_END = 512 * MiB;

struct Params {
    const float* x; const float* mem; const int* pos; const float* g_mix; const float* w_in; const float* w_up_a; const float* w_up_b; const float* w_out;
    const float* g_mem_q; const float* g_mem_kv; const float* w_q_mem; const float* w_kv_mem; const float* w_o_mem; const float* g_ffn;
    const float* w_ffn_gate; const float* w_ffn_up; const float* w_ffn_down; const float* g_final;
    float* out; unsigned char* ws;
};

typedef float f32x2 __attribute__((ext_vector_type(2)));
typedef __bf16 bf16v2 __attribute__((ext_vector_type(2)));
__device__ __forceinline__ unsigned pk_bf16(float lo, float hi) { f32x2 v = {lo, hi}; bf16v2 r = __builtin_convertvector(v, bf16v2); return __builtin_bit_cast(unsigned, r); }
__device__ __forceinline__ bf16_t f2bf(float f) { return (bf16_t)(pk_bf16(f, 0.f) & 0xffffu); }
__device__ __forceinline__ float bf2f(bf16_t b) { return __uint_as_float(((unsigned)b) << 16); }
__device__ __forceinline__ float bflo(unsigned u) { return __uint_as_float(u << 16); }
__device__ __forceinline__ float bfhi(unsigned u) { return __uint_as_float(u & 0xffff0000u); }
__device__ __forceinline__ float wave_sum(float v) {
#pragma unroll
    for (int o = 1; o < 64; o <<= 1) v += __shfl_xor(v, o);
    return v;
}
__device__ __forceinline__ float sigmoidf_(float x) { return 1.f / (1.f + __expf(-x)); }
__device__ __forceinline__ float rstd_of(const float* ss, int row) {
    const f32x4* p = (const f32x4*)(ss + (size_t)row * 16);
    f32x4 a = p[0], b = p[1], c = p[2], d = p[3];
    float s = ((a[0] + a[1]) + (a[2] + a[3])) + ((b[0] + b[1]) + (b[2] + b[3])) + ((c[0] + c[1]) + (c[2] + c[3])) + ((d[0] + d[1]) + (d[2] + d[3]));
    return rsqrtf(s * (1.f / DM) + EPS);
}


#define XB_TMO      128
#define XB_XCNT(j)  (256  + 64 * (j))
#define XB_XSUB(j)  (1280 + 64 * (j))
#define XB_XGEN(j)  (2304 + 64 * (j))
#define XB_TOP      3328
#define XB_TOPGEN   3392
#define XCD_BAR_WORDS 3456
#define XB_SPIN_CAP (1u << 18)
__device__ __forceinline__ unsigned xb_ld(unsigned* p)              { return __hip_atomic_load(p, __ATOMIC_RELAXED, __HIP_MEMORY_SCOPE_AGENT); }
__device__ __forceinline__ unsigned xb_add(unsigned* p, unsigned v) { return __hip_atomic_fetch_add(p, v, __ATOMIC_RELAXED, __HIP_MEMORY_SCOPE_AGENT); }
__device__ __forceinline__ unsigned xb_xcc_id() { return (unsigned)__builtin_amdgcn_s_getreg((3 << 11) | 20) & 0xFu; }
#define XB_SPIN(cond, bar) do { unsigned _sp = 0; while (cond) { __builtin_amdgcn_s_sleep(1); \
    if ((++_sp & 255u) == 0u) { if (xb_ld(&(bar)[XB_TMO])) break; if (_sp > XB_SPIN_CAP) { atomicAdd(&(bar)[XB_TMO], 1u); break; } } } } while (0)
struct XcdBarrier { unsigned* bar; unsigned x; volatile LAS unsigned* st; };
__device__ __forceinline__ XcdBarrier xcd_barrier_post(unsigned* bar, volatile LAS unsigned* st) {
    XcdBarrier b; b.bar = bar; b.x = xb_xcc_id(); b.st = st;
    if (threadIdx.x == 0) (void)xb_add(&bar[XB_XCNT(b.x)], 1u);
    return b;
}
__device__ __forceinline__ void xcd_barrier_complete(unsigned* bar, unsigned x, unsigned& nloc, unsigned& nx) {
    const unsigned G = gridDim.x * gridDim.y * gridDim.z;
    unsigned sum, cnt, mine, sp = 0u;
    for (;;) {
        sum = 0u; cnt = 0u; mine = 0u;
#pragma unroll
        for (unsigned j = 0; j < 16; ++j) { const unsigned c = xb_ld(&bar[XB_XCNT(j)]); sum += c; cnt += (c > 0u) ? 1u : 0u; mine = (j == x) ? c : mine; }
        if (sum == G) break;
        __builtin_amdgcn_s_sleep(1);
        if ((++sp & 255u) == 0u) { if (xb_ld(&bar[XB_TMO])) break; if (sp > XB_SPIN_CAP) { atomicAdd(&bar[XB_TMO], 1u); break; } }
    }
    nloc = mine > 0u ? mine : 1u; nx = cnt > 0u ? cnt : 1u;
}
__device__ __forceinline__ void xcd_barrier(const XcdBarrier& b) {
    asm volatile("s_waitcnt vmcnt(0)" ::: "memory");
    __syncthreads();
    if (threadIdx.x == 0) {
        unsigned* bar = b.bar;
        __builtin_amdgcn_s_waitcnt(0);
        unsigned nloc = b.st[0], nx = b.st[1];
        if (nloc == 0u) { xcd_barrier_complete(bar, b.x, nloc, nx); b.st[0] = nloc; b.st[1] = nx; }
        const unsigned old = xb_add(&bar[XB_XSUB(b.x)], 1u);
        const unsigned gen = old / nloc;
        if (old + 1u == (gen + 1u) * nloc) {
            __builtin_amdgcn_fence(__ATOMIC_RELEASE, "agent");
            asm volatile("s_waitcnt vmcnt(0)" ::: "memory");
            const unsigned og = xb_add(&bar[XB_TOP], 1u);
            const unsigned tg = og / nx;
            if (og + 1u == (tg + 1u) * nx) xb_add(&bar[XB_TOPGEN], 1u);
            else XB_SPIN(xb_ld(&bar[XB_TOPGEN]) == tg, bar);
            __builtin_amdgcn_fence(__ATOMIC_ACQUIRE, "agent");
            xb_add(&bar[XB_XGEN(b.x)], 1u);
            asm volatile("s_waitcnt vmcnt(0)" ::: "memory");
        } else {
            XB_SPIN(xb_ld(&bar[XB_XGEN(b.x)]) == gen, bar);
            __builtin_amdgcn_fence(__ATOMIC_ACQUIRE, "agent");
            asm volatile("s_waitcnt vmcnt(0)" ::: "memory");
        }
    }
    __syncthreads();
}

namespace pg8 {
constexpr int BM = 256, BK = 64, HALF = 128, HTB = HALF * BK * 2, STAGE_BYTES = 8 * HTB, NXCD = 8, WGM = 8;
__host__ __device__ __forceinline__ int lds_byte(int r, int c) { const int st = (r >> 4) * 2 + (c >> 5), rr = r & 15, cc = c & 31, ob = rr * 64 + cc * 2; return st * 1024 + (ob ^ (((ob >> 9) & 1) << 5)); }
__host__ __device__ __forceinline__ void stage_rc(int b, int& R, int& C) { const int st = b / 1024, sb = b % 1024, swz = sb ^ (((sb >> 9) & 1) << 5); R = (st >> 1) * 16 + swz / 64; C = (st & 1) * 32 + (swz % 64) / 2; }
__host__ __device__ __forceinline__ int perm32(int rho) { const int n = rho >> 4, i = rho & 15; return 8 * (i >> 2) + 4 * n + (i & 3); }
struct Unit { int pm, pn; };
struct Gemm { const bf16_t* A; const bf16_t* Bt; int M, N, K; };
struct StaticOrder {
    int nM, nN, nwg, G, c;
    __host__ __device__ void init(int M, int N, int G_, int c_) { nM = M / BM; nN = N / BM; nwg = nM * nN; G = G_; c = c_; }
    __host__ __device__ bool next(int i, Unit& u) const {
        const long L = (long)i * G + c; if (L >= nwg) return false;
        int wgid = (int)L; { const int q = nwg / NXCD, r = nwg % NXCD, xcd = wgid % NXCD, off = wgid / NXCD; wgid = (xcd < r ? xcd * (q + 1) : r * (q + 1) + (xcd - r) * q) + off; }
        const int nig = WGM * nN, gid = wgid / nig, fm = gid * WGM, gsz = (nM - fm) < WGM ? (nM - fm) : WGM;
        u.pm = fm + ((wgid % nig) % gsz); u.pn = (wgid % nig) / gsz; return true;
    }
};

template <class Epi>
__device__ __forceinline__ void gemm_phase(LAS unsigned char* lds, const Gemm g, const StaticOrder& S, const Epi& E) {
    int tid = threadIdx.x; asm volatile("" : "+v"(tid));
    const int wid = __builtin_amdgcn_readfirstlane(tid >> 6), lane = tid & 63, wr = wid >> 2, wc = wid & 3, fr = lane & 15, fq = lane >> 4;
    const int K = g.K, nt = K / BK;
    unsigned voffA[2], voffB[2];
#pragma unroll
    for (int i = 0; i < 2; ++i) { int R, C; stage_rc(tid * 16 + i * 8192, R, C); const int Rb = Epi::LINE ? ((R >> 5) * 64 + perm32(R & 31)) : (Epi::PERM ? ((R & ~31) + perm32(R & 31)) : R);
        voffA[i] = (unsigned)(R * K + C) * 2u; voffB[i] = (unsigned)(Rb * K + C) * 2u; }
    const size_t kstep = (size_t)(BK * 2);
    const size_t hstep = (size_t)HALF * K * 2;
    const size_t tstep = 2 * hstep;
    const size_t hstepB = Epi::LINE ? (size_t)32 * K * 2 : hstep;
    const unsigned ldsw = (unsigned)wid * 1024u;
    const int aoff = lds_byte(wr * 64 + fr, fq * 8), boff = lds_byte(wc * 32 + fr, fq * 8);
#define PG8_SA(b, h) (((b) * 2 + (h)) * HTB)
#define PG8_SB(b, h) ((4 + (b) * 2 + (h)) * HTB)
#define PG8_STAGE(bufoff, gbase, voff) do { _Pragma("unroll") for (int _i = 0; _i < 2; ++_i) \
        __builtin_amdgcn_global_load_lds((const unsigned*)((const char*)(gbase) + (voff)[_i]), (LAS unsigned*)(lds + (bufoff) + ldsw + _i * 8192), 16, 0, 0); } while (0)
#define PG8_LDA(dst, b, h) do { _Pragma("unroll") for (int m = 0; m < 4; ++m) _Pragma("unroll") for (int k = 0; k < 2; ++k) dst[m][k] = *(const LAS bf16x8*)(lds + PG8_SA(b, h) + aoff + m * 2048 + k * 1024); } while (0)
#define PG8_LDB(dst, b, h) do { _Pragma("unroll") for (int n = 0; n < 2; ++n) _Pragma("unroll") for (int k = 0; k < 2; ++k) dst[n][k] = *(const LAS bf16x8*)(lds + PG8_SB(b, h) + boff + n * 2048 + k * 1024); } while (0)
#define PG8_MMA(ai, bj, At, Bt) do { __builtin_amdgcn_s_setprio(1); _Pragma("unroll") for (int m = 0; m < 4; ++m) _Pragma("unroll") for (int n = 0; n < 2; ++n) _Pragma("unroll") for (int k = 0; k < 2; ++k) \
        acc[ai][bj][m][n] = __builtin_amdgcn_mfma_f32_16x16x32_bf16(Bt[n][k], At[m][k], acc[ai][bj][m][n], 0, 0, 0); __builtin_amdgcn_s_setprio(0); } while (0)
#define PG8_WAIT_V(n) asm volatile("s_waitcnt vmcnt(" #n ")" ::: "memory")
#define PG8_WAIT_L(n) asm volatile("s_waitcnt lgkmcnt(" #n ")" ::: "memory")
#define PG8_BAR __builtin_amdgcn_s_barrier()
#define PG8_SCHED __builtin_amdgcn_sched_barrier(0)
    Unit cur, nxt; int ui = 0;
    if (!S.next(0, cur)) return;
    f32x4 acc[2][2][4][2];
#pragma unroll
    for (int a = 0; a < 2; ++a)
#pragma unroll
        for (int b = 0; b < 2; ++b)
#pragma unroll
            for (int m = 0; m < 4; ++m)
#pragma unroll
                for (int n = 0; n < 2; ++n) acc[a][b][m][n] = (f32x4){0.f, 0.f, 0.f, 0.f};
    bf16x8 At[4][2], B0[2][2], B1[2][2];
    const char* cA = (const char*)g.A + (size_t)cur.pm * tstep; const char* cB = (const char*)g.Bt + (size_t)cur.pn * tstep;
    PG8_STAGE(PG8_SB(0, 0), cB, voffB); PG8_STAGE(PG8_SA(0, 0), cA, voffA); PG8_STAGE(PG8_SB(0, 1), cB + hstepB, voffB); PG8_STAGE(PG8_SA(0, 1), cA + hstep, voffA);
    if (wr == 1) PG8_BAR;
    PG8_WAIT_V(4); PG8_BAR;
    PG8_STAGE(PG8_SB(1, 0), cB + kstep, voffB); PG8_STAGE(PG8_SA(1, 0), cA + kstep, voffA); PG8_STAGE(PG8_SB(1, 1), cB + hstepB + kstep, voffB);
    PG8_WAIT_V(6); PG8_BAR;
    for (;;) {
        const bool has_next = S.next(ui + 1, nxt);
        const char* nA = has_next ? (const char*)g.A + (size_t)nxt.pm * tstep : cA; const char* nB = has_next ? (const char*)g.Bt + (size_t)nxt.pn * tstep : cB;
        for (int t = 0; t < nt; t += 2) {
            const bool last = (t == nt - 2);
            const char* a1 = cA + (size_t)(t + 1) * kstep;
            const char* a2 = last ? nA : cA + (size_t)(t + 2) * kstep; const char* b2 = last ? nB : cB + (size_t)(t + 2) * kstep;
            const char* a3 = a2 + kstep; const char* b3 = b2 + kstep;
            if constexpr (Epi::HAS_MID) { if (t == nt / 2) E.mid(acc, cur, wr, wc, fr, fq); }
            PG8_LDB(B0, 0, 0); PG8_SCHED; PG8_LDA(At, 0, 0); PG8_STAGE(PG8_SA(1, 1), a1 + hstep, voffA);
            PG8_WAIT_L(8); PG8_BAR; PG8_WAIT_L(0); PG8_MMA(0, 0, At, B0); PG8_BAR; PG8_SCHED;
            PG8_LDB(B1, 0, 1); PG8_STAGE(PG8_SB(0, 0), b2, voffB);
            PG8_BAR; PG8_WAIT_L(0); PG8_MMA(0, 1, At, B1); PG8_BAR;
            PG8_LDA(At, 0, 1); PG8_STAGE(PG8_SA(0, 0), a2, voffA);
            PG8_BAR; PG8_WAIT_L(0); PG8_MMA(1, 0, At, B0); PG8_BAR; PG8_SCHED;
            PG8_STAGE(PG8_SB(0, 1), b2 + hstepB, voffB);
            PG8_WAIT_V(6); PG8_BAR; PG8_MMA(1, 1, At, B1); PG8_BAR;
            PG8_LDB(B0, 1, 0); PG8_SCHED; PG8_LDA(At, 1, 0); PG8_STAGE(PG8_SA(0, 1), a2 + hstep, voffA);
            PG8_WAIT_L(8); PG8_BAR; PG8_WAIT_L(0); PG8_MMA(0, 0, At, B0); PG8_BAR; PG8_SCHED;
            PG8_LDB(B1, 1, 1); PG8_STAGE(PG8_SB(1, 0), b3, voffB);
            PG8_BAR; PG8_WAIT_L(0); PG8_MMA(0, 1, At, B1); PG8_BAR;
            PG8_LDA(At, 1, 1); PG8_STAGE(PG8_SA(1, 0), a3, voffA);
            PG8_BAR; PG8_WAIT_L(0); PG8_MMA(1, 0, At, B0); PG8_BAR; PG8_SCHED;
            PG8_STAGE(PG8_SB(1, 1), b3 + hstepB, voffB);
            PG8_WAIT_V(6); PG8_BAR; PG8_MMA(1, 1, At, B1); PG8_BAR;
        }
        E(acc, cur, wr, wc, fr, fq);
        if (!has_next) break;
#pragma unroll
        for (int a = 0; a < 2; ++a)
#pragma unroll
            for (int b = 0; b < 2; ++b)
#pragma unroll
                for (int m = 0; m < 4; ++m)
#pragma unroll
                    for (int n = 0; n < 2; ++n) acc[a][b][m][n] = (f32x4){0.f, 0.f, 0.f, 0.f};
        cur = nxt; cA = nA; cB = nB; ++ui;
    }
    PG8_WAIT_V(0);
    if (wr == 0) PG8_BAR;
    PG8_BAR;
#undef PG8_SA
#undef PG8_SB
#undef PG8_STAGE
#undef PG8_LDA
#undef PG8_LDB
#undef PG8_MMA
#undef PG8_WAIT_V
#undef PG8_WAIT_L
#undef PG8_BAR
#undef PG8_SCHED
}
}
using pg8::Unit; using pg8::Gemm;

__device__ __forceinline__ void line_pair(u32x4& a, u32x4& b, bool lo) {
#pragma unroll
    for (int q = 0; q < 4; ++q) {
        const unsigned send = lo ? b[q] : a[q];
        const unsigned recv = (unsigned)__builtin_amdgcn_update_dpp(0, (int)send, 0x128  , 0xf, 0xf, false);
        if (lo) b[q] = recv; else a[q] = recv;
    }
}
struct EpiBf16 {
    static constexpr bool PERM = true, HAS_MID = false, LINE = true;
    bf16_t* O; int ldc; const float* ss; int sig_from; const float* rope; int rope_below; int qkv_tiles; bf16_t* gates;
    __device__ __forceinline__ bf16_t* addr(int row, int col, int pn) const {
        if (qkv_tiles > 0) {
            if (pn < qkv_tiles) return O + (size_t)(col >> 9) * ((size_t)T * 512) + ((size_t)((row >> 11) * 8 + ((col >> 6) & 7)) * SEQ + (row & (SEQ - 1))) * 64 + (col & 63);
            return gates + (size_t)row * 2048 + (col - 256 * qkv_tiles);
        }
        return O + (size_t)row * ldc + col;
    }
    __device__ __forceinline__ void operator()(const f32x4 (&acc)[2][2][4][2], const Unit& u, int wr, int wc, int fr, int fq) const {
        const int row0 = u.pm * 256 + wr * 64 + fr, col0 = u.pn * 256 + wc * 64 + 8 * fq;
        const bool sig = u.pn >= sig_from, lo = fr < 8;
#pragma unroll
        for (int ai = 0; ai < 2; ++ai)
#pragma unroll
            for (int m = 0; m < 4; ++m) {
                const int row = row0 + ai * 128 + m * 16;
                const float rs = ss ? rstd_of(ss, row) : 1.f;
                u32x4 o[2];
#pragma unroll
                for (int bj = 0; bj < 2; ++bj) {
                    f32x4 v0 = acc[ai][bj][m][0] * rs, v1 = acc[ai][bj][m][1] * rs;
                    if (sig) {
#pragma unroll
                        for (int j = 0; j < 4; ++j) { v0[j] = sigmoidf_(v0[j]); v1[j] = sigmoidf_(v1[j]); }
                    }
                    if (bj == 0 && u.pn < rope_below) {
                        f32x4 p0, p1;
#pragma unroll
                        for (int j = 0; j < 4; ++j) { p0[j] = __shfl_xor(v0[j], 16); p1[j] = __shfl_xor(v1[j], 16); }
                        if (fq < 2) {
                            const f32x4 c0 = *(const f32x4*)(rope + (size_t)row * 16), c1 = *(const f32x4*)(rope + (size_t)row * 16 + 4);
                            f32x4 s0 = *(const f32x4*)(rope + (size_t)row * 16 + 8), s1 = *(const f32x4*)(rope + (size_t)row * 16 + 12);
                            if (fq == 0) { s0 = -s0; s1 = -s1; }
                            v0 = v0 * c0 + p0 * s0; v1 = v1 * c1 + p1 * s1;
                        }
                    }
                    o[bj][0] = pk_bf16(v0[0], v0[1]); o[bj][1] = pk_bf16(v0[2], v0[3]); o[bj][2] = pk_bf16(v1[0], v1[1]); o[bj][3] = pk_bf16(v1[2], v1[3]);
                }
                line_pair(o[0], o[1], lo);
                const int colx = col0 + (lo ? 0 : 32);
                *(u32x4*)addr(lo ? row : row - 8, colx, u.pn) = o[0];
                *(u32x4*)addr(lo ? row + 8 : row, colx, u.pn) = o[1];
            }
    }
};
struct EpiGate {
    static constexpr bool PERM = true, HAS_MID = true, LINE = true;
    const bf16_t* gates; bf16_t* O;
    __device__ __forceinline__ void mid(f32x4 (&acc)[2][2][4][2], const Unit& u, int wr, int wc, int fr, int fq) const {
        int row0 = u.pm * 256 + wr * 64 + fr, col0 = u.pn * 256 + wc * 64 + 8 * fq;
        asm volatile("" : "+v"(row0), "+v"(col0));
#pragma unroll
        for (int ai = 0; ai < 2; ++ai)
#pragma unroll
            for (int m = 0; m < 4; ++m) {
                const int row = row0 + ai * 128 + m * 16;
#pragma unroll
                for (int bj = 0; bj < 2; ++bj) {
                    const int col = col0 + bj * 32;
                    const u32x4 ga = *(const u32x4*)(gates + (size_t)row * 2048 + col), gb = *(const u32x4*)(gates + (size_t)row * 2048 + 1024 + col);
#pragma unroll
                    for (int q = 0; q < 4; ++q) {
                        const float a0 = bflo(ga[q]), a1 = bfhi(ga[q]), b0 = fmaxf(bflo(gb[q]), -60.f), b1 = fmaxf(bfhi(gb[q]), -60.f);
                        const float r0 = (1.f + __expf(-b0)) * __builtin_amdgcn_rcpf(1.f + __expf(-a0)), r1 = (1.f + __expf(-b1)) * __builtin_amdgcn_rcpf(1.f + __expf(-a1));
                        acc[ai][bj][m][q >> 1][(q & 1) * 2] *= r0; acc[ai][bj][m][q >> 1][(q & 1) * 2 + 1] *= r1;
                    }
                }
                __builtin_amdgcn_sched_barrier(0);
            }
    }
    __device__ __forceinline__ void operator()(const f32x4 (&acc)[2][2][4][2], const Unit& u, int wr, int wc, int fr, int fq) const {
        const int row0 = u.pm * 256 + wr * 64 + fr, col0 = u.pn * 256 + wc * 64 + 8 * fq; const bool lo = fr < 8;
#pragma unroll
        for (int ai = 0; ai < 2; ++ai)
#pragma unroll
            for (int m = 0; m < 4; ++m) {
                const int row = row0 + ai * 128 + m * 16;
                u32x4 oo[2];
#pragma unroll
                for (int bj = 0; bj < 2; ++bj) {
                    const int col = col0 + bj * 32;
                    const u32x4 gb = *(const u32x4*)(gates + (size_t)row * 2048 + 1024 + col);
                    float r[8];
#pragma unroll
                    for (int q = 0; q < 4; ++q) {
                        const float b0 = fmaxf(bflo(gb[q]), -60.f), b1 = fmaxf(bfhi(gb[q]), -60.f);
                        r[2 * q] = acc[ai][bj][m][q >> 1][(q & 1) * 2] * __builtin_amdgcn_rcpf(1.f + __expf(-b0));
                        r[2 * q + 1] = acc[ai][bj][m][q >> 1][(q & 1) * 2 + 1] * __builtin_amdgcn_rcpf(1.f + __expf(-b1));
                    }
                    oo[bj][0] = pk_bf16(r[0], r[1]); oo[bj][1] = pk_bf16(r[2], r[3]); oo[bj][2] = pk_bf16(r[4], r[5]); oo[bj][3] = pk_bf16(r[6], r[7]);
                }
                line_pair(oo[0], oo[1], lo);
                const int colx = col0 + (lo ? 0 : 32);
                *(u32x4*)(O + (size_t)(lo ? row : row - 8) * DM + colx) = oo[0];
                *(u32x4*)(O + (size_t)(lo ? row + 8 : row) * DM + colx) = oo[1];
            }
    }
};
struct EpiRes {
    static constexpr bool PERM = true, HAS_MID = false, LINE = true;
    const float* R; const bf16_t* Rb; float* H; bf16_t* Hb; float* SS;
    __device__ __forceinline__ void operator()(const f32x4 (&acc)[2][2][4][2], const Unit& u, int wr, int wc, int fr, int fq) const {
        const int row0 = u.pm * 256 + wr * 64 + fr, col0 = u.pn * 256 + wc * 64 + 8 * fq; const bool lo = fr < 8;
#pragma unroll
        for (int ai = 0; ai < 2; ++ai)
#pragma unroll
            for (int m = 0; m < 4; ++m) {
                const int row = row0 + ai * 128 + m * 16;
                float s = 0.f; u32x4 ob[2];
#pragma unroll
                for (int bj = 0; bj < 2; ++bj) {
                    const int col = col0 + bj * 32;
                    f32x4 r0, r1;
                    if (R) { r0 = *(const f32x4*)(R + (size_t)row * DM + col); r1 = *(const f32x4*)(R + (size_t)row * DM + col + 4); }
                    else { const u32x4 rb = *(const u32x4*)(Rb + (size_t)row * DM + col);
                        r0[0] = bflo(rb[0]); r0[1] = bfhi(rb[0]); r0[2] = bflo(rb[1]); r0[3] = bfhi(rb[1]); r1[0] = bflo(rb[2]); r1[1] = bfhi(rb[2]); r1[2] = bflo(rb[3]); r1[3] = bfhi(rb[3]); }
                    const f32x4 h0 = r0 + acc[ai][bj][m][0], h1 = r1 + acc[ai][bj][m][1];
                    if (H) { *(f32x4*)(H + (size_t)row * DM + col) = h0; *(f32x4*)(H + (size_t)row * DM + col + 4) = h1; }
                    ob[bj][0] = pk_bf16(h0[0], h0[1]); ob[bj][1] = pk_bf16(h0[2], h0[3]); ob[bj][2] = pk_bf16(h1[0], h1[1]); ob[bj][3] = pk_bf16(h1[2], h1[3]);
                    s += ((h0[0] * h0[0] + h0[1] * h0[1]) + (h0[2] * h0[2] + h0[3] * h0[3])) + ((h1[0] * h1[0] + h1[1] * h1[1]) + (h1[2] * h1[2] + h1[3] * h1[3]));
                }
                if (Hb) { line_pair(ob[0], ob[1], lo); const int colx = col0 + (lo ? 0 : 32);
                    *(u32x4*)(Hb + (size_t)(lo ? row : row - 8) * DM + colx) = ob[0]; *(u32x4*)(Hb + (size_t)(lo ? row + 8 : row) * DM + colx) = ob[1]; }
                s += __shfl_xor(s, 16); s += __shfl_xor(s, 32);
                if (fq == 0) SS[(size_t)row * 16 + u.pn * 4 + wc] = s;
            }
    }
};
struct EpiSwiGLU {
    static constexpr bool PERM = true, HAS_MID = false, LINE = false;
    bf16_t* O; const float* ss;
    __device__ __forceinline__ void operator()(const f32x4 (&acc)[2][2][4][2], const Unit& u, int wr, int wc, int fr, int fq) const {
        const int row0 = u.pm * 256 + wr * 64 + fr, col0 = u.pn * 128 + wc * 32 + 8 * fq;
#pragma unroll
        for (int ai = 0; ai < 2; ++ai)
#pragma unroll
            for (int m = 0; m < 4; ++m) {
                const int row = row0 + ai * 128 + m * 16;
                const float rs = rstd_of(ss, row);
                float r[8];
#pragma unroll
                for (int n = 0; n < 2; ++n)
#pragma unroll
                    for (int j = 0; j < 4; ++j) { const float gg = acc[ai][0][m][n][j] * rs, uu = acc[ai][1][m][n][j] * rs; r[n * 4 + j] = gg * sigmoidf_(gg) * uu; }
                u32x4 o; o[0] = pk_bf16(r[0], r[1]); o[1] = pk_bf16(r[2], r[3]); o[2] = pk_bf16(r[4], r[5]); o[3] = pk_bf16(r[6], r[7]);
                *(u32x4*)(O + (size_t)row * DFF + col0) = o;
            }
    }
};

struct Ctx { int tid, lane, wave, gw, ngw, gt, ngt; };

__device__ __forceinline__ void p_transpose(const Ctx& c, LAS unsigned char* lds, const float* W, bf16_t* Wt, int K, int N, const float* g, int mode, int& cursor, int ldw = 0, int koff = 0) {
    if (ldw == 0) ldw = K;
    LAS float* scr = (LAS float*)(lds + c.wave * 8704);
    const int nblk = N / 32, nitems = (K / 64) * nblk, lane = c.lane;
    int first = (c.gw - cursor % c.ngw + c.ngw) % c.ngw;
    for (int it = first; it < nitems; it += c.ngw) {
        const int kb = it / nblk, nb = it % nblk, k0 = 64 * kb, n0 = 32 * nb;
#pragma unroll 8
        for (int i = 0; i < 32; ++i) { const int kk = 2 * i + (lane >> 5); float v = W[(size_t)(k0 + kk) * N + n0 + (lane & 31)]; if (g) v *= g[k0 + kk]; scr[kk * 33 + (lane & 31)] = v; }
        asm volatile("s_waitcnt lgkmcnt(0)" ::: "memory");
        const int ch = lane & 7;
#pragma unroll
        for (int j = 0; j < 4; ++j) { const int n = (lane >> 3) + 8 * j; const LAS float* sp = scr + (8 * ch) * 33 + n;
            u32x4 o; o[0] = pk_bf16(sp[0], sp[33]); o[1] = pk_bf16(sp[2 * 33], sp[3 * 33]); o[2] = pk_bf16(sp[4 * 33], sp[5 * 33]); o[3] = pk_bf16(sp[6 * 33], sp[7 * 33]);
            const int nn = n0 + n, row = mode == 0 ? nn : (256 * (nn >> 7) + (nn & 127) + (mode == 2 ? 128 : 0));
            *(u32x4*)(Wt + (size_t)row * ldw + koff + k0 + 8 * ch) = o; }
        asm volatile("s_waitcnt lgkmcnt(0)" ::: "memory");
    }
    cursor += nitems;
}
__device__ __forceinline__ void p_rmsnorm_rows(const Ctx& c, const float* x, const float* g, bf16_t* out, int rows) {
    f32x4 gg[4];
#pragma unroll
    for (int j = 0; j < 4; ++j) gg[j] = ((const f32x4*)g)[c.lane + 64 * j];
    for (int r0 = c.gw; r0 < rows; r0 += 2 * c.ngw) {
        const int r1 = r0 + c.ngw; const bool has1 = r1 < rows; const int r1c = has1 ? r1 : r0;
        const f32x4* xa = (const f32x4*)(x + (size_t)r0 * DM) + c.lane; const f32x4* xb = (const f32x4*)(x + (size_t)r1c * DM) + c.lane;
        f32x4 va[4], vb[4]; float sa = 0.f, sb = 0.f;
#pragma unroll
        for (int j = 0; j < 4; ++j) { va[j] = xa[64 * j]; vb[j] = xb[64 * j]; }
#pragma unroll
        for (int j = 0; j < 4; ++j) { sa += (va[j][0] * va[j][0] + va[j][1] * va[j][1]) + (va[j][2] * va[j][2] + va[j][3] * va[j][3]); sb += (vb[j][0] * vb[j][0] + vb[j][1] * vb[j][1]) + (vb[j][2] * vb[j][2] + vb[j][3] * vb[j][3]); }
        const float ra = rsqrtf(wave_sum(sa) * (1.f / DM) + EPS), rb = rsqrtf(wave_sum(sb) * (1.f / DM) + EPS);
#pragma unroll
        for (int j = 0; j < 4; ++j) {
            u32x2 o; o[0] = pk_bf16(va[j][0] * ra * gg[j][0], va[j][1] * ra * gg[j][1]); o[1] = pk_bf16(va[j][2] * ra * gg[j][2], va[j][3] * ra * gg[j][3]);
            ((u32x2*)(out + (size_t)r0 * DM))[c.lane + 64 * j] = o;
            if (has1) { u32x2 q; q[0] = pk_bf16(vb[j][0] * rb * gg[j][0], vb[j][1] * rb * gg[j][1]); q[1] = pk_bf16(vb[j][2] * rb * gg[j][2], vb[j][3] * rb * gg[j][3]);
                ((u32x2*)(out + (size_t)r1 * DM))[c.lane + 64 * j] = q; }
        }
    }
}
__device__ __forceinline__ void p_rope_table(const Ctx& c, const int* pos, float* tab) {
    for (int i = c.gt; i < T * 8; i += c.ngt) {
        const int tok = i >> 3, f = i & 7;
        const double inv = f == 0 ? 1.0 : f == 1 ? 0.19392274474868576 : f == 2 ? 0.03760603093086393 : f == 3 ? 0.007292664737217109 : f == 4 ? 0.001414213562373095 :
                           f == 5 ? 0.0002742481756762073 : f == 6 ? 5.318295896944988e-05 : 1.031338537721246e-05;
        const double rev = (double)pos[tok] * inv * 0.15915494309189535;
        const float fr = (float)(rev - rint(rev));
        tab[(size_t)tok * 16 + f] = __builtin_amdgcn_cosf(fr);
        tab[(size_t)tok * 16 + 8 + f] = __builtin_amdgcn_sinf(fr);
    }
}
__device__ __forceinline__ void p_final(const Ctx& c, float* out, const float* ss, const float* g) {
    f32x4 gg[4];
#pragma unroll
    for (int j = 0; j < 4; ++j) gg[j] = ((const f32x4*)g)[c.lane + 64 * j];
    for (int r0 = c.gw; r0 < T; r0 += 2 * c.ngw) {
        const int r1 = r0 + c.ngw; const bool has1 = r1 < T; const int r1c = has1 ? r1 : r0;
        f32x4* xa = (f32x4*)(out + (size_t)r0 * DM) + c.lane; f32x4* xb = (f32x4*)(out + (size_t)r1c * DM) + c.lane;
        f32x4 va[4], vb[4];
#pragma unroll
        for (int j = 0; j < 4; ++j) { va[j] = xa[64 * j]; vb[j] = xb[64 * j]; }
        const float ra = rstd_of(ss, r0), rb = rstd_of(ss, r1c);
#pragma unroll
        for (int j = 0; j < 4; ++j) { xa[64 * j] = va[j] * ra * gg[j]; if (has1) xb[64 * j] = vb[j] * rb * gg[j]; }
    }
}

typedef float f32x16 __attribute__((ext_vector_type(16)));
typedef short s16x4 __attribute__((ext_vector_type(4)));
#define MFMA32(a, b, c) __builtin_amdgcn_mfma_f32_32x32x16_bf16((a), (b), (c), 0, 0, 0)
constexpr int ATT_FLAG_OFF = 40960;
#ifndef ATT_DUP_A
#define ATT_DUP_A 0
#endif
#ifndef ATT_DUP_B
#define ATT_DUP_B 0
#endif
template <int MODE, int HDIM, int KT>
__device__ __forceinline__ void attn_item(LAS unsigned char* lds, const bf16_t* Qp, int ldq, const bf16_t* Kp, const bf16_t* Vp, int ldkv, bf16_t* Op, int ldo, int q0, int nkeys) {
    constexpr int KS = HDIM / 16, DD = HDIM / 32, KROW = HDIM * 2 + 16, NCH = HDIM / 8, PER = KT * NCH / 512, NSUB = KT / 32;
    static_assert(2 * KT * KROW + 128 <= ATT_FLAG_OFF, "attention LDS tiles overlap the flag words");
    int tid = threadIdx.x; asm volatile("" : "+v"(tid));
    const int lane = tid & 63, w = __builtin_amdgcn_readfirstlane(tid >> 6), r = lane & 31, hh = lane >> 5;
    const int tq0 = q0 + 32 * w, tq = tq0 + r;
    LAS unsigned char* Ks = lds; LAS unsigned char* Vr = lds + KT * KROW;
    const int trq = (r & 15) >> 2, trp = r & 3, trb = r & 16;
    LAS unsigned* flags = (LAS unsigned*)(lds + ATT_FLAG_OFF);
    bf16x8 Qf[KS];
#pragma unroll
    for (int ks = 0; ks < KS; ++ks) Qf[ks] = *(const bf16x8*)(Qp + (size_t)tq * ldq + 16 * ks + 8 * hh);
    f32x16 Oacc[DD];
#pragma unroll
    for (int dd = 0; dd < DD; ++dd)
#pragma unroll
        for (int i = 0; i < 16; ++i) Oacc[dd][i] = 0.f;
    float m = -INFINITY, l = 0.f, run = (MODE == 1) ? 1.f : 0.f; unsigned done_w = 0u;
    float w8[8], u4[4], fgc[4], fmn[16], fbias = 0.f;
    if (MODE == 0) {
        const int cc = r & 15, e = cc & 3, f = cc >> 3; const bool act = (hh == ((cc >> 2) & 1)); const int c4 = r & 3;
#pragma unroll
        for (int i = 0; i < 8; ++i) { w8[i] = (act && (i & 3) == e && (i >> 2) == f) ? 1.f : 0.f; asm volatile("" : "+v"(w8[i])); }
        fbias = act ? 0.f : -INFINITY; asm volatile("" : "+v"(fbias));
#pragma unroll
        for (int j = 0; j < 4; ++j) { u4[j] = (j == c4) ? 1.f : 0.f; asm volatile("" : "+v"(u4[j])); }
#pragma unroll
        for (int g = 0; g < 4; ++g) { fgc[g] = (((r - 4 * hh - c4 - 8 * g) & 15) == 0) ? 2.f : 1.f; asm volatile("" : "+v"(fgc[g])); }
#pragma unroll
        for (int i = 0; i < 16; ++i) { const int dm = (r - 4 * hh - ((i & 3) + 8 * (i >> 2))) & 15; fmn[i] = 1.f + ((dm & 3) == 0 ? 1.f : 0.f) + (dm == 0 ? 1.f : 0.f); asm volatile("" : "+v"(fmn[i])); }
    }
    const int kt_hi = (MODE == 2) ? (nkeys / KT - 1) : ((q0 + 255) / KT);
    u32x4 kA[PER], vA[PER], kB[PER], vB[PER];
#define ATT_GLOAD(KR, VR, kt) do { _Pragma("unroll") for (int p_ = 0; p_ < PER; ++p_) { const int idx_ = tid + 512 * p_, key_ = idx_ / NCH, ch_ = idx_ % NCH; \
        KR[p_] = *(const u32x4*)(Kp + (size_t)(KT * (kt) + key_) * ldkv + ch_ * 8); VR[p_] = *(const u32x4*)(Vp + (size_t)(KT * (kt) + key_) * ldkv + ch_ * 8); } } while (0)
    auto stage = [&](const u32x4 (&KR)[PER], const u32x4 (&VR)[PER]) -> bool {
        if (MODE == 1 && lane == 0) flags[w] = done_w;
        __syncthreads();
#pragma unroll
        for (int p_ = 0; p_ < PER; ++p_) { const int idx_ = tid + 512 * p_, key_ = idx_ / NCH, ch_ = idx_ % NCH;
            *(LAS u32x4*)(Ks + key_ * KROW + ch_ * 16) = KR[p_];
            *(LAS u32x4*)(Vr + key_ * KROW + ch_ * 16) = VR[p_];
        }
        bool alldone = false;
        if (MODE == 1) { unsigned a = 1u;
#pragma unroll
            for (int i = 0; i < 8; ++i) a &= flags[i];
            alldone = a != 0u; }
        __syncthreads();
        return alldone;
    };
    auto qk = [&](int sub, f32x16& S) {
        bf16x8 kf[KS];
#pragma unroll
        for (int ks = 0; ks < KS; ++ks) kf[ks] = *(const LAS bf16x8*)(Ks + (32 * sub + r) * KROW + (16 * ks + 8 * hh) * 2);
#pragma unroll
        for (int i = 0; i < 16; ++i) S[i] = 0.f;
        __builtin_amdgcn_sched_barrier(0);
#pragma unroll
        for (int ks = 0; ks < KS; ++ks) S = MFMA32(kf[ks], Qf[ks], S);
    };
    auto compute = [&](int kt) {
        f32x16 Sn; bool an;
        { const int tkn = KT * kt + 32 * (NSUB - 1); an = !((MODE != 2 && tkn > tq0 + 31) || (MODE == 1 && done_w)); if (an) qk(NSUB - 1, Sn); }
#pragma unroll
        for (int sub = NSUB - 1; sub >= 0; --sub) {
            const int tk0 = KT * kt + 32 * sub;
            f32x16 S = Sn; const bool a = an;
            if (sub > 0) { const int tkn = tk0 - 32; an = !((MODE != 2 && tkn > tq0 + 31) || (MODE == 1 && done_w)); if (an) qk(sub - 1, Sn); }
            if (!a) continue;
            s16x4 vlo[DD][2], vhi[DD][2];
#pragma unroll
            for (int dd = 0; dd < DD; ++dd)
#pragma unroll
                for (int s2 = 0; s2 < 2; ++s2) {
                    LAS unsigned char* vp = Vr + (32 * sub + 16 * s2 + 4 * hh + trq) * KROW + (32 * dd + trb) * 2 + 8 * trp;
                    vlo[dd][s2] = __builtin_amdgcn_ds_read_tr16_b64_v4i16((LAS s16x4*)vp); vhi[dd][s2] = __builtin_amdgcn_ds_read_tr16_b64_v4i16((LAS s16x4*)(vp + 8 * KROW));
                }
            __builtin_amdgcn_sched_barrier(0);
            const int dbase = tq - tk0 - 4 * hh;
            const int D = tq0 - tk0;
            if (MODE == 0 || MODE == 2) {
                const float C = (MODE == 0 ? 0.125f : 0.08838834764831845f) * 1.4426950408889634f;
                float alpha, ls = 0.f, mn;
                if (MODE == 0 && D >= 544) {
                    float s1 = S[0] * w8[0], s2 = S[8] * w8[0];
#pragma unroll
                    for (int i = 1; i < 8; ++i) { s1 = fmaf(S[i], w8[i], s1); s2 = fmaf(S[8 + i], w8[i], s2); }
                    const float v1 = fmaf(s1, C, fbias), v2 = fmaf(s2, C, fbias);
                    float mx = fmaxf(v1, v2); mx = fmaxf(mx, __shfl_xor(mx, 32));
                    mn = fmaxf(m, mx);
                    alpha = __builtin_amdgcn_exp2f(m - mn);
                    const float p1 = __builtin_amdgcn_exp2f(v1 - mn), p2 = __builtin_amdgcn_exp2f(v2 - mn);
                    ls = p1 + p2;
#pragma unroll
                    for (int i = 0; i < 8; ++i) { S[i] = w8[i] * p1; S[8 + i] = w8[i] * p2; }
                } else if (MODE == 0 && D >= 160 && D <= 480) {
                    float vg[4]; float mx = -INFINITY;
#pragma unroll
                    for (int g = 0; g < 4; ++g) { vg[g] = (fmaf(S[4 * g + 3], u4[3], fmaf(S[4 * g + 2], u4[2], fmaf(S[4 * g + 1], u4[1], S[4 * g] * u4[0])))) * C; mx = fmaxf(mx, vg[g]); }
                    mx = fmaxf(mx, __shfl_xor(mx, 32));
                    mn = fmaxf(m, mx);
                    alpha = __builtin_amdgcn_exp2f(m - mn);
#pragma unroll
                    for (int g = 0; g < 4; ++g) { const float pg = fgc[g] * __builtin_amdgcn_exp2f(vg[g] - mn); ls += pg;
#pragma unroll
                        for (int j = 0; j < 4; ++j) S[4 * g + j] = u4[j] * pg; }
                } else if (MODE == 0 && D >= 32 && D <= 96) {
                    float mx = -INFINITY;
#pragma unroll
                    for (int i = 0; i < 16; ++i) { S[i] = S[i] * C; mx = fmaxf(mx, S[i]); }
                    mx = fmaxf(mx, __shfl_xor(mx, 32));
                    mn = fmaxf(m, mx);
                    alpha = __builtin_amdgcn_exp2f(m - mn);
#pragma unroll
                    for (int i = 0; i < 16; ++i) { const float p = fmn[i] * __builtin_amdgcn_exp2f(S[i] - mn); S[i] = p; ls += p; }
                } else {
                    float fm[16]; float mx = -INFINITY;
#pragma unroll
                    for (int i = 0; i < 16; ++i) {
                        float v = S[i] * C;
                        if (MODE == 0) { const int d = dbase - ((i & 3) + 8 * (i >> 2));
                            int mult = (d <= 128 ? 1 : 0) + ((((d & 3) == 0) && d <= 512) ? 1 : 0) + (((d & 15) == 0) ? 1 : 0);
                            mult = d >= 0 ? mult : 0; fm[i] = (float)mult; v = mult > 0 ? v : -INFINITY; }
                        else fm[i] = 1.f;
                        S[i] = v; mx = fmaxf(mx, v);
                    }
                    mx = fmaxf(mx, __shfl_xor(mx, 32));
                    mn = fmaxf(m, mx); const float ms = (mn == -INFINITY) ? 0.f : mn;
                    alpha = __builtin_amdgcn_exp2f(m - ms);
#pragma unroll
                    for (int i = 0; i < 16; ++i) { const float p = fm[i] * __builtin_amdgcn_exp2f(S[i] - ms); S[i] = p; ls += p; }
                }
                l = l * alpha + ls; m = mn;
                if (!__all(alpha == 1.f)) {
#pragma unroll
                    for (int dd = 0; dd < DD; ++dd) Oacc[dd] = Oacc[dd] * alpha;
                }
            } else {
                float om[16], ex[16], G[4], PG[4];
                if (D < 32) {
#pragma unroll
                    for (int i = 0; i < 16; ++i) { const int d = dbase - ((i & 3) + 8 * (i >> 2)); const bool valid = d > 0;
                        const float x = fminf(fmaxf(S[i] * (0.125f * 1.4426950408889634f), -115.f), 115.f); const float e = __builtin_amdgcn_exp2f(x); const float o1 = __builtin_amdgcn_rcpf(1.f + e);
                        om[i] = valid ? o1 : 1.f; S[i] = valid ? e * o1 : 0.f; }
                } else {
#pragma unroll
                    for (int i = 0; i < 16; ++i) {
                        const float x = fminf(fmaxf(S[i] * (0.125f * 1.4426950408889634f), -115.f), 115.f); const float e = __builtin_amdgcn_exp2f(x); const float o1 = __builtin_amdgcn_rcpf(1.f + e);
                        om[i] = o1; S[i] = e * o1; }
                }
#pragma unroll
                for (int g = 0; g < 4; ++g) { ex[4 * g + 3] = 1.f; ex[4 * g + 2] = om[4 * g + 3]; ex[4 * g + 1] = ex[4 * g + 2] * om[4 * g + 2]; ex[4 * g] = ex[4 * g + 1] * om[4 * g + 1]; G[g] = ex[4 * g] * om[4 * g]; }
#pragma unroll
                for (int g = 0; g < 4; ++g) PG[g] = __shfl_xor(G[g], 32);
                float suf = run;
#pragma unroll
                for (int g = 3; g >= 0; --g) { const float lat = suf * (hh == 0 ? PG[g] : 1.f);
                    S[4 * g + 3] = S[4 * g + 3] * lat; S[4 * g + 2] = S[4 * g + 2] * (lat * ex[4 * g + 2]); S[4 * g + 1] = S[4 * g + 1] * (lat * ex[4 * g + 1]); S[4 * g] = S[4 * g] * (lat * ex[4 * g]);
                    suf *= G[g] * PG[g]; }
                run = suf;
                done_w = __all(run < 1e-30f) ? 1u : 0u;
            }
            u32x4 pp0, pp1;
#pragma unroll
            for (int j = 0; j < 4; ++j) { pp0[j] = pk_bf16(S[2 * j], S[2 * j + 1]); pp1[j] = pk_bf16(S[8 + 2 * j], S[8 + 2 * j + 1]); }
            const bf16x8 P0 = __builtin_bit_cast(bf16x8, pp0), P1 = __builtin_bit_cast(bf16x8, pp1);
#pragma unroll
            for (int dd = 0; dd < DD; ++dd)
#pragma unroll
                for (int s2 = 0; s2 < 2; ++s2) {
                    const bf16x8 vf = __builtin_shufflevector(vlo[dd][s2], vhi[dd][s2], 0, 1, 2, 3, 4, 5, 6, 7);
                    Oacc[dd] = MFMA32(vf, s2 ? P1 : P0, Oacc[dd]);
                }
        }
    };
    ATT_GLOAD(kA, vA, kt_hi);
    if constexpr (MODE == 2) {
#pragma unroll 1
        for (int kt = kt_hi; kt >= 0; --kt) {
            stage(kA, vA);
            if (kt >= 1) ATT_GLOAD(kA, vA, kt - 1);
            compute(kt);
        }
    } else {
        if (kt_hi >= 1) ATT_GLOAD(kB, vB, kt_hi - 1);
#pragma unroll 1
        for (int kt = kt_hi; kt >= 0; kt -= 2) {
            if (stage(kA, vA)) break;
            if (kt >= 2) ATT_GLOAD(kA, vA, kt - 2);
            compute(kt);
            if (kt == 0) break;
            if (stage(kB, vB)) break;
            if (kt >= 3) ATT_GLOAD(kB, vB, kt - 3);
            compute(kt - 1);
        }
    }
#undef ATT_GLOAD
    float inv = 1.f;
    if (MODE != 1) { const float lt = l + __shfl_xor(l, 32); inv = 1.f / lt; }
#pragma unroll
    for (int dd = 0; dd < DD; ++dd)
#pragma unroll
        for (int g = 0; g < 4; g += 2) {
            unsigned a0 = pk_bf16(Oacc[dd][4 * g] * inv, Oacc[dd][4 * g + 1] * inv), a1 = pk_bf16(Oacc[dd][4 * g + 2] * inv, Oacc[dd][4 * g + 3] * inv);
            unsigned b0 = pk_bf16(Oacc[dd][4 * g + 4] * inv, Oacc[dd][4 * g + 5] * inv), b1 = pk_bf16(Oacc[dd][4 * g + 6] * inv, Oacc[dd][4 * g + 7] * inv);
            { auto x = __builtin_amdgcn_permlane32_swap(a0, b0, false, false); a0 = x[0]; b0 = x[1]; }
            { auto x = __builtin_amdgcn_permlane32_swap(a1, b1, false, false); a1 = x[0]; b1 = x[1]; }
            u32x4 o; o[0] = a0; o[1] = a1; o[2] = b0; o[3] = b1;
            *(u32x4*)(Op + (size_t)tq * ldo + 32 * dd + 8 * g + 8 * hh) = o;
        }
}
constexpr int WQ_WORD = 4096;
__device__ __forceinline__ void p_attn_ab(LAS unsigned char* lds, const bf16_t* qkv, bf16_t* OA, bf16_t* OB, unsigned* wq) {
    constexpr size_t TS = (size_t)T * 512;
    volatile LAS unsigned* slot = (volatile LAS unsigned*)(lds + ATT_FLAG_OFF + 64);
    for (;;) {
        if (threadIdx.x == 0) *slot = __hip_atomic_fetch_add(wq, 1u, __ATOMIC_RELAXED, __HIP_MEMORY_SCOPE_AGENT);
        __syncthreads();
        const unsigned it = (unsigned)__builtin_amdgcn_readfirstlane((int)*slot);
        __syncthreads();
        if (it >= 2048u) break;
        const int j = it & 1023, qb = 7 - (j >> 7), bh = j & 127, b = bh >> 3, h = bh & 7;
        const bf16_t* base = qkv + (size_t)bh * SEQ * 64;
        if (it < 1024u) attn_item<0, 64, 128>(lds, base, 64, base + TS, base + 2 * TS, 64, OA + (size_t)b * SEQ * 1024 + h * HD, 1024, qb * 256, SEQ);
        else attn_item<1, 64, 128>(lds, base + 3 * TS, 64, base + 4 * TS, base + 5 * TS, 64, OB + (size_t)b * SEQ * 1024 + h * HD, 1024, qb * 256, SEQ);
    }
}
__device__ __forceinline__ void p_attn_mem(LAS unsigned char* lds, const bf16_t* qm, const bf16_t* kvm, bf16_t* om) {
#pragma unroll 1
    for (int i = 0;; ++i) {
        Unit u; { pg8::StaticOrder S2; S2.init(T, MEMW, (int)gridDim.x, (int)blockIdx.x); if (!S2.next(i, u)) break; }
        const int b = u.pm >> 3, qb = u.pm & 7;
#pragma unroll 1
        for (int hq = 0; hq < 2; ++hq) { const int h = 2 * u.pn + hq;
            attn_item<2, 128, 64>(lds, qm + (size_t)b * SEQ * MEMW + h * 128, MEMW, kvm + (size_t)b * NMEM * 1024 + h * 128, kvm + (size_t)b * NMEM * 1024 + 512 + h * 128, 1024,
                                  om + (size_t)b * SEQ * MEMW + h * 128, MEMW, qb * 256, NMEM); }
    }
}

__device__ __forceinline__ bool sync_if(int k, cg::grid_group& grid, XcdBarrier& xb) {
    if (k == 1) { grid.sync(); xb = xcd_barrier_post(xb.bar, xb.st); }
    else if (k == 8) {
        asm volatile("s_waitcnt vmcnt(0)" ::: "memory");
        __syncthreads();
        if (threadIdx.x == 0) { __builtin_amdgcn_fence(__ATOMIC_ACQUIRE, "agent"); asm volatile("s_waitcnt vmcnt(0)" ::: "memory"); }
        __syncthreads();
    }
    else if (k > 1) xcd_barrier(xb);
    asm volatile("" ::: "memory"); return true; }
constexpr int NPHASE = 13;
#ifndef NAIVE_AB
#define NAIVE_AB 0
#endif
#ifndef NAIVE_MEM
#define NAIVE_MEM 0
#endif
#ifndef ONLY
#define ONLY -1
#endif
#ifndef DUP_MASK
#define DUP_MASK 0
#endif
#define PHASE(k) if ((ONLY < 0 || ONLY == (k)) && ph_lo <= (k) && (k) < ph_hi) if (sync_if((k), grid, xb)) for (int rep_ = 0; rep_ < (((DUP_MASK >> (k)) & 1) ? 2 : 1); ++rep_)
__global__ __launch_bounds__(512, 2) void mega(Params p, int ph_lo, int ph_hi) {
    extern __shared__ __attribute__((aligned(16))) unsigned char shm[];
    LAS unsigned char* lds = (LAS unsigned char*)shm;
    cg::grid_group grid = cg::this_grid();
    Ctx c; c.tid = threadIdx.x; c.lane = c.tid & 63; c.wave = c.tid >> 6; c.gw = blockIdx.x * 8 + c.wave; c.ngw = gridDim.x * 8; c.gt = blockIdx.x * 512 + c.tid; c.ngt = gridDim.x * 512;
    unsigned char* ws = p.ws;
    bf16_t* Wt_in = (bf16_t*)(ws + WS_WIN); bf16_t* Wt_upa = (bf16_t*)(ws + WS_WUPA); bf16_t* Wt_upb = (bf16_t*)(ws + WS_WUPB); bf16_t* Wt_out = (bf16_t*)(ws + WS_WOUT);
    bf16_t* Wt_qm = (bf16_t*)(ws + WS_WQM); bf16_t* Wt_kvm = (bf16_t*)(ws + WS_WKVM); bf16_t* Wt_om = (bf16_t*)(ws + WS_WOM); bf16_t* Wt_gu = (bf16_t*)(ws + WS_WGU); bf16_t* Wt_dn = (bf16_t*)(ws + WS_WDN);
    bf16_t* memn = (bf16_t*)(ws + WS_MEMN); bf16_t* kvm = (bf16_t*)(ws + WS_KVM);
    float* ss1 = (float*)(ws + WS_SS1); float* ss2 = (float*)(ws + WS_SS2); float* ss3 = (float*)(ws + WS_SS3); float* rope = (float*)(ws + WS_ROPE);
    bf16_t* n1 = (bf16_t*)(ws + WS_R1); bf16_t* mixed = (bf16_t*)(ws + WS_R1); bf16_t* h2b = (bf16_t*)(ws + WS_R1);
    bf16_t* proj = (bf16_t*)(ws + WS_PROJ); bf16_t* gates = (bf16_t*)(ws + WS_PROJ + 192 * MiB);
    float* h1 = (float*)(ws + WS_H1); bf16_t* h1b = (bf16_t*)(ws + WS_H1B); bf16_t* qm = (bf16_t*)(ws + WS_QM); bf16_t* om = (bf16_t*)(ws + WS_OM);
    float* h2 = (float*)(ws + WS_H2); bf16_t* act = (bf16_t*)(ws + WS_ACT); bf16_t* OA = (bf16_t*)(ws + WS_OA); bf16_t* OB = (bf16_t*)(ws + WS_OA) + 512;
    float* m1 = p.out; unsigned* bar = (unsigned*)(ws + WS_BAR);
    volatile LAS unsigned* xst = (volatile LAS unsigned*)(lds + pg8::STAGE_BYTES);
    if (c.tid == 0) { xst[0] = 0u; xst[1] = 0u; }
    __syncthreads();
    XcdBarrier xb; xb.bar = bar; xb.x = 0u; xb.st = xst;
    pg8::StaticOrder S;
    {
        PHASE(0) {
            int cur = 0;
            p_transpose(c, lds, p.w_in, Wt_in, DM, INC, nullptr, 0, cur);
            p_transpose(c, lds, p.w_ffn_gate, Wt_gu, DM, DFF, p.g_ffn, 1, cur);
            p_transpose(c, lds, p.w_ffn_up, Wt_gu, DM, DFF, p.g_ffn, 2, cur);
            p_transpose(c, lds, p.w_ffn_down, Wt_dn, DFF, DM, nullptr, 0, cur);
            p_transpose(c, lds, p.w_up_a, Wt_upa, 512, DM, nullptr, 0, cur, 1024, 0);
            p_transpose(c, lds, p.w_up_b, Wt_upa, 512, DM, nullptr, 0, cur, 1024, 512);
            p_transpose(c, lds, p.w_out, Wt_out, DM, DM, nullptr, 0, cur);
            p_transpose(c, lds, p.w_q_mem, Wt_qm, DM, MEMW, p.g_mem_q, 0, cur);
            p_transpose(c, lds, p.w_kv_mem, Wt_kvm, DM, 2 * MEMW, nullptr, 0, cur);
            p_transpose(c, lds, p.w_o_mem, Wt_om, MEMW, DM, nullptr, 0, cur);
            p_rmsnorm_rows(c, p.x, p.g_mix, n1, T);
            p_rmsnorm_rows(c, p.mem, p.g_mem_kv, memn, BATCH * NMEM);
            p_rope_table(c, p.pos, rope);
            if (blockIdx.x == 0) { for (int i = c.tid; i < XCD_BAR_WORDS; i += 512) bar[i] = 0u; if (c.tid == 0) bar[WQ_WORD] = 0u; }
        }
        PHASE(1) {
            Gemm g{n1, Wt_in, T, INC, DM}; EpiBf16 E{proj, INC, nullptr, 1 << 30, rope, 4, 12, gates};   S.init(g.M, g.N, gridDim.x, blockIdx.x); pg8::gemm_phase(lds, g, S, E);
        }
        PHASE(3) {
            { Gemm g{memn, Wt_kvm, BATCH * NMEM, 1024, DM}; EpiBf16 E{kvm, 1024, nullptr, 1 << 30, nullptr, 0, 0, nullptr}; S.init(g.M, g.N, gridDim.x, blockIdx.x); pg8::gemm_phase(lds, g, S, E); }
            p_attn_ab(lds, proj, OA, OB, bar + WQ_WORD);
        }
        PHASE(5) { Gemm g{OA, Wt_upa, T, DM, DM}; EpiGate E{gates, mixed}; S.init(g.M, g.N, gridDim.x, blockIdx.x); pg8::gemm_phase(lds, g, S, E); }
        PHASE(6) { Gemm g{mixed, Wt_out, T, DM, DM}; EpiRes E{p.x, nullptr, nullptr, h1b, ss1}; S.init(g.M, g.N, gridDim.x, blockIdx.x); pg8::gemm_phase(lds, g, S, E); }
        PHASE(7) { Gemm g{h1b, Wt_qm, T, MEMW, DM}; EpiBf16 E{qm, MEMW, ss1, 1 << 30, nullptr, 0, 0, nullptr}; S.init(g.M, g.N, gridDim.x, blockIdx.x); pg8::gemm_phase(lds, g, S, E); }
        PHASE(8) {
            p_attn_mem(lds, qm, kvm, om);
        }
        PHASE(9) { Gemm g{om, Wt_om, T, DM, MEMW}; EpiRes E{nullptr, h1b, nullptr, h2b, ss2}; S.init(g.M, g.N, gridDim.x, blockIdx.x); pg8::gemm_phase(lds, g, S, E); }
        PHASE(10) { Gemm g{h2b, Wt_gu, T, 2 * DFF, DM}; EpiSwiGLU E{act, ss2}; S.init(g.M, g.N, gridDim.x, blockIdx.x); pg8::gemm_phase(lds, g, S, E); }
        PHASE(11) { Gemm g{act, Wt_dn, T, DM, DFF}; EpiRes E{nullptr, h2b, p.out, nullptr, ss3}; S.init(g.M, g.N, gridDim.x, blockIdx.x); pg8::gemm_phase(lds, g, S, E); }
        PHASE(12) p_final(c, p.out, ss3, p.g_final);
    }
}

constexpr int LDS_BYTES = pg8::STAGE_BYTES + 16;
#ifndef ONE_LAUNCH
#define ONE_LAUNCH 1
#endif
extern "C" void kernel_launch(void* const* d_in, const int* in_sizes, int n_in, void* d_out, int out_size, void* d_ws, size_t ws_size, hipStream_t stream) {
    static int grid = 0;
    if (grid == 0) {
        if (n_in != 18 || out_size != T * DM || ws_size < WS_END) { fprintf(stderr, "kernel_launch: unexpected shapes (n_in %d out %d ws %zu)\n", n_in, out_size, ws_size); grid = -1; return; }
        int dev = 0, cus = 0, per_cu = 0;
        (void)hipGetDevice(&dev); (void)hipDeviceGetAttribute(&cus, hipDeviceAttributeMultiprocessorCount, dev);
        if (hipFuncSetAttribute((const void*)mega, hipFuncAttributeMaxDynamicSharedMemorySize, LDS_BYTES) != hipSuccess) { fprintf(stderr, "hipFuncSetAttribute failed\n"); grid = -1; return; }
        if (hipOccupancyMaxActiveBlocksPerMultiprocessor(&per_cu, (const void*)mega, 512, LDS_BYTES) != hipSuccess || per_cu < 1) { fprintf(stderr, "occupancy query: %d\n", per_cu); per_cu = 1; }
        (void)hipGetLastError();
        grid = cus * 1;
    }
    if (grid < 0) return;
    Params p{};
    p.x = (const float*)d_in[0]; p.mem = (const float*)d_in[1]; p.pos = (const int*)d_in[2]; p.g_mix = (const float*)d_in[3]; p.w_in = (const float*)d_in[4];
    p.w_up_a = (const float*)d_in[5]; p.w_up_b = (const float*)d_in[6]; p.w_out = (const float*)d_in[7]; p.g_mem_q = (const float*)d_in[8]; p.g_mem_kv = (const float*)d_in[9];
    p.w_q_mem = (const float*)d_in[10]; p.w_kv_mem = (const float*)d_in[11]; p.w_o_mem = (const float*)d_in[12]; p.g_ffn = (const float*)d_in[13];
    p.w_ffn_gate = (const float*)d_in[14]; p.w_ffn_up = (const float*)d_in[15]; p.w_ffn_down = (const float*)d_in[16]; p.g_final = (const float*)d_in[17];
    p.out = (float*)d_out; p.ws = (unsigned char*)d_ws;
#if ONE_LAUNCH
    int lo = 0, hi = NPHASE;
    void* args[] = {&p, &lo, &hi};
    hipError_t e = hipLaunchCooperativeKernel((const void*)mega, dim3(grid), dim3(512), args, LDS_BYTES, stream);
    if (e != hipSuccess) fprintf(stderr, "cooperative launch failed: %s\n", hipGetErrorString(e));
#else
    for (int ph = 0; ph < NPHASE; ++ph) hipLaunchKernelGGL(mega, dim3(grid), dim3(512), LDS_BYTES, stream, p, ph, ph + 1);
#endif
}
```

```cpp
#include <hip/hip_runtime.h>
#include <hip/hip_cooperative_groups.h>
#include <cstdio>
namespace cg = cooperative_groups;

#define LAS __attribute__((address_space(3)))
typedef unsigned short bf16_t;
typedef short bf16x8 __attribute__((ext_vector_type(8)));
typedef float f32x4 __attribute__((ext_vector_type(4)));
typedef unsigned u32x4 __attribute__((ext_vector_type(4)));
typedef unsigned u32x2 __attribute__((ext_vector_type(2)));

constexpr int BATCH = 16, SEQ = 2048, DM = 1024, T = BATCH * SEQ;
constexpr int HD = 64, NHA = 8, NHB = 8;
constexpr int INC = 5120;
constexpr int C_QA = 0, C_KA = 512, C_VA = 1024, C_QB = 1536, C_KB = 2048, C_VB = 2560, C_GA = 3072, C_GB = 4096;
constexpr int NMEM = 256, MEMW = 512, DFF = 2816;
constexpr float EPS = 1e-6f;

constexpr size_t MiB = 1ull << 20;
constexpr size_t WS_WIN = 0, WS_WUPA = 10 * MiB, WS_WUPB = 11 * MiB, WS_WOUT = 12 * MiB, WS_WQM = 14 * MiB, WS_WKVM = 15 * MiB,
                 WS_WOM = 17 * MiB, WS_WGU = 18 * MiB, WS_WDN = 29 * MiB, WS_MEMN = 36 * MiB, WS_KVM = 44 * MiB,
                 WS_SS1 = 52 * MiB, WS_SS2 = 54 * MiB, WS_SS3 = 56 * MiB, WS_ROPE = 58 * MiB, WS_BAR = 60 * MiB;
constexpr size_t WS_R1 = 64 * MiB;
constexpr size_t WS_PROJ = 128 * MiB;
constexpr size_t WS_H1 = 128 * MiB, WS_H1B = 256 * MiB, WS_QM = 320 * MiB, WS_OM = 352 * MiB, WS_H2 = 384 * MiB, WS_ACT = 128 * MiB;
constexpr size_t WS_OA = 448 * MiB, WS_OB = 480 * MiB;
constexpr size_t WS_END = 512 * MiB;

struct Params {
    const float* x; const float* mem; const int* pos; const float* g_mix; const float* w_in; const float* w_up_a; const float* w_up_b; const float* w_out;
    const float* g_mem_q; const float* g_mem_kv; const float* w_q_mem; const float* w_kv_mem; const float* w_o_mem; const float* g_ffn;
    const float* w_ffn_gate; const float* w_ffn_up; const float* w_ffn_down; const float* g_final;
    float* out; unsigned char* ws;
};

typedef float f32x2 __attribute__((ext_vector_type(2)));
typedef __bf16 bf16v2 __attribute__((ext_vector_type(2)));
__device__ __forceinline__ unsigned pk_bf16(float lo, float hi) { f32x2 v = {lo, hi}; bf16v2 r = __builtin_convertvector(v, bf16v2); return __builtin_bit_cast(unsigned, r); }
__device__ __forceinline__ bf16_t f2bf(float f) { return (bf16_t)(pk_bf16(f, 0.f) & 0xffffu); }
__device__ __forceinline__ float bf2f(bf16_t b) { return __uint_as_float(((unsigned)b) << 16); }
__device__ __forceinline__ float bflo(unsigned u) { return __uint_as_float(u << 16); }
__device__ __forceinline__ float bfhi(unsigned u) { return __uint_as_float(u & 0xffff0000u); }
__device__ __forceinline__ float wave_sum(float v) {
#pragma unroll
    for (int o = 1; o < 64; o <<= 1) v += __shfl_xor(v, o);
    return v;
}
__device__ __forceinline__ float sigmoidf_(float x) { return __builtin_amdgcn_rcpf(1.f + __builtin_amdgcn_exp2f(x * -1.4426950408889634f)); }
__device__ __forceinline__ float rstd_of(const float* ss, int row) {
    const f32x4* p = (const f32x4*)(ss + (size_t)row * 16);
    f32x4 a = p[0], b = p[1], c = p[2], d = p[3];
    float s = ((a[0] + a[1]) + (a[2] + a[3])) + ((b[0] + b[1]) + (b[2] + b[3])) + ((c[0] + c[1]) + (c[2] + c[3])) + ((d[0] + d[1]) + (d[2] + d[3]));
    return rsqrtf(s * (1.f / DM) + EPS);
}


#define XB_TMO      128
#define XB_XCNT(j)  (256  + 64 * (j))
#define XB_XSUB(j)  (1280 + 64 * (j))
#define XB_XGEN(j)  (2304 + 64 * (j))
#define XB_TOP      3328
#define XB_TOPGEN   3392
#define XCD_BAR_WORDS 3456
#define XB_SPIN_CAP (1u << 18)
__device__ __forceinline__ unsigned xb_ld(unsigned* p)              { return __hip_atomic_load(p, __ATOMIC_RELAXED, __HIP_MEMORY_SCOPE_AGENT); }
__device__ __forceinline__ unsigned xb_add(unsigned* p, unsigned v) { return __hip_atomic_fetch_add(p, v, __ATOMIC_RELAXED, __HIP_MEMORY_SCOPE_AGENT); }
__device__ __forceinline__ unsigned xb_xcc_id() { return (unsigned)__builtin_amdgcn_s_getreg((3 << 11) | 20) & 0xFu; }
#define XB_SPIN(cond, bar) do { unsigned _sp = 0; while (cond) { __builtin_amdgcn_s_sleep(1); \
    if ((++_sp & 255u) == 0u) { if (xb_ld(&(bar)[XB_TMO])) break; if (_sp > XB_SPIN_CAP) { atomicAdd(&(bar)[XB_TMO], 1u); break; } } } } while (0)
struct XcdBarrier { unsigned* bar; unsigned x; volatile LAS unsigned* st; };
__device__ __forceinline__ XcdBarrier xcd_barrier_post(unsigned* bar, volatile LAS unsigned* st) {
    XcdBarrier b; b.bar = bar; b.x = xb_xcc_id(); b.st = st;
    if (threadIdx.x == 0) (void)xb_add(&bar[XB_XCNT(b.x)], 1u);
    return b;
}
__device__ __forceinline__ void xcd_barrier_complete(unsigned* bar, unsigned x, unsigned& nloc, unsigned& nx) {
    const unsigned G = gridDim.x * gridDim.y * gridDim.z;
    unsigned sum, cnt, mine, sp = 0u;
    for (;;) {
        sum = 0u; cnt = 0u; mine = 0u;
#pragma unroll
        for (unsigned j = 0; j < 16; ++j) { const unsigned c = xb_ld(&bar[XB_XCNT(j)]); sum += c; cnt += (c > 0u) ? 1u : 0u; mine = (j == x) ? c : mine; }
        if (sum == G) break;
        __builtin_amdgcn_s_sleep(1);
        if ((++sp & 255u) == 0u) { if (xb_ld(&bar[XB_TMO])) break; if (sp > XB_SPIN_CAP) { atomicAdd(&bar[XB_TMO], 1u); break; } }
    }
    nloc = mine > 0u ? mine : 1u; nx = cnt > 0u ? cnt : 1u;
}
__device__ __forceinline__ void xcd_barrier(const XcdBarrier& b) {
    asm volatile("s_waitcnt vmcnt(0)" ::: "memory");
    __syncthreads();
    if (threadIdx.x == 0) {
        unsigned* bar = b.bar;
        __builtin_amdgcn_s_waitcnt(0);
        unsigned nloc = b.st[0], nx = b.st[1];
        if (nloc == 0u) { xcd_barrier_complete(bar, b.x, nloc, nx); b.st[0] = nloc; b.st[1] = nx; }
        const unsigned old = xb_add(&bar[XB_XSUB(b.x)], 1u);
        const unsigned gen = old / nloc;
        if (old + 1u == (gen + 1u) * nloc) {
            __builtin_amdgcn_fence(__ATOMIC_RELEASE, "agent");
            asm volatile("s_waitcnt vmcnt(0)" ::: "memory");
            const unsigned og = xb_add(&bar[XB_TOP], 1u);
            const unsigned tg = og / nx;
            if (og + 1u == (tg + 1u) * nx) xb_add(&bar[XB_TOPGEN], 1u);
            else XB_SPIN(xb_ld(&bar[XB_TOPGEN]) == tg, bar);
            __builtin_amdgcn_fence(__ATOMIC_ACQUIRE, "agent");
            xb_add(&bar[XB_XGEN(b.x)], 1u);
            asm volatile("s_waitcnt vmcnt(0)" ::: "memory");
        } else {
            XB_SPIN(xb_ld(&bar[XB_XGEN(b.x)]) == gen, bar);
            __builtin_amdgcn_fence(__ATOMIC_ACQUIRE, "agent");
            asm volatile("s_waitcnt vmcnt(0)" ::: "memory");
        }
    }
    __syncthreads();
}

namespace pg8 {
constexpr int BM = 256, BK = 64, HALF = 128, HTB = HALF * BK * 2, STAGE_BYTES = 8 * HTB, NXCD = 8, WGM = 8;
__host__ __device__ __forceinline__ int lds_byte(int r, int c) { const int st = (r >> 4) * 2 + (c >> 5), rr = r & 15, cc = c & 31, ob = rr * 64 + cc * 2; return st * 1024 + (ob ^ (((ob >> 9) & 1) << 5)); }
__host__ __device__ __forceinline__ void stage_rc(int b, int& R, int& C) { const int st = b / 1024, sb = b % 1024, swz = sb ^ (((sb >> 9) & 1) << 5); R = (st >> 1) * 16 + swz / 64; C = (st & 1) * 32 + (swz % 64) / 2; }
__host__ __device__ __forceinline__ int perm32(int rho) { const int n = rho >> 4, i = rho & 15; return 8 * (i >> 2) + 4 * n + (i & 3); }
struct Unit { int pm, pn; };
struct Gemm { const bf16_t* A; const bf16_t* Bt; int M, N, K; };
struct StaticOrder {
    int nM, nN, nwg, G, c;
    __host__ __device__ void init(int M, int N, int G_, int c_) { nM = M / BM; nN = N / BM; nwg = nM * nN; G = G_; c = c_; }
    __host__ __device__ bool next(int i, Unit& u) const {
        const long L = (long)i * G + c; if (L >= nwg) return false;
        int wgid = (int)L; { const int q = nwg / NXCD, r = nwg % NXCD, xcd = wgid % NXCD, off = wgid / NXCD; wgid = (xcd < r ? xcd * (q + 1) : r * (q + 1) + (xcd - r) * q) + off; }
        const int nig = WGM * nN, gid = wgid / nig, fm = gid * WGM, gsz = (nM - fm) < WGM ? (nM - fm) : WGM;
        u.pm = fm + ((wgid % nig) % gsz); u.pn = (wgid % nig) / gsz; return true;
    }
};

template <class Epi>
__device__ __forceinline__ void gemm_phase(LAS unsigned char* lds, const Gemm g, const StaticOrder& S, const Epi& E) {
    int tid = threadIdx.x; asm volatile("" : "+v"(tid));
    const int wid = __builtin_amdgcn_readfirstlane(tid >> 6), lane = tid & 63, wr = wid >> 2, wc = wid & 3, fr = lane & 15, fq = lane >> 4;
    const int K = g.K, nt = K / BK;
    unsigned voffA[2], voffB[2];
#pragma unroll
    for (int i = 0; i < 2; ++i) { int R, C; stage_rc(tid * 16 + i * 8192, R, C); const int Rb = Epi::LINE ? ((R >> 5) * 64 + perm32(R & 31)) : (Epi::PERM ? ((R & ~31) + perm32(R & 31)) : R);
        voffA[i] = (unsigned)(R * K + C) * 2u; voffB[i] = (unsigned)(Rb * K + C) * 2u; }
    const size_t kstep = (size_t)(BK * 2);
    const size_t hstep = (size_t)HALF * K * 2;
    const size_t tstep = 2 * hstep;
    const size_t hstepB = Epi::LINE ? (size_t)32 * K * 2 : hstep;
    const unsigned ldsw = (unsigned)wid * 1024u;
    const int aoff = lds_byte(wr * 64 + fr, fq * 8), boff = lds_byte(wc * 32 + fr, fq * 8);
#define PG8_SA(b, h) (((b) * 2 + (h)) * HTB)
#define PG8_SB(b, h) ((4 + (b) * 2 + (h)) * HTB)
#define PG8_STAGE(bufoff, gbase, voff) do { _Pragma("unroll") for (int _i = 0; _i < 2; ++_i) \
        __builtin_amdgcn_global_load_lds((const unsigned*)((const char*)(gbase) + (voff)[_i]), (LAS unsigned*)(lds + (bufoff) + ldsw + _i * 8192), 16, 0, 0); } while (0)
#define PG8_LDA(dst, b, h) do { _Pragma("unroll") for (int m = 0; m < 4; ++m) _Pragma("unroll") for (int k = 0; k < 2; ++k) dst[m][k] = *(const LAS bf16x8*)(lds + PG8_SA(b, h) + aoff + m * 2048 + k * 1024); } while (0)
#define PG8_LDB(dst, b, h) do { _Pragma("unroll") for (int n = 0; n < 2; ++n) _Pragma("unroll") for (int k = 0; k < 2; ++k) dst[n][k] = *(const LAS bf16x8*)(lds + PG8_SB(b, h) + boff + n * 2048 + k * 1024); } while (0)
#define PG8_MMA(ai, bj, At, Bt) do { __builtin_amdgcn_s_setprio(1); _Pragma("unroll") for (int m = 0; m < 4; ++m) _Pragma("unroll") for (int n = 0; n < 2; ++n) _Pragma("unroll") for (int k = 0; k < 2; ++k) \
        acc[ai][bj][m][n] = __builtin_amdgcn_mfma_f32_16x16x32_bf16(Bt[n][k], At[m][k], acc[ai][bj][m][n], 0, 0, 0); __builtin_amdgcn_s_setprio(0); } while (0)
#define PG8_WAIT_V(n) asm volatile("s_waitcnt vmcnt(" #n ")" ::: "memory")
#define PG8_WAIT_L(n) asm volatile("s_waitcnt lgkmcnt(" #n ")" ::: "memory")
#define PG8_BAR __builtin_amdgcn_s_barrier()
#define PG8_SCHED __builtin_amdgcn_sched_barrier(0)
    Unit cur, nxt; int ui = 0;
    if (!S.next(0, cur)) return;
    f32x4 acc[2][2][4][2];
#pragma unroll
    for (int a = 0; a < 2; ++a)
#pragma unroll
        for (int b = 0; b < 2; ++b)
#pragma unroll
            for (int m = 0; m < 4; ++m)
#pragma unroll
                for (int n = 0; n < 2; ++n) acc[a][b][m][n] = (f32x4){0.f, 0.f, 0.f, 0.f};
    bf16x8 At[4][2], B0[2][2], B1[2][2];
    const char* cA = (const char*)g.A + (size_t)cur.pm * tstep; const char* cB = (const char*)g.Bt + (size_t)cur.pn * tstep;
    PG8_STAGE(PG8_SB(0, 0), cB, voffB); PG8_STAGE(PG8_SA(0, 0), cA, voffA); PG8_STAGE(PG8_SB(0, 1), cB + hstepB, voffB); PG8_STAGE(PG8_SA(0, 1), cA + hstep, voffA);
    if (wr == 1) PG8_BAR;
    PG8_WAIT_V(4); PG8_BAR;
    PG8_STAGE(PG8_SB(1, 0), cB + kstep, voffB); PG8_STAGE(PG8_SA(1, 0), cA + kstep, voffA); PG8_STAGE(PG8_SB(1, 1), cB + hstepB + kstep, voffB);
    PG8_WAIT_V(6); PG8_BAR;
    for (;;) {
        const bool has_next = S.next(ui + 1, nxt);
        const char* nA = has_next ? (const char*)g.A + (size_t)nxt.pm * tstep : cA; const char* nB = has_next ? (const char*)g.Bt + (size_t)nxt.pn * tstep : cB;
        for (int t = 0; t < nt; t += 2) {
            const bool last = (t == nt - 2);
            const char* a1 = cA + (size_t)(t + 1) * kstep;
            const char* a2 = last ? nA : cA + (size_t)(t + 2) * kstep; const char* b2 = last ? nB : cB + (size_t)(t + 2) * kstep;
            const char* a3 = a2 + kstep; const char* b3 = b2 + kstep;
            if constexpr (Epi::HAS_MID) { if (t == nt / 2) E.mid(acc, cur, wr, wc, fr, fq); }
            PG8_LDB(B0, 0, 0); PG8_SCHED; PG8_LDA(At, 0, 0); PG8_STAGE(PG8_SA(1, 1), a1 + hstep, voffA);
            PG8_WAIT_L(8); PG8_BAR; PG8_WAIT_L(0); PG8_MMA(0, 0, At, B0); PG8_BAR; PG8_SCHED;
            PG8_LDB(B1, 0, 1); PG8_STAGE(PG8_SB(0, 0), b2, voffB);
            PG8_BAR; PG8_WAIT_L(0); PG8_MMA(0, 1, At, B1); PG8_BAR;
            PG8_LDA(At, 0, 1); PG8_STAGE(PG8_SA(0, 0), a2, voffA);
            PG8_BAR; PG8_WAIT_L(0); PG8_MMA(1, 0, At, B0); PG8_BAR; PG8_SCHED;
            PG8_STAGE(PG8_SB(0, 1), b2 + hstepB, voffB);
            PG8_WAIT_V(6); PG8_BAR; PG8_MMA(1, 1, At, B1); PG8_BAR;
            PG8_LDB(B0, 1, 0); PG8_SCHED; PG8_LDA(At, 1, 0); PG8_STAGE(PG8_SA(0, 1), a2 + hstep, voffA);
            PG8_WAIT_L(8); PG8_BAR; PG8_WAIT_L(0); PG8_MMA(0, 0, At, B0); PG8_BAR; PG8_SCHED;
            PG8_LDB(B1, 1, 1); PG8_STAGE(PG8_SB(1, 0), b3, voffB);
            PG8_BAR; PG8_WAIT_L(0); PG8_MMA(0, 1, At, B1); PG8_BAR;
            PG8_LDA(At, 1, 1); PG8_STAGE(PG8_SA(1, 0), a3, voffA);
            PG8_BAR; PG8_WAIT_L(0); PG8_MMA(1, 0, At, B0); PG8_BAR; PG8_SCHED;
            PG8_STAGE(PG8_SB(1, 1), b3 + hstepB, voffB);
            PG8_WAIT_V(6); PG8_BAR; PG8_MMA(1, 1, At, B1); PG8_BAR;
        }
        E(acc, cur, wr, wc, fr, fq);
        if (!has_next) break;
#pragma unroll
        for (int a = 0; a < 2; ++a)
#pragma unroll
            for (int b = 0; b < 2; ++b)
#pragma unroll
                for (int m = 0; m < 4; ++m)
#pragma unroll
                    for (int n = 0; n < 2; ++n) acc[a][b][m][n] = (f32x4){0.f, 0.f, 0.f, 0.f};
        cur = nxt; cA = nA; cB = nB; ++ui;
    }
    PG8_WAIT_V(0);
    if (wr == 0) PG8_BAR;
    PG8_BAR;
#undef PG8_SA
#undef PG8_SB
#undef PG8_STAGE
#undef PG8_LDA
#undef PG8_LDB
#undef PG8_MMA
#undef PG8_WAIT_V
#undef PG8_WAIT_L
#undef PG8_BAR
#undef PG8_SCHED
}
}
using pg8::Unit; using pg8::Gemm;

__device__ __forceinline__ void line_pair(u32x4& a, u32x4& b, bool lo) {
#pragma unroll
    for (int q = 0; q < 4; ++q) {
        const unsigned send = lo ? b[q] : a[q];
        const unsigned recv = (unsigned)__builtin_amdgcn_update_dpp(0, (int)send, 0x128  , 0xf, 0xf, false);
        if (lo) b[q] = recv; else a[q] = recv;
    }
}
struct EpiBf16 {
    static constexpr bool PERM = true, HAS_MID = false, LINE = true;
    bf16_t* O; int ldc; const float* ss; int sig_from; const float* rope; int rope_below; int qkv_tiles; bf16_t* gates;
    __device__ __forceinline__ bf16_t* addr(int row, int col, int pn) const {
        if (qkv_tiles > 0) {
            if (pn < qkv_tiles) return O + (size_t)(col >> 9) * ((size_t)T * 512) + ((size_t)((row >> 11) * 8 + ((col >> 6) & 7)) * SEQ + (row & (SEQ - 1))) * 64 + (col & 63);
            return gates + (size_t)row * 2048 + (col - 256 * qkv_tiles);
        }
        return O + (size_t)row * ldc + col;
    }
    __device__ __forceinline__ void operator()(const f32x4 (&acc)[2][2][4][2], const Unit& u, int wr, int wc, int fr, int fq) const {
        const int row0 = u.pm * 256 + wr * 64 + fr, col0 = u.pn * 256 + wc * 64 + 8 * fq;
        const bool sig = u.pn >= sig_from, lo = fr < 8;
#pragma unroll
        for (int ai = 0; ai < 2; ++ai)
#pragma unroll
            for (int m = 0; m < 4; ++m) {
                const int row = row0 + ai * 128 + m * 16;
                const float rs = ss ? rstd_of(ss, row) : 1.f;
                u32x4 o[2];
#pragma unroll
                for (int bj = 0; bj < 2; ++bj) {
                    f32x4 v0 = acc[ai][bj][m][0] * rs, v1 = acc[ai][bj][m][1] * rs;
                    if (sig) {
#pragma unroll
                        for (int j = 0; j < 4; ++j) { v0[j] = sigmoidf_(v0[j]); v1[j] = sigmoidf_(v1[j]); }
                    }
                    if (bj == 0 && u.pn < rope_below) {
                        f32x4 p0, p1;
#pragma unroll
                        for (int j = 0; j < 4; ++j) { p0[j] = __shfl_xor(v0[j], 16); p1[j] = __shfl_xor(v1[j], 16); }
                        if (fq < 2) {
                            const f32x4 c0 = *(const f32x4*)(rope + (size_t)row * 16), c1 = *(const f32x4*)(rope + (size_t)row * 16 + 4);
                            f32x4 s0 = *(const f32x4*)(rope + (size_t)row * 16 + 8), s1 = *(const f32x4*)(rope + (size_t)row * 16 + 12);
                            if (fq == 0) { s0 = -s0; s1 = -s1; }
                            v0 = v0 * c0 + p0 * s0; v1 = v1 * c1 + p1 * s1;
                        }
                    }
                    o[bj][0] = pk_bf16(v0[0], v0[1]); o[bj][1] = pk_bf16(v0[2], v0[3]); o[bj][2] = pk_bf16(v1[0], v1[1]); o[bj][3] = pk_bf16(v1[2], v1[3]);
                }
                line_pair(o[0], o[1], lo);
                const int colx = col0 + (lo ? 0 : 32);
                *(u32x4*)addr(lo ? row : row - 8, colx, u.pn) = o[0];
                *(u32x4*)addr(lo ? row + 8 : row, colx, u.pn) = o[1];
            }
    }
};
struct EpiGate {
    static constexpr bool PERM = true, HAS_MID = true, LINE = true;
    const bf16_t* gates; bf16_t* O;
    __device__ __forceinline__ void mid(f32x4 (&acc)[2][2][4][2], const Unit& u, int wr, int wc, int fr, int fq) const {
        int row0 = u.pm * 256 + wr * 64 + fr, col0 = u.pn * 256 + wc * 64 + 8 * fq;
        asm volatile("" : "+v"(row0), "+v"(col0));
#pragma unroll
        for (int ai = 0; ai < 2; ++ai)
#pragma unroll
            for (int m = 0; m < 4; ++m) {
                const int row = row0 + ai * 128 + m * 16;
#pragma unroll
                for (int bj = 0; bj < 2; ++bj) {
                    const int col = col0 + bj * 32;
                    const u32x4 ga = *(const u32x4*)(gates + (size_t)row * 2048 + col), gb = *(const u32x4*)(gates + (size_t)row * 2048 + 1024 + col);
#pragma unroll
                    for (int q = 0; q < 4; ++q) {
                        const float a0 = bflo(ga[q]), a1 = bfhi(ga[q]), b0 = fmaxf(bflo(gb[q]), -60.f), b1 = fmaxf(bfhi(gb[q]), -60.f);
                        const float r0 = (1.f + __expf(-b0)) * __builtin_amdgcn_rcpf(1.f + __expf(-a0)), r1 = (1.f + __expf(-b1)) * __builtin_amdgcn_rcpf(1.f + __expf(-a1));
                        acc[ai][bj][m][q >> 1][(q & 1) * 2] *= r0; acc[ai][bj][m][q >> 1][(q & 1) * 2 + 1] *= r1;
                    }
                }
                __builtin_amdgcn_sched_barrier(0);
            }
    }
    __device__ __forceinline__ void operator()(const f32x4 (&acc)[2][2][4][2], const Unit& u, int wr, int wc, int fr, int fq) const {
        const int row0 = u.pm * 256 + wr * 64 + fr, col0 = u.pn * 256 + wc * 64 + 8 * fq; const bool lo = fr < 8;
#pragma unroll
        for (int ai = 0; ai < 2; ++ai)
#pragma unroll
            for (int m = 0; m < 4; ++m) {
                const int row = row0 + ai * 128 + m * 16;
                u32x4 oo[2];
#pragma unroll
                for (int bj = 0; bj < 2; ++bj) {
                    const int col = col0 + bj * 32;
                    const u32x4 gb = *(const u32x4*)(gates + (size_t)row * 2048 + 1024 + col);
                    float r[8];
#pragma unroll
                    for (int q = 0; q < 4; ++q) {
                        const float b0 = fmaxf(bflo(gb[q]), -60.f), b1 = fmaxf(bfhi(gb[q]), -60.f);
                        r[2 * q] = acc[ai][bj][m][q >> 1][(q & 1) * 2] * __builtin_amdgcn_rcpf(1.f + __expf(-b0));
                        r[2 * q + 1] = acc[ai][bj][m][q >> 1][(q & 1) * 2 + 1] * __builtin_amdgcn_rcpf(1.f + __expf(-b1));
                    }
                    oo[bj][0] = pk_bf16(r[0], r[1]); oo[bj][1] = pk_bf16(r[2], r[3]); oo[bj][2] = pk_bf16(r[4], r[5]); oo[bj][3] = pk_bf16(r[6], r[7]);
                }
                line_pair(oo[0], oo[1], lo);
                const int colx = col0 + (lo ? 0 : 32);
                *(u32x4*)(O + (size_t)(lo ? row : row - 8) * DM + colx) = oo[0];
                *(u32x4*)(O + (size_t)(lo ? row + 8 : row) * DM + colx) = oo[1];
            }
    }
};
struct EpiRes {
    static constexpr bool PERM = true, HAS_MID = false, LINE = true;
    const float* R; const bf16_t* Rb; float* H; bf16_t* Hb; float* SS;
    __device__ __forceinline__ void operator()(const f32x4 (&acc)[2][2][4][2], const Unit& u, int wr, int wc, int fr, int fq) const {
        const int row0 = u.pm * 256 + wr * 64 + fr, col0 = u.pn * 256 + wc * 64 + 8 * fq; const bool lo = fr < 8;
#pragma unroll
        for (int ai = 0; ai < 2; ++ai)
#pragma unroll
            for (int m = 0; m < 4; ++m) {
                const int row = row0 + ai * 128 + m * 16;
                float s = 0.f; u32x4 ob[2];
#pragma unroll
                for (int bj = 0; bj < 2; ++bj) {
                    const int col = col0 + bj * 32;
                    f32x4 r0, r1;
                    if (R) { r0 = *(const f32x4*)(R + (size_t)row * DM + col); r1 = *(const f32x4*)(R + (size_t)row * DM + col + 4); }
                    else { const u32x4 rb = *(const u32x4*)(Rb + (size_t)row * DM + col);
                        r0[0] = bflo(rb[0]); r0[1] = bfhi(rb[0]); r0[2] = bflo(rb[1]); r0[3] = bfhi(rb[1]); r1[0] = bflo(rb[2]); r1[1] = bfhi(rb[2]); r1[2] = bflo(rb[3]); r1[3] = bfhi(rb[3]); }
                    const f32x4 h0 = r0 + acc[ai][bj][m][0], h1 = r1 + acc[ai][bj][m][1];
                    if (H) { *(f32x4*)(H + (size_t)row * DM + col) = h0; *(f32x4*)(H + (size_t)row * DM + col + 4) = h1; }
                    ob[bj][0] = pk_bf16(h0[0], h0[1]); ob[bj][1] = pk_bf16(h0[2], h0[3]); ob[bj][2] = pk_bf16(h1[0], h1[1]); ob[bj][3] = pk_bf16(h1[2], h1[3]);
                    s += ((h0[0] * h0[0] + h0[1] * h0[1]) + (h0[2] * h0[2] + h0[3] * h0[3])) + ((h1[0] * h1[0] + h1[1] * h1[1]) + (h1[2] * h1[2] + h1[3] * h1[3]));
                }
                if (Hb) { line_pair(ob[0], ob[1], lo); const int colx = col0 + (lo ? 0 : 32);
                    *(u32x4*)(Hb + (size_t)(lo ? row : row - 8) * DM + colx) = ob[0]; *(u32x4*)(Hb + (size_t)(lo ? row + 8 : row) * DM + colx) = ob[1]; }
                s += __shfl_xor(s, 16); s += __shfl_xor(s, 32);
                if (fq == 0) SS[(size_t)row * 16 + u.pn * 4 + wc] = s;
            }
    }
};
struct EpiSwiGLU {
    static constexpr bool PERM = true, HAS_MID = false, LINE = false;
    bf16_t* O; const float* ss;
    __device__ __forceinline__ void operator()(const f32x4 (&acc)[2][2][4][2], const Unit& u, int wr, int wc, int fr, int fq) const {
        const int row0 = u.pm * 256 + wr * 64 + fr, col0 = u.pn * 128 + wc * 32 + 8 * fq;
#pragma unroll
        for (int ai = 0; ai < 2; ++ai)
#pragma unroll
            for (int m = 0; m < 4; ++m) {
                const int row = row0 + ai * 128 + m * 16;
                const float rs = rstd_of(ss, row);
                float r[8];
#pragma unroll
                for (int n = 0; n < 2; ++n)
#pragma unroll
                    for (int j = 0; j < 4; ++j) { const float gg = acc[ai][0][m][n][j] * rs, uu = acc[ai][1][m][n][j] * rs; r[n * 4 + j] = gg * sigmoidf_(gg) * uu; }
                u32x4 o; o[0] = pk_bf16(r[0], r[1]); o[1] = pk_bf16(r[2], r[3]); o[2] = pk_bf16(r[4], r[5]); o[3] = pk_bf16(r[6], r[7]);
                *(u32x4*)(O + (size_t)row * DFF + col0) = o;
            }
    }
};

struct Ctx { int tid, lane, wave, gw, ngw, gt, ngt; };

__device__ __forceinline__ void p_transpose(const Ctx& c, LAS unsigned char* lds, const float* W, bf16_t* Wt, int K, int N, const float* g, int mode, int& cursor, int ldw = 0, int koff = 0) {
    if (ldw == 0) ldw = K;
    LAS float* scr = (LAS float*)(lds + c.wave * 8704);
    const int nblk = N / 32, nitems = (K / 64) * nblk, lane = c.lane;
    int first = (c.gw - cursor % c.ngw + c.ngw) % c.ngw;
    for (int it = first; it < nitems; it += c.ngw) {
        const int kb = it / nblk, nb = it % nblk, k0 = 64 * kb, n0 = 32 * nb;
#pragma unroll 8
        for (int i = 0; i < 32; ++i) { const int kk = 2 * i + (lane >> 5); float v = W[(size_t)(k0 + kk) * N + n0 + (lane & 31)]; if (g) v *= g[k0 + kk]; scr[kk * 33 + (lane & 31)] = v; }
        asm volatile("s_waitcnt lgkmcnt(0)" ::: "memory");
        const int ch = lane & 7;
#pragma unroll
        for (int j = 0; j < 4; ++j) { const int n = (lane >> 3) + 8 * j; const LAS float* sp = scr + (8 * ch) * 33 + n;
            u32x4 o; o[0] = pk_bf16(sp[0], sp[33]); o[1] = pk_bf16(sp[2 * 33], sp[3 * 33]); o[2] = pk_bf16(sp[4 * 33], sp[5 * 33]); o[3] = pk_bf16(sp[6 * 33], sp[7 * 33]);
            const int nn = n0 + n, row = mode == 0 ? nn : (256 * (nn >> 7) + (nn & 127) + (mode == 2 ? 128 : 0));
            *(u32x4*)(Wt + (size_t)row * ldw + koff + k0 + 8 * ch) = o; }
        asm volatile("s_waitcnt lgkmcnt(0)" ::: "memory");
    }
    cursor += nitems;
}
__device__ __forceinline__ void p_rmsnorm_rows(const Ctx& c, const float* x, const float* g, bf16_t* out, int rows) {
    f32x4 gg[4];
#pragma unroll
    for (int j = 0; j < 4; ++j) gg[j] = ((const f32x4*)g)[c.lane + 64 * j];
    for (int r0 = c.gw; r0 < rows; r0 += 2 * c.ngw) {
        const int r1 = r0 + c.ngw; const bool has1 = r1 < rows; const int r1c = has1 ? r1 : r0;
        const f32x4* xa = (const f32x4*)(x + (size_t)r0 * DM) + c.lane; const f32x4* xb = (const f32x4*)(x + (size_t)r1c * DM) + c.lane;
        f32x4 va[4], vb[4]; float sa = 0.f, sb = 0.f;
#pragma unroll
        for (int j = 0; j < 4; ++j) { va[j] = xa[64 * j]; vb[j] = xb[64 * j]; }
#pragma unroll
        for (int j = 0; j < 4; ++j) { sa += (va[j][0] * va[j][0] + va[j][1] * va[j][1]) + (va[j][2] * va[j][2] + va[j][3] * va[j][3]); sb += (vb[j][0] * vb[j][0] + vb[j][1] * vb[j][1]) + (vb[j][2] * vb[j][2] + vb[j][3] * vb[j][3]); }
        const float ra = rsqrtf(wave_sum(sa) * (1.f / DM) + EPS), rb = rsqrtf(wave_sum(sb) * (1.f / DM) + EPS);
#pragma unroll
        for (int j = 0; j < 4; ++j) {
            u32x2 o; o[0] = pk_bf16(va[j][0] * ra * gg[j][0], va[j][1] * ra * gg[j][1]); o[1] = pk_bf16(va[j][2] * ra * gg[j][2], va[j][3] * ra * gg[j][3]);
            ((u32x2*)(out + (size_t)r0 * DM))[c.lane + 64 * j] = o;
            if (has1) { u32x2 q; q[0] = pk_bf16(vb[j][0] * rb * gg[j][0], vb[j][1] * rb * gg[j][1]); q[1] = pk_bf16(vb[j][2] * rb * gg[j][2], vb[j][3] * rb * gg[j][3]);
                ((u32x2*)(out + (size_t)r1 * DM))[c.lane + 64 * j] = q; }
        }
    }
}
__device__ __forceinline__ void p_rope_table(const Ctx& c, const int* pos, float* tab) {
    for (int i = c.gt; i < T * 8; i += c.ngt) {
        const int tok = i >> 3, f = i & 7;
        const double inv = f == 0 ? 1.0 : f == 1 ? 0.19392274474868576 : f == 2 ? 0.03760603093086393 : f == 3 ? 0.007292664737217109 : f == 4 ? 0.001414213562373095 :
                           f == 5 ? 0.0002742481756762073 : f == 6 ? 5.318295896944988e-05 : 1.031338537721246e-05;
        const double rev = (double)pos[tok] * inv * 0.15915494309189535;
        const float fr = (float)(rev - rint(rev));
        tab[(size_t)tok * 16 + f] = __builtin_amdgcn_cosf(fr);
        tab[(size_t)tok * 16 + 8 + f] = __builtin_amdgcn_sinf(fr);
    }
}
__device__ __forceinline__ void p_final(const Ctx& c, float* out, const float* ss, const float* g) {
    f32x4 gg[4];
#pragma unroll
    for (int j = 0; j < 4; ++j) gg[j] = ((const f32x4*)g)[c.lane + 64 * j];
    for (int r0 = c.gw; r0 < T; r0 += 2 * c.ngw) {
        const int r1 = r0 + c.ngw; const bool has1 = r1 < T; const int r1c = has1 ? r1 : r0;
        f32x4* xa = (f32x4*)(out + (size_t)r0 * DM) + c.lane; f32x4* xb = (f32x4*)(out + (size_t)r1c * DM) + c.lane;
        f32x4 va[4], vb[4];
#pragma unroll
        for (int j = 0; j < 4; ++j) { va[j] = xa[64 * j]; vb[j] = xb[64 * j]; }
        const float ra = rstd_of(ss, r0), rb = rstd_of(ss, r1c);
#pragma unroll
        for (int j = 0; j < 4; ++j) { xa[64 * j] = va[j] * ra * gg[j]; if (has1) xb[64 * j] = vb[j] * rb * gg[j]; }
    }
}

typedef float f32x16 __attribute__((ext_vector_type(16)));
typedef short s16x4 __attribute__((ext_vector_type(4)));
#define MFMA32(a, b, c) __builtin_amdgcn_mfma_f32_32x32x16_bf16((a), (b), (c), 0, 0, 0)
constexpr int ATT_FLAG_OFF = 40960;
#ifndef ATT_DUP_A
#define ATT_DUP_A 0
#endif
#ifndef ATT_DUP_B
#define ATT_DUP_B 0
#endif
template <int MODE, int HDIM, int KT>
__device__ __forceinline__ void attn_item(LAS unsigned char* lds, const bf16_t* Qp, int ldq, const bf16_t* Kp, const bf16_t* Vp, int ldkv, bf16_t* Op, int ldo, int q0, int nkeys) {
    constexpr int KS = HDIM / 16, DD = HDIM / 32, KROW = HDIM * 2 + 16, NCH = HDIM / 8, PER = KT * NCH / 512, NSUB = KT / 32;
    static_assert(2 * KT * KROW + 128 <= ATT_FLAG_OFF, "attention LDS tiles overlap the flag words");
    int tid = threadIdx.x; asm volatile("" : "+v"(tid));
    const int lane = tid & 63, w = __builtin_amdgcn_readfirstlane(tid >> 6), r = lane & 31, hh = lane >> 5;
    const int tq0 = q0 + 32 * w, tq = tq0 + r;
    LAS unsigned char* Ks = lds; LAS unsigned char* Vr = lds + KT * KROW;
    const int trq = (r & 15) >> 2, trp = r & 3, trb = r & 16;
    LAS unsigned* flags = (LAS unsigned*)(lds + ATT_FLAG_OFF);
    bf16x8 Qf[KS];
#pragma unroll
    for (int ks = 0; ks < KS; ++ks) Qf[ks] = *(const bf16x8*)(Qp + (size_t)tq * ldq + 16 * ks + 8 * hh);
    f32x16 Oacc[DD];
#pragma unroll
    for (int dd = 0; dd < DD; ++dd)
#pragma unroll
        for (int i = 0; i < 16; ++i) Oacc[dd][i] = 0.f;
    float m = -INFINITY, l = 0.f, run = (MODE == 1) ? 1.f : 0.f; unsigned done_w = 0u;
    float w8[8], u4[4], fgc[4], fmn[16], fbias = 0.f;
    if (MODE == 0) {
        const int cc = r & 15, e = cc & 3, f = cc >> 3; const bool act = (hh == ((cc >> 2) & 1)); const int c4 = r & 3;
#pragma unroll
        for (int i = 0; i < 8; ++i) { w8[i] = (act && (i & 3) == e && (i >> 2) == f) ? 1.f : 0.f; asm volatile("" : "+v"(w8[i])); }
        fbias = act ? 0.f : -INFINITY; asm volatile("" : "+v"(fbias));
#pragma unroll
        for (int j = 0; j < 4; ++j) { u4[j] = (j == c4) ? 1.f : 0.f; asm volatile("" : "+v"(u4[j])); }
#pragma unroll
        for (int g = 0; g < 4; ++g) { fgc[g] = (((r - 4 * hh - c4 - 8 * g) & 15) == 0) ? 2.f : 1.f; asm volatile("" : "+v"(fgc[g])); }
#pragma unroll
        for (int i = 0; i < 16; ++i) { const int dm = (r - 4 * hh - ((i & 3) + 8 * (i >> 2))) & 15; fmn[i] = 1.f + ((dm & 3) == 0 ? 1.f : 0.f) + (dm == 0 ? 1.f : 0.f); asm volatile("" : "+v"(fmn[i])); }
    }
    const int kt_hi = (MODE == 2) ? (nkeys / KT - 1) : ((q0 + 255) / KT);
    u32x4 kA[PER], vA[PER], kB[PER], vB[PER];
#define ATT_GLOAD(KR, VR, kt) do { _Pragma("unroll") for (int p_ = 0; p_ < PER; ++p_) { const int idx_ = tid + 512 * p_, key_ = idx_ / NCH, ch_ = idx_ % NCH; \
        KR[p_] = *(const u32x4*)(Kp + (size_t)(KT * (kt) + key_) * ldkv + ch_ * 8); VR[p_] = *(const u32x4*)(Vp + (size_t)(KT * (kt) + key_) * ldkv + ch_ * 8); } } while (0)
    auto stage = [&](const u32x4 (&KR)[PER], const u32x4 (&VR)[PER]) -> bool {
        if (MODE == 1 && lane == 0) flags[w] = done_w;
        __syncthreads();
#pragma unroll
        for (int p_ = 0; p_ < PER; ++p_) { const int idx_ = tid + 512 * p_, key_ = idx_ / NCH, ch_ = idx_ % NCH;
            *(LAS u32x4*)(Ks + key_ * KROW + ch_ * 16) = KR[p_];
            *(LAS u32x4*)(Vr + key_ * KROW + ch_ * 16) = VR[p_];
        }
        bool alldone = false;
        if (MODE == 1) { unsigned a = 1u;
#pragma unroll
            for (int i = 0; i < 8; ++i) a &= flags[i];
            alldone = a != 0u; }
        __syncthreads();
        return alldone;
    };
    auto qk = [&](int sub, f32x16& S) {
        bf16x8 kf[KS];
#pragma unroll
        for (int ks = 0; ks < KS; ++ks) kf[ks] = *(const LAS bf16x8*)(Ks + (32 * sub + r) * KROW + (16 * ks + 8 * hh) * 2);
#pragma unroll
        for (int i = 0; i < 16; ++i) S[i] = 0.f;
        __builtin_amdgcn_sched_barrier(0);
#pragma unroll
        for (int ks = 0; ks < KS; ++ks) S = MFMA32(kf[ks], Qf[ks], S);
    };
    auto compute = [&](int kt) {
        f32x16 Sn; bool an;
        { const int tkn = KT * kt + 32 * (NSUB - 1); an = !((MODE != 2 && tkn > tq0 + 31) || (MODE == 1 && done_w)); if (an) qk(NSUB - 1, Sn); }
#pragma unroll
        for (int sub = NSUB - 1; sub >= 0; --sub) {
            const int tk0 = KT * kt + 32 * sub;
            f32x16 S = Sn; const bool a = an;
            if (sub > 0) { const int tkn = tk0 - 32; an = !((MODE != 2 && tkn > tq0 + 31) || (MODE == 1 && done_w)); if (an) qk(sub - 1, Sn); }
            if (!a) continue;
            s16x4 vlo[DD][2], vhi[DD][2];
#pragma unroll
            for (int dd = 0; dd < DD; ++dd)
#pragma unroll
                for (int s2 = 0; s2 < 2; ++s2) {
                    LAS unsigned char* vp = Vr + (32 * sub + 16 * s2 + 4 * hh + trq) * KROW + (32 * dd + trb) * 2 + 8 * trp;
                    vlo[dd][s2] = __builtin_amdgcn_ds_read_tr16_b64_v4i16((LAS s16x4*)vp); vhi[dd][s2] = __builtin_amdgcn_ds_read_tr16_b64_v4i16((LAS s16x4*)(vp + 8 * KROW));
                }
            __builtin_amdgcn_sched_barrier(0);
            const int dbase = tq - tk0 - 4 * hh;
            const int D = tq0 - tk0;
            if (MODE == 0 || MODE == 2) {
                const float C = (MODE == 0 ? 0.125f : 0.08838834764831845f) * 1.4426950408889634f;
                float alpha, ls = 0.f, mn;
                if (MODE == 0 && D >= 544) {
                    float s1 = S[0] * w8[0], s2 = S[8] * w8[0];
#pragma unroll
                    for (int i = 1; i < 8; ++i) { s1 = fmaf(S[i], w8[i], s1); s2 = fmaf(S[8 + i], w8[i], s2); }
                    const float v1 = fmaf(s1, C, fbias), v2 = fmaf(s2, C, fbias);
                    float mx = fmaxf(v1, v2); mx = fmaxf(mx, __shfl_xor(mx, 32));
                    mn = fmaxf(m, mx);
                    alpha = __builtin_amdgcn_exp2f(m - mn);
                    const float p1 = __builtin_amdgcn_exp2f(v1 - mn), p2 = __builtin_amdgcn_exp2f(v2 - mn);
                    ls = p1 + p2;
#pragma unroll
                    for (int i = 0; i < 8; ++i) { S[i] = w8[i] * p1; S[8 + i] = w8[i] * p2; }
                } else if (MODE == 0 && D >= 160 && D <= 480) {
                    float vg[4]; float mx = -INFINITY;
#pragma unroll
                    for (int g = 0; g < 4; ++g) { vg[g] = (fmaf(S[4 * g + 3], u4[3], fmaf(S[4 * g + 2], u4[2], fmaf(S[4 * g + 1], u4[1], S[4 * g] * u4[0])))) * C; mx = fmaxf(mx, vg[g]); }
                    mx = fmaxf(mx, __shfl_xor(mx, 32));
                    mn = fmaxf(m, mx);
                    alpha = __builtin_amdgcn_exp2f(m - mn);
#pragma unroll
                    for (int g = 0; g < 4; ++g) { const float pg = fgc[g] * __builtin_amdgcn_exp2f(vg[g] - mn); ls += pg;
#pragma unroll
                        for (int j = 0; j < 4; ++j) S[4 * g + j] = u4[j] * pg; }
                } else if (MODE == 0 && D >= 32 && D <= 96) {
                    float mx = -INFINITY;
#pragma unroll
                    for (int i = 0; i < 16; ++i) { S[i] = S[i] * C; mx = fmaxf(mx, S[i]); }
                    mx = fmaxf(mx, __shfl_xor(mx, 32));
                    mn = fmaxf(m, mx);
                    alpha = __builtin_amdgcn_exp2f(m - mn);
#pragma unroll
                    for (int i = 0; i < 16; ++i) { const float p = fmn[i] * __builtin_amdgcn_exp2f(S[i] - mn); S[i] = p; ls += p; }
                } else {
                    float fm[16]; float mx = -INFINITY;
#pragma unroll
                    for (int i = 0; i < 16; ++i) {
                        float v = S[i] * C;
                        if (MODE == 0) { const int d = dbase - ((i & 3) + 8 * (i >> 2));
                            int mult = (d <= 128 ? 1 : 0) + ((((d & 3) == 0) && d <= 512) ? 1 : 0) + (((d & 15) == 0) ? 1 : 0);
                            mult = d >= 0 ? mult : 0; fm[i] = (float)mult; v = mult > 0 ? v : -INFINITY; }
                        else fm[i] = 1.f;
                        S[i] = v; mx = fmaxf(mx, v);
                    }
                    mx = fmaxf(mx, __shfl_xor(mx, 32));
                    mn = fmaxf(m, mx); const float ms = (mn == -INFINITY) ? 0.f : mn;
                    alpha = __builtin_amdgcn_exp2f(m - ms);
#pragma unroll
                    for (int i = 0; i < 16; ++i) { const float p = fm[i] * __builtin_amdgcn_exp2f(S[i] - ms); S[i] = p; ls += p; }
                }
                l = l * alpha + ls; m = mn;
                if (!__all(alpha == 1.f)) {
#pragma unroll
                    for (int dd = 0; dd < DD; ++dd) Oacc[dd] = Oacc[dd] * alpha;
                }
            } else {
                float om[16], ex[16], G[4], PG[4];
                if (D < 32) {
#pragma unroll
                    for (int i = 0; i < 16; ++i) { const int d = dbase - ((i & 3) + 8 * (i >> 2)); const bool valid = d > 0;
                        const float x = fminf(fmaxf(S[i] * (0.125f * 1.4426950408889634f), -115.f), 115.f); const float e = __builtin_amdgcn_exp2f(x); const float o1 = __builtin_amdgcn_rcpf(1.f + e);
                        om[i] = valid ? o1 : 1.f; S[i] = valid ? e * o1 : 0.f; }
                } else {
#pragma unroll
                    for (int i = 0; i < 16; ++i) {
                        const float x = fminf(fmaxf(S[i] * (0.125f * 1.4426950408889634f), -115.f), 115.f); const float e = __builtin_amdgcn_exp2f(x); const float o1 = __builtin_amdgcn_rcpf(1.f + e);
                        om[i] = o1; S[i] = e * o1; }
                }
#pragma unroll
                for (int g = 0; g < 4; ++g) { ex[4 * g + 3] = 1.f; ex[4 * g + 2] = om[4 * g + 3]; ex[4 * g + 1] = ex[4 * g + 2] * om[4 * g + 2]; ex[4 * g] = ex[4 * g + 1] * om[4 * g + 1]; G[g] = ex[4 * g] * om[4 * g]; }
#pragma unroll
                for (int g = 0; g < 4; ++g) PG[g] = __shfl_xor(G[g], 32);
                float suf = run;
#pragma unroll
                for (int g = 3; g >= 0; --g) { const float lat = suf * (hh == 0 ? PG[g] : 1.f);
                    S[4 * g + 3] = S[4 * g + 3] * lat; S[4 * g + 2] = S[4 * g + 2] * (lat * ex[4 * g + 2]); S[4 * g + 1] = S[4 * g + 1] * (lat * ex[4 * g + 1]); S[4 * g] = S[4 * g] * (lat * ex[4 * g]);
                    suf *= G[g] * PG[g]; }
                run = suf;
                done_w = __all(run < 1e-30f) ? 1u : 0u;
            }
            u32x4 pp0, pp1;
#pragma unroll
            for (int j = 0; j < 4; ++j) { pp0[j] = pk_bf16(S[2 * j], S[2 * j + 1]); pp1[j] = pk_bf16(S[8 + 2 * j], S[8 + 2 * j + 1]); }
            const bf16x8 P0 = __builtin_bit_cast(bf16x8, pp0), P1 = __builtin_bit_cast(bf16x8, pp1);
#pragma unroll
            for (int dd = 0; dd < DD; ++dd)
#pragma unroll
                for (int s2 = 0; s2 < 2; ++s2) {
                    const bf16x8 vf = __builtin_shufflevector(vlo[dd][s2], vhi[dd][s2], 0, 1, 2, 3, 4, 5, 6, 7);
                    Oacc[dd] = MFMA32(vf, s2 ? P1 : P0, Oacc[dd]);
                }
        }
    };
    ATT_GLOAD(kA, vA, kt_hi);
    if constexpr (MODE == 2) {
#pragma unroll 1
        for (int kt = kt_hi; kt >= 0; --kt) {
            stage(kA, vA);
            if (kt >= 1) ATT_GLOAD(kA, vA, kt - 1);
            compute(kt);
        }
    } else {
        if (kt_hi >= 1) ATT_GLOAD(kB, vB, kt_hi - 1);
#pragma unroll 1
        for (int kt = kt_hi; kt >= 0; kt -= 2) {
            if (stage(kA, vA)) break;
            if (kt >= 2) ATT_GLOAD(kA, vA, kt - 2);
            compute(kt);
            if (kt == 0) break;
            if (stage(kB, vB)) break;
            if (kt >= 3) ATT_GLOAD(kB, vB, kt - 3);
            compute(kt - 1);
        }
    }
#undef ATT_GLOAD
    float inv = 1.f;
    if (MODE != 1) { const float lt = l + __shfl_xor(l, 32); inv = 1.f / lt; }
#pragma unroll
    for (int dd = 0; dd < DD; ++dd)
#pragma unroll
        for (int g = 0; g < 4; g += 2) {
            unsigned a0 = pk_bf16(Oacc[dd][4 * g] * inv, Oacc[dd][4 * g + 1] * inv), a1 = pk_bf16(Oacc[dd][4 * g + 2] * inv, Oacc[dd][4 * g + 3] * inv);
            unsigned b0 = pk_bf16(Oacc[dd][4 * g + 4] * inv, Oacc[dd][4 * g + 5] * inv), b1 = pk_bf16(Oacc[dd][4 * g + 6] * inv, Oacc[dd][4 * g + 7] * inv);
            { auto x = __builtin_amdgcn_permlane32_swap(a0, b0, false, false); a0 = x[0]; b0 = x[1]; }
            { auto x = __builtin_amdgcn_permlane32_swap(a1, b1, false, false); a1 = x[0]; b1 = x[1]; }
            u32x4 o; o[0] = a0; o[1] = a1; o[2] = b0; o[3] = b1;
            *(u32x4*)(Op + (size_t)tq * ldo + 32 * dd + 8 * g + 8 * hh) = o;
        }
}
constexpr int WQ_WORD = 4096;
__device__ __forceinline__ void p_attn_ab(LAS unsigned char* lds, const bf16_t* qkv, bf16_t* OA, bf16_t* OB, unsigned* wq) {
    constexpr size_t TS = (size_t)T * 512;
    volatile LAS unsigned* slot = (volatile LAS unsigned*)(lds + ATT_FLAG_OFF + 64);
    for (;;) {
        if (threadIdx.x == 0) *slot = __hip_atomic_fetch_add(wq, 1u, __ATOMIC_RELAXED, __HIP_MEMORY_SCOPE_AGENT);
        __syncthreads();
        const unsigned it = (unsigned)__builtin_amdgcn_readfirstlane((int)*slot);
        __syncthreads();
        if (it >= 2048u) break;
        const int j = it & 1023, qb = 7 - (j >> 7), bh = j & 127, b = bh >> 3, h = bh & 7;
        const bf16_t* base = qkv + (size_t)bh * SEQ * 64;
        if (it < 1024u) attn_item<0, 64, 128>(lds, base, 64, base + TS, base + 2 * TS, 64, OA + (size_t)b * SEQ * 1024 + h * HD, 1024, qb * 256, SEQ);
        else attn_item<1, 64, 128>(lds, base + 3 * TS, 64, base + 4 * TS, base + 5 * TS, 64, OB + (size_t)b * SEQ * 1024 + h * HD, 1024, qb * 256, SEQ);
    }
}
__device__ __forceinline__ void p_attn_mem(LAS unsigned char* lds, const bf16_t* qm, const bf16_t* kvm, bf16_t* om) {
#pragma unroll 1
    for (int i = 0;; ++i) {
        Unit u; { pg8::StaticOrder S2; S2.init(T, MEMW, (int)gridDim.x, (int)blockIdx.x); if (!S2.next(i, u)) break; }
        const int b = u.pm >> 3, qb = u.pm & 7;
#pragma unroll 1
        for (int hq = 0; hq < 2; ++hq) { const int h = 2 * u.pn + hq;
            attn_item<2, 128, 64>(lds, qm + (size_t)b * SEQ * MEMW + h * 128, MEMW, kvm + (size_t)b * NMEM * 1024 + h * 128, kvm + (size_t)b * NMEM * 1024 + 512 + h * 128, 1024,
                                  om + (size_t)b * SEQ * MEMW + h * 128, MEMW, qb * 256, NMEM); }
    }
}

__device__ __forceinline__ bool sync_if(int k, cg::grid_group& grid, XcdBarrier& xb) {
    if (k == 1) { grid.sync(); xb = xcd_barrier_post(xb.bar, xb.st); }
    else if (k == 8) {
        asm volatile("s_waitcnt vmcnt(0)" ::: "memory");
        __syncthreads();
        if (threadIdx.x == 0) { __builtin_amdgcn_fence(__ATOMIC_ACQUIRE, "agent"); asm volatile("s_waitcnt vmcnt(0)" ::: "memory"); }
        __syncthreads();
    }
    else if (k > 1) xcd_barrier(xb);
    asm volatile("" ::: "memory"); return true; }
constexpr int NPHASE = 13;
#ifndef NAIVE_AB
#define NAIVE_AB 0
#endif
#ifndef NAIVE_MEM
#define NAIVE_MEM 0
#endif
#ifndef ONLY
#define ONLY -1
#endif
#ifndef DUP_MASK
#define DUP_MASK 0
#endif
#define PHASE(k) if ((ONLY < 0 || ONLY == (k)) && ph_lo <= (k) && (k) < ph_hi) if (sync_if((k), grid, xb)) for (int rep_ = 0; rep_ < (((DUP_MASK >> (k)) & 1) ? 2 : 1); ++rep_)
__global__ __launch_bounds__(512, 2) void mega(Params p, int ph_lo, int ph_hi) {
    extern __shared__ __attribute__((aligned(16))) unsigned char shm[];
    LAS unsigned char* lds = (LAS unsigned char*)shm;
    cg::grid_group grid = cg::this_grid();
    Ctx c; c.tid = threadIdx.x; c.lane = c.tid & 63; c.wave = c.tid >> 6; c.gw = blockIdx.x * 8 + c.wave; c.ngw = gridDim.x * 8; c.gt = blockIdx.x * 512 + c.tid; c.ngt = gridDim.x * 512;
    unsigned char* ws = p.ws;
    bf16_t* Wt_in = (bf16_t*)(ws + WS_WIN); bf16_t* Wt_upa = (bf16_t*)(ws + WS_WUPA); bf16_t* Wt_upb = (bf16_t*)(ws + WS_WUPB); bf16_t* Wt_out = (bf16_t*)(ws + WS_WOUT);
    bf16_t* Wt_qm = (bf16_t*)(ws + WS_WQM); bf16_t* Wt_kvm = (bf16_t*)(ws + WS_WKVM); bf16_t* Wt_om = (bf16_t*)(ws + WS_WOM); bf16_t* Wt_gu = (bf16_t*)(ws + WS_WGU); bf16_t* Wt_dn = (bf16_t*)(ws + WS_WDN);
    bf16_t* memn = (bf16_t*)(ws + WS_MEMN); bf16_t* kvm = (bf16_t*)(ws + WS_KVM);
    float* ss1 = (float*)(ws + WS_SS1); float* ss2 = (float*)(ws + WS_SS2); float* ss3 = (float*)(ws + WS_SS3); float* rope = (float*)(ws + WS_ROPE);
    bf16_t* n1 = (bf16_t*)(ws + WS_R1); bf16_t* mixed = (bf16_t*)(ws + WS_R1); bf16_t* h2b = (bf16_t*)(ws + WS_R1);
    bf16_t* proj = (bf16_t*)(ws + WS_PROJ); bf16_t* gates = (bf16_t*)(ws + WS_PROJ + 192 * MiB);
    float* h1 = (float*)(ws + WS_H1); bf16_t* h1b = (bf16_t*)(ws + WS_H1B); bf16_t* qm = (bf16_t*)(ws + WS_QM); bf16_t* om = (bf16_t*)(ws + WS_OM);
    float* h2 = (float*)(ws + WS_H2); bf16_t* act = (bf16_t*)(ws + WS_ACT); bf16_t* OA = (bf16_t*)(ws + WS_OA); bf16_t* OB = (bf16_t*)(ws + WS_OA) + 512;
    float* m1 = p.out; unsigned* bar = (unsigned*)(ws + WS_BAR);
    volatile LAS unsigned* xst = (volatile LAS unsigned*)(lds + pg8::STAGE_BYTES);
    if (c.tid == 0) { xst[0] = 0u; xst[1] = 0u; }
    __syncthreads();
    XcdBarrier xb; xb.bar = bar; xb.x = 0u; xb.st = xst;
    pg8::StaticOrder S;
    {
        PHASE(0) {
            int cur = 0;
            p_transpose(c, lds, p.w_in, Wt_in, DM, INC, nullptr, 0, cur);
            p_transpose(c, lds, p.w_ffn_gate, Wt_gu, DM, DFF, p.g_ffn, 1, cur);
            p_transpose(c, lds, p.w_ffn_up, Wt_gu, DM, DFF, p.g_ffn, 2, cur);
            p_transpose(c, lds, p.w_ffn_down, Wt_dn, DFF, DM, nullptr, 0, cur);
            p_transpose(c, lds, p.w_up_a, Wt_upa, 512, DM, nullptr, 0, cur, 1024, 0);
            p_transpose(c, lds, p.w_up_b, Wt_upa, 512, DM, nullptr, 0, cur, 1024, 512);
            p_transpose(c, lds, p.w_out, Wt_out, DM, DM, nullptr, 0, cur);
            p_transpose(c, lds, p.w_q_mem, Wt_qm, DM, MEMW, p.g_mem_q, 0, cur);
            p_transpose(c, lds, p.w_kv_mem, Wt_kvm, DM, 2 * MEMW, nullptr, 0, cur);
            p_transpose(c, lds, p.w_o_mem, Wt_om, MEMW, DM, nullptr, 0, cur);
            p_rmsnorm_rows(c, p.x, p.g_mix, n1, T);
            p_rmsnorm_rows(c, p.mem, p.g_mem_kv, memn, BATCH * NMEM);
            p_rope_table(c, p.pos, rope);
            if (blockIdx.x == 0) { for (int i = c.tid; i < XCD_BAR_WORDS; i += 512) bar[i] = 0u; if (c.tid == 0) bar[WQ_WORD] = 0u; }
        }
        PHASE(1) {
            Gemm g{n1, Wt_in, T, INC, DM}; EpiBf16 E{proj, INC, nullptr, 1 << 30, rope, 4, 12, gates};   S.init(g.M, g.N, gridDim.x, blockIdx.x); pg8::gemm_phase(lds, g, S, E);
        }
        PHASE(3) {
            { Gemm g{memn, Wt_kvm, BATCH * NMEM, 1024, DM}; EpiBf16 E{kvm, 1024, nullptr, 1 << 30, nullptr, 0, 0, nullptr}; S.init(g.M, g.N, gridDim.x, blockIdx.x); pg8::gemm_phase(lds, g, S, E); }
            p_attn_ab(lds, proj, OA, OB, bar + WQ_WORD);
        }
        PHASE(5) { Gemm g{OA, Wt_upa, T, DM, DM}; EpiGate E{gates, mixed}; S.init(g.M, g.N, gridDim.x, blockIdx.x); pg8::gemm_phase(lds, g, S, E); }
        PHASE(6) { Gemm g{mixed, Wt_out, T, DM, DM}; EpiRes E{p.x, nullptr, nullptr, h1b, ss1}; S.init(g.M, g.N, gridDim.x, blockIdx.x); pg8::gemm_phase(lds, g, S, E); }
        PHASE(7) { Gemm g{h1b, Wt_qm, T, MEMW, DM}; EpiBf16 E{qm, MEMW, ss1, 1 << 30, nullptr, 0, 0, nullptr}; S.init(g.M, g.N, gridDim.x, blockIdx.x); pg8::gemm_phase(lds, g, S, E); }
        PHASE(8) {
            p_attn_mem(lds, qm, kvm, om);
        }
        PHASE(9) { Gemm g{om, Wt_om, T, DM, MEMW}; EpiRes E{nullptr, h1b, nullptr, h2b, ss2}; S.init(g.M, g.N, gridDim.x, blockIdx.x); pg8::gemm_phase(lds, g, S, E); }
        PHASE(10) { Gemm g{h2b, Wt_gu, T, 2 * DFF, DM}; EpiSwiGLU E{act, ss2}; S.init(g.M, g.N, gridDim.x, blockIdx.x); pg8::gemm_phase(lds, g, S, E); }
        PHASE(11) { Gemm g{act, Wt_dn, T, DM, DFF}; EpiRes E{nullptr, h2b, p.out, nullptr, ss3}; S.init(g.M, g.N, gridDim.x, blockIdx.x); pg8::gemm_phase(lds, g, S, E); }
        PHASE(12) p_final(c, p.out, ss3, p.g_final);
    }
}

constexpr int LDS_BYTES = pg8::STAGE_BYTES + 16;
#ifndef ONE_LAUNCH
#define ONE_LAUNCH 1
#endif
extern "C" void kernel_launch(void* const* d_in, const int* in_sizes, int n_in, void* d_out, int out_size, void* d_ws, size_t ws_size, hipStream_t stream) {
    static int grid = 0;
    if (grid == 0) {
        if (n_in != 18 || out_size != T * DM || ws_size < WS_END) { fprintf(stderr, "kernel_launch: unexpected shapes (n_in %d out %d ws %zu)\n", n_in, out_size, ws_size); grid = -1; return; }
        int dev = 0, cus = 0, per_cu = 0;
        (void)hipGetDevice(&dev); (void)hipDeviceGetAttribute(&cus, hipDeviceAttributeMultiprocessorCount, dev);
        if (hipFuncSetAttribute((const void*)mega, hipFuncAttributeMaxDynamicSharedMemorySize, LDS_BYTES) != hipSuccess) { fprintf(stderr, "hipFuncSetAttribute failed\n"); grid = -1; return; }
        if (hipOccupancyMaxActiveBlocksPerMultiprocessor(&per_cu, (const void*)mega, 512, LDS_BYTES) != hipSuccess || per_cu < 1) { fprintf(stderr, "occupancy query: %d\n", per_cu); per_cu = 1; }
        (void)hipGetLastError();
        grid = cus * 1;
    }
    if (grid < 0) return;
    Params p{};
    p.x = (const float*)d_in[0]; p.mem = (const float*)d_in[1]; p.pos = (const int*)d_in[2]; p.g_mix = (const float*)d_in[3]; p.w_in = (const float*)d_in[4];
    p.w_up_a = (const float*)d_in[5]; p.w_up_b = (const float*)d_in[6]; p.w_out = (const float*)d_in[7]; p.g_mem_q = (const float*)d_in[8]; p.g_mem_kv = (const float*)d_in[9];
    p.w_q_mem = (const float*)d_in[10]; p.w_kv_mem = (const float*)d_in[11]; p.w_o_mem = (const float*)d_in[12]; p.g_ffn = (const float*)d_in[13];
    p.w_ffn_gate = (const float*)d_in[14]; p.w_ffn_up = (const float*)d_in[15]; p.w_ffn_down = (const float*)d_in[16]; p.g_final = (const float*)d_in[17];
    p.out = (float*)d_out; p.ws = (unsigned char*)d_ws;
#if ONE_LAUNCH
    int lo = 0, hi = NPHASE;
    void* args[] = {&p, &lo, &hi};
    hipError_t e = hipLaunchCooperativeKernel((const void*)mega, dim3(grid), dim3(512), args, LDS_BYTES, stream);
    if (e != hipSuccess) fprintf(stderr, "cooperative launch failed: %s\n", hipGetErrorString(e));
#else
    for (int ph = 0; ph < NPHASE; ++ph) hipLaunchKernelGGL(mega, dim3(grid), dim3(512), LDS_BYTES, stream, p, ph, ph + 1);
#endif
}
```

```cpp
#include <hip/hip_runtime.h>
#include <hip/hip_cooperative_groups.h>
#include <cstdio>
namespace cg = cooperative_groups;

#define LAS __attribute__((address_space(3)))
typedef unsigned short bf16_t;
typedef short bf16x8 __attribute__((ext_vector_type(8)));
typedef float f32x4 __attribute__((ext_vector_type(4)));
typedef unsigned u32x4 __attribute__((ext_vector_type(4)));
typedef unsigned u32x2 __attribute__((ext_vector_type(2)));

constexpr int BATCH = 16, SEQ = 2048, DM = 1024, T = BATCH * SEQ;
constexpr int HD = 64, NHA = 8, NHB = 8;
constexpr int INC = 5120;
constexpr int C_QA = 0, C_KA = 512, C_VA = 1024, C_QB = 1536, C_KB = 2048, C_VB = 2560, C_GA = 3072, C_GB = 4096;
constexpr int NMEM = 256, MEMW = 512, DFF = 2816;
constexpr float EPS = 1e-6f;

constexpr size_t MiB = 1ull << 20;
constexpr size_t WS_WIN = 0, WS_WUPA = 10 * MiB, WS_WUPB = 11 * MiB, WS_WOUT = 12 * MiB, WS_WQM = 14 * MiB, WS_WKVM = 15 * MiB,
                 WS_WOM = 17 * MiB, WS_WGU = 18 * MiB, WS_WDN = 29 * MiB, WS_MEMN = 36 * MiB, WS_KVM = 44 * MiB,
                 WS_SS1 = 52 * MiB, WS_SS2 = 54 * MiB, WS_SS3 = 56 * MiB, WS_ROPE = 58 * MiB, WS_BAR = 60 * MiB;
constexpr size_t WS_R1 = 64 * MiB;
constexpr size_t WS_PROJ = 128 * MiB;
constexpr size_t WS_H1 = 128 * MiB, WS_H1B = 256 * MiB, WS_QM = 320 * MiB, WS_OM = 352 * MiB, WS_H2 = 384 * MiB, WS_ACT = 128 * MiB;
constexpr size_t WS_OA = 448 * MiB, WS_OB = 480 * MiB;
constexpr size_t WS_END = 512 * MiB;

struct Params {
    const float* x; const float* mem; const int* pos; const float* g_mix; const float* w_in; const float* w_up_a; const float* w_up_b; const float* w_out;
    const float* g_mem_q; const float* g_mem_kv; const float* w_q_mem; const float* w_kv_mem; const float* w_o_mem; const float* g_ffn;
    const float* w_ffn_gate; const float* w_ffn_up; const float* w_ffn_down; const float* g_final;
    float* out; unsigned char* ws;
};

typedef float f32x2 __attribute__((ext_vector_type(2)));
typedef __bf16 bf16v2 __attribute__((ext_vector_type(2)));
__device__ __forceinline__ unsigned pk_bf16(float lo, float hi) { f32x2 v = {lo, hi}; bf16v2 r = __builtin_convertvector(v, bf16v2); return __builtin_bit_cast(unsigned, r); }
__device__ __forceinline__ bf16_t f2bf(float f) { return (bf16_t)(pk_bf16(f, 0.f) & 0xffffu); }
__device__ __forceinline__ float bf2f(bf16_t b) { return __uint_as_float(((unsigned)b) << 16); }
__device__ __forceinline__ float bflo(unsigned u) { return __uint_as_float(u << 16); }
__device__ __forceinline__ float bfhi(unsigned u) { return __uint_as_float(u & 0xffff0000u); }
__device__ __forceinline__ float wave_sum(float v) {
#pragma unroll
    for (int o = 1; o < 64; o <<= 1) v += __shfl_xor(v, o);
    return v;
}
__device__ __forceinline__ float sigmoidf_(float x) { return __builtin_amdgcn_rcpf(1.f + __builtin_amdgcn_exp2f(x * -1.4426950408889634f)); }
__device__ __forceinline__ float rstd_of(const float* ss, int row) {
    const f32x4* p = (const f32x4*)(ss + (size_t)row * 16);
    f32x4 a = p[0], b = p[1], c = p[2], d = p[3];
    float s = ((a[0] + a[1]) + (a[2] + a[3])) + ((b[0] + b[1]) + (b[2] + b[3])) + ((c[0] + c[1]) + (c[2] + c[3])) + ((d[0] + d[1]) + (d[2] + d[3]));
    return rsqrtf(s * (1.f / DM) + EPS);
}


#define XB_TMO      128
#define XB_XCNT(j)  (256  + 64 * (j))
#define XB_XSUB(j)  (1280 + 64 * (j))
#define XB_XGEN(j)  (2304 + 64 * (j))
#define XB_TOP      3328
#define XB_TOPGEN   3392
#define XCD_BAR_WORDS 3456
#define XB_SPIN_CAP (1u << 18)
__device__ __forceinline__ unsigned xb_ld(unsigned* p)              { return __hip_atomic_load(p, __ATOMIC_RELAXED, __HIP_MEMORY_SCOPE_AGENT); }
__device__ __forceinline__ unsigned xb_add(unsigned* p, unsigned v) { return __hip_atomic_fetch_add(p, v, __ATOMIC_RELAXED, __HIP_MEMORY_SCOPE_AGENT); }
__device__ __forceinline__ unsigned xb_xcc_id() { return (unsigned)__builtin_amdgcn_s_getreg((3 << 11) | 20) & 0xFu; }
#define XB_SPIN(cond, bar) do { unsigned _sp = 0; while (cond) { __builtin_amdgcn_s_sleep(1); \
    if ((++_sp & 255u) == 0u) { if (xb_ld(&(bar)[XB_TMO])) break; if (_sp > XB_SPIN_CAP) { atomicAdd(&(bar)[XB_TMO], 1u); break; } } } } while (0)
struct XcdBarrier { unsigned* bar; unsigned x; volatile LAS unsigned* st; };
__device__ __forceinline__ XcdBarrier xcd_barrier_post(unsigned* bar, volatile LAS unsigned* st) {
    XcdBarrier b; b.bar = bar; b.x = xb_xcc_id(); b.st = st;
    if (threadIdx.x == 0) (void)xb_add(&bar[XB_XCNT(b.x)], 1u);
    return b;
}
__device__ __forceinline__ void xcd_barrier_complete(unsigned* bar, unsigned x, unsigned& nloc, unsigned& nx) {
    const unsigned G = gridDim.x * gridDim.y * gridDim.z;
    unsigned sum, cnt, mine, sp = 0u;
    for (;;) {
        sum = 0u; cnt = 0u; mine = 0u;
#pragma unroll
        for (unsigned j = 0; j < 16; ++j) { const unsigned c = xb_ld(&bar[XB_XCNT(j)]); sum += c; cnt += (c > 0u) ? 1u : 0u; mine = (j == x) ? c : mine; }
        if (sum == G) break;
        __builtin_amdgcn_s_sleep(1);
        if ((++sp & 255u) == 0u) { if (xb_ld(&bar[XB_TMO])) break; if (sp > XB_SPIN_CAP) { atomicAdd(&bar[XB_TMO], 1u); break; } }
    }
    nloc = mine > 0u ? mine : 1u; nx = cnt > 0u ? cnt : 1u;
}
__device__ __forceinline__ void xcd_barrier(const XcdBarrier& b) {
    asm volatile("s_waitcnt vmcnt(0)" ::: "memory");
    __syncthreads();
    if (threadIdx.x == 0) {
        unsigned* bar = b.bar;
        __builtin_amdgcn_s_waitcnt(0);
        unsigned nloc = b.st[0], nx = b.st[1];
        if (nloc == 0u) { xcd_barrier_complete(bar, b.x, nloc, nx); b.st[0] = nloc; b.st[1] = nx; }
        const unsigned old = xb_add(&bar[XB_XSUB(b.x)], 1u);
        const unsigned gen = old / nloc;
        if (old + 1u == (gen + 1u) * nloc) {
            __builtin_amdgcn_fence(__ATOMIC_RELEASE, "agent");
            asm volatile("s_waitcnt vmcnt(0)" ::: "memory");
            const unsigned og = xb_add(&bar[XB_TOP], 1u);
            const unsigned tg = og / nx;
            if (og + 1u == (tg + 1u) * nx) xb_add(&bar[XB_TOPGEN], 1u);
            else XB_SPIN(xb_ld(&bar[XB_TOPGEN]) == tg, bar);
            __builtin_amdgcn_fence(__ATOMIC_ACQUIRE, "agent");
            xb_add(&bar[XB_XGEN(b.x)], 1u);
            asm volatile("s_waitcnt vmcnt(0)" ::: "memory");
        } else {
            XB_SPIN(xb_ld(&bar[XB_XGEN(b.x)]) == gen, bar);
            __builtin_amdgcn_fence(__ATOMIC_ACQUIRE, "agent");
            asm volatile("s_waitcnt vmcnt(0)" ::: "memory");
        }
    }
    __syncthreads();
}

namespace pg8 {
constexpr int BM = 256, BK = 64, HALF = 128, HTB = HALF * BK * 2, STAGE_BYTES = 8 * HTB, NXCD = 8, WGM = 4;
__host__ __device__ __forceinline__ int lds_byte(int r, int c) { const int st = (r >> 4) * 2 + (c >> 5), rr = r & 15, cc = c & 31, ob = rr * 64 + cc * 2; return st * 1024 + (ob ^ (((ob >> 9) & 1) << 5)); }
__host__ __device__ __forceinline__ void stage_rc(int b, int& R, int& C) { const int st = b / 1024, sb = b % 1024, swz = sb ^ (((sb >> 9) & 1) << 5); R = (st >> 1) * 16 + swz / 64; C = (st & 1) * 32 + (swz % 64) / 2; }
__host__ __device__ __forceinline__ int perm32(int rho) { const int n = rho >> 4, i = rho & 15; return 8 * (i >> 2) + 4 * n + (i & 3); }
struct Unit { int pm, pn; };
struct Gemm { const bf16_t* A; const bf16_t* Bt; int M, N, K; };
struct StaticOrder {
    int nM, nN, nwg, G, c;
    __host__ __device__ void init(int M, int N, int G_, int c_) { nM = M / BM; nN = N / BM; nwg = nM * nN; G = G_; c = c_; }
    __host__ __device__ bool next(int i, Unit& u) const {
        const long L = (long)i * G + c; if (L >= nwg) return false;
        int wgid = (int)L; { const int q = nwg / NXCD, r = nwg % NXCD, xcd = wgid % NXCD, off = wgid / NXCD; wgid = (xcd < r ? xcd * (q + 1) : r * (q + 1) + (xcd - r) * q) + off; }
        const int nig = WGM * nN, gid = wgid / nig, fm = gid * WGM, gsz = (nM - fm) < WGM ? (nM - fm) : WGM;
        u.pm = fm + ((wgid % nig) % gsz); u.pn = (wgid % nig) / gsz; return true;
    }
};

template <class Epi>
__device__ __forceinline__ void gemm_phase(LAS unsigned char* lds, const Gemm g, const StaticOrder& S, const Epi& E) {
    int tid = threadIdx.x; asm volatile("" : "+v"(tid));
    const int wid = __builtin_amdgcn_readfirstlane(tid >> 6), lane = tid & 63, wr = wid >> 2, wc = wid & 3, fr = lane & 15, fq = lane >> 4;
    const int K = g.K, nt = K / BK;
    unsigned voffA[2], voffB[2];
#pragma unroll
    for (int i = 0; i < 2; ++i) { int R, C; stage_rc(tid * 16 + i * 8192, R, C); const int Rb = Epi::LINE ? ((R >> 5) * 64 + perm32(R & 31)) : (Epi::PERM ? ((R & ~31) + perm32(R & 31)) : R);
        voffA[i] = (unsigned)(R * K + C) * 2u; voffB[i] = (unsigned)(Rb * K + C) * 2u; }
    const size_t kstep = (size_t)(BK * 2);
    const size_t hstep = (size_t)HALF * K * 2;
    const size_t tstep = 2 * hstep;
    const size_t hstepB = Epi::LINE ? (size_t)32 * K * 2 : hstep;
    const unsigned ldsw = (unsigned)wid * 1024u;
    const int aoff = lds_byte(wr * 64 + fr, fq * 8), boff = lds_byte(wc * 32 + fr, fq * 8);
#define PG8_SA(b, h) (((b) * 2 + (h)) * HTB)
#define PG8_SB(b, h) ((4 + (b) * 2 + (h)) * HTB)
#define PG8_STAGE(bufoff, gbase, voff) do { _Pragma("unroll") for (int _i = 0; _i < 2; ++_i) \
        __builtin_amdgcn_global_load_lds((const unsigned*)((const char*)(gbase) + (voff)[_i]), (LAS unsigned*)(lds + (bufoff) + ldsw + _i * 8192), 16, 0, 0); } while (0)
#define PG8_LDA(dst, b, h) do { _Pragma("unroll") for (int m = 0; m < 4; ++m) _Pragma("unroll") for (int k = 0; k < 2; ++k) dst[m][k] = *(const LAS bf16x8*)(lds + PG8_SA(b, h) + aoff + m * 2048 + k * 1024); } while (0)
#define PG8_LDB(dst, b, h) do { _Pragma("unroll") for (int n = 0; n < 2; ++n) _Pragma("unroll") for (int k = 0; k < 2; ++k) dst[n][k] = *(const LAS bf16x8*)(lds + PG8_SB(b, h) + boff + n * 2048 + k * 1024); } while (0)
#define PG8_MMA(ai, bj, At, Bt) do { __builtin_amdgcn_s_setprio(1); _Pragma("unroll") for (int m = 0; m < 4; ++m) _Pragma("unroll") for (int n = 0; n < 2; ++n) _Pragma("unroll") for (int k = 0; k < 2; ++k) \
        acc[ai][bj][m][n] = __builtin_amdgcn_mfma_f32_16x16x32_bf16(Bt[n][k], At[m][k], acc[ai][bj][m][n], 0, 0, 0); __builtin_amdgcn_s_setprio(0); } while (0)
#define PG8_WAIT_V(n) asm volatile("s_waitcnt vmcnt(" #n ")" ::: "memory")
#define PG8_WAIT_L(n) asm volatile("s_waitcnt lgkmcnt(" #n ")" ::: "memory")
#define PG8_BAR __builtin_amdgcn_s_barrier()
#define PG8_SCHED __builtin_amdgcn_sched_barrier(0)
    Unit cur, nxt; int ui = 0;
    if (!S.next(0, cur)) return;
    f32x4 acc[2][2][4][2];
#pragma unroll
    for (int a = 0; a < 2; ++a)
#pragma unroll
        for (int b = 0; b < 2; ++b)
#pragma unroll
            for (int m = 0; m < 4; ++m)
#pragma unroll
                for (int n = 0; n < 2; ++n) acc[a][b][m][n] = (f32x4){0.f, 0.f, 0.f, 0.f};
    bf16x8 At[4][2], B0[2][2], B1[2][2];
    const char* cA = (const char*)g.A + (size_t)cur.pm * tstep; const char* cB = (const char*)g.Bt + (size_t)cur.pn * tstep;
    PG8_STAGE(PG8_SB(0, 0), cB, voffB); PG8_STAGE(PG8_SA(0, 0), cA, voffA); PG8_STAGE(PG8_SB(0, 1), cB + hstepB, voffB); PG8_STAGE(PG8_SA(0, 1), cA + hstep, voffA);
    if (wr == 1) PG8_BAR;
    PG8_WAIT_V(4); PG8_BAR;
    PG8_STAGE(PG8_SB(1, 0), cB + kstep, voffB); PG8_STAGE(PG8_SA(1, 0), cA + kstep, voffA); PG8_STAGE(PG8_SB(1, 1), cB + hstepB + kstep, voffB);
    PG8_WAIT_V(6); PG8_BAR;
    for (;;) {
        const bool has_next = S.next(ui + 1, nxt);
        const char* nA = has_next ? (const char*)g.A + (size_t)nxt.pm * tstep : cA; const char* nB = has_next ? (const char*)g.Bt + (size_t)nxt.pn * tstep : cB;
        for (int t = 0; t < nt; t += 2) {
            const bool last = (t == nt - 2);
            const char* a1 = cA + (size_t)(t + 1) * kstep;
            const char* a2 = last ? nA : cA + (size_t)(t + 2) * kstep; const char* b2 = last ? nB : cB + (size_t)(t + 2) * kstep;
            const char* a3 = a2 + kstep; const char* b3 = b2 + kstep;
            if constexpr (Epi::HAS_MID) { if (t == nt / 2) E.mid(acc, cur, wr, wc, fr, fq); }
            PG8_LDB(B0, 0, 0); PG8_SCHED; PG8_LDA(At, 0, 0); PG8_STAGE(PG8_SA(1, 1), a1 + hstep, voffA);
            PG8_WAIT_L(8); PG8_BAR; PG8_WAIT_L(0); PG8_MMA(0, 0, At, B0); PG8_BAR; PG8_SCHED;
            PG8_LDB(B1, 0, 1); PG8_STAGE(PG8_SB(0, 0), b2, voffB);
            PG8_BAR; PG8_WAIT_L(0); PG8_MMA(0, 1, At, B1); PG8_BAR;
            PG8_LDA(At, 0, 1); PG8_STAGE(PG8_SA(0, 0), a2, voffA);
            PG8_BAR; PG8_WAIT_L(0); PG8_MMA(1, 0, At, B0); PG8_BAR; PG8_SCHED;
            PG8_STAGE(PG8_SB(0, 1), b2 + hstepB, voffB);
            PG8_WAIT_V(6); PG8_BAR; PG8_MMA(1, 1, At, B1); PG8_BAR;
            PG8_LDB(B0, 1, 0); PG8_SCHED; PG8_LDA(At, 1, 0); PG8_STAGE(PG8_SA(0, 1), a2 + hstep, voffA);
            PG8_WAIT_L(8); PG8_BAR; PG8_WAIT_L(0); PG8_MMA(0, 0, At, B0); PG8_BAR; PG8_SCHED;
            PG8_LDB(B1, 1, 1); PG8_STAGE(PG8_SB(1, 0), b3, voffB);
            PG8_BAR; PG8_WAIT_L(0); PG8_MMA(0, 1, At, B1); PG8_BAR;
            PG8_LDA(At, 1, 1); PG8_STAGE(PG8_SA(1, 0), a3, voffA);
            PG8_BAR; PG8_WAIT_L(0); PG8_MMA(1, 0, At, B0); PG8_BAR; PG8_SCHED;
            PG8_STAGE(PG8_SB(1, 1), b3 + hstepB, voffB);
            PG8_WAIT_V(6); PG8_BAR; PG8_MMA(1, 1, At, B1); PG8_BAR;
        }
        E(acc, cur, wr, wc, fr, fq);
        if (!has_next) break;
#pragma unroll
        for (int a = 0; a < 2; ++a)
#pragma unroll
            for (int b = 0; b < 2; ++b)
#pragma unroll
                for (int m = 0; m < 4; ++m)
#pragma unroll
                    for (int n = 0; n < 2; ++n) acc[a][b][m][n] = (f32x4){0.f, 0.f, 0.f, 0.f};
        cur = nxt; cA = nA; cB = nB; ++ui;
    }
    PG8_WAIT_V(0);
    if (wr == 0) PG8_BAR;
    PG8_BAR;
#undef PG8_SA
#undef PG8_SB
#undef PG8_STAGE
#undef PG8_LDA
#undef PG8_LDB
#undef PG8_MMA
#undef PG8_WAIT_V
#undef PG8_WAIT_L
#undef PG8_BAR
#undef PG8_SCHED
}
}
using pg8::Unit; using pg8::Gemm;

__device__ __forceinline__ void line_pair(u32x4& a, u32x4& b, bool lo) {
#pragma unroll
    for (int q = 0; q < 4; ++q) {
        const unsigned send = lo ? b[q] : a[q];
        const unsigned recv = (unsigned)__builtin_amdgcn_update_dpp(0, (int)send, 0x128  , 0xf, 0xf, false);
        if (lo) b[q] = recv; else a[q] = recv;
    }
}
struct EpiBf16 {
    static constexpr bool PERM = true, HAS_MID = false, LINE = true;
    bf16_t* O; int ldc; const float* ss; int sig_from; const float* rope; int rope_below; int qkv_tiles; bf16_t* gates;
    __device__ __forceinline__ bf16_t* addr(int row, int col, int pn) const {
        if (qkv_tiles > 0) {
            if (pn < qkv_tiles) return O + (size_t)(col >> 9) * ((size_t)T * 512) + ((size_t)((row >> 11) * 8 + ((col >> 6) & 7)) * SEQ + (row & (SEQ - 1))) * 64 + (col & 63);
            return gates + (size_t)row * 2048 + (col - 256 * qkv_tiles);
        }
        return O + (size_t)row * ldc + col;
    }
    __device__ __forceinline__ void operator()(const f32x4 (&acc)[2][2][4][2], const Unit& u, int wr, int wc, int fr, int fq) const {
        const int row0 = u.pm * 256 + wr * 64 + fr, col0 = u.pn * 256 + wc * 64 + 8 * fq;
        const bool sig = u.pn >= sig_from, lo = fr < 8;
#pragma unroll
        for (int ai = 0; ai < 2; ++ai)
#pragma unroll
            for (int m = 0; m < 4; ++m) {
                const int row = row0 + ai * 128 + m * 16;
                const float rs = ss ? rstd_of(ss, row) : 1.f;
                u32x4 o[2];
#pragma unroll
                for (int bj = 0; bj < 2; ++bj) {
                    f32x4 v0 = acc[ai][bj][m][0] * rs, v1 = acc[ai][bj][m][1] * rs;
                    if (sig) {
#pragma unroll
                        for (int j = 0; j < 4; ++j) { v0[j] = sigmoidf_(v0[j]); v1[j] = sigmoidf_(v1[j]); }
                    }
                    if (bj == 0 && u.pn < rope_below) {
                        f32x4 p0, p1;
#pragma unroll
                        for (int j = 0; j < 4; ++j) { p0[j] = __shfl_xor(v0[j], 16); p1[j] = __shfl_xor(v1[j], 16); }
                        if (fq < 2) {
                            const f32x4 c0 = *(const f32x4*)(rope + (size_t)row * 16), c1 = *(const f32x4*)(rope + (size_t)row * 16 + 4);
                            f32x4 s0 = *(const f32x4*)(rope + (size_t)row * 16 + 8), s1 = *(const f32x4*)(rope + (size_t)row * 16 + 12);
                            if (fq == 0) { s0 = -s0; s1 = -s1; }
                            v0 = v0 * c0 + p0 * s0; v1 = v1 * c1 + p1 * s1;
                        }
                    }
                    o[bj][0] = pk_bf16(v0[0], v0[1]); o[bj][1] = pk_bf16(v0[2], v0[3]); o[bj][2] = pk_bf16(v1[0], v1[1]); o[bj][3] = pk_bf16(v1[2], v1[3]);
                }
                line_pair(o[0], o[1], lo);
                const int colx = col0 + (lo ? 0 : 32);
                *(u32x4*)addr(lo ? row : row - 8, colx, u.pn) = o[0];
                *(u32x4*)addr(lo ? row + 8 : row, colx, u.pn) = o[1];
            }
    }
};
struct EpiGate {
    static constexpr bool PERM = true, HAS_MID = true, LINE = true;
    const bf16_t* gates; bf16_t* O;
    __device__ __forceinline__ void mid(f32x4 (&acc)[2][2][4][2], const Unit& u, int wr, int wc, int fr, int fq) const {
        int row0 = u.pm * 256 + wr * 64 + fr, col0 = u.pn * 256 + wc * 64 + 8 * fq;
        asm volatile("" : "+v"(row0), "+v"(col0));
#pragma unroll
        for (int ai = 0; ai < 2; ++ai)
#pragma unroll
            for (int m = 0; m < 4; ++m) {
                const int row = row0 + ai * 128 + m * 16;
#pragma unroll
                for (int bj = 0; bj < 2; ++bj) {
                    const int col = col0 + bj * 32;
                    const u32x4 ga = *(const u32x4*)(gates + (size_t)row * 2048 + col), gb = *(const u32x4*)(gates + (size_t)row * 2048 + 1024 + col);
#pragma unroll
                    for (int q = 0; q < 4; ++q) {
                        const float a0 = bflo(ga[q]), a1 = bfhi(ga[q]), b0 = fmaxf(bflo(gb[q]), -60.f), b1 = fmaxf(bfhi(gb[q]), -60.f);
                        const float r0 = (1.f + __expf(-b0)) * __builtin_amdgcn_rcpf(1.f + __expf(-a0)), r1 = (1.f + __expf(-b1)) * __builtin_amdgcn_rcpf(1.f + __expf(-a1));
                        acc[ai][bj][m][q >> 1][(q & 1) * 2] *= r0; acc[ai][bj][m][q >> 1][(q & 1) * 2 + 1] *= r1;
                    }
                }
                __builtin_amdgcn_sched_barrier(0);
            }
    }
    __device__ __forceinline__ void operator()(const f32x4 (&acc)[2][2][4][2], const Unit& u, int wr, int wc, int fr, int fq) const {
        const int row0 = u.pm * 256 + wr * 64 + fr, col0 = u.pn * 256 + wc * 64 + 8 * fq; const bool lo = fr < 8;
#pragma unroll
        for (int ai = 0; ai < 2; ++ai)
#pragma unroll
            for (int m = 0; m < 4; ++m) {
                const int row = row0 + ai * 128 + m * 16;
                u32x4 oo[2];
#pragma unroll
                for (int bj = 0; bj < 2; ++bj) {
                    const int col = col0 + bj * 32;
                    const u32x4 gb = *(const u32x4*)(gates + (size_t)row * 2048 + 1024 + col);
                    float r[8];
#pragma unroll
                    for (int q = 0; q < 4; ++q) {
                        const float b0 = fmaxf(bflo(gb[q]), -60.f), b1 = fmaxf(bfhi(gb[q]), -60.f);
                        r[2 * q] = acc[ai][bj][m][q >> 1][(q & 1) * 2] * __builtin_amdgcn_rcpf(1.f + __expf(-b0));
                        r[2 * q + 1] = acc[ai][bj][m][q >> 1][(q & 1) * 2 + 1] * __builtin_amdgcn_rcpf(1.f + __expf(-b1));
                    }
                    oo[bj][0] = pk_bf16(r[0], r[1]); oo[bj][1] = pk_bf16(r[2], r[3]); oo[bj][2] = pk_bf16(r[4], r[5]); oo[bj][3] = pk_bf16(r[6], r[7]);
                }
                line_pair(oo[0], oo[1], lo);
                const int colx = col0 + (lo ? 0 : 32);
                *(u32x4*)(O + (size_t)(lo ? row : row - 8) * DM + colx) = oo[0];
                *(u32x4*)(O + (size_t)(lo ? row + 8 : row) * DM + colx) = oo[1];
            }
    }
};
struct EpiRes {
    static constexpr bool PERM = true, HAS_MID = false, LINE = true;
    const float* R; const bf16_t* Rb; float* H; bf16_t* Hb; float* SS;
    __device__ __forceinline__ void operator()(const f32x4 (&acc)[2][2][4][2], const Unit& u, int wr, int wc, int fr, int fq) const {
        const int row0 = u.pm * 256 + wr * 64 + fr, col0 = u.pn * 256 + wc * 64 + 8 * fq; const bool lo = fr < 8;
#pragma unroll
        for (int ai = 0; ai < 2; ++ai)
#pragma unroll
            for (int m = 0; m < 4; ++m) {
                const int row = row0 + ai * 128 + m * 16;
                float s = 0.f; u32x4 ob[2];
#pragma unroll
                for (int bj = 0; bj < 2; ++bj) {
                    const int col = col0 + bj * 32;
                    f32x4 r0, r1;
                    if (R) { r0 = *(const f32x4*)(R + (size_t)row * DM + col); r1 = *(const f32x4*)(R + (size_t)row * DM + col + 4); }
                    else { const u32x4 rb = *(const u32x4*)(Rb + (size_t)row * DM + col);
                        r0[0] = bflo(rb[0]); r0[1] = bfhi(rb[0]); r0[2] = bflo(rb[1]); r0[3] = bfhi(rb[1]); r1[0] = bflo(rb[2]); r1[1] = bfhi(rb[2]); r1[2] = bflo(rb[3]); r1[3] = bfhi(rb[3]); }
                    const f32x4 h0 = r0 + acc[ai][bj][m][0], h1 = r1 + acc[ai][bj][m][1];
                    if (H) { *(f32x4*)(H + (size_t)row * DM + col) = h0; *(f32x4*)(H + (size_t)row * DM + col + 4) = h1; }
                    ob[bj][0] = pk_bf16(h0[0], h0[1]); ob[bj][1] = pk_bf16(h0[2], h0[3]); ob[bj][2] = pk_bf16(h1[0], h1[1]); ob[bj][3] = pk_bf16(h1[2], h1[3]);
                    s += ((h0[0] * h0[0] + h0[1] * h0[1]) + (h0[2] * h0[2] + h0[3] * h0[3])) + ((h1[0] * h1[0] + h1[1] * h1[1]) + (h1[2] * h1[2] + h1[3] * h1[3]));
                }
                if (Hb) { line_pair(ob[0], ob[1], lo); const int colx = col0 + (lo ? 0 : 32);
                    *(u32x4*)(Hb + (size_t)(lo ? row : row - 8) * DM + colx) = ob[0]; *(u32x4*)(Hb + (size_t)(lo ? row + 8 : row) * DM + colx) = ob[1]; }
                s += __shfl_xor(s, 16); s += __shfl_xor(s, 32);
                if (fq == 0) SS[(size_t)row * 16 + u.pn * 4 + wc] = s;
            }
    }
};
struct EpiSwiGLU {
    static constexpr bool PERM = true, HAS_MID = false, LINE = false;
    bf16_t* O; const float* ss;
    __device__ __forceinline__ void operator()(const f32x4 (&acc)[2][2][4][2], const Unit& u, int wr, int wc, int fr, int fq) const {
        const int row0 = u.pm * 256 + wr * 64 + fr, col0 = u.pn * 128 + wc * 32 + 8 * fq;
#pragma unroll
        for (int ai = 0; ai < 2; ++ai)
#pragma unroll
            for (int m = 0; m < 4; ++m) {
                const int row = row0 + ai * 128 + m * 16;
                const float rs = rstd_of(ss, row);
                float r[8];
#pragma unroll
                for (int n = 0; n < 2; ++n)
#pragma unroll
                    for (int j = 0; j < 4; ++j) { const float gg = acc[ai][0][m][n][j] * rs, uu = acc[ai][1][m][n][j] * rs; r[n * 4 + j] = gg * sigmoidf_(gg) * uu; }
                u32x4 o; o[0] = pk_bf16(r[0], r[1]); o[1] = pk_bf16(r[2], r[3]); o[2] = pk_bf16(r[4], r[5]); o[3] = pk_bf16(r[6], r[7]);
                *(u32x4*)(O + (size_t)row * DFF + col0) = o;
            }
    }
};

struct Ctx { int tid, lane, wave, gw, ngw, gt, ngt; };

__device__ __forceinline__ void p_transpose(const Ctx& c, LAS unsigned char* lds, const float* W, bf16_t* Wt, int K, int N, const float* g, int mode, int& cursor, int ldw = 0, int koff = 0) {
    if (ldw == 0) ldw = K;
    LAS float* scr = (LAS float*)(lds + c.wave * 8704);
    const int nblk = N / 32, nitems = (K / 64) * nblk, lane = c.lane;
    int first = (c.gw - cursor % c.ngw + c.ngw) % c.ngw;
    for (int it = first; it < nitems; it += c.ngw) {
        const int kb = it / nblk, nb = it % nblk, k0 = 64 * kb, n0 = 32 * nb;
#pragma unroll 8
        for (int i = 0; i < 32; ++i) { const int kk = 2 * i + (lane >> 5); float v = W[(size_t)(k0 + kk) * N + n0 + (lane & 31)]; if (g) v *= g[k0 + kk]; scr[kk * 33 + (lane & 31)] = v; }
        asm volatile("s_waitcnt lgkmcnt(0)" ::: "memory");
        const int ch = lane & 7;
#pragma unroll
        for (int j = 0; j < 4; ++j) { const int n = (lane >> 3) + 8 * j; const LAS float* sp = scr + (8 * ch) * 33 + n;
            u32x4 o; o[0] = pk_bf16(sp[0], sp[33]); o[1] = pk_bf16(sp[2 * 33], sp[3 * 33]); o[2] = pk_bf16(sp[4 * 33], sp[5 * 33]); o[3] = pk_bf16(sp[6 * 33], sp[7 * 33]);
            const int nn = n0 + n, row = mode == 0 ? nn : (256 * (nn >> 7) + (nn & 127) + (mode == 2 ? 128 : 0));
            *(u32x4*)(Wt + (size_t)row * ldw + koff + k0 + 8 * ch) = o; }
        asm volatile("s_waitcnt lgkmcnt(0)" ::: "memory");
    }
    cursor += nitems;
}
__device__ __forceinline__ void p_rmsnorm_rows(const Ctx& c, const float* x, const float* g, bf16_t* out, int rows) {
    f32x4 gg[4];
#pragma unroll
    for (int j = 0; j < 4; ++j) gg[j] = ((const f32x4*)g)[c.lane + 64 * j];
    for (int r0 = c.gw; r0 < rows; r0 += 2 * c.ngw) {
        const int r1 = r0 + c.ngw; const bool has1 = r1 < rows; const int r1c = has1 ? r1 : r0;
        const f32x4* xa = (const f32x4*)(x + (size_t)r0 * DM) + c.lane; const f32x4* xb = (const f32x4*)(x + (size_t)r1c * DM) + c.lane;
        f32x4 va[4], vb[4]; float sa = 0.f, sb = 0.f;
#pragma unroll
        for (int j = 0; j < 4; ++j) { va[j] = xa[64 * j]; vb[j] = xb[64 * j]; }
#pragma unroll
        for (int j = 0; j < 4; ++j) { sa += (va[j][0] * va[j][0] + va[j][1] * va[j][1]) + (va[j][2] * va[j][2] + va[j][3] * va[j][3]); sb += (vb[j][0] * vb[j][0] + vb[j][1] * vb[j][1]) + (vb[j][2] * vb[j][2] + vb[j][3] * vb[j][3]); }
        const float ra = rsqrtf(wave_sum(sa) * (1.f / DM) + EPS), rb = rsqrtf(wave_sum(sb) * (1.f / DM) + EPS);
#pragma unroll
        for (int j = 0; j < 4; ++j) {
            u32x2 o; o[0] = pk_bf16(va[j][0] * ra * gg[j][0], va[j][1] * ra * gg[j][1]); o[1] = pk_bf16(va[j][2] * ra * gg[j][2], va[j][3] * ra * gg[j][3]);
            ((u32x2*)(out + (size_t)r0 * DM))[c.lane + 64 * j] = o;
            if (has1) { u32x2 q; q[0] = pk_bf16(vb[j][0] * rb * gg[j][0], vb[j][1] * rb * gg[j][1]); q[1] = pk_bf16(vb[j][2] * rb * gg[j][2], vb[j][3] * rb * gg[j][3]);
                ((u32x2*)(out + (size_t)r1 * DM))[c.lane + 64 * j] = q; }
        }
    }
}
__device__ __forceinline__ void p_rope_table(const Ctx& c, const int* pos, float* tab) {
    for (int i = c.gt; i < T * 8; i += c.ngt) {
        const int tok = i >> 3, f = i & 7;
        const double inv = f == 0 ? 1.0 : f == 1 ? 0.19392274474868576 : f == 2 ? 0.03760603093086393 : f == 3 ? 0.007292664737217109 : f == 4 ? 0.001414213562373095 :
                           f == 5 ? 0.0002742481756762073 : f == 6 ? 5.318295896944988e-05 : 1.031338537721246e-05;
        const double rev = (double)pos[tok] * inv * 0.15915494309189535;
        const float fr = (float)(rev - rint(rev));
        tab[(size_t)tok * 16 + f] = __builtin_amdgcn_cosf(fr);
        tab[(size_t)tok * 16 + 8 + f] = __builtin_amdgcn_sinf(fr);
    }
}
__device__ __forceinline__ void p_final(const Ctx& c, float* out, const float* ss, const float* g) {
    f32x4 gg[4];
#pragma unroll
    for (int j = 0; j < 4; ++j) gg[j] = ((const f32x4*)g)[c.lane + 64 * j];
    for (int r0 = c.gw; r0 < T; r0 += 2 * c.ngw) {
        const int r1 = r0 + c.ngw; const bool has1 = r1 < T; const int r1c = has1 ? r1 : r0;
        f32x4* xa = (f32x4*)(out + (size_t)r0 * DM) + c.lane; f32x4* xb = (f32x4*)(out + (size_t)r1c * DM) + c.lane;
        f32x4 va[4], vb[4];
#pragma unroll
        for (int j = 0; j < 4; ++j) { va[j] = xa[64 * j]; vb[j] = xb[64 * j]; }
        const float ra = rstd_of(ss, r0), rb = rstd_of(ss, r1c);
#pragma unroll
        for (int j = 0; j < 4; ++j) { xa[64 * j] = va[j] * ra * gg[j]; if (has1) xb[64 * j] = vb[j] * rb * gg[j]; }
    }
}

typedef float f32x16 __attribute__((ext_vector_type(16)));
typedef short s16x4 __attribute__((ext_vector_type(4)));
#define MFMA32(a, b, c) __builtin_amdgcn_mfma_f32_32x32x16_bf16((a), (b), (c), 0, 0, 0)
constexpr int ATT_FLAG_OFF = 40960;
#ifndef ATT_DUP_A
#define ATT_DUP_A 0
#endif
#ifndef ATT_DUP_B
#define ATT_DUP_B 0
#endif
template <int MODE, int HDIM, int KT>
__device__ __forceinline__ void attn_item(LAS unsigned char* lds, const bf16_t* Qp, int ldq, const bf16_t* Kp, const bf16_t* Vp, int ldkv, bf16_t* Op, int ldo, int q0, int nkeys) {
    constexpr int KS = HDIM / 16, DD = HDIM / 32, KROW = HDIM * 2 + 16, NCH = HDIM / 8, PER = KT * NCH / 512, NSUB = KT / 32;
    static_assert(2 * KT * KROW + 128 <= ATT_FLAG_OFF, "attention LDS tiles overlap the flag words");
    int tid = threadIdx.x; asm volatile("" : "+v"(tid));
    const int lane = tid & 63, w = __builtin_amdgcn_readfirstlane(tid >> 6), r = lane & 31, hh = lane >> 5;
    const int tq0 = q0 + 32 * w, tq = tq0 + r;
    LAS unsigned char* Ks = lds; LAS unsigned char* Vr = lds + KT * KROW;
    const int trq = (r & 15) >> 2, trp = r & 3, trb = r & 16;
    LAS unsigned* flags = (LAS unsigned*)(lds + ATT_FLAG_OFF);
    bf16x8 Qf[KS];
#pragma unroll
    for (int ks = 0; ks < KS; ++ks) Qf[ks] = *(const bf16x8*)(Qp + (size_t)tq * ldq + 16 * ks + 8 * hh);
    f32x16 Oacc[DD];
#pragma unroll
    for (int dd = 0; dd < DD; ++dd)
#pragma unroll
        for (int i = 0; i < 16; ++i) Oacc[dd][i] = 0.f;
    float m = -INFINITY, l = 0.f, run = (MODE == 1) ? 1.f : 0.f; unsigned done_w = 0u;
    float w8[8], u4[4], fgc[4], fmn[16], fbias = 0.f;
    if (MODE == 0) {
        const int cc = r & 15, e = cc & 3, f = cc >> 3; const bool act = (hh == ((cc >> 2) & 1)); const int c4 = r & 3;
#pragma unroll
        for (int i = 0; i < 8; ++i) { w8[i] = (act && (i & 3) == e && (i >> 2) == f) ? 1.f : 0.f; asm volatile("" : "+v"(w8[i])); }
        fbias = act ? 0.f : -INFINITY; asm volatile("" : "+v"(fbias));
#pragma unroll
        for (int j = 0; j < 4; ++j) { u4[j] = (j == c4) ? 1.f : 0.f; asm volatile("" : "+v"(u4[j])); }
#pragma unroll
        for (int g = 0; g < 4; ++g) { fgc[g] = (((r - 4 * hh - c4 - 8 * g) & 15) == 0) ? 2.f : 1.f; asm volatile("" : "+v"(fgc[g])); }
#pragma unroll
        for (int i = 0; i < 16; ++i) { const int dm = (r - 4 * hh - ((i & 3) + 8 * (i >> 2))) & 15; fmn[i] = 1.f + ((dm & 3) == 0 ? 1.f : 0.f) + (dm == 0 ? 1.f : 0.f); asm volatile("" : "+v"(fmn[i])); }
    }
    const int kt_hi = (MODE == 2) ? (nkeys / KT - 1) : ((q0 + 255) / KT);
    u32x4 kA[PER], vA[PER], kB[PER], vB[PER];
#define ATT_GLOAD(KR, VR, kt) do { _Pragma("unroll") for (int p_ = 0; p_ < PER; ++p_) { const int idx_ = tid + 512 * p_, key_ = idx_ / NCH, ch_ = idx_ % NCH; \
        KR[p_] = *(const u32x4*)(Kp + (size_t)(KT * (kt) + key_) * ldkv + ch_ * 8); VR[p_] = *(const u32x4*)(Vp + (size_t)(KT * (kt) + key_) * ldkv + ch_ * 8); } } while (0)
    auto stage = [&](const u32x4 (&KR)[PER], const u32x4 (&VR)[PER]) -> bool {
        if (MODE == 1 && lane == 0) flags[w] = done_w;
        __syncthreads();
#pragma unroll
        for (int p_ = 0; p_ < PER; ++p_) { const int idx_ = tid + 512 * p_, key_ = idx_ / NCH, ch_ = idx_ % NCH;
            *(LAS u32x4*)(Ks + key_ * KROW + ch_ * 16) = KR[p_];
            *(LAS u32x4*)(Vr + key_ * KROW + ch_ * 16) = VR[p_];
        }
        bool alldone = false;
        if (MODE == 1) { unsigned a = 1u;
#pragma unroll
            for (int i = 0; i < 8; ++i) a &= flags[i];
            alldone = a != 0u; }
        __syncthreads();
        return alldone;
    };
    auto qk = [&](int sub, f32x16& S) {
        bf16x8 kf[KS];
#pragma unroll
        for (int ks = 0; ks < KS; ++ks) kf[ks] = *(const LAS bf16x8*)(Ks + (32 * sub + r) * KROW + (16 * ks + 8 * hh) * 2);
#pragma unroll
        for (int i = 0; i < 16; ++i) S[i] = 0.f;
        __builtin_amdgcn_sched_barrier(0);
#pragma unroll
        for (int ks = 0; ks < KS; ++ks) S = MFMA32(kf[ks], Qf[ks], S);
    };
    auto compute = [&](int kt) {
        f32x16 Sn; bool an;
        { const int tkn = KT * kt + 32 * (NSUB - 1); an = !((MODE != 2 && tkn > tq0 + 31) || (MODE == 1 && done_w)); if (an) qk(NSUB - 1, Sn); }
#pragma unroll
        for (int sub = NSUB - 1; sub >= 0; --sub) {
            const int tk0 = KT * kt + 32 * sub;
            f32x16 S = Sn; const bool a = an;
            if (sub > 0) { const int tkn = tk0 - 32; an = !((MODE != 2 && tkn > tq0 + 31) || (MODE == 1 && done_w)); if (an) qk(sub - 1, Sn); }
            if (!a) continue;
            s16x4 vlo[DD][2], vhi[DD][2];
#pragma unroll
            for (int dd = 0; dd < DD; ++dd)
#pragma unroll
                for (int s2 = 0; s2 < 2; ++s2) {
                    LAS unsigned char* vp = Vr + (32 * sub + 16 * s2 + 4 * hh + trq) * KROW + (32 * dd + trb) * 2 + 8 * trp;
                    vlo[dd][s2] = __builtin_amdgcn_ds_read_tr16_b64_v4i16((LAS s16x4*)vp); vhi[dd][s2] = __builtin_amdgcn_ds_read_tr16_b64_v4i16((LAS s16x4*)(vp + 8 * KROW));
                }
            __builtin_amdgcn_sched_barrier(0);
            const int dbase = tq - tk0 - 4 * hh;
            const int D = tq0 - tk0;
            if (MODE == 0 || MODE == 2) {
                const float C = (MODE == 0 ? 0.125f : 0.08838834764831845f) * 1.4426950408889634f;
                float alpha, ls = 0.f, mn;
                if (MODE == 0 && D >= 544) {
                    float s1 = S[0] * w8[0], s2 = S[8] * w8[0];
#pragma unroll
                    for (int i = 1; i < 8; ++i) { s1 = fmaf(S[i], w8[i], s1); s2 = fmaf(S[8 + i], w8[i], s2); }
                    const float v1 = fmaf(s1, C, fbias), v2 = fmaf(s2, C, fbias);
                    float mx = fmaxf(v1, v2); mx = fmaxf(mx, __shfl_xor(mx, 32));
                    mn = fmaxf(m, mx);
                    alpha = __builtin_amdgcn_exp2f(m - mn);
                    const float p1 = __builtin_amdgcn_exp2f(v1 - mn), p2 = __builtin_amdgcn_exp2f(v2 - mn);
                    ls = p1 + p2;
#pragma unroll
                    for (int i = 0; i < 8; ++i) { S[i] = w8[i] * p1; S[8 + i] = w8[i] * p2; }
                } else if (MODE == 0 && D >= 160 && D <= 480) {
                    float vg[4]; float mx = -INFINITY;
#pragma unroll
                    for (int g = 0; g < 4; ++g) { vg[g] = (fmaf(S[4 * g + 3], u4[3], fmaf(S[4 * g + 2], u4[2], fmaf(S[4 * g + 1], u4[1], S[4 * g] * u4[0])))) * C; mx = fmaxf(mx, vg[g]); }
                    mx = fmaxf(mx, __shfl_xor(mx, 32));
                    mn = fmaxf(m, mx);
                    alpha = __builtin_amdgcn_exp2f(m - mn);
#pragma unroll
                    for (int g = 0; g < 4; ++g) { const float pg = fgc[g] * __builtin_amdgcn_exp2f(vg[g] - mn); ls += pg;
#pragma unroll
                        for (int j = 0; j < 4; ++j) S[4 * g + j] = u4[j] * pg; }
                } else if (MODE == 0 && D >= 32 && D <= 96) {
                    float mx = -INFINITY;
#pragma unroll
                    for (int i = 0; i < 16; ++i) { S[i] = S[i] * C; mx = fmaxf(mx, S[i]); }
                    mx = fmaxf(mx, __shfl_xor(mx, 32));
                    mn = fmaxf(m, mx);
                    alpha = __builtin_amdgcn_exp2f(m - mn);
#pragma unroll
                    for (int i = 0; i < 16; ++i) { const float p = fmn[i] * __builtin_amdgcn_exp2f(S[i] - mn); S[i] = p; ls += p; }
                } else {
                    float fm[16]; float mx = -INFINITY;
#pragma unroll
                    for (int i = 0; i < 16; ++i) {
                        float v = S[i] * C;
                        if (MODE == 0) { const int d = dbase - ((i & 3) + 8 * (i >> 2));
                            int mult = (d <= 128 ? 1 : 0) + ((((d & 3) == 0) && d <= 512) ? 1 : 0) + (((d & 15) == 0) ? 1 : 0);
                            mult = d >= 0 ? mult : 0; fm[i] = (float)mult; v = mult > 0 ? v : -INFINITY; }
                        else fm[i] = 1.f;
                        S[i] = v; mx = fmaxf(mx, v);
                    }
                    mx = fmaxf(mx, __shfl_xor(mx, 32));
                    mn = fmaxf(m, mx); const float ms = (mn == -INFINITY) ? 0.f : mn;
                    alpha = __builtin_amdgcn_exp2f(m - ms);
#pragma unroll
                    for (int i = 0; i < 16; ++i) { const float p = fm[i] * __builtin_amdgcn_exp2f(S[i] - ms); S[i] = p; ls += p; }
                }
                l = l * alpha + ls; m = mn;
                if (!__all(alpha == 1.f)) {
#pragma unroll
                    for (int dd = 0; dd < DD; ++dd) Oacc[dd] = Oacc[dd] * alpha;
                }
            } else {
                float om[16], ex[16], G[4], PG[4];
                if (D < 32) {
#pragma unroll
                    for (int i = 0; i < 16; ++i) { const int d = dbase - ((i & 3) + 8 * (i >> 2)); const bool valid = d > 0;
                        const float x = fminf(fmaxf(S[i] * (0.125f * 1.4426950408889634f), -115.f), 115.f); const float e = __builtin_amdgcn_exp2f(x); const float o1 = __builtin_amdgcn_rcpf(1.f + e);
                        om[i] = valid ? o1 : 1.f; S[i] = valid ? e * o1 : 0.f; }
                } else {
#pragma unroll
                    for (int i = 0; i < 16; ++i) {
                        const float x = fminf(fmaxf(S[i] * (0.125f * 1.4426950408889634f), -115.f), 115.f); const float e = __builtin_amdgcn_exp2f(x); const float o1 = __builtin_amdgcn_rcpf(1.f + e);
                        om[i] = o1; S[i] = e * o1; }
                }
#pragma unroll
                for (int g = 0; g < 4; ++g) { ex[4 * g + 3] = 1.f; ex[4 * g + 2] = om[4 * g + 3]; ex[4 * g + 1] = ex[4 * g + 2] * om[4 * g + 2]; ex[4 * g] = ex[4 * g + 1] * om[4 * g + 1]; G[g] = ex[4 * g] * om[4 * g]; }
#pragma unroll
                for (int g = 0; g < 4; ++g) PG[g] = __shfl_xor(G[g], 32);
                float suf = run;
#pragma unroll
                for (int g = 3; g >= 0; --g) { const float lat = suf * (hh == 0 ? PG[g] : 1.f);
                    S[4 * g + 3] = S[4 * g + 3] * lat; S[4 * g + 2] = S[4 * g + 2] * (lat * ex[4 * g + 2]); S[4 * g + 1] = S[4 * g + 1] * (lat * ex[4 * g + 1]); S[4 * g] = S[4 * g] * (lat * ex[4 * g]);
                    suf *= G[g] * PG[g]; }
                run = suf;
                done_w = __all(run < 1e-30f) ? 1u : 0u;
            }
            u32x4 pp0, pp1;
#pragma unroll
            for (int j = 0; j < 4; ++j) { pp0[j] = pk_bf16(S[2 * j], S[2 * j + 1]); pp1[j] = pk_bf16(S[8 + 2 * j], S[8 + 2 * j + 1]); }
            const bf16x8 P0 = __builtin_bit_cast(bf16x8, pp0), P1 = __builtin_bit_cast(bf16x8, pp1);
#pragma unroll
            for (int dd = 0; dd < DD; ++dd)
#pragma unroll
                for (int s2 = 0; s2 < 2; ++s2) {
                    const bf16x8 vf = __builtin_shufflevector(vlo[dd][s2], vhi[dd][s2], 0, 1, 2, 3, 4, 5, 6, 7);
                    Oacc[dd] = MFMA32(vf, s2 ? P1 : P0, Oacc[dd]);
                }
        }
    };
    ATT_GLOAD(kA, vA, kt_hi);
    if constexpr (MODE == 2) {
#pragma unroll 1
        for (int kt = kt_hi; kt >= 0; --kt) {
            stage(kA, vA);
            if (kt >= 1) ATT_GLOAD(kA, vA, kt - 1);
            compute(kt);
        }
    } else {
        if (kt_hi >= 1) ATT_GLOAD(kB, vB, kt_hi - 1);
#pragma unroll 1
        for (int kt = kt_hi; kt >= 0; kt -= 2) {
            if (stage(kA, vA)) break;
            if (kt >= 2) ATT_GLOAD(kA, vA, kt - 2);
            compute(kt);
            if (kt == 0) break;
            if (stage(kB, vB)) break;
            if (kt >= 3) ATT_GLOAD(kB, vB, kt - 3);
            compute(kt - 1);
        }
    }
#undef ATT_GLOAD
    float inv = 1.f;
    if (MODE != 1) { const float lt = l + __shfl_xor(l, 32); inv = 1.f / lt; }
#pragma unroll
    for (int dd = 0; dd < DD; ++dd)
#pragma unroll
        for (int g = 0; g < 4; g += 2) {
            unsigned a0 = pk_bf16(Oacc[dd][4 * g] * inv, Oacc[dd][4 * g + 1] * inv), a1 = pk_bf16(Oacc[dd][4 * g + 2] * inv, Oacc[dd][4 * g + 3] * inv);
            unsigned b0 = pk_bf16(Oacc[dd][4 * g + 4] * inv, Oacc[dd][4 * g + 5] * inv), b1 = pk_bf16(Oacc[dd][4 * g + 6] * inv, Oacc[dd][4 * g + 7] * inv);
            { auto x = __builtin_amdgcn_permlane32_swap(a0, b0, false, false); a0 = x[0]; b0 = x[1]; }
            { auto x = __builtin_amdgcn_permlane32_swap(a1, b1, false, false); a1 = x[0]; b1 = x[1]; }
            u32x4 o; o[0] = a0; o[1] = a1; o[2] = b0; o[3] = b1;
            *(u32x4*)(Op + (size_t)tq * ldo + 32 * dd + 8 * g + 8 * hh) = o;
        }
}
constexpr int WQ_WORD = 4096;
__device__ __forceinline__ void p_attn_ab(LAS unsigned char* lds, const bf16_t* qkv, bf16_t* OA, bf16_t* OB, unsigned* wq) {
    constexpr size_t TS = (size_t)T * 512;
    volatile LAS unsigned* slot = (volatile LAS unsigned*)(lds + ATT_FLAG_OFF + 64);
    for (;;) {
        if (threadIdx.x == 0) *slot = __hip_atomic_fetch_add(wq, 1u, __ATOMIC_RELAXED, __HIP_MEMORY_SCOPE_AGENT);
        __syncthreads();
        const unsigned it = (unsigned)__builtin_amdgcn_readfirstlane((int)*slot);
        __syncthreads();
        if (it >= 2048u) break;
        const int j = it & 1023, qb = 7 - (j >> 7), bh = j & 127, b = bh >> 3, h = bh & 7;
        const bf16_t* base = qkv + (size_t)bh * SEQ * 64;
        if (it < 1024u) attn_item<0, 64, 128>(lds, base, 64, base + TS, base + 2 * TS, 64, OA + (size_t)b * SEQ * 1024 + h * HD, 1024, qb * 256, SEQ);
        else attn_item<1, 64, 128>(lds, base + 3 * TS, 64, base + 4 * TS, base + 5 * TS, 64, OB + (size_t)b * SEQ * 1024 + h * HD, 1024, qb * 256, SEQ);
    }
}
__device__ __forceinline__ void p_attn_mem(LAS unsigned char* lds, const bf16_t* qm, const bf16_t* kvm, bf16_t* om) {
#pragma unroll 1
    for (int i = 0;; ++i) {
        Unit u; { pg8::StaticOrder S2; S2.init(T, MEMW, (int)gridDim.x, (int)blockIdx.x); if (!S2.next(i, u)) break; }
        const int b = u.pm >> 3, qb = u.pm & 7;
#pragma unroll 1
        for (int hq = 0; hq < 2; ++hq) { const int h = 2 * u.pn + hq;
            attn_item<2, 128, 64>(lds, qm + (size_t)b * SEQ * MEMW + h * 128, MEMW, kvm + (size_t)b * NMEM * 1024 + h * 128, kvm + (size_t)b * NMEM * 1024 + 512 + h * 128, 1024,
                                  om + (size_t)b * SEQ * MEMW + h * 128, MEMW, qb * 256, NMEM); }
    }
}

__device__ __forceinline__ bool sync_if(int k, cg::grid_group& grid, XcdBarrier& xb) {
    if (k == 1) { grid.sync(); xb = xcd_barrier_post(xb.bar, xb.st); }
    else if (k == 8) {
        asm volatile("s_waitcnt vmcnt(0)" ::: "memory");
        __syncthreads();
        if (threadIdx.x == 0) { __builtin_amdgcn_fence(__ATOMIC_ACQUIRE, "agent"); asm volatile("s_waitcnt vmcnt(0)" ::: "memory"); }
        __syncthreads();
    }
    else if (k > 1) xcd_barrier(xb);
    asm volatile("" ::: "memory"); return true; }
constexpr int NPHASE = 13;
#ifndef NAIVE_AB
#define NAIVE_AB 0
#endif
#ifndef NAIVE_MEM
#define NAIVE_MEM 0
#endif
#ifndef ONLY
#define ONLY -1
#endif
#ifndef DUP_MASK
#define DUP_MASK 0
#endif
#define PHASE(k) if ((ONLY < 0 || ONLY == (k)) && ph_lo <= (k) && (k) < ph_hi) if (sync_if((k), grid, xb)) for (int rep_ = 0; rep_ < (((DUP_MASK >> (k)) & 1) ? 2 : 1); ++rep_)
__global__ __launch_bounds__(512, 2) void mega(Params p, int ph_lo, int ph_hi) {
    extern __shared__ __attribute__((aligned(16))) unsigned char shm[];
    LAS unsigned char* lds = (LAS unsigned char*)shm;
    cg::grid_group grid = cg::this_grid();
    Ctx c; c.tid = threadIdx.x; c.lane = c.tid & 63; c.wave = c.tid >> 6; c.gw = blockIdx.x * 8 + c.wave; c.ngw = gridDim.x * 8; c.gt = blockIdx.x * 512 + c.tid; c.ngt = gridDim.x * 512;
    unsigned char* ws = p.ws;
    bf16_t* Wt_in = (bf16_t*)(ws + WS_WIN); bf16_t* Wt_upa = (bf16_t*)(ws + WS_WUPA); bf16_t* Wt_upb = (bf16_t*)(ws + WS_WUPB); bf16_t* Wt_out = (bf16_t*)(ws + WS_WOUT);
    bf16_t* Wt_qm = (bf16_t*)(ws + WS_WQM); bf16_t* Wt_kvm = (bf16_t*)(ws + WS_WKVM); bf16_t* Wt_om = (bf16_t*)(ws + WS_WOM); bf16_t* Wt_gu = (bf16_t*)(ws + WS_WGU); bf16_t* Wt_dn = (bf16_t*)(ws + WS_WDN);
    bf16_t* memn = (bf16_t*)(ws + WS_MEMN); bf16_t* kvm = (bf16_t*)(ws + WS_KVM);
    float* ss1 = (float*)(ws + WS_SS1); float* ss2 = (float*)(ws + WS_SS2); float* ss3 = (float*)(ws + WS_SS3); float* rope = (float*)(ws + WS_ROPE);
    bf16_t* n1 = (bf16_t*)(ws + WS_R1); bf16_t* mixed = (bf16_t*)(ws + WS_R1); bf16_t* h2b = (bf16_t*)(ws + WS_R1);
    bf16_t* proj = (bf16_t*)(ws + WS_PROJ); bf16_t* gates = (bf16_t*)(ws + WS_PROJ + 192 * MiB);
    float* h1 = (float*)(ws + WS_H1); bf16_t* h1b = (bf16_t*)(ws + WS_H1B); bf16_t* qm = (bf16_t*)(ws + WS_QM); bf16_t* om = (bf16_t*)(ws + WS_OM);
    float* h2 = (float*)(ws + WS_H2); bf16_t* act = (bf16_t*)(ws + WS_ACT); bf16_t* OA = (bf16_t*)(ws + WS_OA); bf16_t* OB = (bf16_t*)(ws + WS_OA) + 512;
    float* m1 = p.out; unsigned* bar = (unsigned*)(ws + WS_BAR);
    volatile LAS unsigned* xst = (volatile LAS unsigned*)(lds + pg8::STAGE_BYTES);
    if (c.tid == 0) { xst[0] = 0u; xst[1] = 0u; }
    __syncthreads();
    XcdBarrier xb; xb.bar = bar; xb.x = 0u; xb.st = xst;
    pg8::StaticOrder S;
    {
        PHASE(0) {
            int cur = 0;
            p_transpose(c, lds, p.w_in, Wt_in, DM, INC, nullptr, 0, cur);
            p_transpose(c, lds, p.w_ffn_gate, Wt_gu, DM, DFF, p.g_ffn, 1, cur);
            p_transpose(c, lds, p.w_ffn_up, Wt_gu, DM, DFF, p.g_ffn, 2, cur);
            p_transpose(c, lds, p.w_ffn_down, Wt_dn, DFF, DM, nullptr, 0, cur);
            p_transpose(c, lds, p.w_up_a, Wt_upa, 512, DM, nullptr, 0, cur, 1024, 0);
            p_transpose(c, lds, p.w_up_b, Wt_upa, 512, DM, nullptr, 0, cur, 1024, 512);
            p_transpose(c, lds, p.w_out, Wt_out, DM, DM, nullptr, 0, cur);
            p_transpose(c, lds, p.w_q_mem, Wt_qm, DM, MEMW, p.g_mem_q, 0, cur);
            p_transpose(c, lds, p.w_kv_mem, Wt_kvm, DM, 2 * MEMW, nullptr, 0, cur);
            p_transpose(c, lds, p.w_o_mem, Wt_om, MEMW, DM, nullptr, 0, cur);
            p_rmsnorm_rows(c, p.x, p.g_mix, n1, T);
            p_rmsnorm_rows(c, p.mem, p.g_mem_kv, memn, BATCH * NMEM);
            p_rope_table(c, p.pos, rope);
            if (blockIdx.x == 0) { for (int i = c.tid; i < XCD_BAR_WORDS; i += 512) bar[i] = 0u; if (c.tid == 0) bar[WQ_WORD] = 0u; }
        }
        PHASE(1) {
            Gemm g{n1, Wt_in, T, INC, DM}; EpiBf16 E{proj, INC, nullptr, 1 << 30, rope, 4, 12, gates};   S.init(g.M, g.N, gridDim.x, blockIdx.x); pg8::gemm_phase(lds, g, S, E);
        }
        PHASE(3) {
            { Gemm g{memn, Wt_kvm, BATCH * NMEM, 1024, DM}; EpiBf16 E{kvm, 1024, nullptr, 1 << 30, nullptr, 0, 0, nullptr}; S.init(g.M, g.N, gridDim.x, blockIdx.x); pg8::gemm_phase(lds, g, S, E); }
            p_attn_ab(lds, proj, OA, OB, bar + WQ_WORD);
        }
        PHASE(5) { Gemm g{OA, Wt_upa, T, DM, DM}; EpiGate E{gates, mixed}; S.init(g.M, g.N, gridDim.x, blockIdx.x); pg8::gemm_phase(lds, g, S, E); }
        PHASE(6) { Gemm g{mixed, Wt_out, T, DM, DM}; EpiRes E{p.x, nullptr, nullptr, h1b, ss1}; S.init(g.M, g.N, gridDim.x, blockIdx.x); pg8::gemm_phase(lds, g, S, E); }
        PHASE(7) { Gemm g{h1b, Wt_qm, T, MEMW, DM}; EpiBf16 E{qm, MEMW, ss1, 1 << 30, nullptr, 0, 0, nullptr}; S.init(g.M, g.N, gridDim.x, blockIdx.x); pg8::gemm_phase(lds, g, S, E); }
        PHASE(8) {
            p_attn_mem(lds, qm, kvm, om);
        }
        PHASE(9) { Gemm g{om, Wt_om, T, DM, MEMW}; EpiRes E{nullptr, h1b, nullptr, h2b, ss2}; S.init(g.M, g.N, gridDim.x, blockIdx.x); pg8::gemm_phase(lds, g, S, E); }
        PHASE(10) { Gemm g{h2b, Wt_gu, T, 2 * DFF, DM}; EpiSwiGLU E{act, ss2}; S.init(g.M, g.N, gridDim.x, blockIdx.x); pg8::gemm_phase(lds, g, S, E); }
        PHASE(11) { Gemm g{act, Wt_dn, T, DM, DFF}; EpiRes E{nullptr, h2b, p.out, nullptr, ss3}; S.init(g.M, g.N, gridDim.x, blockIdx.x); pg8::gemm_phase(lds, g, S, E); }
        PHASE(12) p_final(c, p.out, ss3, p.g_final);
    }
}

constexpr int LDS_BYTES = pg8::STAGE_BYTES + 16;
#ifndef ONE_LAUNCH
#define ONE_LAUNCH 1
#endif
extern "C" void kernel_launch(void* const* d_in, const int* in_sizes, int n_in, void* d_out, int out_size, void* d_ws, size_t ws_size, hipStream_t stream) {
    static int grid = 0;
    if (grid == 0) {
        if (n_in != 18 || out_size != T * DM || ws_size < WS_END) { fprintf(stderr, "kernel_launch: unexpected shapes (n_in %d out %d ws %zu)\n", n_in, out_size, ws_size); grid = -1; return; }
        int dev = 0, cus = 0, per_cu = 0;
        (void)hipGetDevice(&dev); (void)hipDeviceGetAttribute(&cus, hipDeviceAttributeMultiprocessorCount, dev);
        if (hipFuncSetAttribute((const void*)mega, hipFuncAttributeMaxDynamicSharedMemorySize, LDS_BYTES) != hipSuccess) { fprintf(stderr, "hipFuncSetAttribute failed\n"); grid = -1; return; }
        if (hipOccupancyMaxActiveBlocksPerMultiprocessor(&per_cu, (const void*)mega, 512, LDS_BYTES) != hipSuccess || per_cu < 1) { fprintf(stderr, "occupancy query: %d\n", per_cu); per_cu = 1; }
        (void)hipGetLastError();
        grid = cus * 1;
    }
    if (grid < 0) return;
    Params p{};
    p.x = (const float*)d_in[0]; p.mem = (const float*)d_in[1]; p.pos = (const int*)d_in[2]; p.g_mix = (const float*)d_in[3]; p.w_in = (const float*)d_in[4];
    p.w_up_a = (const float*)d_in[5]; p.w_up_b = (const float*)d_in[6]; p.w_out = (const float*)d_in[7]; p.g_mem_q = (const float*)d_in[8]; p.g_mem_kv = (const float*)d_in[9];
    p.w_q_mem = (const float*)d_in[10]; p.w_kv_mem = (const float*)d_in[11]; p.w_o_mem = (const float*)d_in[12]; p.g_ffn = (const float*)d_in[13];
    p.w_ffn_gate = (const float*)d_in[14]; p.w_ffn_up = (const float*)d_in[15]; p.w_ffn_down = (const float*)d_in[16]; p.g_final = (const float*)d_in[17];
    p.out = (float*)d_out; p.ws = (unsigned char*)d_ws;
#if ONE_LAUNCH
    int lo = 0, hi = NPHASE;
    void* args[] = {&p, &lo, &hi};
    hipError_t e = hipLaunchCooperativeKernel((const void*)mega, dim3(grid), dim3(512), args, LDS_BYTES, stream);
    if (e != hipSuccess) fprintf(stderr, "cooperative launch failed: %s\n", hipGetErrorString(e));
#else
    for (int ph = 0; ph < NPHASE; ++ph) hipLaunchKernelGGL(mega, dim3(grid), dim3(512), LDS_BYTES, stream, p, ph, ph + 1);
#endif
}
```

```cpp
#include <hip/hip_runtime.h>
#include <hip/hip_cooperative_groups.h>
#include <cstdio>
namespace cg = cooperative_groups;

#define LAS __attribute__((address_space(3)))
typedef unsigned short bf16_t;
typedef short bf16x8 __attribute__((ext_vector_type(8)));
typedef float f32x4 __attribute__((ext_vector_type(4)));
typedef unsigned u32x4 __attribute__((ext_vector_type(4)));
typedef unsigned u32x2 __attribute__((ext_vector_type(2)));

constexpr int BATCH = 16, SEQ = 2048, DM = 1024, T = BATCH * SEQ;
constexpr int HD = 64, NHA = 8, NHB = 8;
constexpr int INC = 5120;
constexpr int C_QA = 0, C_KA = 512, C_VA = 1024, C_QB = 1536, C_KB = 2048, C_VB = 2560, C_GA = 3072, C_GB = 4096;
constexpr int NMEM = 256, MEMW = 512, DFF = 2816;
constexpr float EPS = 1e-6f;

constexpr size_t MiB = 1ull << 20;
constexpr size_t WS_WIN = 0, WS_WUPA = 10 * MiB, WS_WUPB = 11 * MiB, WS_WOUT = 12 * MiB, WS_WQM = 14 * MiB, WS_WKVM = 15 * MiB,
                 WS_WOM = 17 * MiB, WS_WGU = 18 * MiB, WS_WDN = 29 * MiB, WS_MEMN = 36 * MiB, WS_KVM = 44 * MiB,
                 WS_SS1 = 52 * MiB, WS_SS2 = 54 * MiB, WS_SS3 = 56 * MiB, WS_ROPE = 58 * MiB, WS_BAR = 60 * MiB;
constexpr size_t WS_R1 = 64 * MiB;
constexpr size_t WS_PROJ = 128 * MiB;
constexpr size_t WS_H1 = 128 * MiB, WS_H1B = 256 * MiB, WS_QM = 320 * MiB, WS_OM = 352 * MiB, WS_H2 = 384 * MiB, WS_ACT = 128 * MiB;
constexpr size_t WS_OA = 448 * MiB, WS_OB = 480 * MiB;
constexpr size_t WS_END = 512 * MiB;

struct Params {
    const float* x; const float* mem; const int* pos; const float* g_mix; const float* w_in; const float* w_up_a; const float* w_up_b; const float* w_out;
    const float* g_mem_q; const float* g_mem_kv; const float* w_q_mem; const float* w_kv_mem; const float* w_o_mem; const float* g_ffn;
    const float* w_ffn_gate; const float* w_ffn_up; const float* w_ffn_down; const float* g_final;
    float* out; unsigned char* ws;
};

typedef float f32x2 __attribute__((ext_vector_type(2)));
typedef __bf16 bf16v2 __attribute__((ext_vector_type(2)));
__device__ __forceinline__ unsigned pk_bf16(float lo, float hi) { f32x2 v = {lo, hi}; bf16v2 r = __builtin_convertvector(v, bf16v2); return __builtin_bit_cast(unsigned, r); }
__device__ __forceinline__ bf16_t f2bf(float f) { return (bf16_t)(pk_bf16(f, 0.f) & 0xffffu); }
__device__ __forceinline__ float bf2f(bf16_t b) { return __uint_as_float(((unsigned)b) << 16); }
__device__ __forceinline__ float bflo(unsigned u) { return __uint_as_float(u << 16); }
__device__ __forceinline__ float bfhi(unsigned u) { return __uint_as_float(u & 0xffff0000u); }
__device__ __forceinline__ float wave_sum(float v) {
#pragma unroll
    for (int o = 1; o < 64; o <<= 1) v += __shfl_xor(v, o);
    return v;
}
__device__ __forceinline__ float sigmoidf_(float x) { return __builtin_amdgcn_rcpf(1.f + __builtin_amdgcn_exp2f(x * -1.4426950408889634f)); }
__device__ __forceinline__ float rstd_of(const float* ss, int row) {
    const f32x4* p = (const f32x4*)(ss + (size_t)row * 16);
    f32x4 a = p[0], b = p[1], c = p[2], d = p[3];
    float s = ((a[0] + a[1]) + (a[2] + a[3])) + ((b[0] + b[1]) + (b[2] + b[3])) + ((c[0] + c[1]) + (c[2] + c[3])) + ((d[0] + d[1]) + (d[2] + d[3]));
    return rsqrtf(s * (1.f / DM) + EPS);
}


#define XB_TMO      128
#define XB_XCNT(j)  (256  + 64 * (j))
#define XB_XSUB(j)  (1280 + 64 * (j))
#define XB_XGEN(j)  (2304 + 64 * (j))
#define XB_TOP      3328
#define XB_TOPGEN   3392
#define XCD_BAR_WORDS 3456
#define XB_SPIN_CAP (1u << 18)
__device__ __forceinline__ unsigned xb_ld(unsigned* p)              { return __hip_atomic_load(p, __ATOMIC_RELAXED, __HIP_MEMORY_SCOPE_AGENT); }
__device__ __forceinline__ unsigned xb_add(unsigned* p, unsigned v) { return __hip_atomic_fetch_add(p, v, __ATOMIC_RELAXED, __HIP_MEMORY_SCOPE_AGENT); }
__device__ __forceinline__ unsigned xb_xcc_id() { return (unsigned)__builtin_amdgcn_s_getreg((3 << 11) | 20) & 0xFu; }
#define XB_SPIN(cond, bar) do { unsigned _sp = 0; while (cond) { __builtin_amdgcn_s_sleep(1); \
    if ((++_sp & 255u) == 0u) { if (xb_ld(&(bar)[XB_TMO])) break; if (_sp > XB_SPIN_CAP) { atomicAdd(&(bar)[XB_TMO], 1u); break; } } } } while (0)
struct XcdBarrier { unsigned* bar; unsigned x; volatile LAS unsigned* st; };
__device__ __forceinline__ XcdBarrier xcd_barrier_post(unsigned* bar, volatile LAS unsigned* st) {
    XcdBarrier b; b.bar = bar; b.x = xb_xcc_id(); b.st = st;
    if (threadIdx.x == 0) (void)xb_add(&bar[XB_XCNT(b.x)], 1u);
    return b;
}
__device__ __forceinline__ void xcd_barrier_complete(unsigned* bar, unsigned x, unsigned& nloc, unsigned& nx) {
    const unsigned G = gridDim.x * gridDim.y * gridDim.z;
    unsigned sum, cnt, mine, sp = 0u;
    for (;;) {
        sum = 0u; cnt = 0u; mine = 0u;
#pragma unroll
        for (unsigned j = 0; j < 16; ++j) { const unsigned c = xb_ld(&bar[XB_XCNT(j)]); sum += c; cnt += (c > 0u) ? 1u : 0u; mine = (j == x) ? c : mine; }
        if (sum == G) break;
        __builtin_amdgcn_s_sleep(1);
        if ((++sp & 255u) == 0u) { if (xb_ld(&bar[XB_TMO])) break; if (sp > XB_SPIN_CAP) { atomicAdd(&bar[XB_TMO], 1u); break; } }
    }
    nloc = mine > 0u ? mine : 1u; nx = cnt > 0u ? cnt : 1u;
}
__device__ __forceinline__ void xcd_barrier(const XcdBarrier& b) {
    asm volatile("s_waitcnt vmcnt(0)" ::: "memory");
    __syncthreads();
    if (threadIdx.x == 0) {
        unsigned* bar = b.bar;
        __builtin_amdgcn_s_waitcnt(0);
        unsigned nloc = b.st[0], nx = b.st[1];
        if (nloc == 0u) { xcd_barrier_complete(bar, b.x, nloc, nx); b.st[0] = nloc; b.st[1] = nx; }
        const unsigned old = xb_add(&bar[XB_XSUB(b.x)], 1u);
        const unsigned gen = old / nloc;
        if (old + 1u == (gen + 1u) * nloc) {
            __builtin_amdgcn_fence(__ATOMIC_RELEASE, "agent");
            asm volatile("s_waitcnt vmcnt(0)" ::: "memory");
            const unsigned og = xb_add(&bar[XB_TOP], 1u);
            const unsigned tg = og / nx;
            if (og + 1u == (tg + 1u) * nx) xb_add(&bar[XB_TOPGEN], 1u);
            else XB_SPIN(xb_ld(&bar[XB_TOPGEN]) == tg, bar);
            __builtin_amdgcn_fence(__ATOMIC_ACQUIRE, "agent");
            xb_add(&bar[XB_XGEN(b.x)], 1u);
            asm volatile("s_waitcnt vmcnt(0)" ::: "memory");
        } else {
            XB_SPIN(xb_ld(&bar[XB_XGEN(b.x)]) == gen, bar);
            __builtin_amdgcn_fence(__ATOMIC_ACQUIRE, "agent");
            asm volatile("s_waitcnt vmcnt(0)" ::: "memory");
        }
    }
    __syncthreads();
}

namespace pg8 {
constexpr int BM = 256, BK = 64, HALF = 128, HTB = HALF * BK * 2, STAGE_BYTES = 8 * HTB, NXCD = 8, WGM = 4;
__host__ __device__ __forceinline__ int lds_byte(int r, int c) { const int st = (r >> 4) * 2 + (c >> 5), rr = r & 15, cc = c & 31, ob = rr * 64 + cc * 2; return st * 1024 + (ob ^ (((ob >> 9) & 1) << 5)); }
__host__ __device__ __forceinline__ void stage_rc(int b, int& R, int& C) { const int st = b / 1024, sb = b % 1024, swz = sb ^ (((sb >> 9) & 1) << 5); R = (st >> 1) * 16 + swz / 64; C = (st & 1) * 32 + (swz % 64) / 2; }
__host__ __device__ __forceinline__ int perm32(int rho) { const int n = rho >> 4, i = rho & 15; return 8 * (i >> 2) + 4 * n + (i & 3); }
struct Unit { int pm, pn; };
struct Gemm { const bf16_t* A; const bf16_t* Bt; int M, N, K; };
struct StaticOrder {
    int nM, nN, nwg, G, c;
    __host__ __device__ void init(int M, int N, int G_, int c_) { nM = M / BM; nN = N / BM; nwg = nM * nN; G = G_; c = c_; }
    __host__ __device__ bool next(int i, Unit& u) const {
        const long L = (long)i * G + c; if (L >= nwg) return false;
        int wgid = (int)L; { const int q = nwg / NXCD, r = nwg % NXCD, xcd = wgid % NXCD, off = wgid / NXCD; wgid = (xcd < r ? xcd * (q + 1) : r * (q + 1) + (xcd - r) * q) + off; }
        const int nig = WGM * nN, gid = wgid / nig, fm = gid * WGM, gsz = (nM - fm) < WGM ? (nM - fm) : WGM;
        u.pm = fm + ((wgid % nig) % gsz); u.pn = (wgid % nig) / gsz; return true;
    }
};

template <class Epi>
__device__ __forceinline__ void gemm_phase(LAS unsigned char* lds, const Gemm g, const StaticOrder& S, const Epi& E) {
    int tid = threadIdx.x; asm volatile("" : "+v"(tid));
    const int wid = __builtin_amdgcn_readfirstlane(tid >> 6), lane = tid & 63, wr = wid >> 2, wc = wid & 3, fr = lane & 15, fq = lane >> 4;
    const int K = g.K, nt = K / BK;
    unsigned voffA[2], voffB[2];
#pragma unroll
    for (int i = 0; i < 2; ++i) { int R, C; stage_rc(tid * 16 + i * 8192, R, C); const int Rb = Epi::LINE ? ((R >> 5) * 64 + perm32(R & 31)) : (Epi::PERM ? ((R & ~31) + perm32(R & 31)) : R);
        voffA[i] = (unsigned)(R * K + C) * 2u; voffB[i] = (unsigned)(Rb * K + C) * 2u; }
    const size_t kstep = (size_t)(BK * 2);
    const size_t hstep = (size_t)HALF * K * 2;
    const size_t tstep = 2 * hstep;
    const size_t hstepB = Epi::LINE ? (size_t)32 * K * 2 : hstep;
    const unsigned ldsw = (unsigned)wid * 1024u;
    const int aoff = lds_byte(wr * 64 + fr, fq * 8), boff = lds_byte(wc * 32 + fr, fq * 8);
#define PG8_SA(b, h) (((b) * 2 + (h)) * HTB)
#define PG8_SB(b, h) ((4 + (b) * 2 + (h)) * HTB)
#define PG8_STAGE(bufoff, gbase, voff) do { _Pragma("unroll") for (int _i = 0; _i < 2; ++_i) \
        __builtin_amdgcn_global_load_lds((const unsigned*)((const char*)(gbase) + (voff)[_i]), (LAS unsigned*)(lds + (bufoff) + ldsw + _i * 8192), 16, 0, 0); } while (0)
#define PG8_LDA(dst, b, h) do { _Pragma("unroll") for (int m = 0; m < 4; ++m) _Pragma("unroll") for (int k = 0; k < 2; ++k) dst[m][k] = *(const LAS bf16x8*)(lds + PG8_SA(b, h) + aoff + m * 2048 + k * 1024); } while (0)
#define PG8_LDB(dst, b, h) do { _Pragma("unroll") for (int n = 0; n < 2; ++n) _Pragma("unroll") for (int k = 0; k < 2; ++k) dst[n][k] = *(const LAS bf16x8*)(lds + PG8_SB(b, h) + boff + n * 2048 + k * 1024); } while (0)
#define PG8_MMA(ai, bj, At, Bt) do { __builtin_amdgcn_s_setprio(1); _Pragma("unroll") for (int m = 0; m < 4; ++m) _Pragma("unroll") for (int n = 0; n < 2; ++n) _Pragma("unroll") for (int k = 0; k < 2; ++k) \
        acc[ai][bj][m][n] = __builtin_amdgcn_mfma_f32_16x16x32_bf16(Bt[n][k], At[m][k], acc[ai][bj][m][n], 0, 0, 0); __builtin_amdgcn_s_setprio(0); } while (0)
#define PG8_WAIT_V(n) asm volatile("s_waitcnt vmcnt(" #n ")" ::: "memory")
#define PG8_WAIT_L(n) asm volatile("s_waitcnt lgkmcnt(" #n ")" ::: "memory")
#define PG8_BAR __builtin_amdgcn_s_barrier()
#define PG8_SCHED __builtin_amdgcn_sched_barrier(0)
    Unit cur, nxt; int ui = 0;
    if (!S.next(0, cur)) return;
    f32x4 acc[2][2][4][2];
#pragma unroll
    for (int a = 0; a < 2; ++a)
#pragma unroll
        for (int b = 0; b < 2; ++b)
#pragma unroll
            for (int m = 0; m < 4; ++m)
#pragma unroll
                for (int n = 0; n < 2; ++n) acc[a][b][m][n] = (f32x4){0.f, 0.f, 0.f, 0.f};
    bf16x8 At[4][2], B0[2][2], B1[2][2];
    const char* cA = (const char*)g.A + (size_t)cur.pm * tstep; const char* cB = (const char*)g.Bt + (size_t)cur.pn * tstep;
    PG8_STAGE(PG8_SB(0, 0), cB, voffB); PG8_STAGE(PG8_SA(0, 0), cA, voffA); PG8_STAGE(PG8_SB(0, 1), cB + hstepB, voffB); PG8_STAGE(PG8_SA(0, 1), cA + hstep, voffA);
    if (wr == 1) PG8_BAR;
    PG8_WAIT_V(4); PG8_BAR;
    PG8_STAGE(PG8_SB(1, 0), cB + kstep, voffB); PG8_STAGE(PG8_SA(1, 0), cA + kstep, voffA); PG8_STAGE(PG8_SB(1, 1), cB + hstepB + kstep, voffB);
    PG8_WAIT_V(6); PG8_BAR;
    for (;;) {
        const bool has_next = S.next(ui + 1, nxt);
        const char* nA = has_next ? (const char*)g.A + (size_t)nxt.pm * tstep : cA; const char* nB = has_next ? (const char*)g.Bt + (size_t)nxt.pn * tstep : cB;
        for (int t = 0; t < nt; t += 2) {
            const bool last = (t == nt - 2);
            const char* a1 = cA + (size_t)(t + 1) * kstep;
            const char* a2 = last ? nA : cA + (size_t)(t + 2) * kstep; const char* b2 = last ? nB : cB + (size_t)(t + 2) * kstep;
            const char* a3 = a2 + kstep; const char* b3 = b2 + kstep;
            if constexpr (Epi::HAS_MID) { if (t == nt / 2) E.mid(acc, cur, wr, wc, fr, fq); }
            PG8_LDB(B0, 0, 0); PG8_SCHED; PG8_LDA(At, 0, 0); PG8_STAGE(PG8_SA(1, 1), a1 + hstep, voffA);
            PG8_WAIT_L(8); PG8_BAR; PG8_WAIT_L(0); PG8_MMA(0, 0, At, B0); PG8_BAR; PG8_SCHED;
            PG8_LDB(B1, 0, 1); PG8_STAGE(PG8_SB(0, 0), b2, voffB);
            PG8_BAR; PG8_WAIT_L(0); PG8_MMA(0, 1, At, B1); PG8_BAR;
            PG8_LDA(At, 0, 1); PG8_STAGE(PG8_SA(0, 0), a2, voffA);
            PG8_BAR; PG8_WAIT_L(0); PG8_MMA(1, 0, At, B0); PG8_BAR; PG8_SCHED;
            PG8_STAGE(PG8_SB(0, 1), b2 + hstepB, voffB);
            PG8_WAIT_V(6); PG8_BAR; PG8_MMA(1, 1, At, B1); PG8_BAR;
            PG8_LDB(B0, 1, 0); PG8_SCHED; PG8_LDA(At, 1, 0); PG8_STAGE(PG8_SA(0, 1), a2 + hstep, voffA);
            PG8_WAIT_L(8); PG8_BAR; PG8_WAIT_L(0); PG8_MMA(0, 0, At, B0); PG8_BAR; PG8_SCHED;
            PG8_LDB(B1, 1, 1); PG8_STAGE(PG8_SB(1, 0), b3, voffB);
            PG8_BAR; PG8_WAIT_L(0); PG8_MMA(0, 1, At, B1); PG8_BAR;
            PG8_LDA(At, 1, 1); PG8_STAGE(PG8_SA(1, 0), a3, voffA);
            PG8_BAR; PG8_WAIT_L(0); PG8_MMA(1, 0, At, B0); PG8_BAR; PG8_SCHED;
            PG8_STAGE(PG8_SB(1, 1), b3 + hstepB, voffB);
            PG8_WAIT_V(6); PG8_BAR; PG8_MMA(1, 1, At, B1); PG8_BAR;
        }
        E(acc, cur, wr, wc, fr, fq);
        if (!has_next) break;
#pragma unroll
        for (int a = 0; a < 2; ++a)
#pragma unroll
            for (int b = 0; b < 2; ++b)
#pragma unroll
                for (int m = 0; m < 4; ++m)
#pragma unroll
                    for (int n = 0; n < 2; ++n) acc[a][b][m][n] = (f32x4){0.f, 0.f, 0.f, 0.f};
        cur = nxt; cA = nA; cB = nB; ++ui;
    }
    PG8_WAIT_V(0);
    if (wr == 0) PG8_BAR;
    PG8_BAR;
#undef PG8_SA
#undef PG8_SB
#undef PG8_STAGE
#undef PG8_LDA
#undef PG8_LDB
#undef PG8_MMA
#undef PG8_WAIT_V
#undef PG8_WAIT_L
#undef PG8_BAR
#undef PG8_SCHED
}
}
using pg8::Unit; using pg8::Gemm;

__device__ __forceinline__ void line_pair(u32x4& a, u32x4& b, bool lo) {
#pragma unroll
    for (int q = 0; q < 4; ++q) {
        const unsigned send = lo ? b[q] : a[q];
        const unsigned recv = (unsigned)__builtin_amdgcn_update_dpp(0, (int)send, 0x128  , 0xf, 0xf, false);
        if (lo) b[q] = recv; else a[q] = recv;
    }
}
struct EpiBf16 {
    static constexpr bool PERM = true, HAS_MID = false, LINE = true;
    bf16_t* O; int ldc; const float* ss; int sig_from; const float* rope; int rope_below; int qkv_tiles; bf16_t* gates;
    __device__ __forceinline__ bf16_t* addr(int row, int col, int pn) const {
        if (qkv_tiles > 0) {
            if (pn < qkv_tiles) return O + (size_t)(col >> 9) * ((size_t)T * 512) + ((size_t)((row >> 11) * 8 + ((col >> 6) & 7)) * SEQ + (row & (SEQ - 1))) * 64 + (col & 63);
            return gates + (size_t)row * 2048 + (col - 256 * qkv_tiles);
        }
        return O + (size_t)row * ldc + col;
    }
    __device__ __forceinline__ void operator()(const f32x4 (&acc)[2][2][4][2], const Unit& u, int wr, int wc, int fr, int fq) const {
        const int row0 = u.pm * 256 + wr * 64 + fr, col0 = u.pn * 256 + wc * 64 + 8 * fq;
        const bool sig = u.pn >= sig_from, lo = fr < 8;
#pragma unroll
        for (int ai = 0; ai < 2; ++ai)
#pragma unroll
            for (int m = 0; m < 4; ++m) {
                const int row = row0 + ai * 128 + m * 16;
                const float rs = ss ? rstd_of(ss, row) : 1.f;
                u32x4 o[2];
#pragma unroll
                for (int bj = 0; bj < 2; ++bj) {
                    f32x4 v0 = acc[ai][bj][m][0] * rs, v1 = acc[ai][bj][m][1] * rs;
                    if (sig) {
#pragma unroll
                        for (int j = 0; j < 4; ++j) { v0[j] = sigmoidf_(v0[j]); v1[j] = sigmoidf_(v1[j]); }
                    }
                    if (bj == 0 && u.pn < rope_below) {
                        f32x4 p0, p1;
#pragma unroll
                        for (int j = 0; j < 4; ++j) { p0[j] = __shfl_xor(v0[j], 16); p1[j] = __shfl_xor(v1[j], 16); }
                        if (fq < 2) {
                            const f32x4 c0 = *(const f32x4*)(rope + (size_t)row * 16), c1 = *(const f32x4*)(rope + (size_t)row * 16 + 4);
                            f32x4 s0 = *(const f32x4*)(rope + (size_t)row * 16 + 8), s1 = *(const f32x4*)(rope + (size_t)row * 16 + 12);
                            if (fq == 0) { s0 = -s0; s1 = -s1; }
                            v0 = v0 * c0 + p0 * s0; v1 = v1 * c1 + p1 * s1;
                        }
                    }
                    o[bj][0] = pk_bf16(v0[0], v0[1]); o[bj][1] = pk_bf16(v0[2], v0[3]); o[bj][2] = pk_bf16(v1[0], v1[1]); o[bj][3] = pk_bf16(v1[2], v1[3]);
                }
                line_pair(o[0], o[1], lo);
                const int colx = col0 + (lo ? 0 : 32);
                *(u32x4*)addr(lo ? row : row - 8, colx, u.pn) = o[0];
                *(u32x4*)addr(lo ? row + 8 : row, colx, u.pn) = o[1];
            }
    }
};
struct EpiGate {
    static constexpr bool PERM = true, HAS_MID = true, LINE = true;
    const bf16_t* gates; bf16_t* O;
    __device__ __forceinline__ void mid(f32x4 (&acc)[2][2][4][2], const Unit& u, int wr, int wc, int fr, int fq) const {
        int row0 = u.pm * 256 + wr * 64 + fr, col0 = u.pn * 256 + wc * 64 + 8 * fq;
        asm volatile("" : "+v"(row0), "+v"(col0));
        u32x4 ga[2][2], gb[2][2];
        { const bf16_t* gp = gates + (size_t)row0 * 2048 + col0;
          ga[0][0] = *(const u32x4*)gp; gb[0][0] = *(const u32x4*)(gp + 1024); ga[0][1] = *(const u32x4*)(gp + 32); gb[0][1] = *(const u32x4*)(gp + 1024 + 32); }
#pragma unroll
        for (int g = 0; g < 8; ++g) {
            const int ai = g >> 2, m = g & 3, cb = g & 1, nb = cb ^ 1;
            if (g + 1 < 8) { const int row = row0 + ((g + 1) >> 2) * 128 + ((g + 1) & 3) * 16; const bf16_t* gp = gates + (size_t)row * 2048 + col0;
                ga[nb][0] = *(const u32x4*)gp; gb[nb][0] = *(const u32x4*)(gp + 1024); ga[nb][1] = *(const u32x4*)(gp + 32); gb[nb][1] = *(const u32x4*)(gp + 1024 + 32); }
#pragma unroll
            for (int bj = 0; bj < 2; ++bj)
#pragma unroll
                for (int q = 0; q < 4; ++q) {
                    const float a0 = bflo(ga[cb][bj][q]), a1 = bfhi(ga[cb][bj][q]), b0 = fmaxf(bflo(gb[cb][bj][q]), -60.f), b1 = fmaxf(bfhi(gb[cb][bj][q]), -60.f);
                    const float r0 = (1.f + __expf(-b0)) * __builtin_amdgcn_rcpf(1.f + __expf(-a0)), r1 = (1.f + __expf(-b1)) * __builtin_amdgcn_rcpf(1.f + __expf(-a1));
                    acc[ai][bj][m][q >> 1][(q & 1) * 2] *= r0; acc[ai][bj][m][q >> 1][(q & 1) * 2 + 1] *= r1;
                }
            __builtin_amdgcn_sched_barrier(0);
        }
    }
    __device__ __forceinline__ void operator()(const f32x4 (&acc)[2][2][4][2], const Unit& u, int wr, int wc, int fr, int fq) const {
        const int row0 = u.pm * 256 + wr * 64 + fr, col0 = u.pn * 256 + wc * 64 + 8 * fq; const bool lo = fr < 8;
#pragma unroll
        for (int ai = 0; ai < 2; ++ai)
#pragma unroll
            for (int m = 0; m < 4; ++m) {
                const int row = row0 + ai * 128 + m * 16;
                u32x4 oo[2];
#pragma unroll
                for (int bj = 0; bj < 2; ++bj) {
                    const int col = col0 + bj * 32;
                    const u32x4 gb = *(const u32x4*)(gates + (size_t)row * 2048 + 1024 + col);
                    float r[8];
#pragma unroll
                    for (int q = 0; q < 4; ++q) {
                        const float b0 = fmaxf(bflo(gb[q]), -60.f), b1 = fmaxf(bfhi(gb[q]), -60.f);
                        r[2 * q] = acc[ai][bj][m][q >> 1][(q & 1) * 2] * __builtin_amdgcn_rcpf(1.f + __expf(-b0));
                        r[2 * q + 1] = acc[ai][bj][m][q >> 1][(q & 1) * 2 + 1] * __builtin_amdgcn_rcpf(1.f + __expf(-b1));
                    }
                    oo[bj][0] = pk_bf16(r[0], r[1]); oo[bj][1] = pk_bf16(r[2], r[3]); oo[bj][2] = pk_bf16(r[4], r[5]); oo[bj][3] = pk_bf16(r[6], r[7]);
                }
                line_pair(oo[0], oo[1], lo);
                const int colx = col0 + (lo ? 0 : 32);
                *(u32x4*)(O + (size_t)(lo ? row : row - 8) * DM + colx) = oo[0];
                *(u32x4*)(O + (size_t)(lo ? row + 8 : row) * DM + colx) = oo[1];
            }
    }
};
struct EpiRes {
    static constexpr bool PERM = true, HAS_MID = false, LINE = true;
    const float* R; const bf16_t* Rb; float* H; bf16_t* Hb; float* SS;
    __device__ __forceinline__ void operator()(const f32x4 (&acc)[2][2][4][2], const Unit& u, int wr, int wc, int fr, int fq) const {
        const int row0 = u.pm * 256 + wr * 64 + fr, col0 = u.pn * 256 + wc * 64 + 8 * fq; const bool lo = fr < 8;
#pragma unroll
        for (int ai = 0; ai < 2; ++ai)
#pragma unroll
            for (int m = 0; m < 4; ++m) {
                const int row = row0 + ai * 128 + m * 16;
                float s = 0.f; u32x4 ob[2];
#pragma unroll
                for (int bj = 0; bj < 2; ++bj) {
                    const int col = col0 + bj * 32;
                    f32x4 r0, r1;
                    if (R) { r0 = *(const f32x4*)(R + (size_t)row * DM + col); r1 = *(const f32x4*)(R + (size_t)row * DM + col + 4); }
                    else { const u32x4 rb = *(const u32x4*)(Rb + (size_t)row * DM + col);
                        r0[0] = bflo(rb[0]); r0[1] = bfhi(rb[0]); r0[2] = bflo(rb[1]); r0[3] = bfhi(rb[1]); r1[0] = bflo(rb[2]); r1[1] = bfhi(rb[2]); r1[2] = bflo(rb[3]); r1[3] = bfhi(rb[3]); }
                    const f32x4 h0 = r0 + acc[ai][bj][m][0], h1 = r1 + acc[ai][bj][m][1];
                    if (H) { *(f32x4*)(H + (size_t)row * DM + col) = h0; *(f32x4*)(H + (size_t)row * DM + col + 4) = h1; }
                    ob[bj][0] = pk_bf16(h0[0], h0[1]); ob[bj][1] = pk_bf16(h0[2], h0[3]); ob[bj][2] = pk_bf16(h1[0], h1[1]); ob[bj][3] = pk_bf16(h1[2], h1[3]);
                    s += ((h0[0] * h0[0] + h0[1] * h0[1]) + (h0[2] * h0[2] + h0[3] * h0[3])) + ((h1[0] * h1[0] + h1[1] * h1[1]) + (h1[2] * h1[2] + h1[3] * h1[3]));
                }
                if (Hb) { line_pair(ob[0], ob[1], lo); const int colx = col0 + (lo ? 0 : 32);
                    *(u32x4*)(Hb + (size_t)(lo ? row : row - 8) * DM + colx) = ob[0]; *(u32x4*)(Hb + (size_t)(lo ? row + 8 : row) * DM + colx) = ob[1]; }
                s += __shfl_xor(s, 16); s += __shfl_xor(s, 32);
                if (fq == 0) SS[(size_t)row * 16 + u.pn * 4 + wc] = s;
            }
    }
};
struct EpiSwiGLU {
    static constexpr bool PERM = true, HAS_MID = false, LINE = false;
    bf16_t* O; const float* ss;
    __device__ __forceinline__ void operator()(const f32x4 (&acc)[2][2][4][2], const Unit& u, int wr, int wc, int fr, int fq) const {
        const int row0 = u.pm * 256 + wr * 64 + fr, col0 = u.pn * 128 + wc * 32 + 8 * fq;
#pragma unroll
        for (int ai = 0; ai < 2; ++ai)
#pragma unroll
            for (int m = 0; m < 4; ++m) {
                const int row = row0 + ai * 128 + m * 16;
                const float rs = rstd_of(ss, row);
                float r[8];
#pragma unroll
                for (int n = 0; n < 2; ++n)
#pragma unroll
                    for (int j = 0; j < 4; ++j) { const float gg = acc[ai][0][m][n][j] * rs, uu = acc[ai][1][m][n][j] * rs; r[n * 4 + j] = gg * sigmoidf_(gg) * uu; }
                u32x4 o; o[0] = pk_bf16(r[0], r[1]); o[1] = pk_bf16(r[2], r[3]); o[2] = pk_bf16(r[4], r[5]); o[3] = pk_bf16(r[6], r[7]);
                *(u32x4*)(O + (size_t)row * DFF + col0) = o;
            }
    }
};

struct Ctx { int tid, lane, wave, gw, ngw, gt, ngt; };

__device__ __forceinline__ void p_transpose(const Ctx& c, LAS unsigned char* lds, const float* W, bf16_t* Wt, int K, int N, const float* g, int mode, int& cursor, int ldw = 0, int koff = 0) {
    if (ldw == 0) ldw = K;
    LAS float* scr = (LAS float*)(lds + c.wave * 8704);
    const int nblk = N / 32, nitems = (K / 64) * nblk, lane = c.lane;
    int first = (c.gw - cursor % c.ngw + c.ngw) % c.ngw;
    for (int it = first; it < nitems; it += c.ngw) {
        const int kb = it / nblk, nb = it % nblk, k0 = 64 * kb, n0 = 32 * nb;
#pragma unroll 8
        for (int i = 0; i < 32; ++i) { const int kk = 2 * i + (lane >> 5); float v = W[(size_t)(k0 + kk) * N + n0 + (lane & 31)]; if (g) v *= g[k0 + kk]; scr[kk * 33 + (lane & 31)] = v; }
        asm volatile("s_waitcnt lgkmcnt(0)" ::: "memory");
        const int ch = lane & 7;
#pragma unroll
        for (int j = 0; j < 4; ++j) { const int n = (lane >> 3) + 8 * j; const LAS float* sp = scr + (8 * ch) * 33 + n;
            u32x4 o; o[0] = pk_bf16(sp[0], sp[33]); o[1] = pk_bf16(sp[2 * 33], sp[3 * 33]); o[2] = pk_bf16(sp[4 * 33], sp[5 * 33]); o[3] = pk_bf16(sp[6 * 33], sp[7 * 33]);
            const int nn = n0 + n, row = mode == 0 ? nn : (256 * (nn >> 7) + (nn & 127) + (mode == 2 ? 128 : 0));
            *(u32x4*)(Wt + (size_t)row * ldw + koff + k0 + 8 * ch) = o; }
        asm volatile("s_waitcnt lgkmcnt(0)" ::: "memory");
    }
    cursor += nitems;
}
__device__ __forceinline__ void p_rmsnorm_rows(const Ctx& c, const float* x, const float* g, bf16_t* out, int rows) {
    f32x4 gg[4];
#pragma unroll
    for (int j = 0; j < 4; ++j) gg[j] = ((const f32x4*)g)[c.lane + 64 * j];
    for (int r0 = c.gw; r0 < rows; r0 += 2 * c.ngw) {
        const int r1 = r0 + c.ngw; const bool has1 = r1 < rows; const int r1c = has1 ? r1 : r0;
        const f32x4* xa = (const f32x4*)(x + (size_t)r0 * DM) + c.lane; const f32x4* xb = (const f32x4*)(x + (size_t)r1c * DM) + c.lane;
        f32x4 va[4], vb[4]; float sa = 0.f, sb = 0.f;
#pragma unroll
        for (int j = 0; j < 4; ++j) { va[j] = xa[64 * j]; vb[j] = xb[64 * j]; }
#pragma unroll
        for (int j = 0; j < 4; ++j) { sa += (va[j][0] * va[j][0] + va[j][1] * va[j][1]) + (va[j][2] * va[j][2] + va[j][3] * va[j][3]); sb += (vb[j][0] * vb[j][0] + vb[j][1] * vb[j][1]) + (vb[j][2] * vb[j][2] + vb[j][3] * vb[j][3]); }
        const float ra = rsqrtf(wave_sum(sa) * (1.f / DM) + EPS), rb = rsqrtf(wave_sum(sb) * (1.f / DM) + EPS);
#pragma unroll
        for (int j = 0; j < 4; ++j) {
            u32x2 o; o[0] = pk_bf16(va[j][0] * ra * gg[j][0], va[j][1] * ra * gg[j][1]); o[1] = pk_bf16(va[j][2] * ra * gg[j][2], va[j][3] * ra * gg[j][3]);
            ((u32x2*)(out + (size_t)r0 * DM))[c.lane + 64 * j] = o;
            if (has1) { u32x2 q; q[0] = pk_bf16(vb[j][0] * rb * gg[j][0], vb[j][1] * rb * gg[j][1]); q[1] = pk_bf16(vb[j][2] * rb * gg[j][2], vb[j][3] * rb * gg[j][3]);
                ((u32x2*)(out + (size_t)r1 * DM))[c.lane + 64 * j] = q; }
        }
    }
}
__device__ __forceinline__ void p_rope_table(const Ctx& c, const int* pos, float* tab) {
    for (int i = c.gt; i < T * 8; i += c.ngt) {
        const int tok = i >> 3, f = i & 7;
        const double inv = f == 0 ? 1.0 : f == 1 ? 0.19392274474868576 : f == 2 ? 0.03760603093086393 : f == 3 ? 0.007292664737217109 : f == 4 ? 0.001414213562373095 :
                           f == 5 ? 0.0002742481756762073 : f == 6 ? 5.318295896944988e-05 : 1.031338537721246e-05;
        const double rev = (double)pos[tok] * inv * 0.15915494309189535;
        const float fr = (float)(rev - rint(rev));
        tab[(size_t)tok * 16 + f] = __builtin_amdgcn_cosf(fr);
        tab[(size_t)tok * 16 + 8 + f] = __builtin_amdgcn_sinf(fr);
    }
}
__device__ __forceinline__ void p_final(const Ctx& c, float* out, const float* ss, const float* g) {
    f32x4 gg[4];
#pragma unroll
    for (int j = 0; j < 4; ++j) gg[j] = ((const f32x4*)g)[c.lane + 64 * j];
    for (int r0 = c.gw; r0 < T; r0 += 2 * c.ngw) {
        const int r1 = r0 + c.ngw; const bool has1 = r1 < T; const int r1c = has1 ? r1 : r0;
        f32x4* xa = (f32x4*)(out + (size_t)r0 * DM) + c.lane; f32x4* xb = (f32x4*)(out + (size_t)r1c * DM) + c.lane;
        f32x4 va[4], vb[4];
#pragma unroll
        for (int j = 0; j < 4; ++j) { va[j] = xa[64 * j]; vb[j] = xb[64 * j]; }
        const float ra = rstd_of(ss, r0), rb = rstd_of(ss, r1c);
#pragma unroll
        for (int j = 0; j < 4; ++j) { xa[64 * j] = va[j] * ra * gg[j]; if (has1) xb[64 * j] = vb[j] * rb * gg[j]; }
    }
}

typedef float f32x16 __attribute__((ext_vector_type(16)));
typedef short s16x4 __attribute__((ext_vector_type(4)));
#define MFMA32(a, b, c) __builtin_amdgcn_mfma_f32_32x32x16_bf16((a), (b), (c), 0, 0, 0)
constexpr int ATT_FLAG_OFF = 40960;
#ifndef ATT_DUP_A
#define ATT_DUP_A 0
#endif
#ifndef ATT_DUP_B
#define ATT_DUP_B 0
#endif
template <int MODE, int HDIM, int KT>
__device__ __forceinline__ void attn_item(LAS unsigned char* lds, const bf16_t* Qp, int ldq, const bf16_t* Kp, const bf16_t* Vp, int ldkv, bf16_t* Op, int ldo, int q0, int nkeys) {
    constexpr int KS = HDIM / 16, DD = HDIM / 32, KROW = HDIM * 2 + 16, NCH = HDIM / 8, PER = KT * NCH / 512, NSUB = KT / 32;
    static_assert(2 * KT * KROW + 128 <= ATT_FLAG_OFF, "attention LDS tiles overlap the flag words");
    int tid = threadIdx.x; asm volatile("" : "+v"(tid));
    const int lane = tid & 63, w = __builtin_amdgcn_readfirstlane(tid >> 6), r = lane & 31, hh = lane >> 5;
    const int tq0 = q0 + 32 * w, tq = tq0 + r;
    LAS unsigned char* Ks = lds; LAS unsigned char* Vr = lds + KT * KROW;
    const int trq = (r & 15) >> 2, trp = r & 3, trb = r & 16;
    LAS unsigned* flags = (LAS unsigned*)(lds + ATT_FLAG_OFF);
    bf16x8 Qf[KS];
#pragma unroll
    for (int ks = 0; ks < KS; ++ks) Qf[ks] = *(const bf16x8*)(Qp + (size_t)tq * ldq + 16 * ks + 8 * hh);
    f32x16 Oacc[DD];
#pragma unroll
    for (int dd = 0; dd < DD; ++dd)
#pragma unroll
        for (int i = 0; i < 16; ++i) Oacc[dd][i] = 0.f;
    float m = -INFINITY, l = 0.f, run = (MODE == 1) ? 1.f : 0.f; unsigned done_w = 0u;
    float w8[8], u4[4], fgc[4], fmn[16], fbias = 0.f;
    if (MODE == 0) {
        const int cc = r & 15, e = cc & 3, f = cc >> 3; const bool act = (hh == ((cc >> 2) & 1)); const int c4 = r & 3;
#pragma unroll
        for (int i = 0; i < 8; ++i) { w8[i] = (act && (i & 3) == e && (i >> 2) == f) ? 1.f : 0.f; asm volatile("" : "+v"(w8[i])); }
        fbias = act ? 0.f : -INFINITY; asm volatile("" : "+v"(fbias));
#pragma unroll
        for (int j = 0; j < 4; ++j) { u4[j] = (j == c4) ? 1.f : 0.f; asm volatile("" : "+v"(u4[j])); }
#pragma unroll
        for (int g = 0; g < 4; ++g) { fgc[g] = (((r - 4 * hh - c4 - 8 * g) & 15) == 0) ? 2.f : 1.f; asm volatile("" : "+v"(fgc[g])); }
#pragma unroll
        for (int i = 0; i < 16; ++i) { const int dm = (r - 4 * hh - ((i & 3) + 8 * (i >> 2))) & 15; fmn[i] = 1.f + ((dm & 3) == 0 ? 1.f : 0.f) + (dm == 0 ? 1.f : 0.f); asm volatile("" : "+v"(fmn[i])); }
    }
    const int kt_hi = (MODE == 2) ? (nkeys / KT - 1) : ((q0 + 255) / KT);
    u32x4 kA[PER], vA[PER], kB[PER], vB[PER];
#define ATT_GLOAD(KR, VR, kt) do { _Pragma("unroll") for (int p_ = 0; p_ < PER; ++p_) { const int idx_ = tid + 512 * p_, key_ = idx_ / NCH, ch_ = idx_ % NCH; \
        KR[p_] = *(const u32x4*)(Kp + (size_t)(KT * (kt) + key_) * ldkv + ch_ * 8); VR[p_] = *(const u32x4*)(Vp + (size_t)(KT * (kt) + key_) * ldkv + ch_ * 8); } } while (0)
    auto stage = [&](const u32x4 (&KR)[PER], const u32x4 (&VR)[PER]) -> bool {
        if (MODE == 1 && lane == 0) flags[w] = done_w;
        __syncthreads();
#pragma unroll
        for (int p_ = 0; p_ < PER; ++p_) { const int idx_ = tid + 512 * p_, key_ = idx_ / NCH, ch_ = idx_ % NCH;
            *(LAS u32x4*)(Ks + key_ * KROW + ch_ * 16) = KR[p_];
            *(LAS u32x4*)(Vr + key_ * KROW + ch_ * 16) = VR[p_];
        }
        bool alldone = false;
        if (MODE == 1) { unsigned a = 1u;
#pragma unroll
            for (int i = 0; i < 8; ++i) a &= flags[i];
            alldone = a != 0u; }
        __syncthreads();
        return alldone;
    };
    auto qk = [&](int sub, f32x16& S) {
        bf16x8 kf[KS];
#pragma unroll
        for (int ks = 0; ks < KS; ++ks) kf[ks] = *(const LAS bf16x8*)(Ks + (32 * sub + r) * KROW + (16 * ks + 8 * hh) * 2);
#pragma unroll
        for (int i = 0; i < 16; ++i) S[i] = 0.f;
        __builtin_amdgcn_sched_barrier(0);
#pragma unroll
        for (int ks = 0; ks < KS; ++ks) S = MFMA32(kf[ks], Qf[ks], S);
    };
    auto compute = [&](int kt) {
        f32x16 Sn; bool an;
        { const int tkn = KT * kt + 32 * (NSUB - 1); an = !((MODE != 2 && tkn > tq0 + 31) || (MODE == 1 && done_w)); if (an) qk(NSUB - 1, Sn); }
#pragma unroll
        for (int sub = NSUB - 1; sub >= 0; --sub) {
            const int tk0 = KT * kt + 32 * sub;
            f32x16 S = Sn; const bool a = an;
            if (sub > 0) { const int tkn = tk0 - 32; an = !((MODE != 2 && tkn > tq0 + 31) || (MODE == 1 && done_w)); if (an) qk(sub - 1, Sn); }
            if (!a) continue;
            s16x4 vlo[DD][2], vhi[DD][2];
#pragma unroll
            for (int dd = 0; dd < DD; ++dd)
#pragma unroll
                for (int s2 = 0; s2 < 2; ++s2) {
                    LAS unsigned char* vp = Vr + (32 * sub + 16 * s2 + 4 * hh + trq) * KROW + (32 * dd + trb) * 2 + 8 * trp;
                    vlo[dd][s2] = __builtin_amdgcn_ds_read_tr16_b64_v4i16((LAS s16x4*)vp); vhi[dd][s2] = __builtin_amdgcn_ds_read_tr16_b64_v4i16((LAS s16x4*)(vp + 8 * KROW));
                }
            __builtin_amdgcn_sched_barrier(0);
            const int dbase = tq - tk0 - 4 * hh;
            const int D = tq0 - tk0;
            if (MODE == 0 || MODE == 2) {
                const float C = (MODE == 0 ? 0.125f : 0.08838834764831845f) * 1.4426950408889634f;
                float alpha, ls = 0.f, mn;
                if (MODE == 0 && D >= 544) {
                    float s1 = S[0] * w8[0], s2 = S[8] * w8[0];
#pragma unroll
                    for (int i = 1; i < 8; ++i) { s1 = fmaf(S[i], w8[i], s1); s2 = fmaf(S[8 + i], w8[i], s2); }
                    const float v1 = fmaf(s1, C, fbias), v2 = fmaf(s2, C, fbias);
                    float mx = fmaxf(v1, v2); mx = fmaxf(mx, __shfl_xor(mx, 32));
                    mn = fmaxf(m, mx);
                    alpha = __builtin_amdgcn_exp2f(m - mn);
                    const float p1 = __builtin_amdgcn_exp2f(v1 - mn), p2 = __builtin_amdgcn_exp2f(v2 - mn);
                    ls = p1 + p2;
#pragma unroll
                    for (int i = 0; i < 8; ++i) { S[i] = w8[i] * p1; S[8 + i] = w8[i] * p2; }
                } else if (MODE == 0 && D >= 160 && D <= 480) {
                    float vg[4]; float mx = -INFINITY;
#pragma unroll
                    for (int g = 0; g < 4; ++g) { vg[g] = (fmaf(S[4 * g + 3], u4[3], fmaf(S[4 * g + 2], u4[2], fmaf(S[4 * g + 1], u4[1], S[4 * g] * u4[0])))) * C; mx = fmaxf(mx, vg[g]); }
                    mx = fmaxf(mx, __shfl_xor(mx, 32));
                    mn = fmaxf(m, mx);
                    alpha = __builtin_amdgcn_exp2f(m - mn);
#pragma unroll
                    for (int g = 0; g < 4; ++g) { const float pg = fgc[g] * __builtin_amdgcn_exp2f(vg[g] - mn); ls += pg;
#pragma unroll
                        for (int j = 0; j < 4; ++j) S[4 * g + j] = u4[j] * pg; }
                } else if (MODE == 0 && D >= 32 && D <= 96) {
                    float mx = -INFINITY;
#pragma unroll
                    for (int i = 0; i < 16; ++i) { S[i] = S[i] * C; mx = fmaxf(mx, S[i]); }
                    mx = fmaxf(mx, __shfl_xor(mx, 32));
                    mn = fmaxf(m, mx);
                    alpha = __builtin_amdgcn_exp2f(m - mn);
#pragma unroll
                    for (int i = 0; i < 16; ++i) { const float p = fmn[i] * __builtin_amdgcn_exp2f(S[i] - mn); S[i] = p; ls += p; }
                } else {
                    float fm[16]; float mx = -INFINITY;
#pragma unroll
                    for (int i = 0; i < 16; ++i) {
                        float v = S[i] * C;
                        if (MODE == 0) { const int d = dbase - ((i & 3) + 8 * (i >> 2));
                            int mult = (d <= 128 ? 1 : 0) + ((((d & 3) == 0) && d <= 512) ? 1 : 0) + (((d & 15) == 0) ? 1 : 0);
                            mult = d >= 0 ? mult : 0; fm[i] = (float)mult; v = mult > 0 ? v : -INFINITY; }
                        else fm[i] = 1.f;
                        S[i] = v; mx = fmaxf(mx, v);
                    }
                    mx = fmaxf(mx, __shfl_xor(mx, 32));
                    mn = fmaxf(m, mx); const float ms = (mn == -INFINITY) ? 0.f : mn;
                    alpha = __builtin_amdgcn_exp2f(m - ms);
#pragma unroll
                    for (int i = 0; i < 16; ++i) { const float p = fm[i] * __builtin_amdgcn_exp2f(S[i] - ms); S[i] = p; ls += p; }
                }
                l = l * alpha + ls; m = mn;
                if (!__all(alpha == 1.f)) {
#pragma unroll
                    for (int dd = 0; dd < DD; ++dd) Oacc[dd] = Oacc[dd] * alpha;
                }
            } else {
                float om[16], ex[16], G[4], PG[4];
                if (D < 32) {
#pragma unroll
                    for (int i = 0; i < 16; ++i) { const int d = dbase - ((i & 3) + 8 * (i >> 2)); const bool valid = d > 0;
                        const float x = fminf(fmaxf(S[i] * (0.125f * 1.4426950408889634f), -115.f), 115.f); const float e = __builtin_amdgcn_exp2f(x); const float o1 = __builtin_amdgcn_rcpf(1.f + e);
                        om[i] = valid ? o1 : 1.f; S[i] = valid ? e * o1 : 0.f; }
                } else {
#pragma unroll
                    for (int i = 0; i < 16; ++i) {
                        const float x = fminf(fmaxf(S[i] * (0.125f * 1.4426950408889634f), -115.f), 115.f); const float e = __builtin_amdgcn_exp2f(x); const float o1 = __builtin_amdgcn_rcpf(1.f + e);
                        om[i] = o1; S[i] = e * o1; }
                }
#pragma unroll
                for (int g = 0; g < 4; ++g) { ex[4 * g + 3] = 1.f; ex[4 * g + 2] = om[4 * g + 3]; ex[4 * g + 1] = ex[4 * g + 2] * om[4 * g + 2]; ex[4 * g] = ex[4 * g + 1] * om[4 * g + 1]; G[g] = ex[4 * g] * om[4 * g]; }
#pragma unroll
                for (int g = 0; g < 4; ++g) PG[g] = __shfl_xor(G[g], 32);
                float suf = run;
#pragma unroll
                for (int g = 3; g >= 0; --g) { const float lat = suf * (hh == 0 ? PG[g] : 1.f);
                    S[4 * g + 3] = S[4 * g + 3] * lat; S[4 * g + 2] = S[4 * g + 2] * (lat * ex[4 * g + 2]); S[4 * g + 1] = S[4 * g + 1] * (lat * ex[4 * g + 1]); S[4 * g] = S[4 * g] * (lat * ex[4 * g]);
                    suf *= G[g] * PG[g]; }
                run = suf;
                done_w = __all(run < 1e-30f) ? 1u : 0u;
            }
            u32x4 pp0, pp1;
#pragma unroll
            for (int j = 0; j < 4; ++j) { pp0[j] = pk_bf16(S[2 * j], S[2 * j + 1]); pp1[j] = pk_bf16(S[8 + 2 * j], S[8 + 2 * j + 1]); }
            const bf16x8 P0 = __builtin_bit_cast(bf16x8, pp0), P1 = __builtin_bit_cast(bf16x8, pp1);
#pragma unroll
            for (int dd = 0; dd < DD; ++dd)
#pragma unroll
                for (int s2 = 0; s2 < 2; ++s2) {
                    const bf16x8 vf = __builtin_shufflevector(vlo[dd][s2], vhi[dd][s2], 0, 1, 2, 3, 4, 5, 6, 7);
                    Oacc[dd] = MFMA32(vf, s2 ? P1 : P0, Oacc[dd]);
                }
        }
    };
    ATT_GLOAD(kA, vA, kt_hi);
    if constexpr (MODE == 2) {
#pragma unroll 1
        for (int kt = kt_hi; kt >= 0; --kt) {
            stage(kA, vA);
            if (kt >= 1) ATT_GLOAD(kA, vA, kt - 1);
            compute(kt);
        }
    } else {
        if (kt_hi >= 1) ATT_GLOAD(kB, vB, kt_hi - 1);
#pragma unroll 1
        for (int kt = kt_hi; kt >= 0; kt -= 2) {
            if (stage(kA, vA)) break;
            if (kt >= 2) ATT_GLOAD(kA, vA, kt - 2);
            compute(kt);
            if (kt == 0) break;
            if (stage(kB, vB)) break;
            if (kt >= 3) ATT_GLOAD(kB, vB, kt - 3);
            compute(kt - 1);
        }
    }
#undef ATT_GLOAD
    float inv = 1.f;
    if (MODE != 1) { const float lt = l + __shfl_xor(l, 32); inv = 1.f / lt; }
#pragma unroll
    for (int dd = 0; dd < DD; ++dd)
#pragma unroll
        for (int g = 0; g < 4; g += 2) {
            unsigned a0 = pk_bf16(Oacc[dd][4 * g] * inv, Oacc[dd][4 * g + 1] * inv), a1 = pk_bf16(Oacc[dd][4 * g + 2] * inv, Oacc[dd][4 * g + 3] * inv);
            unsigned b0 = pk_bf16(Oacc[dd][4 * g + 4] * inv, Oacc[dd][4 * g + 5] * inv), b1 = pk_bf16(Oacc[dd][4 * g + 6] * inv, Oacc[dd][4 * g + 7] * inv);
            { auto x = __builtin_amdgcn_permlane32_swap(a0, b0, false, false); a0 = x[0]; b0 = x[1]; }
            { auto x = __builtin_amdgcn_permlane32_swap(a1, b1, false, false); a1 = x[0]; b1 = x[1]; }
            u32x4 o; o[0] = a0; o[1] = a1; o[2] = b0; o[3] = b1;
            *(u32x4*)(Op + (size_t)tq * ldo + 32 * dd + 8 * g + 8 * hh) = o;
        }
}
constexpr int WQ_WORD = 4096;
__device__ __forceinline__ void p_attn_ab(LAS unsigned char* lds, const bf16_t* qkv, bf16_t* OA, bf16_t* OB, unsigned* wq) {
    constexpr size_t TS = (size_t)T * 512;
    volatile LAS unsigned* slot = (volatile LAS unsigned*)(lds + ATT_FLAG_OFF + 64);
    for (;;) {
        if (threadIdx.x == 0) *slot = __hip_atomic_fetch_add(wq, 1u, __ATOMIC_RELAXED, __HIP_MEMORY_SCOPE_AGENT);
        __syncthreads();
        const unsigned it = (unsigned)__builtin_amdgcn_readfirstlane((int)*slot);
        __syncthreads();
        if (it >= 2048u) break;
        const int j = it & 1023, qb = 7 - (j >> 7), bh = j & 127, b = bh >> 3, h = bh & 7;
        const bf16_t* base = qkv + (size_t)bh * SEQ * 64;
        if (it < 1024u) attn_item<0, 64, 128>(lds, base, 64, base + TS, base + 2 * TS, 64, OA + (size_t)b * SEQ * 1024 + h * HD, 1024, qb * 256, SEQ);
        else attn_item<1, 64, 128>(lds, base + 3 * TS, 64, base + 4 * TS, base + 5 * TS, 64, OB + (size_t)b * SEQ * 1024 + h * HD, 1024, qb * 256, SEQ);
    }
}
__device__ __forceinline__ void p_attn_mem(LAS unsigned char* lds, const bf16_t* qm, const bf16_t* kvm, bf16_t* om) {
#pragma unroll 1
    for (int i = 0;; ++i) {
        Unit u; { pg8::StaticOrder S2; S2.init(T, MEMW, (int)gridDim.x, (int)blockIdx.x); if (!S2.next(i, u)) break; }
        const int b = u.pm >> 3, qb = u.pm & 7;
#pragma unroll 1
        for (int hq = 0; hq < 2; ++hq) { const int h = 2 * u.pn + hq;
            attn_item<2, 128, 64>(lds, qm + (size_t)b * SEQ * MEMW + h * 128, MEMW, kvm + (size_t)b * NMEM * 1024 + h * 128, kvm + (size_t)b * NMEM * 1024 + 512 + h * 128, 1024,
                                  om + (size_t)b * SEQ * MEMW + h * 128, MEMW, qb * 256, NMEM); }
    }
}

__device__ __forceinline__ bool sync_if(int k, cg::grid_group& grid, XcdBarrier& xb) {
    if (k == 1) { grid.sync(); xb = xcd_barrier_post(xb.bar, xb.st); }
    else if (k == 8) {
        asm volatile("s_waitcnt vmcnt(0)" ::: "memory");
        __syncthreads();
        if (threadIdx.x == 0) { __builtin_amdgcn_fence(__ATOMIC_ACQUIRE, "agent"); asm volatile("s_waitcnt vmcnt(0)" ::: "memory"); }
        __syncthreads();
    }
    else if (k > 1) xcd_barrier(xb);
    asm volatile("" ::: "memory"); return true; }
constexpr int NPHASE = 13;
#ifndef NAIVE_AB
#define NAIVE_AB 0
#endif
#ifndef NAIVE_MEM
#define NAIVE_MEM 0
#endif
#ifndef ONLY
#define ONLY -1
#endif
#ifndef DUP_MASK
#define DUP_MASK 0
#endif
#define PHASE(k) if ((ONLY < 0 || ONLY == (k)) && ph_lo <= (k) && (k) < ph_hi) if (sync_if((k), grid, xb)) for (int rep_ = 0; rep_ < (((DUP_MASK >> (k)) & 1) ? 2 : 1); ++rep_)
__global__ __launch_bounds__(512, 2) void mega(Params p, int ph_lo, int ph_hi) {
    extern __shared__ __attribute__((aligned(16))) unsigned char shm[];
    LAS unsigned char* lds = (LAS unsigned char*)shm;
    cg::grid_group grid = cg::this_grid();
    Ctx c; c.tid = threadIdx.x; c.lane = c.tid & 63; c.wave = c.tid >> 6; c.gw = blockIdx.x * 8 + c.wave; c.ngw = gridDim.x * 8; c.gt = blockIdx.x * 512 + c.tid; c.ngt = gridDim.x * 512;
    unsigned char* ws = p.ws;
    bf16_t* Wt_in = (bf16_t*)(ws + WS_WIN); bf16_t* Wt_upa = (bf16_t*)(ws + WS_WUPA); bf16_t* Wt_upb = (bf16_t*)(ws + WS_WUPB); bf16_t* Wt_out = (bf16_t*)(ws + WS_WOUT);
    bf16_t* Wt_qm = (bf16_t*)(ws + WS_WQM); bf16_t* Wt_kvm = (bf16_t*)(ws + WS_WKVM); bf16_t* Wt_om = (bf16_t*)(ws + WS_WOM); bf16_t* Wt_gu = (bf16_t*)(ws + WS_WGU); bf16_t* Wt_dn = (bf16_t*)(ws + WS_WDN);
    bf16_t* memn = (bf16_t*)(ws + WS_MEMN); bf16_t* kvm = (bf16_t*)(ws + WS_KVM);
    float* ss1 = (float*)(ws + WS_SS1); float* ss2 = (float*)(ws + WS_SS2); float* ss3 = (float*)(ws + WS_SS3); float* rope = (float*)(ws + WS_ROPE);
    bf16_t* n1 = (bf16_t*)(ws + WS_R1); bf16_t* mixed = (bf16_t*)(ws + WS_R1); bf16_t* h2b = (bf16_t*)(ws + WS_R1);
    bf16_t* proj = (bf16_t*)(ws + WS_PROJ); bf16_t* gates = (bf16_t*)(ws + WS_PROJ + 192 * MiB);
    float* h1 = (float*)(ws + WS_H1); bf16_t* h1b = (bf16_t*)(ws + WS_H1B); bf16_t* qm = (bf16_t*)(ws + WS_QM); bf16_t* om = (bf16_t*)(ws + WS_OM);
    float* h2 = (float*)(ws + WS_H2); bf16_t* act = (bf16_t*)(ws + WS_ACT); bf16_t* OA = (bf16_t*)(ws + WS_OA); bf16_t* OB = (bf16_t*)(ws + WS_OA) + 512;
    float* m1 = p.out; unsigned* bar = (unsigned*)(ws + WS_BAR);
    volatile LAS unsigned* xst = (volatile LAS unsigned*)(lds + pg8::STAGE_BYTES);
    if (c.tid == 0) { xst[0] = 0u; xst[1] = 0u; }
    __syncthreads();
    XcdBarrier xb; xb.bar = bar; xb.x = 0u; xb.st = xst;
    pg8::StaticOrder S;
    {
        PHASE(0) {
            int cur = 0;
            p_transpose(c, lds, p.w_in, Wt_in, DM, INC, nullptr, 0, cur);
            p_transpose(c, lds, p.w_ffn_gate, Wt_gu, DM, DFF, p.g_ffn, 1, cur);
            p_transpose(c, lds, p.w_ffn_up, Wt_gu, DM, DFF, p.g_ffn, 2, cur);
            p_transpose(c, lds, p.w_ffn_down, Wt_dn, DFF, DM, nullptr, 0, cur);
            p_transpose(c, lds, p.w_up_a, Wt_upa, 512, DM, nullptr, 0, cur, 1024, 0);
            p_transpose(c, lds, p.w_up_b, Wt_upa, 512, DM, nullptr, 0, cur, 1024, 512);
            p_transpose(c, lds, p.w_out, Wt_out, DM, DM, nullptr, 0, cur);
            p_transpose(c, lds, p.w_q_mem, Wt_qm, DM, MEMW, p.g_mem_q, 0, cur);
            p_transpose(c, lds, p.w_kv_mem, Wt_kvm, DM, 2 * MEMW, nullptr, 0, cur);
            p_transpose(c, lds, p.w_o_mem, Wt_om, MEMW, DM, nullptr, 0, cur);
            p_rmsnorm_rows(c, p.x, p.g_mix, n1, T);
            p_rmsnorm_rows(c, p.mem, p.g_mem_kv, memn, BATCH * NMEM);
            p_rope_table(c, p.pos, rope);
            if (blockIdx.x == 0) { for (int i = c.tid; i < XCD_BAR_WORDS; i += 512) bar[i] = 0u; if (c.tid == 0) bar[WQ_WORD] = 0u; }
        }
        PHASE(1) {
            Gemm g{n1, Wt_in, T, INC, DM}; EpiBf16 E{proj, INC, nullptr, 1 << 30, rope, 4, 12, gates};   S.init(g.M, g.N, gridDim.x, blockIdx.x); pg8::gemm_phase(lds, g, S, E);
        }
        PHASE(3) {
            { Gemm g{memn, Wt_kvm, BATCH * NMEM, 1024, DM}; EpiBf16 E{kvm, 1024, nullptr, 1 << 30, nullptr, 0, 0, nullptr}; S.init(g.M, g.N, gridDim.x, blockIdx.x); pg8::gemm_phase(lds, g, S, E); }
            p_attn_ab(lds, proj, OA, OB, bar + WQ_WORD);
        }
        PHASE(5) { Gemm g{OA, Wt_upa, T, DM, DM}; EpiGate E{gates, mixed}; S.init(g.M, g.N, gridDim.x, blockIdx.x); pg8::gemm_phase(lds, g, S, E); }
        PHASE(6) { Gemm g{mixed, Wt_out, T, DM, DM}; EpiRes E{p.x, nullptr, nullptr, h1b, ss1}; S.init(g.M, g.N, gridDim.x, blockIdx.x); pg8::gemm_phase(lds, g, S, E); }
        PHASE(7) { Gemm g{h1b, Wt_qm, T, MEMW, DM}; EpiBf16 E{qm, MEMW, ss1, 1 << 30, nullptr, 0, 0, nullptr}; S.init(g.M, g.N, gridDim.x, blockIdx.x); pg8::gemm_phase(lds, g, S, E); }
        PHASE(8) {
            p_attn_mem(lds, qm, kvm, om);
        }
        PHASE(9) { Gemm g{om, Wt_om, T, DM, MEMW}; EpiRes E{nullptr, h1b, nullptr, h2b, ss2}; S.init(g.M, g.N, gridDim.x, blockIdx.x); pg8::gemm_phase(lds, g, S, E); }
        PHASE(10) { Gemm g{h2b, Wt_gu, T, 2 * DFF, DM}; EpiSwiGLU E{act, ss2}; S.init(g.M, g.N, gridDim.x, blockIdx.x); pg8::gemm_phase(lds, g, S, E); }
        PHASE(11) { Gemm g{act, Wt_dn, T, DM, DFF}; EpiRes E{nullptr, h2b, p.out, nullptr, ss3}; S.init(g.M, g.N, gridDim.x, blockIdx.x); pg8::gemm_phase(lds, g, S, E); }
        PHASE(12) p_final(c, p.out, ss3, p.g_final);
    }
}

constexpr int LDS_BYTES = pg8::STAGE_BYTES + 16;
#ifndef ONE_LAUNCH
#define ONE_LAUNCH 1
#endif
extern "C" void kernel_launch(void* const* d_in, const int* in_sizes, int n_in, void* d_out, int out_size, void* d_ws, size_t ws_size, hipStream_t stream) {
    static int grid = 0;
    if (grid == 0) {
        if (n_in != 18 || out_size != T * DM || ws_size < WS_END) { fprintf(stderr, "kernel_launch: unexpected shapes (n_in %d out %d ws %zu)\n", n_in, out_size, ws_size); grid = -1; return; }
        int dev = 0, cus = 0, per_cu = 0;
        (void)hipGetDevice(&dev); (void)hipDeviceGetAttribute(&cus, hipDeviceAttributeMultiprocessorCount, dev);
        if (hipFuncSetAttribute((const void*)mega, hipFuncAttributeMaxDynamicSharedMemorySize, LDS_BYTES) != hipSuccess) { fprintf(stderr, "hipFuncSetAttribute failed\n"); grid = -1; return; }
        if (hipOccupancyMaxActiveBlocksPerMultiprocessor(&per_cu, (const void*)mega, 512, LDS_BYTES) != hipSuccess || per_cu < 1) { fprintf(stderr, "occupancy query: %d\n", per_cu); per_cu = 1; }
        (void)hipGetLastError();
        grid = cus * 1;
    }
    if (grid < 0) return;
    Params p{};
    p.x = (const float*)d_in[0]; p.mem = (const float*)d_in[1]; p.pos = (const int*)d_in[2]; p.g_mix = (const float*)d_in[3]; p.w_in = (const float*)d_in[4];
    p.w_up_a = (const float*)d_in[5]; p.w_up_b = (const float*)d_in[6]; p.w_out = (const float*)d_in[7]; p.g_mem_q = (const float*)d_in[8]; p.g_mem_kv = (const float*)d_in[9];
    p.w_q_mem = (const float*)d_in[10]; p.w_kv_mem = (const float*)d_in[11]; p.w_o_mem = (const float*)d_in[12]; p.g_ffn = (const float*)d_in[13];
    p.w_ffn_gate = (const float*)d_in[14]; p.w_ffn_up = (const float*)d_in[15]; p.w_ffn_down = (const float*)d_in[16]; p.g_final = (const float*)d_in[17];
    p.out = (float*)d_out; p.ws = (unsigned char*)d_ws;
#if ONE_LAUNCH
    int lo = 0, hi = NPHASE;
    void* args[] = {&p, &lo, &hi};
    hipError_t e = hipLaunchCooperativeKernel((const void*)mega, dim3(grid), dim3(512), args, LDS_BYTES, stream);
    if (e != hipSuccess) fprintf(stderr, "cooperative launch failed: %s\n", hipGetErrorString(e));
#else
    for (int ph = 0; ph < NPHASE; ++ph) hipLaunchKernelGGL(mega, dim3(grid), dim3(512), LDS_BYTES, stream, p, ph, ph + 1);
#endif
}
```

```cpp
#include <hip/hip_runtime.h>
#include <hip/hip_cooperative_groups.h>
#include <cstdio>
namespace cg = cooperative_groups;

#define LAS __attribute__((address_space(3)))
typedef unsigned short bf16_t;
typedef short bf16x8 __attribute__((ext_vector_type(8)));
typedef float f32x4 __attribute__((ext_vector_type(4)));
typedef unsigned u32x4 __attribute__((ext_vector_type(4)));
typedef unsigned u32x2 __attribute__((ext_vector_type(2)));

constexpr int BATCH = 16, SEQ = 2048, DM = 1024, T = BATCH * SEQ;
constexpr int HD = 64, NHA = 8, NHB = 8;
constexpr int INC = 5120;
constexpr int C_QA = 0, C_KA = 512, C_VA = 1024, C_QB = 1536, C_KB = 2048, C_VB = 2560, C_GA = 3072, C_GB = 4096;
constexpr int NMEM = 256, MEMW = 512, DFF = 2816;
constexpr float EPS = 1e-6f;

constexpr size_t MiB = 1ull << 20;
constexpr size_t WS_WIN = 0, WS_WUPA = 10 * MiB, WS_WUPB = 11 * MiB, WS_WOUT = 12 * MiB, WS_WQM = 14 * MiB, WS_WKVM = 15 * MiB,
                 WS_WOM = 17 * MiB, WS_WGU = 18 * MiB, WS_WDN = 29 * MiB, WS_MEMN = 36 * MiB, WS_KVM = 44 * MiB,
                 WS_SS1 = 52 * MiB, WS_SS2 = 54 * MiB, WS_SS3 = 56 * MiB, WS_ROPE = 58 * MiB, WS_BAR = 60 * MiB;
constexpr size_t WS_R1 = 64 * MiB;
constexpr size_t WS_PROJ = 128 * MiB;
constexpr size_t WS_H1 = 128 * MiB, WS_H1B = 256 * MiB, WS_QM = 320 * MiB, WS_OM = 352 * MiB, WS_H2 = 384 * MiB, WS_ACT = 128 * MiB;
constexpr size_t WS_OA = 448 * MiB, WS_OB = 480 * MiB;
constexpr size_t WS_END = 512 * MiB;

struct Params {
    const float* x; const float* mem; const int* pos; const float* g_mix; const float* w_in; const float* w_up_a; const float* w_up_b; const float* w_out;
    const float* g_mem_q; const float* g_mem_kv; const float* w_q_mem; const float* w_kv_mem; const float* w_o_mem; const float* g_ffn;
    const float* w_ffn_gate; const float* w_ffn_up; const float* w_ffn_down; const float* g_final;
    float* out; unsigned char* ws;
};

typedef float f32x2 __attribute__((ext_vector_type(2)));
typedef __bf16 bf16v2 __attribute__((ext_vector_type(2)));
__device__ __forceinline__ unsigned pk_bf16(float lo, float hi) { f32x2 v = {lo, hi}; bf16v2 r = __builtin_convertvector(v, bf16v2); return __builtin_bit_cast(unsigned, r); }
__device__ __forceinline__ bf16_t f2bf(float f) { return (bf16_t)(pk_bf16(f, 0.f) & 0xffffu); }
__device__ __forceinline__ float bf2f(bf16_t b) { return __uint_as_float(((unsigned)b) << 16); }
__device__ __forceinline__ float bflo(unsigned u) { return __uint_as_float(u << 16); }
__device__ __forceinline__ float bfhi(unsigned u) { return __uint_as_float(u & 0xffff0000u); }
__device__ __forceinline__ float wave_sum(float v) {
#pragma unroll
    for (int o = 1; o < 64; o <<= 1) v += __shfl_xor(v, o);
    return v;
}
__device__ __forceinline__ float sigmoidf_(float x) { return __builtin_amdgcn_rcpf(1.f + __builtin_amdgcn_exp2f(x * -1.4426950408889634f)); }
__device__ __forceinline__ float rstd_of(const float* ss, int row) {
    const f32x4* p = (const f32x4*)(ss + (size_t)row * 16);
    f32x4 a = p[0], b = p[1], c = p[2], d = p[3];
    float s = ((a[0] + a[1]) + (a[2] + a[3])) + ((b[0] + b[1]) + (b[2] + b[3])) + ((c[0] + c[1]) + (c[2] + c[3])) + ((d[0] + d[1]) + (d[2] + d[3]));
    return rsqrtf(s * (1.f / DM) + EPS);
}


__device__ __forceinline__ void rstd_rows8(const float* ss, int row0, float (&rs)[8]) {
#pragma unroll
    for (int h = 0; h < 4; ++h) {
        f32x4 t[2][4];
#pragma unroll
        for (int j = 0; j < 2; ++j) { const int k = 2 * h + j; const f32x4* p = (const f32x4*)(ss + (size_t)(row0 + (k >> 2) * 128 + (k & 3) * 16) * 16);
#pragma unroll
            for (int q = 0; q < 4; ++q) t[j][q] = p[q]; }
#pragma unroll
        for (int j = 0; j < 2; ++j) { const f32x4 v = (t[j][0] + t[j][1]) + (t[j][2] + t[j][3]); rs[2 * h + j] = rsqrtf(((v[0] + v[1]) + (v[2] + v[3])) * (1.f / DM) + EPS); }
        __builtin_amdgcn_sched_barrier(0);
    }
}

#define XB_TMO      128
#define XB_XCNT(j)  (256  + 64 * (j))
#define XB_XSUB(j)  (1280 + 64 * (j))
#define XB_XGEN(j)  (2304 + 64 * (j))
#define XB_TOP      3328
#define XB_TOPGEN   3392
#define XCD_BAR_WORDS 3456
#define XB_SPIN_CAP (1u << 18)
__device__ __forceinline__ unsigned xb_ld(unsigned* p)              { return __hip_atomic_load(p, __ATOMIC_RELAXED, __HIP_MEMORY_SCOPE_AGENT); }
__device__ __forceinline__ unsigned xb_add(unsigned* p, unsigned v) { return __hip_atomic_fetch_add(p, v, __ATOMIC_RELAXED, __HIP_MEMORY_SCOPE_AGENT); }
__device__ __forceinline__ unsigned xb_xcc_id() { return (unsigned)__builtin_amdgcn_s_getreg((3 << 11) | 20) & 0xFu; }
#define XB_SPIN(cond, bar) do { unsigned _sp = 0; while (cond) { __builtin_amdgcn_s_sleep(1); \
    if ((++_sp & 255u) == 0u) { if (xb_ld(&(bar)[XB_TMO])) break; if (_sp > XB_SPIN_CAP) { atomicAdd(&(bar)[XB_TMO], 1u); break; } } } } while (0)
struct XcdBarrier { unsigned* bar; unsigned x; volatile LAS unsigned* st; };
__device__ __forceinline__ XcdBarrier xcd_barrier_post(unsigned* bar, volatile LAS unsigned* st) {
    XcdBarrier b; b.bar = bar; b.x = xb_xcc_id(); b.st = st;
    if (threadIdx.x == 0) (void)xb_add(&bar[XB_XCNT(b.x)], 1u);
    return b;
}
__device__ __forceinline__ void xcd_barrier_complete(unsigned* bar, unsigned x, unsigned& nloc, unsigned& nx) {
    const unsigned G = gridDim.x * gridDim.y * gridDim.z;
    unsigned sum, cnt, mine, sp = 0u;
    for (;;) {
        sum = 0u; cnt = 0u; mine = 0u;
#pragma unroll
        for (unsigned j = 0; j < 16; ++j) { const unsigned c = xb_ld(&bar[XB_XCNT(j)]); sum += c; cnt += (c > 0u) ? 1u : 0u; mine = (j == x) ? c : mine; }
        if (sum == G) break;
        __builtin_amdgcn_s_sleep(1);
        if ((++sp & 255u) == 0u) { if (xb_ld(&bar[XB_TMO])) break; if (sp > XB_SPIN_CAP) { atomicAdd(&bar[XB_TMO], 1u); break; } }
    }
    nloc = mine > 0u ? mine : 1u; nx = cnt > 0u ? cnt : 1u;
}
__device__ __forceinline__ void xcd_barrier(const XcdBarrier& b) {
    asm volatile("s_waitcnt vmcnt(0)" ::: "memory");
    __syncthreads();
    if (threadIdx.x == 0) {
        unsigned* bar = b.bar;
        __builtin_amdgcn_s_waitcnt(0);
        unsigned nloc = b.st[0], nx = b.st[1];
        if (nloc == 0u) { xcd_barrier_complete(bar, b.x, nloc, nx); b.st[0] = nloc; b.st[1] = nx; }
        const unsigned old = xb_add(&bar[XB_XSUB(b.x)], 1u);
        const unsigned gen = old / nloc;
        if (old + 1u == (gen + 1u) * nloc) {
            __builtin_amdgcn_fence(__ATOMIC_RELEASE, "agent");
            asm volatile("s_waitcnt vmcnt(0)" ::: "memory");
            const unsigned og = xb_add(&bar[XB_TOP], 1u);
            const unsigned tg = og / nx;
            if (og + 1u == (tg + 1u) * nx) xb_add(&bar[XB_TOPGEN], 1u);
            else XB_SPIN(xb_ld(&bar[XB_TOPGEN]) == tg, bar);
            __builtin_amdgcn_fence(__ATOMIC_ACQUIRE, "agent");
            xb_add(&bar[XB_XGEN(b.x)], 1u);
            asm volatile("s_waitcnt vmcnt(0)" ::: "memory");
        } else {
            XB_SPIN(xb_ld(&bar[XB_XGEN(b.x)]) == gen, bar);
            __builtin_amdgcn_fence(__ATOMIC_ACQUIRE, "agent");
            asm volatile("s_waitcnt vmcnt(0)" ::: "memory");
        }
    }
    __syncthreads();
}

namespace pg8 {
constexpr int BM = 256, BK = 64, HALF = 128, HTB = HALF * BK * 2, STAGE_BYTES = 8 * HTB, NXCD = 8, WGM = 4;
__host__ __device__ __forceinline__ int lds_byte(int r, int c) { const int st = (r >> 4) * 2 + (c >> 5), rr = r & 15, cc = c & 31, ob = rr * 64 + cc * 2; return st * 1024 + (ob ^ (((ob >> 9) & 1) << 5)); }
__host__ __device__ __forceinline__ void stage_rc(int b, int& R, int& C) { const int st = b / 1024, sb = b % 1024, swz = sb ^ (((sb >> 9) & 1) << 5); R = (st >> 1) * 16 + swz / 64; C = (st & 1) * 32 + (swz % 64) / 2; }
__host__ __device__ __forceinline__ int perm32(int rho) { const int n = rho >> 4, i = rho & 15; return 8 * (i >> 2) + 4 * n + (i & 3); }
struct Unit { int pm, pn; };
struct Gemm { const bf16_t* A; const bf16_t* Bt; int M, N, K; };
struct StaticOrder {
    int nM, nN, nwg, G, c;
    __host__ __device__ void init(int M, int N, int G_, int c_) { nM = M / BM; nN = N / BM; nwg = nM * nN; G = G_; c = c_; }
    __host__ __device__ bool next(int i, Unit& u) const {
        const long L = (long)i * G + c; if (L >= nwg) return false;
        int wgid = (int)L; { const int q = nwg / NXCD, r = nwg % NXCD, xcd = wgid % NXCD, off = wgid / NXCD; wgid = (xcd < r ? xcd * (q + 1) : r * (q + 1) + (xcd - r) * q) + off; }
        const int nig = WGM * nN, gid = wgid / nig, fm = gid * WGM, gsz = (nM - fm) < WGM ? (nM - fm) : WGM;
        u.pm = fm + ((wgid % nig) % gsz); u.pn = (wgid % nig) / gsz; return true;
    }
};

template <class Epi>
__device__ __forceinline__ void gemm_phase(LAS unsigned char* lds, const Gemm g, const StaticOrder& S, const Epi& E) {
    int tid = threadIdx.x; asm volatile("" : "+v"(tid));
    const int wid = __builtin_amdgcn_readfirstlane(tid >> 6), lane = tid & 63, wr = wid >> 2, wc = wid & 3, fr = lane & 15, fq = lane >> 4;
    const int K = g.K, nt = K / BK;
    unsigned voffA[2], voffB[2];
#pragma unroll
    for (int i = 0; i < 2; ++i) { int R, C; stage_rc(tid * 16 + i * 8192, R, C); const int Rb = Epi::LINE ? ((R >> 5) * 64 + perm32(R & 31)) : (Epi::PERM ? ((R & ~31) + perm32(R & 31)) : R);
        voffA[i] = (unsigned)(R * K + C) * 2u; voffB[i] = (unsigned)(Rb * K + C) * 2u; }
    const size_t kstep = (size_t)(BK * 2);
    const size_t hstep = (size_t)HALF * K * 2;
    const size_t tstep = 2 * hstep;
    const size_t hstepB = Epi::LINE ? (size_t)32 * K * 2 : hstep;
    const unsigned ldsw = (unsigned)wid * 1024u;
    const int aoff = lds_byte(wr * 64 + fr, fq * 8), boff = lds_byte(wc * 32 + fr, fq * 8);
#define PG8_SA(b, h) (((b) * 2 + (h)) * HTB)
#define PG8_SB(b, h) ((4 + (b) * 2 + (h)) * HTB)
#define PG8_STAGE(bufoff, gbase, voff) do { _Pragma("unroll") for (int _i = 0; _i < 2; ++_i) \
        __builtin_amdgcn_global_load_lds((const unsigned*)((const char*)(gbase) + (voff)[_i]), (LAS unsigned*)(lds + (bufoff) + ldsw + _i * 8192), 16, 0, 0); } while (0)
#define PG8_LDA(dst, b, h) do { _Pragma("unroll") for (int m = 0; m < 4; ++m) _Pragma("unroll") for (int k = 0; k < 2; ++k) dst[m][k] = *(const LAS bf16x8*)(lds + PG8_SA(b, h) + aoff + m * 2048 + k * 1024); } while (0)
#define PG8_LDB(dst, b, h) do { _Pragma("unroll") for (int n = 0; n < 2; ++n) _Pragma("unroll") for (int k = 0; k < 2; ++k) dst[n][k] = *(const LAS bf16x8*)(lds + PG8_SB(b, h) + boff + n * 2048 + k * 1024); } while (0)
#define PG8_MMA(ai, bj, At, Bt) do { __builtin_amdgcn_s_setprio(1); _Pragma("unroll") for (int m = 0; m < 4; ++m) _Pragma("unroll") for (int n = 0; n < 2; ++n) _Pragma("unroll") for (int k = 0; k < 2; ++k) \
        acc[ai][bj][m][n] = __builtin_amdgcn_mfma_f32_16x16x32_bf16(Bt[n][k], At[m][k], acc[ai][bj][m][n], 0, 0, 0); __builtin_amdgcn_s_setprio(0); } while (0)
#define PG8_WAIT_V(n) asm volatile("s_waitcnt vmcnt(" #n ")" ::: "memory")
#define PG8_WAIT_L(n) asm volatile("s_waitcnt lgkmcnt(" #n ")" ::: "memory")
#define PG8_BAR __builtin_amdgcn_s_barrier()
#define PG8_SCHED __builtin_amdgcn_sched_barrier(0)
    Unit cur, nxt; int ui = 0;
    if (!S.next(0, cur)) return;
    f32x4 acc[2][2][4][2];
#pragma unroll
    for (int a = 0; a < 2; ++a)
#pragma unroll
        for (int b = 0; b < 2; ++b)
#pragma unroll
            for (int m = 0; m < 4; ++m)
#pragma unroll
                for (int n = 0; n < 2; ++n) acc[a][b][m][n] = (f32x4){0.f, 0.f, 0.f, 0.f};
    bf16x8 At[4][2], B0[2][2], B1[2][2];
    const char* cA = (const char*)g.A + (size_t)cur.pm * tstep; const char* cB = (const char*)g.Bt + (size_t)cur.pn * tstep;
    PG8_STAGE(PG8_SB(0, 0), cB, voffB); PG8_STAGE(PG8_SA(0, 0), cA, voffA); PG8_STAGE(PG8_SB(0, 1), cB + hstepB, voffB); PG8_STAGE(PG8_SA(0, 1), cA + hstep, voffA);
    if (wr == 1) PG8_BAR;
    PG8_WAIT_V(4); PG8_BAR;
    PG8_STAGE(PG8_SB(1, 0), cB + kstep, voffB); PG8_STAGE(PG8_SA(1, 0), cA + kstep, voffA); PG8_STAGE(PG8_SB(1, 1), cB + hstepB + kstep, voffB);
    PG8_WAIT_V(6); PG8_BAR;
    for (;;) {
        const bool has_next = S.next(ui + 1, nxt);
        const char* nA = has_next ? (const char*)g.A + (size_t)nxt.pm * tstep : cA; const char* nB = has_next ? (const char*)g.Bt + (size_t)nxt.pn * tstep : cB;
        for (int t = 0; t < nt; t += 2) {
            const bool last = (t == nt - 2);
            const char* a1 = cA + (size_t)(t + 1) * kstep;
            const char* a2 = last ? nA : cA + (size_t)(t + 2) * kstep; const char* b2 = last ? nB : cB + (size_t)(t + 2) * kstep;
            const char* a3 = a2 + kstep; const char* b3 = b2 + kstep;
            if constexpr (Epi::HAS_MID) { if (t == nt / 2) E.mid(acc, cur, wr, wc, fr, fq); }
            PG8_LDB(B0, 0, 0); PG8_SCHED; PG8_LDA(At, 0, 0); PG8_STAGE(PG8_SA(1, 1), a1 + hstep, voffA);
            PG8_WAIT_L(8); PG8_BAR; PG8_WAIT_L(0); PG8_MMA(0, 0, At, B0); PG8_BAR; PG8_SCHED;
            PG8_LDB(B1, 0, 1); PG8_STAGE(PG8_SB(0, 0), b2, voffB);
            PG8_BAR; PG8_WAIT_L(0); PG8_MMA(0, 1, At, B1); PG8_BAR;
            PG8_LDA(At, 0, 1); PG8_STAGE(PG8_SA(0, 0), a2, voffA);
            PG8_BAR; PG8_WAIT_L(0); PG8_MMA(1, 0, At, B0); PG8_BAR; PG8_SCHED;
            PG8_STAGE(PG8_SB(0, 1), b2 + hstepB, voffB);
            PG8_WAIT_V(6); PG8_BAR; PG8_MMA(1, 1, At, B1); PG8_BAR;
            PG8_LDB(B0, 1, 0); PG8_SCHED; PG8_LDA(At, 1, 0); PG8_STAGE(PG8_SA(0, 1), a2 + hstep, voffA);
            PG8_WAIT_L(8); PG8_BAR; PG8_WAIT_L(0); PG8_MMA(0, 0, At, B0); PG8_BAR; PG8_SCHED;
            PG8_LDB(B1, 1, 1); PG8_STAGE(PG8_SB(1, 0), b3, voffB);
            PG8_BAR; PG8_WAIT_L(0); PG8_MMA(0, 1, At, B1); PG8_BAR;
            PG8_LDA(At, 1, 1); PG8_STAGE(PG8_SA(1, 0), a3, voffA);
            PG8_BAR; PG8_WAIT_L(0); PG8_MMA(1, 0, At, B0); PG8_BAR; PG8_SCHED;
            PG8_STAGE(PG8_SB(1, 1), b3 + hstepB, voffB);
            PG8_WAIT_V(6); PG8_BAR; PG8_MMA(1, 1, At, B1); PG8_BAR;
        }
        E(acc, cur, wr, wc, fr, fq);
        if (!has_next) break;
#pragma unroll
        for (int a = 0; a < 2; ++a)
#pragma unroll
            for (int b = 0; b < 2; ++b)
#pragma unroll
                for (int m = 0; m < 4; ++m)
#pragma unroll
                    for (int n = 0; n < 2; ++n) acc[a][b][m][n] = (f32x4){0.f, 0.f, 0.f, 0.f};
        cur = nxt; cA = nA; cB = nB; ++ui;
    }
    PG8_WAIT_V(0);
    if (wr == 0) PG8_BAR;
    PG8_BAR;
#undef PG8_SA
#undef PG8_SB
#undef PG8_STAGE
#undef PG8_LDA
#undef PG8_LDB
#undef PG8_MMA
#undef PG8_WAIT_V
#undef PG8_WAIT_L
#undef PG8_BAR
#undef PG8_SCHED
}
}
using pg8::Unit; using pg8::Gemm;

__device__ __forceinline__ void line_pair(u32x4& a, u32x4& b, bool lo) {
#pragma unroll
    for (int q = 0; q < 4; ++q) {
        const unsigned send = lo ? b[q] : a[q];
        const unsigned recv = (unsigned)__builtin_amdgcn_update_dpp(0, (int)send, 0x128  , 0xf, 0xf, false);
        if (lo) b[q] = recv; else a[q] = recv;
    }
}
struct EpiBf16 {
    static constexpr bool PERM = true, HAS_MID = false, LINE = true;
    bf16_t* O; int ldc; const float* ss; int sig_from; const float* rope; int rope_below; int qkv_tiles; bf16_t* gates;
    __device__ __forceinline__ bf16_t* addr(int row, int col, int pn) const {
        if (qkv_tiles > 0) {
            if (pn < qkv_tiles) return O + (size_t)(col >> 9) * ((size_t)T * 512) + ((size_t)((row >> 11) * 8 + ((col >> 6) & 7)) * SEQ + (row & (SEQ - 1))) * 64 + (col & 63);
            return gates + (size_t)row * 2048 + (col - 256 * qkv_tiles);
        }
        return O + (size_t)row * ldc + col;
    }
    __device__ __forceinline__ void operator()(const f32x4 (&acc)[2][2][4][2], const Unit& u, int wr, int wc, int fr, int fq) const {
        const int row0 = u.pm * 256 + wr * 64 + fr, col0 = u.pn * 256 + wc * 64 + 8 * fq;
        const bool sig = u.pn >= sig_from, lo = fr < 8;
        float rs8[8];
        if (ss) rstd_rows8(ss, row0, rs8);
        else {
#pragma unroll
            for (int k = 0; k < 8; ++k) rs8[k] = 1.f; }
#pragma unroll
        for (int ai = 0; ai < 2; ++ai)
#pragma unroll
            for (int m = 0; m < 4; ++m) {
                const int row = row0 + ai * 128 + m * 16;
                const float rs = rs8[ai * 4 + m];
                u32x4 o[2];
#pragma unroll
                for (int bj = 0; bj < 2; ++bj) {
                    f32x4 v0 = acc[ai][bj][m][0] * rs, v1 = acc[ai][bj][m][1] * rs;
                    if (sig) {
#pragma unroll
                        for (int j = 0; j < 4; ++j) { v0[j] = sigmoidf_(v0[j]); v1[j] = sigmoidf_(v1[j]); }
                    }
                    if (bj == 0 && u.pn < rope_below) {
                        f32x4 p0, p1;
#pragma unroll
                        for (int j = 0; j < 4; ++j) { p0[j] = __shfl_xor(v0[j], 16); p1[j] = __shfl_xor(v1[j], 16); }
                        if (fq < 2) {
                            const f32x4 c0 = *(const f32x4*)(rope + (size_t)row * 16), c1 = *(const f32x4*)(rope + (size_t)row * 16 + 4);
                            f32x4 s0 = *(const f32x4*)(rope + (size_t)row * 16 + 8), s1 = *(const f32x4*)(rope + (size_t)row * 16 + 12);
                            if (fq == 0) { s0 = -s0; s1 = -s1; }
                            v0 = v0 * c0 + p0 * s0; v1 = v1 * c1 + p1 * s1;
                        }
                    }
                    o[bj][0] = pk_bf16(v0[0], v0[1]); o[bj][1] = pk_bf16(v0[2], v0[3]); o[bj][2] = pk_bf16(v1[0], v1[1]); o[bj][3] = pk_bf16(v1[2], v1[3]);
                }
                line_pair(o[0], o[1], lo);
                const int colx = col0 + (lo ? 0 : 32);
                *(u32x4*)addr(lo ? row : row - 8, colx, u.pn) = o[0];
                *(u32x4*)addr(lo ? row + 8 : row, colx, u.pn) = o[1];
            }
    }
};
struct EpiGate {
    static constexpr bool PERM = true, HAS_MID = true, LINE = true;
    const bf16_t* gates; bf16_t* O;
    __device__ __forceinline__ void mid(f32x4 (&acc)[2][2][4][2], const Unit& u, int wr, int wc, int fr, int fq) const {
        int row0 = u.pm * 256 + wr * 64 + fr, col0 = u.pn * 256 + wc * 64 + 8 * fq;
        asm volatile("" : "+v"(row0), "+v"(col0));
        u32x4 ga[2][2], gb[2][2];
        { const bf16_t* gp = gates + (size_t)row0 * 2048 + col0;
          ga[0][0] = *(const u32x4*)gp; gb[0][0] = *(const u32x4*)(gp + 1024); ga[0][1] = *(const u32x4*)(gp + 32); gb[0][1] = *(const u32x4*)(gp + 1024 + 32); }
#pragma unroll
        for (int g = 0; g < 8; ++g) {
            const int ai = g >> 2, m = g & 3, cb = g & 1, nb = cb ^ 1;
            if (g + 1 < 8) { const int row = row0 + ((g + 1) >> 2) * 128 + ((g + 1) & 3) * 16; const bf16_t* gp = gates + (size_t)row * 2048 + col0;
                ga[nb][0] = *(const u32x4*)gp; gb[nb][0] = *(const u32x4*)(gp + 1024); ga[nb][1] = *(const u32x4*)(gp + 32); gb[nb][1] = *(const u32x4*)(gp + 1024 + 32); }
#pragma unroll
            for (int bj = 0; bj < 2; ++bj)
#pragma unroll
                for (int q = 0; q < 4; ++q) {
                    const float a0 = bflo(ga[cb][bj][q]), a1 = bfhi(ga[cb][bj][q]), b0 = fmaxf(bflo(gb[cb][bj][q]), -60.f), b1 = fmaxf(bfhi(gb[cb][bj][q]), -60.f);
                    const float r0 = (1.f + __expf(-b0)) * __builtin_amdgcn_rcpf(1.f + __expf(-a0)), r1 = (1.f + __expf(-b1)) * __builtin_amdgcn_rcpf(1.f + __expf(-a1));
                    acc[ai][bj][m][q >> 1][(q & 1) * 2] *= r0; acc[ai][bj][m][q >> 1][(q & 1) * 2 + 1] *= r1;
                }
            __builtin_amdgcn_sched_barrier(0);
        }
    }
    __device__ __forceinline__ void operator()(const f32x4 (&acc)[2][2][4][2], const Unit& u, int wr, int wc, int fr, int fq) const {
        const int row0 = u.pm * 256 + wr * 64 + fr, col0 = u.pn * 256 + wc * 64 + 8 * fq; const bool lo = fr < 8;
#pragma unroll
        for (int ai = 0; ai < 2; ++ai)
#pragma unroll
            for (int m = 0; m < 4; ++m) {
                const int row = row0 + ai * 128 + m * 16;
                u32x4 oo[2];
#pragma unroll
                for (int bj = 0; bj < 2; ++bj) {
                    const int col = col0 + bj * 32;
                    const u32x4 gb = *(const u32x4*)(gates + (size_t)row * 2048 + 1024 + col);
                    float r[8];
#pragma unroll
                    for (int q = 0; q < 4; ++q) {
                        const float b0 = fmaxf(bflo(gb[q]), -60.f), b1 = fmaxf(bfhi(gb[q]), -60.f);
                        r[2 * q] = acc[ai][bj][m][q >> 1][(q & 1) * 2] * __builtin_amdgcn_rcpf(1.f + __expf(-b0));
                        r[2 * q + 1] = acc[ai][bj][m][q >> 1][(q & 1) * 2 + 1] * __builtin_amdgcn_rcpf(1.f + __expf(-b1));
                    }
                    oo[bj][0] = pk_bf16(r[0], r[1]); oo[bj][1] = pk_bf16(r[2], r[3]); oo[bj][2] = pk_bf16(r[4], r[5]); oo[bj][3] = pk_bf16(r[6], r[7]);
                }
                line_pair(oo[0], oo[1], lo);
                const int colx = col0 + (lo ? 0 : 32);
                *(u32x4*)(O + (size_t)(lo ? row : row - 8) * DM + colx) = oo[0];
                *(u32x4*)(O + (size_t)(lo ? row + 8 : row) * DM + colx) = oo[1];
            }
    }
};
struct EpiRes {
    static constexpr bool PERM = true, HAS_MID = false, LINE = true;
    const float* R; const bf16_t* Rb; float* H; bf16_t* Hb; float* SS;
    __device__ __forceinline__ void operator()(const f32x4 (&acc)[2][2][4][2], const Unit& u, int wr, int wc, int fr, int fq) const {
        const int row0 = u.pm * 256 + wr * 64 + fr, col0 = u.pn * 256 + wc * 64 + 8 * fq; const bool lo = fr < 8;
#pragma unroll
        for (int ai = 0; ai < 2; ++ai)
#pragma unroll
            for (int m = 0; m < 4; ++m) {
                const int row = row0 + ai * 128 + m * 16;
                float s = 0.f; u32x4 ob[2];
#pragma unroll
                for (int bj = 0; bj < 2; ++bj) {
                    const int col = col0 + bj * 32;
                    f32x4 r0, r1;
                    if (R) { r0 = *(const f32x4*)(R + (size_t)row * DM + col); r1 = *(const f32x4*)(R + (size_t)row * DM + col + 4); }
                    else { const u32x4 rb = *(const u32x4*)(Rb + (size_t)row * DM + col);
                        r0[0] = bflo(rb[0]); r0[1] = bfhi(rb[0]); r0[2] = bflo(rb[1]); r0[3] = bfhi(rb[1]); r1[0] = bflo(rb[2]); r1[1] = bfhi(rb[2]); r1[2] = bflo(rb[3]); r1[3] = bfhi(rb[3]); }
                    const f32x4 h0 = r0 + acc[ai][bj][m][0], h1 = r1 + acc[ai][bj][m][1];
                    if (H) { *(f32x4*)(H + (size_t)row * DM + col) = h0; *(f32x4*)(H + (size_t)row * DM + col + 4) = h1; }
                    ob[bj][0] = pk_bf16(h0[0], h0[1]); ob[bj][1] = pk_bf16(h0[2], h0[3]); ob[bj][2] = pk_bf16(h1[0], h1[1]); ob[bj][3] = pk_bf16(h1[2], h1[3]);
                    s += ((h0[0] * h0[0] + h0[1] * h0[1]) + (h0[2] * h0[2] + h0[3] * h0[3])) + ((h1[0] * h1[0] + h1[1] * h1[1]) + (h1[2] * h1[2] + h1[3] * h1[3]));
                }
                if (Hb) { line_pair(ob[0], ob[1], lo); const int colx = col0 + (lo ? 0 : 32);
                    *(u32x4*)(Hb + (size_t)(lo ? row : row - 8) * DM + colx) = ob[0]; *(u32x4*)(Hb + (size_t)(lo ? row + 8 : row) * DM + colx) = ob[1]; }
                s += __shfl_xor(s, 16); s += __shfl_xor(s, 32);
                if (fq == 0) SS[(size_t)row * 16 + u.pn * 4 + wc] = s;
            }
    }
};
struct EpiSwiGLU {
    static constexpr bool PERM = true, HAS_MID = false, LINE = false;
    bf16_t* O; const float* ss;
    __device__ __forceinline__ void operator()(const f32x4 (&acc)[2][2][4][2], const Unit& u, int wr, int wc, int fr, int fq) const {
        const int row0 = u.pm * 256 + wr * 64 + fr, col0 = u.pn * 128 + wc * 32 + 8 * fq;
        float rs8[8]; rstd_rows8(ss, row0, rs8);
#pragma unroll
        for (int ai = 0; ai < 2; ++ai)
#pragma unroll
            for (int m = 0; m < 4; ++m) {
                const int row = row0 + ai * 128 + m * 16;
                const float rs = rs8[ai * 4 + m];
                float r[8];
#pragma unroll
                for (int n = 0; n < 2; ++n)
#pragma unroll
                    for (int j = 0; j < 4; ++j) { const float gg = acc[ai][0][m][n][j] * rs, uu = acc[ai][1][m][n][j] * rs; r[n * 4 + j] = gg * sigmoidf_(gg) * uu; }
                u32x4 o; o[0] = pk_bf16(r[0], r[1]); o[1] = pk_bf16(r[2], r[3]); o[2] = pk_bf16(r[4], r[5]); o[3] = pk_bf16(r[6], r[7]);
                *(u32x4*)(O + (size_t)row * DFF + col0) = o;
            }
    }
};

struct Ctx { int tid, lane, wave, gw, ngw, gt, ngt; };

__device__ __forceinline__ void p_transpose(const Ctx& c, LAS unsigned char* lds, const float* W, bf16_t* Wt, int K, int N, const float* g, int mode, int& cursor, int ldw = 0, int koff = 0) {
    if (ldw == 0) ldw = K;
    LAS float* scr = (LAS float*)(lds + c.wave * 8704);
    const int nblk = N / 32, nitems = (K / 64) * nblk, lane = c.lane;
    int first = (c.gw - cursor % c.ngw + c.ngw) % c.ngw;
    for (int it = first; it < nitems; it += c.ngw) {
        const int kb = it / nblk, nb = it % nblk, k0 = 64 * kb, n0 = 32 * nb;
#pragma unroll 8
        for (int i = 0; i < 32; ++i) { const int kk = 2 * i + (lane >> 5); float v = W[(size_t)(k0 + kk) * N + n0 + (lane & 31)]; if (g) v *= g[k0 + kk]; scr[kk * 33 + (lane & 31)] = v; }
        asm volatile("s_waitcnt lgkmcnt(0)" ::: "memory");
        const int ch = lane & 7;
#pragma unroll
        for (int j = 0; j < 4; ++j) { const int n = (lane >> 3) + 8 * j; const LAS float* sp = scr + (8 * ch) * 33 + n;
            u32x4 o; o[0] = pk_bf16(sp[0], sp[33]); o[1] = pk_bf16(sp[2 * 33], sp[3 * 33]); o[2] = pk_bf16(sp[4 * 33], sp[5 * 33]); o[3] = pk_bf16(sp[6 * 33], sp[7 * 33]);
            const int nn = n0 + n, row = mode == 0 ? nn : (256 * (nn >> 7) + (nn & 127) + (mode == 2 ? 128 : 0));
            *(u32x4*)(Wt + (size_t)row * ldw + koff + k0 + 8 * ch) = o; }
        asm volatile("s_waitcnt lgkmcnt(0)" ::: "memory");
    }
    cursor += nitems;
}
__device__ __forceinline__ void p_rmsnorm_rows(const Ctx& c, const float* x, const float* g, bf16_t* out, int rows) {
    f32x4 gg[4];
#pragma unroll
    for (int j = 0; j < 4; ++j) gg[j] = ((const f32x4*)g)[c.lane + 64 * j];
    for (int r0 = c.gw; r0 < rows; r0 += 2 * c.ngw) {
        const int r1 = r0 + c.ngw; const bool has1 = r1 < rows; const int r1c = has1 ? r1 : r0;
        const f32x4* xa = (const f32x4*)(x + (size_t)r0 * DM) + c.lane; const f32x4* xb = (const f32x4*)(x + (size_t)r1c * DM) + c.lane;
        f32x4 va[4], vb[4]; float sa = 0.f, sb = 0.f;
#pragma unroll
        for (int j = 0; j < 4; ++j) { va[j] = xa[64 * j]; vb[j] = xb[64 * j]; }
#pragma unroll
        for (int j = 0; j < 4; ++j) { sa += (va[j][0] * va[j][0] + va[j][1] * va[j][1]) + (va[j][2] * va[j][2] + va[j][3] * va[j][3]); sb += (vb[j][0] * vb[j][0] + vb[j][1] * vb[j][1]) + (vb[j][2] * vb[j][2] + vb[j][3] * vb[j][3]); }
        const float ra = rsqrtf(wave_sum(sa) * (1.f / DM) + EPS), rb = rsqrtf(wave_sum(sb) * (1.f / DM) + EPS);
#pragma unroll
        for (int j = 0; j < 4; ++j) {
            u32x2 o; o[0] = pk_bf16(va[j][0] * ra * gg[j][0], va[j][1] * ra * gg[j][1]); o[1] = pk_bf16(va[j][2] * ra * gg[j][2], va[j][3] * ra * gg[j][3]);
            ((u32x2*)(out + (size_t)r0 * DM))[c.lane + 64 * j] = o;
            if (has1) { u32x2 q; q[0] = pk_bf16(vb[j][0] * rb * gg[j][0], vb[j][1] * rb * gg[j][1]); q[1] = pk_bf16(vb[j][2] * rb * gg[j][2], vb[j][3] * rb * gg[j][3]);
                ((u32x2*)(out + (size_t)r1 * DM))[c.lane + 64 * j] = q; }
        }
    }
}
__device__ __forceinline__ void p_rope_table(const Ctx& c, const int* pos, float* tab) {
    for (int i = c.gt; i < T * 8; i += c.ngt) {
        const int tok = i >> 3, f = i & 7;
        const double inv = f == 0 ? 1.0 : f == 1 ? 0.19392274474868576 : f == 2 ? 0.03760603093086393 : f == 3 ? 0.007292664737217109 : f == 4 ? 0.001414213562373095 :
                           f == 5 ? 0.0002742481756762073 : f == 6 ? 5.318295896944988e-05 : 1.031338537721246e-05;
        const double rev = (double)pos[tok] * inv * 0.15915494309189535;
        const float fr = (float)(rev - rint(rev));
        tab[(size_t)tok * 16 + f] = __builtin_amdgcn_cosf(fr);
        tab[(size_t)tok * 16 + 8 + f] = __builtin_amdgcn_sinf(fr);
    }
}
__device__ __forceinline__ void p_final(const Ctx& c, float* out, const float* ss, const float* g) {
    f32x4 gg[4];
#pragma unroll
    for (int j = 0; j < 4; ++j) gg[j] = ((const f32x4*)g)[c.lane + 64 * j];
    for (int r0 = c.gw; r0 < T; r0 += 2 * c.ngw) {
        const int r1 = r0 + c.ngw; const bool has1 = r1 < T; const int r1c = has1 ? r1 : r0;
        f32x4* xa = (f32x4*)(out + (size_t)r0 * DM) + c.lane; f32x4* xb = (f32x4*)(out + (size_t)r1c * DM) + c.lane;
        f32x4 va[4], vb[4];
#pragma unroll
        for (int j = 0; j < 4; ++j) { va[j] = xa[64 * j]; vb[j] = xb[64 * j]; }
        const float ra = rstd_of(ss, r0), rb = rstd_of(ss, r1c);
#pragma unroll
        for (int j = 0; j < 4; ++j) { xa[64 * j] = va[j] * ra * gg[j]; if (has1) xb[64 * j] = vb[j] * rb * gg[j]; }
    }
}

typedef float f32x16 __attribute__((ext_vector_type(16)));
typedef short s16x4 __attribute__((ext_vector_type(4)));
#define MFMA32(a, b, c) __builtin_amdgcn_mfma_f32_32x32x16_bf16((a), (b), (c), 0, 0, 0)
constexpr int ATT_FLAG_OFF = 40960;
#ifndef ATT_DUP_A
#define ATT_DUP_A 0
#endif
#ifndef ATT_DUP_B
#define ATT_DUP_B 0
#endif
template <int MODE, int HDIM, int KT>
__device__ __forceinline__ void attn_item(LAS unsigned char* lds, const bf16_t* Qp, int ldq, const bf16_t* Kp, const bf16_t* Vp, int ldkv, bf16_t* Op, int ldo, int q0, int nkeys) {
    constexpr int KS = HDIM / 16, DD = HDIM / 32, KROW = HDIM * 2 + 16, NCH = HDIM / 8, PER = KT * NCH / 512, NSUB = KT / 32;
    static_assert(2 * KT * KROW + 128 <= ATT_FLAG_OFF, "attention LDS tiles overlap the flag words");
    int tid = threadIdx.x; asm volatile("" : "+v"(tid));
    const int lane = tid & 63, w = __builtin_amdgcn_readfirstlane(tid >> 6), r = lane & 31, hh = lane >> 5;
    const int tq0 = q0 + 32 * w, tq = tq0 + r;
    LAS unsigned char* Ks = lds; LAS unsigned char* Vr = lds + KT * KROW;
    const int trq = (r & 15) >> 2, trp = r & 3, trb = r & 16;
    LAS unsigned* flags = (LAS unsigned*)(lds + ATT_FLAG_OFF);
    bf16x8 Qf[KS];
#pragma unroll
    for (int ks = 0; ks < KS; ++ks) Qf[ks] = *(const bf16x8*)(Qp + (size_t)tq * ldq + 16 * ks + 8 * hh);
    f32x16 Oacc[DD];
#pragma unroll
    for (int dd = 0; dd < DD; ++dd)
#pragma unroll
        for (int i = 0; i < 16; ++i) Oacc[dd][i] = 0.f;
    float m = -INFINITY, l = 0.f, run = (MODE == 1) ? 1.f : 0.f; unsigned done_w = 0u;
    float w8[8], u4[4], fgc[4], fmn[16], fbias = 0.f;
    if (MODE == 0) {
        const int cc = r & 15, e = cc & 3, f = cc >> 3; const bool act = (hh == ((cc >> 2) & 1)); const int c4 = r & 3;
#pragma unroll
        for (int i = 0; i < 8; ++i) { w8[i] = (act && (i & 3) == e && (i >> 2) == f) ? 1.f : 0.f; asm volatile("" : "+v"(w8[i])); }
        fbias = act ? 0.f : -INFINITY; asm volatile("" : "+v"(fbias));
#pragma unroll
        for (int j = 0; j < 4; ++j) { u4[j] = (j == c4) ? 1.f : 0.f; asm volatile("" : "+v"(u4[j])); }
#pragma unroll
        for (int g = 0; g < 4; ++g) { fgc[g] = (((r - 4 * hh - c4 - 8 * g) & 15) == 0) ? 2.f : 1.f; asm volatile("" : "+v"(fgc[g])); }
#pragma unroll
        for (int i = 0; i < 16; ++i) { const int dm = (r - 4 * hh - ((i & 3) + 8 * (i >> 2))) & 15; fmn[i] = 1.f + ((dm & 3) == 0 ? 1.f : 0.f) + (dm == 0 ? 1.f : 0.f); asm volatile("" : "+v"(fmn[i])); }
    }
    const int kt_hi = (MODE == 2) ? (nkeys / KT - 1) : ((q0 + 255) / KT);
    u32x4 kA[PER], vA[PER], kB[PER], vB[PER];
#define ATT_GLOAD(KR, VR, kt) do { _Pragma("unroll") for (int p_ = 0; p_ < PER; ++p_) { const int idx_ = tid + 512 * p_, key_ = idx_ / NCH, ch_ = idx_ % NCH; \
        KR[p_] = *(const u32x4*)(Kp + (size_t)(KT * (kt) + key_) * ldkv + ch_ * 8); VR[p_] = *(const u32x4*)(Vp + (size_t)(KT * (kt) + key_) * ldkv + ch_ * 8); } } while (0)
    auto stage = [&](const u32x4 (&KR)[PER], const u32x4 (&VR)[PER]) -> bool {
        if (MODE == 1 && lane == 0) flags[w] = done_w;
        __syncthreads();
#pragma unroll
        for (int p_ = 0; p_ < PER; ++p_) { const int idx_ = tid + 512 * p_, key_ = idx_ / NCH, ch_ = idx_ % NCH;
            *(LAS u32x4*)(Ks + key_ * KROW + ch_ * 16) = KR[p_];
            *(LAS u32x4*)(Vr + key_ * KROW + ch_ * 16) = VR[p_];
        }
        bool alldone = false;
        if (MODE == 1) { unsigned a = 1u;
#pragma unroll
            for (int i = 0; i < 8; ++i) a &= flags[i];
            alldone = a != 0u; }
        __syncthreads();
        return alldone;
    };
    auto qk = [&](int sub, f32x16& S) {
        bf16x8 kf[KS];
#pragma unroll
        for (int ks = 0; ks < KS; ++ks) kf[ks] = *(const LAS bf16x8*)(Ks + (32 * sub + r) * KROW + (16 * ks + 8 * hh) * 2);
#pragma unroll
        for (int i = 0; i < 16; ++i) S[i] = 0.f;
        __builtin_amdgcn_sched_barrier(0);
#pragma unroll
        for (int ks = 0; ks < KS; ++ks) S = MFMA32(kf[ks], Qf[ks], S);
    };
    auto compute = [&](int kt) {
        f32x16 Sn; bool an;
        { const int tkn = KT * kt + 32 * (NSUB - 1); an = !((MODE != 2 && tkn > tq0 + 31) || (MODE == 1 && done_w)); if (an) qk(NSUB - 1, Sn); }
#pragma unroll
        for (int sub = NSUB - 1; sub >= 0; --sub) {
            const int tk0 = KT * kt + 32 * sub;
            f32x16 S = Sn; const bool a = an;
            if (sub > 0) { const int tkn = tk0 - 32; an = !((MODE != 2 && tkn > tq0 + 31) || (MODE == 1 && done_w)); if (an) qk(sub - 1, Sn); }
            if (!a) continue;
            s16x4 vlo[DD][2], vhi[DD][2];
#pragma unroll
            for (int dd = 0; dd < DD; ++dd)
#pragma unroll
                for (int s2 = 0; s2 < 2; ++s2) {
                    LAS unsigned char* vp = Vr + (32 * sub + 16 * s2 + 4 * hh + trq) * KROW + (32 * dd + trb) * 2 + 8 * trp;
                    vlo[dd][s2] = __builtin_amdgcn_ds_read_tr16_b64_v4i16((LAS s16x4*)vp); vhi[dd][s2] = __builtin_amdgcn_ds_read_tr16_b64_v4i16((LAS s16x4*)(vp + 8 * KROW));
                }
            __builtin_amdgcn_sched_barrier(0);
            const int dbase = tq - tk0 - 4 * hh;
            const int D = tq0 - tk0;
            if (MODE == 0 || MODE == 2) {
                const float C = (MODE == 0 ? 0.125f : 0.08838834764831845f) * 1.4426950408889634f;
                float alpha, ls = 0.f, mn;
                if (MODE == 0 && D >= 544) {
                    float s1 = S[0] * w8[0], s2 = S[8] * w8[0];
#pragma unroll
                    for (int i = 1; i < 8; ++i) { s1 = fmaf(S[i], w8[i], s1); s2 = fmaf(S[8 + i], w8[i], s2); }
                    const float v1 = fmaf(s1, C, fbias), v2 = fmaf(s2, C, fbias);
                    float mx = fmaxf(v1, v2); mx = fmaxf(mx, __shfl_xor(mx, 32));
                    mn = fmaxf(m, mx);
                    alpha = __builtin_amdgcn_exp2f(m - mn);
                    const float p1 = __builtin_amdgcn_exp2f(v1 - mn), p2 = __builtin_amdgcn_exp2f(v2 - mn);
                    ls = p1 + p2;
#pragma unroll
                    for (int i = 0; i < 8; ++i) { S[i] = w8[i] * p1; S[8 + i] = w8[i] * p2; }
                } else if (MODE == 0 && D >= 160 && D <= 480) {
                    float vg[4]; float mx = -INFINITY;
#pragma unroll
                    for (int g = 0; g < 4; ++g) { vg[g] = (fmaf(S[4 * g + 3], u4[3], fmaf(S[4 * g + 2], u4[2], fmaf(S[4 * g + 1], u4[1], S[4 * g] * u4[0])))) * C; mx = fmaxf(mx, vg[g]); }
                    mx = fmaxf(mx, __shfl_xor(mx, 32));
                    mn = fmaxf(m, mx);
                    alpha = __builtin_amdgcn_exp2f(m - mn);
#pragma unroll
                    for (int g = 0; g < 4; ++g) { const float pg = fgc[g] * __builtin_amdgcn_exp2f(vg[g] - mn); ls += pg;
#pragma unroll
                        for (int j = 0; j < 4; ++j) S[4 * g + j] = u4[j] * pg; }
                } else if (MODE == 0 && D >= 32 && D <= 96) {
                    float mx = -INFINITY;
#pragma unroll
                    for (int i = 0; i < 16; ++i) { S[i] = S[i] * C; mx = fmaxf(mx, S[i]); }
                    mx = fmaxf(mx, __shfl_xor(mx, 32));
                    mn = fmaxf(m, mx);
                    alpha = __builtin_amdgcn_exp2f(m - mn);
#pragma unroll
                    for (int i = 0; i < 16; ++i) { const float p = fmn[i] * __builtin_amdgcn_exp2f(S[i] - mn); S[i] = p; ls += p; }
                } else {
                    float fm[16]; float mx = -INFINITY;
#pragma unroll
                    for (int i = 0; i < 16; ++i) {
                        float v = S[i] * C;
                        if (MODE == 0) { const int d = dbase - ((i & 3) + 8 * (i >> 2));
                            int mult = (d <= 128 ? 1 : 0) + ((((d & 3) == 0) && d <= 512) ? 1 : 0) + (((d & 15) == 0) ? 1 : 0);
                            mult = d >= 0 ? mult : 0; fm[i] = (float)mult; v = mult > 0 ? v : -INFINITY; }
                        else fm[i] = 1.f;
                        S[i] = v; mx = fmaxf(mx, v);
                    }
                    mx = fmaxf(mx, __shfl_xor(mx, 32));
                    mn = fmaxf(m, mx); const float ms = (mn == -INFINITY) ? 0.f : mn;
                    alpha = __builtin_amdgcn_exp2f(m - ms);
#pragma unroll
                    for (int i = 0; i < 16; ++i) { const float p = fm[i] * __builtin_amdgcn_exp2f(S[i] - ms); S[i] = p; ls += p; }
                }
                l = l * alpha + ls; m = mn;
                if (!__all(alpha == 1.f)) {
#pragma unroll
                    for (int dd = 0; dd < DD; ++dd) Oacc[dd] = Oacc[dd] * alpha;
                }
            } else {
                float om[16], ex[16], G[4], PG[4];
                if (D < 32) {
#pragma unroll
                    for (int i = 0; i < 16; ++i) { const int d = dbase - ((i & 3) + 8 * (i >> 2)); const bool valid = d > 0;
                        const float x = fminf(fmaxf(S[i] * (0.125f * 1.4426950408889634f), -115.f), 115.f); const float e = __builtin_amdgcn_exp2f(x); const float o1 = __builtin_amdgcn_rcpf(1.f + e);
                        om[i] = valid ? o1 : 1.f; S[i] = valid ? e * o1 : 0.f; }
                } else {
#pragma unroll
                    for (int i = 0; i < 16; ++i) {
                        const float x = fminf(fmaxf(S[i] * (0.125f * 1.4426950408889634f), -115.f), 115.f); const float e = __builtin_amdgcn_exp2f(x); const float o1 = __builtin_amdgcn_rcpf(1.f + e);
                        om[i] = o1; S[i] = e * o1; }
                }
#pragma unroll
                for (int g = 0; g < 4; ++g) { ex[4 * g + 3] = 1.f; ex[4 * g + 2] = om[4 * g + 3]; ex[4 * g + 1] = ex[4 * g + 2] * om[4 * g + 2]; ex[4 * g] = ex[4 * g + 1] * om[4 * g + 1]; G[g] = ex[4 * g] * om[4 * g]; }
#pragma unroll
                for (int g = 0; g < 4; ++g) PG[g] = __shfl_xor(G[g], 32);
                float suf = run;
#pragma unroll
                for (int g = 3; g >= 0; --g) { const float lat = suf * (hh == 0 ? PG[g] : 1.f);
                    S[4 * g + 3] = S[4 * g + 3] * lat; S[4 * g + 2] = S[4 * g + 2] * (lat * ex[4 * g + 2]); S[4 * g + 1] = S[4 * g + 1] * (lat * ex[4 * g + 1]); S[4 * g] = S[4 * g] * (lat * ex[4 * g]);
                    suf *= G[g] * PG[g]; }
                run = suf;
                done_w = __all(run < 1e-30f) ? 1u : 0u;
            }
            u32x4 pp0, pp1;
#pragma unroll
            for (int j = 0; j < 4; ++j) { pp0[j] = pk_bf16(S[2 * j], S[2 * j + 1]); pp1[j] = pk_bf16(S[8 + 2 * j], S[8 + 2 * j + 1]); }
            const bf16x8 P0 = __builtin_bit_cast(bf16x8, pp0), P1 = __builtin_bit_cast(bf16x8, pp1);
#pragma unroll
            for (int dd = 0; dd < DD; ++dd)
#pragma unroll
                for (int s2 = 0; s2 < 2; ++s2) {
                    const bf16x8 vf = __builtin_shufflevector(vlo[dd][s2], vhi[dd][s2], 0, 1, 2, 3, 4, 5, 6, 7);
                    Oacc[dd] = MFMA32(vf, s2 ? P1 : P0, Oacc[dd]);
                }
        }
    };
    ATT_GLOAD(kA, vA, kt_hi);
    if constexpr (MODE == 2) {
#pragma unroll 1
        for (int kt = kt_hi; kt >= 0; --kt) {
            stage(kA, vA);
            if (kt >= 1) ATT_GLOAD(kA, vA, kt - 1);
            compute(kt);
        }
    } else {
        if (kt_hi >= 1) ATT_GLOAD(kB, vB, kt_hi - 1);
#pragma unroll 1
        for (int kt = kt_hi; kt >= 0; kt -= 2) {
            if (stage(kA, vA)) break;
            if (kt >= 2) ATT_GLOAD(kA, vA, kt - 2);
            compute(kt);
            if (kt == 0) break;
            if (stage(kB, vB)) break;
            if (kt >= 3) ATT_GLOAD(kB, vB, kt - 3);
            compute(kt - 1);
        }
    }
#undef ATT_GLOAD
    float inv = 1.f;
    if (MODE != 1) { const float lt = l + __shfl_xor(l, 32); inv = 1.f / lt; }
#pragma unroll
    for (int dd = 0; dd < DD; ++dd)
#pragma unroll
        for (int g = 0; g < 4; g += 2) {
            unsigned a0 = pk_bf16(Oacc[dd][4 * g] * inv, Oacc[dd][4 * g + 1] * inv), a1 = pk_bf16(Oacc[dd][4 * g + 2] * inv, Oacc[dd][4 * g + 3] * inv);
            unsigned b0 = pk_bf16(Oacc[dd][4 * g + 4] * inv, Oacc[dd][4 * g + 5] * inv), b1 = pk_bf16(Oacc[dd][4 * g + 6] * inv, Oacc[dd][4 * g + 7] * inv);
            { auto x = __builtin_amdgcn_permlane32_swap(a0, b0, false, false); a0 = x[0]; b0 = x[1]; }
            { auto x = __builtin_amdgcn_permlane32_swap(a1, b1, false, false); a1 = x[0]; b1 = x[1]; }
            u32x4 o; o[0] = a0; o[1] = a1; o[2] = b0; o[3] = b1;
            *(u32x4*)(Op + (size_t)tq * ldo + 32 * dd + 8 * g + 8 * hh) = o;
        }
}
constexpr int WQ_WORD = 4096;
__device__ __forceinline__ void p_attn_ab(LAS unsigned char* lds, const bf16_t* qkv, bf16_t* OA, bf16_t* OB, unsigned* wq) {
    constexpr size_t TS = (size_t)T * 512;
    volatile LAS unsigned* slot = (volatile LAS unsigned*)(lds + ATT_FLAG_OFF + 64);
    for (;;) {
        if (threadIdx.x == 0) *slot = __hip_atomic_fetch_add(wq, 1u, __ATOMIC_RELAXED, __HIP_MEMORY_SCOPE_AGENT);
        __syncthreads();
        const unsigned it = (unsigned)__builtin_amdgcn_readfirstlane((int)*slot);
        __syncthreads();
        if (it >= 2048u) break;
        const int j = it & 1023, qb = 7 - (j >> 7), bh = j & 127, b = bh >> 3, h = bh & 7;
        const bf16_t* base = qkv + (size_t)bh * SEQ * 64;
        if (it < 1024u) attn_item<0, 64, 128>(lds, base, 64, base + TS, base + 2 * TS, 64, OA + (size_t)b * SEQ * 1024 + h * HD, 1024, qb * 256, SEQ);
        else attn_item<1, 64, 128>(lds, base + 3 * TS, 64, base + 4 * TS, base + 5 * TS, 64, OB + (size_t)b * SEQ * 1024 + h * HD, 1024, qb * 256, SEQ);
    }
}
__device__ __forceinline__ void p_attn_mem(LAS unsigned char* lds, const bf16_t* qm, const bf16_t* kvm, bf16_t* om) {
#pragma unroll 1
    for (int i = 0;; ++i) {
        Unit u; { pg8::StaticOrder S2; S2.init(T, MEMW, (int)gridDim.x, (int)blockIdx.x); if (!S2.next(i, u)) break; }
        const int b = u.pm >> 3, qb = u.pm & 7;
#pragma unroll 1
        for (int hq = 0; hq < 2; ++hq) { const int h = 2 * u.pn + hq;
            attn_item<2, 128, 64>(lds, qm + (size_t)b * SEQ * MEMW + h * 128, MEMW, kvm + (size_t)b * NMEM * 1024 + h * 128, kvm + (size_t)b * NMEM * 1024 + 512 + h * 128, 1024,
                                  om + (size_t)b * SEQ * MEMW + h * 128, MEMW, qb * 256, NMEM); }
    }
}

__device__ __forceinline__ bool sync_if(int k, cg::grid_group& grid, XcdBarrier& xb) {
    if (k == 1) { grid.sync(); xb = xcd_barrier_post(xb.bar, xb.st); }
    else if (k == 8) {
        asm volatile("s_waitcnt vmcnt(0)" ::: "memory");
        __syncthreads();
        if (threadIdx.x == 0) { __builtin_amdgcn_fence(__ATOMIC_ACQUIRE, "agent"); asm volatile("s_waitcnt vmcnt(0)" ::: "memory"); }
        __syncthreads();
    }
    else if (k > 1) xcd_barrier(xb);
    asm volatile("" ::: "memory"); return true; }
constexpr int NPHASE = 13;
#ifndef NAIVE_AB
#define NAIVE_AB 0
#endif
#ifndef NAIVE_MEM
#define NAIVE_MEM 0
#endif
#ifndef ONLY
#define ONLY -1
#endif
#ifndef DUP_MASK
#define DUP_MASK 0
#endif
#define PHASE(k) if ((ONLY < 0 || ONLY == (k)) && ph_lo <= (k) && (k) < ph_hi) if (sync_if((k), grid, xb)) for (int rep_ = 0; rep_ < (((DUP_MASK >> (k)) & 1) ? 2 : 1); ++rep_)
__global__ __launch_bounds__(512, 2) void mega(Params p, int ph_lo, int ph_hi) {
    extern __shared__ __attribute__((aligned(16))) unsigned char shm[];
    LAS unsigned char* lds = (LAS unsigned char*)shm;
    cg::grid_group grid = cg::this_grid();
    Ctx c; c.tid = threadIdx.x; c.lane = c.tid & 63; c.wave = c.tid >> 6; c.gw = blockIdx.x * 8 + c.wave; c.ngw = gridDim.x * 8; c.gt = blockIdx.x * 512 + c.tid; c.ngt = gridDim.x * 512;
    unsigned char* ws = p.ws;
    bf16_t* Wt_in = (bf16_t*)(ws + WS_WIN); bf16_t* Wt_upa = (bf16_t*)(ws + WS_WUPA); bf16_t* Wt_upb = (bf16_t*)(ws + WS_WUPB); bf16_t* Wt_out = (bf16_t*)(ws + WS_WOUT);
    bf16_t* Wt_qm = (bf16_t*)(ws + WS_WQM); bf16_t* Wt_kvm = (bf16_t*)(ws + WS_WKVM); bf16_t* Wt_om = (bf16_t*)(ws + WS_WOM); bf16_t* Wt_gu = (bf16_t*)(ws + WS_WGU); bf16_t* Wt_dn = (bf16_t*)(ws + WS_WDN);
    bf16_t* memn = (bf16_t*)(ws + WS_MEMN); bf16_t* kvm = (bf16_t*)(ws + WS_KVM);
    float* ss1 = (float*)(ws + WS_SS1); float* ss2 = (float*)(ws + WS_SS2); float* ss3 = (float*)(ws + WS_SS3); float* rope = (float*)(ws + WS_ROPE);
    bf16_t* n1 = (bf16_t*)(ws + WS_R1); bf16_t* mixed = (bf16_t*)(ws + WS_R1); bf16_t* h2b = (bf16_t*)(ws + WS_R1);
    bf16_t* proj = (bf16_t*)(ws + WS_PROJ); bf16_t* gates = (bf16_t*)(ws + WS_PROJ + 192 * MiB);
    float* h1 = (float*)(ws + WS_H1); bf16_t* h1b = (bf16_t*)(ws + WS_H1B); bf16_t* qm = (bf16_t*)(ws + WS_QM); bf16_t* om = (bf16_t*)(ws + WS_OM);
    float* h2 = (float*)(ws + WS_H2); bf16_t* act = (bf16_t*)(ws + WS_ACT); bf16_t* OA = (bf16_t*)(ws + WS_OA); bf16_t* OB = (bf16_t*)(ws + WS_OA) + 512;
    float* m1 = p.out; unsigned* bar = (unsigned*)(ws + WS_BAR);
    volatile LAS unsigned* xst = (volatile LAS unsigned*)(lds + pg8::STAGE_BYTES);
    if (c.tid == 0) { xst[0] = 0u; xst[1] = 0u; }
    __syncthreads();
    XcdBarrier xb; xb.bar = bar; xb.x = 0u; xb.st = xst;
    pg8::StaticOrder S;
    {
        PHASE(0) {
            int cur = 0;
            p_transpose(c, lds, p.w_in, Wt_in, DM, INC, nullptr, 0, cur);
            p_transpose(c, lds, p.w_ffn_gate, Wt_gu, DM, DFF, p.g_ffn, 1, cur);
            p_transpose(c, lds, p.w_ffn_up, Wt_gu, DM, DFF, p.g_ffn, 2, cur);
            p_transpose(c, lds, p.w_ffn_down, Wt_dn, DFF, DM, nullptr, 0, cur);
            p_transpose(c, lds, p.w_up_a, Wt_upa, 512, DM, nullptr, 0, cur, 1024, 0);
            p_transpose(c, lds, p.w_up_b, Wt_upa, 512, DM, nullptr, 0, cur, 1024, 512);
            p_transpose(c, lds, p.w_out, Wt_out, DM, DM, nullptr, 0, cur);
            p_transpose(c, lds, p.w_q_mem, Wt_qm, DM, MEMW, p.g_mem_q, 0, cur);
            p_transpose(c, lds, p.w_kv_mem, Wt_kvm, DM, 2 * MEMW, nullptr, 0, cur);
            p_transpose(c, lds, p.w_o_mem, Wt_om, MEMW, DM, nullptr, 0, cur);
            p_rmsnorm_rows(c, p.x, p.g_mix, n1, T);
            p_rmsnorm_rows(c, p.mem, p.g_mem_kv, memn, BATCH * NMEM);
            p_rope_table(c, p.pos, rope);
            if (blockIdx.x == 0) { for (int i = c.tid; i < XCD_BAR_WORDS; i += 512) bar[i] = 0u; if (c.tid == 0) bar[WQ_WORD] = 0u; }
        }
        PHASE(1) {
            Gemm g{n1, Wt_in, T, INC, DM}; EpiBf16 E{proj, INC, nullptr, 1 << 30, rope, 4, 12, gates};   S.init(g.M, g.N, gridDim.x, blockIdx.x); pg8::gemm_phase(lds, g, S, E);
        }
        PHASE(3) {
            { Gemm g{memn, Wt_kvm, BATCH * NMEM, 1024, DM}; EpiBf16 E{kvm, 1024, nullptr, 1 << 30, nullptr, 0, 0, nullptr}; S.init(g.M, g.N, gridDim.x, blockIdx.x); pg8::gemm_phase(lds, g, S, E); }
            p_attn_ab(lds, proj, OA, OB, bar + WQ_WORD);
        }
        PHASE(5) { Gemm g{OA, Wt_upa, T, DM, DM}; EpiGate E{gates, mixed}; S.init(g.M, g.N, gridDim.x, blockIdx.x); pg8::gemm_phase(lds, g, S, E); }
        PHASE(6) { Gemm g{mixed, Wt_out, T, DM, DM}; EpiRes E{p.x, nullptr, nullptr, h1b, ss1}; S.init(g.M, g.N, gridDim.x, blockIdx.x); pg8::gemm_phase(lds, g, S, E); }
        PHASE(7) { Gemm g{h1b, Wt_qm, T, MEMW, DM}; EpiBf16 E{qm, MEMW, ss1, 1 << 30, nullptr, 0, 0, nullptr}; S.init(g.M, g.N, gridDim.x, blockIdx.x); pg8::gemm_phase(lds, g, S, E); }
        PHASE(8) {
            p_attn_mem(lds, qm, kvm, om);
        }
        PHASE(9) { Gemm g{om, Wt_om, T, DM, MEMW}; EpiRes E{nullptr, h1b, nullptr, h2b, ss2}; S.init(g.M, g.N, gridDim.x, blockIdx.x); pg8::gemm_phase(lds, g, S, E); }
        PHASE(10) { Gemm g{h2b, Wt_gu, T, 2 * DFF, DM}; EpiSwiGLU E{act, ss2}; S.init(g.M, g.N, gridDim.x, blockIdx.x); pg8::gemm_phase(lds, g, S, E); }
        PHASE(11) { Gemm g{act, Wt_dn, T, DM, DFF}; EpiRes E{nullptr, h2b, p.out, nullptr, ss3}; S.init(g.M, g.N, gridDim.x, blockIdx.x); pg8::gemm_phase(lds, g, S, E); }
        PHASE(12) p_final(c, p.out, ss3, p.g_final);
    }
}

constexpr int LDS_BYTES = pg8::STAGE_BYTES + 16;
#ifndef ONE_LAUNCH
#define ONE_LAUNCH 1
#endif
extern "C" void kernel_launch(void* const* d_in, const int* in_sizes, int n_in, void* d_out, int out_size, void* d_ws, size_t ws_size, hipStream_t stream) {
    static int grid = 0;
    if (grid == 0) {
        if (n_in != 18 || out_size != T * DM || ws_size < WS_END) { fprintf(stderr, "kernel_launch: unexpected shapes (n_in %d out %d ws %zu)\n", n_in, out_size, ws_size); grid = -1; return; }
        int dev = 0, cus = 0, per_cu = 0;
        (void)hipGetDevice(&dev); (void)hipDeviceGetAttribute(&cus, hipDeviceAttributeMultiprocessorCount, dev);
        if (hipFuncSetAttribute((const void*)mega, hipFuncAttributeMaxDynamicSharedMemorySize, LDS_BYTES) != hipSuccess) { fprintf(stderr, "hipFuncSetAttribute failed\n"); grid = -1; return; }
        if (hipOccupancyMaxActiveBlocksPerMultiprocessor(&per_cu, (const void*)mega, 512, LDS_BYTES) != hipSuccess || per_cu < 1) { fprintf(stderr, "occupancy query: %d\n", per_cu); per_cu = 1; }
        (void)hipGetLastError();
        grid = cus * 1;
    }
    if (grid < 0) return;
    Params p{};
    p.x = (const float*)d_in[0]; p.mem = (const float*)d_in[1]; p.pos = (const int*)d_in[2]; p.g_mix = (const float*)d_in[3]; p.w_in = (const float*)d_in[4];
    p.w_up_a = (const float*)d_in[5]; p.w_up_b = (const float*)d_in[6]; p.w_out = (const float*)d_in[7]; p.g_mem_q = (const float*)d_in[8]; p.g_mem_kv = (const float*)d_in[9];
    p.w_q_mem = (const float*)d_in[10]; p.w_kv_mem = (const float*)d_in[11]; p.w_o_mem = (const float*)d_in[12]; p.g_ffn = (const float*)d_in[13];
    p.w_ffn_gate = (const float*)d_in[14]; p.w_ffn_up = (const float*)d_in[15]; p.w_ffn_down = (const float*)d_in[16]; p.g_final = (const float*)d_in[17];
    p.out = (float*)d_out; p.ws = (unsigned char*)d_ws;
#if ONE_LAUNCH
    int lo = 0, hi = NPHASE;
    void* args[] = {&p, &lo, &hi};
    hipError_t e = hipLaunchCooperativeKernel((const void*)mega, dim3(grid), dim3(512), args, LDS_BYTES, stream);
    if (e != hipSuccess) fprintf(stderr, "cooperative launch failed: %s\n", hipGetErrorString(e));
#else
    for (int ph = 0; ph < NPHASE; ++ph) hipLaunchKernelGGL(mega, dim3(grid), dim3(512), LDS_BYTES, stream, p, ph, ph + 1);
#endif
}
```

```cpp
#include <hip/hip_runtime.h>
#include <hip/hip_cooperative_groups.h>
#include <cstdio>
namespace cg = cooperative_groups;

#define LAS __attribute__((address_space(3)))
typedef unsigned short bf16_t;
typedef short bf16x8 __attribute__((ext_vector_type(8)));
typedef float f32x4 __attribute__((ext_vector_type(4)));
typedef unsigned u32x4 __attribute__((ext_vector_type(4)));
typedef unsigned u32x2 __attribute__((ext_vector_type(2)));

constexpr int BATCH = 16, SEQ = 2048, DM = 1024, T = BATCH * SEQ;
constexpr int HD = 64, NHA = 8, NHB = 8;
constexpr int INC = 5120;
constexpr int C_QA = 0, C_KA = 512, C_VA = 1024, C_QB = 1536, C_KB = 2048, C_VB = 2560, C_GA = 3072, C_GB = 4096;
constexpr int NMEM = 256, MEMW = 512, DFF = 2816;
constexpr float EPS = 1e-6f;

constexpr size_t MiB = 1ull << 20;
constexpr size_t WS_WIN = 0, WS_WUPA = 10 * MiB, WS_WUPB = 11 * MiB, WS_WOUT = 12 * MiB, WS_WQM = 14 * MiB, WS_WKVM = 15 * MiB,
                 WS_WOM = 17 * MiB, WS_WGU = 18 * MiB, WS_WDN = 29 * MiB, WS_MEMN = 36 * MiB, WS_KVM = 44 * MiB,
                 WS_SS1 = 52 * MiB, WS_SS2 = 54 * MiB, WS_SS3 = 56 * MiB, WS_ROPE = 58 * MiB, WS_BAR = 60 * MiB;
constexpr size_t WS_R1 = 64 * MiB;
constexpr size_t WS_PROJ = 128 * MiB;
constexpr size_t WS_H1 = 128 * MiB, WS_H1B = 256 * MiB, WS_QM = 320 * MiB, WS_OM = 352 * MiB, WS_H2 = 384 * MiB, WS_ACT = 128 * MiB;
constexpr size_t WS_OA = 448 * MiB, WS_OB = 480 * MiB;
constexpr size_t WS_END = 512 * MiB;

struct Params {
    const float* x; const float* mem; const int* pos; const float* g_mix; const float* w_in; const float* w_up_a; const float* w_up_b; const float* w_out;
    const float* g_mem_q; const float* g_mem_kv; const float* w_q_mem; const float* w_kv_mem; const float* w_o_mem; const float* g_ffn;
    const float* w_ffn_gate; const float* w_ffn_up; const float* w_ffn_down; const float* g_final;
    float* out; unsigned char* ws;
};

typedef float f32x2 __attribute__((ext_vector_type(2)));
typedef __bf16 bf16v2 __attribute__((ext_vector_type(2)));
__device__ __forceinline__ unsigned pk_bf16(float lo, float hi) { f32x2 v = {lo, hi}; bf16v2 r = __builtin_convertvector(v, bf16v2); return __builtin_bit_cast(unsigned, r); }
__device__ __forceinline__ bf16_t f2bf(float f) { return (bf16_t)(pk_bf16(f, 0.f) & 0xffffu); }
__device__ __forceinline__ float bf2f(bf16_t b) { return __uint_as_float(((unsigned)b) << 16); }
__device__ __forceinline__ float bflo(unsigned u) { return __uint_as_float(u << 16); }
__device__ __forceinline__ float bfhi(unsigned u) { return __uint_as_float(u & 0xffff0000u); }
__device__ __forceinline__ float wave_sum(float v) {
#pragma unroll
    for (int o = 1; o < 64; o <<= 1) v += __shfl_xor(v, o);
    return v;
}
__device__ __forceinline__ float sigmoidf_(float x) { return __builtin_amdgcn_rcpf(1.f + __builtin_amdgcn_exp2f(x * -1.4426950408889634f)); }
__device__ __forceinline__ float rstd_of(const float* ss, int row) {
    const f32x4* p = (const f32x4*)(ss + (size_t)row * 16);
    f32x4 a = p[0], b = p[1], c = p[2], d = p[3];
    float s = ((a[0] + a[1]) + (a[2] + a[3])) + ((b[0] + b[1]) + (b[2] + b[3])) + ((c[0] + c[1]) + (c[2] + c[3])) + ((d[0] + d[1]) + (d[2] + d[3]));
    return rsqrtf(s * (1.f / DM) + EPS);
}


__device__ __forceinline__ void rstd_rows8(const float* ss, int row0, float (&rs)[8]) {
#pragma unroll
    for (int h = 0; h < 4; ++h) {
        f32x4 t[2][4];
#pragma unroll
        for (int j = 0; j < 2; ++j) { const int k = 2 * h + j; const f32x4* p = (const f32x4*)(ss + (size_t)(row0 + (k >> 2) * 128 + (k & 3) * 16) * 16);
#pragma unroll
            for (int q = 0; q < 4; ++q) t[j][q] = p[q]; }
#pragma unroll
        for (int j = 0; j < 2; ++j) { const f32x4 v = (t[j][0] + t[j][1]) + (t[j][2] + t[j][3]); rs[2 * h + j] = rsqrtf(((v[0] + v[1]) + (v[2] + v[3])) * (1.f / DM) + EPS); }
        __builtin_amdgcn_sched_barrier(0);
    }
}

#define XB_TMO      128
#define XB_XCNT(j)  (256  + 64 * (j))
#define XB_XSUB(j)  (1280 + 64 * (j))
#define XB_XGEN(j)  (2304 + 64 * (j))
#define XB_TOP      3328
#define XB_TOPGEN   3392
#define XCD_BAR_WORDS 3456
#define XB_SPIN_CAP (1u << 18)
__device__ __forceinline__ unsigned xb_ld(unsigned* p)              { return __hip_atomic_load(p, __ATOMIC_RELAXED, __HIP_MEMORY_SCOPE_AGENT); }
__device__ __forceinline__ unsigned xb_add(unsigned* p, unsigned v) { return __hip_atomic_fetch_add(p, v, __ATOMIC_RELAXED, __HIP_MEMORY_SCOPE_AGENT); }
__device__ __forceinline__ unsigned xb_xcc_id() { return (unsigned)__builtin_amdgcn_s_getreg((3 << 11) | 20) & 0xFu; }
#define XB_SPIN(cond, bar) do { unsigned _sp = 0; while (cond) { __builtin_amdgcn_s_sleep(1); \
    if ((++_sp & 255u) == 0u) { if (xb_ld(&(bar)[XB_TMO])) break; if (_sp > XB_SPIN_CAP) { atomicAdd(&(bar)[XB_TMO], 1u); break; } } } } while (0)
struct XcdBarrier { unsigned* bar; unsigned x; volatile LAS unsigned* st; };
__device__ __forceinline__ XcdBarrier xcd_barrier_post(unsigned* bar, volatile LAS unsigned* st) {
    XcdBarrier b; b.bar = bar; b.x = xb_xcc_id(); b.st = st;
    if (threadIdx.x == 0) (void)xb_add(&bar[XB_XCNT(b.x)], 1u);
    return b;
}
__device__ __forceinline__ void xcd_barrier_complete(unsigned* bar, unsigned x, unsigned& nloc, unsigned& nx) {
    const unsigned G = gridDim.x * gridDim.y * gridDim.z;
    unsigned sum, cnt, mine, sp = 0u;
    for (;;) {
        sum = 0u; cnt = 0u; mine = 0u;
#pragma unroll
        for (unsigned j = 0; j < 16; ++j) { const unsigned c = xb_ld(&bar[XB_XCNT(j)]); sum += c; cnt += (c > 0u) ? 1u : 0u; mine = (j == x) ? c : mine; }
        if (sum == G) break;
        __builtin_amdgcn_s_sleep(1);
        if ((++sp & 255u) == 0u) { if (xb_ld(&bar[XB_TMO])) break; if (sp > XB_SPIN_CAP) { atomicAdd(&bar[XB_TMO], 1u); break; } }
    }
    nloc = mine > 0u ? mine : 1u; nx = cnt > 0u ? cnt : 1u;
}
__device__ __forceinline__ void xcd_barrier(const XcdBarrier& b) {
    asm volatile("s_waitcnt vmcnt(0)" ::: "memory");
    __syncthreads();
    if (threadIdx.x == 0) {
        unsigned* bar = b.bar;
        __builtin_amdgcn_s_waitcnt(0);
        unsigned nloc = b.st[0], nx = b.st[1];
        if (nloc == 0u) { xcd_barrier_complete(bar, b.x, nloc, nx); b.st[0] = nloc; b.st[1] = nx; }
        const unsigned old = xb_add(&bar[XB_XSUB(b.x)], 1u);
        const unsigned gen = old / nloc;
        if (old + 1u == (gen + 1u) * nloc) {
            __builtin_amdgcn_fence(__ATOMIC_RELEASE, "agent");
            asm volatile("s_waitcnt vmcnt(0)" ::: "memory");
            const unsigned og = xb_add(&bar[XB_TOP], 1u);
            const unsigned tg = og / nx;
            if (og + 1u == (tg + 1u) * nx) xb_add(&bar[XB_TOPGEN], 1u);
            else XB_SPIN(xb_ld(&bar[XB_TOPGEN]) == tg, bar);
            __builtin_amdgcn_fence(__ATOMIC_ACQUIRE, "agent");
            xb_add(&bar[XB_XGEN(b.x)], 1u);
            asm volatile("s_waitcnt vmcnt(0)" ::: "memory");
        } else {
            XB_SPIN(xb_ld(&bar[XB_XGEN(b.x)]) == gen, bar);
            __builtin_amdgcn_fence(__ATOMIC_ACQUIRE, "agent");
            asm volatile("s_waitcnt vmcnt(0)" ::: "memory");
        }
    }
    __syncthreads();
}

namespace pg8 {
constexpr int BM = 256, BK = 64, HALF = 128, HTB = HALF * BK * 2, STAGE_BYTES = 8 * HTB, NXCD = 8, WGM = 4;
__host__ __device__ __forceinline__ int lds_byte(int r, int c) { const int st = (r >> 4) * 2 + (c >> 5), rr = r & 15, cc = c & 31, ob = rr * 64 + cc * 2; return st * 1024 + (ob ^ (((ob >> 9) & 1) << 5)); }
__host__ __device__ __forceinline__ void stage_rc(int b, int& R, int& C) { const int st = b / 1024, sb = b % 1024, swz = sb ^ (((sb >> 9) & 1) << 5); R = (st >> 1) * 16 + swz / 64; C = (st & 1) * 32 + (swz % 64) / 2; }
__host__ __device__ __forceinline__ int perm32(int rho) { const int n = rho >> 4, i = rho & 15; return 8 * (i >> 2) + 4 * n + (i & 3); }
struct Unit { int pm, pn; };
struct Gemm { const bf16_t* A; const bf16_t* Bt; int M, N, K; };
struct StaticOrder {
    int nM, nN, nwg, G, c;
    __host__ __device__ void init(int M, int N, int G_, int c_) { nM = M / BM; nN = N / BM; nwg = nM * nN; G = G_; c = c_; }
    __host__ __device__ bool next(int i, Unit& u) const {
        const long L = (long)i * G + c; if (L >= nwg) return false;
        int wgid = (int)L; { const int q = nwg / NXCD, r = nwg % NXCD, xcd = wgid % NXCD, off = wgid / NXCD; wgid = (xcd < r ? xcd * (q + 1) : r * (q + 1) + (xcd - r) * q) + off; }
        const int nig = WGM * nN, gid = wgid / nig, fm = gid * WGM, gsz = (nM - fm) < WGM ? (nM - fm) : WGM;
        u.pm = fm + ((wgid % nig) % gsz); u.pn = (wgid % nig) / gsz; return true;
    }
};

template <class Epi>
__device__ __forceinline__ void gemm_phase(LAS unsigned char* lds, const Gemm g, const StaticOrder& S, const Epi& E) {
    int tid = threadIdx.x; asm volatile("" : "+v"(tid));
    const int wid = __builtin_amdgcn_readfirstlane(tid >> 6), lane = tid & 63, wr = wid >> 2, wc = wid & 3, fr = lane & 15, fq = lane >> 4;
    const int K = g.K, nt = K / BK;
    unsigned voffA[2], voffB[2];
#pragma unroll
    for (int i = 0; i < 2; ++i) { int R, C; stage_rc(tid * 16 + i * 8192, R, C); const int Rb = Epi::LINE ? ((R >> 5) * 64 + perm32(R & 31)) : (Epi::PERM ? ((R & ~31) + perm32(R & 31)) : R);
        voffA[i] = (unsigned)(R * K + C) * 2u; voffB[i] = (unsigned)(Rb * K + C) * 2u; }
    const size_t kstep = (size_t)(BK * 2);
    const size_t hstep = (size_t)HALF * K * 2;
    const size_t tstep = 2 * hstep;
    const size_t hstepB = Epi::LINE ? (size_t)32 * K * 2 : hstep;
    const unsigned ldsw = (unsigned)wid * 1024u;
    const int aoff = lds_byte(wr * 64 + fr, fq * 8), boff = lds_byte(wc * 32 + fr, fq * 8);
#define PG8_SA(b, h) (((b) * 2 + (h)) * HTB)
#define PG8_SB(b, h) ((4 + (b) * 2 + (h)) * HTB)
#define PG8_STAGE(bufoff, gbase, voff) do { _Pragma("unroll") for (int _i = 0; _i < 2; ++_i) \
        __builtin_amdgcn_global_load_lds((const unsigned*)((const char*)(gbase) + (voff)[_i]), (LAS unsigned*)(lds + (bufoff) + ldsw + _i * 8192), 16, 0, 0); } while (0)
#define PG8_LDA(dst, b, h) do { _Pragma("unroll") for (int m = 0; m < 4; ++m) _Pragma("unroll") for (int k = 0; k < 2; ++k) dst[m][k] = *(const LAS bf16x8*)(lds + PG8_SA(b, h) + aoff + m * 2048 + k * 1024); } while (0)
#define PG8_LDB(dst, b, h) do { _Pragma("unroll") for (int n = 0; n < 2; ++n) _Pragma("unroll") for (int k = 0; k < 2; ++k) dst[n][k] = *(const LAS bf16x8*)(lds + PG8_SB(b, h) + boff + n * 2048 + k * 1024); } while (0)
#define PG8_MMA(ai, bj, At, Bt) do { __builtin_amdgcn_s_setprio(1); _Pragma("unroll") for (int m = 0; m < 4; ++m) _Pragma("unroll") for (int n = 0; n < 2; ++n) _Pragma("unroll") for (int k = 0; k < 2; ++k) \
        acc[ai][bj][m][n] = __builtin_amdgcn_mfma_f32_16x16x32_bf16(Bt[n][k], At[m][k], acc[ai][bj][m][n], 0, 0, 0); __builtin_amdgcn_s_setprio(0); } while (0)
#define PG8_WAIT_V(n) asm volatile("s_waitcnt vmcnt(" #n ")" ::: "memory")
#define PG8_WAIT_L(n) asm volatile("s_waitcnt lgkmcnt(" #n ")" ::: "memory")
#define PG8_BAR __builtin_amdgcn_s_barrier()
#define PG8_SCHED __builtin_amdgcn_sched_barrier(0)
    Unit cur, nxt; int ui = 0;
    if (!S.next(0, cur)) return;
    f32x4 acc[2][2][4][2];
#pragma unroll
    for (int a = 0; a < 2; ++a)
#pragma unroll
        for (int b = 0; b < 2; ++b)
#pragma unroll
            for (int m = 0; m < 4; ++m)
#pragma unroll
                for (int n = 0; n < 2; ++n) acc[a][b][m][n] = (f32x4){0.f, 0.f, 0.f, 0.f};
    bf16x8 At[4][2], B0[2][2], B1[2][2];
    const char* cA = (const char*)g.A + (size_t)cur.pm * tstep; const char* cB = (const char*)g.Bt + (size_t)cur.pn * tstep;
    PG8_STAGE(PG8_SB(0, 0), cB, voffB); PG8_STAGE(PG8_SA(0, 0), cA, voffA); PG8_STAGE(PG8_SB(0, 1), cB + hstepB, voffB); PG8_STAGE(PG8_SA(0, 1), cA + hstep, voffA);
    if (wr == 1) PG8_BAR;
    PG8_WAIT_V(4); PG8_BAR;
    PG8_STAGE(PG8_SB(1, 0), cB + kstep, voffB); PG8_STAGE(PG8_SA(1, 0), cA + kstep, voffA); PG8_STAGE(PG8_SB(1, 1), cB + hstepB + kstep, voffB);
    PG8_WAIT_V(6); PG8_BAR;
    for (;;) {
        const bool has_next = S.next(ui + 1, nxt);
        const char* nA = has_next ? (const char*)g.A + (size_t)nxt.pm * tstep : cA; const char* nB = has_next ? (const char*)g.Bt + (size_t)nxt.pn * tstep : cB;
        for (int t = 0; t < nt; t += 2) {
            const bool last = (t == nt - 2);
            const char* a1 = cA + (size_t)(t + 1) * kstep;
            const char* a2 = last ? nA : cA + (size_t)(t + 2) * kstep; const char* b2 = last ? nB : cB + (size_t)(t + 2) * kstep;
            const char* a3 = a2 + kstep; const char* b3 = b2 + kstep;
            if constexpr (Epi::HAS_MID) { if (t == nt / 2) E.mid(acc, cur, wr, wc, fr, fq); }
            PG8_LDB(B0, 0, 0); PG8_SCHED; PG8_LDA(At, 0, 0); PG8_STAGE(PG8_SA(1, 1), a1 + hstep, voffA);
            PG8_WAIT_L(8); PG8_BAR; PG8_WAIT_L(0); PG8_MMA(0, 0, At, B0); PG8_BAR; PG8_SCHED;
            PG8_LDB(B1, 0, 1); PG8_STAGE(PG8_SB(0, 0), b2, voffB);
            PG8_BAR; PG8_WAIT_L(0); PG8_MMA(0, 1, At, B1); PG8_BAR;
            PG8_LDA(At, 0, 1); PG8_STAGE(PG8_SA(0, 0), a2, voffA);
            PG8_BAR; PG8_WAIT_L(0); PG8_MMA(1, 0, At, B0); PG8_BAR; PG8_SCHED;
            PG8_STAGE(PG8_SB(0, 1), b2 + hstepB, voffB);
            PG8_WAIT_V(6); PG8_BAR; PG8_MMA(1, 1, At, B1); PG8_BAR;
            PG8_LDB(B0, 1, 0); PG8_SCHED; PG8_LDA(At, 1, 0); PG8_STAGE(PG8_SA(0, 1), a2 + hstep, voffA);
            PG8_WAIT_L(8); PG8_BAR; PG8_WAIT_L(0); PG8_MMA(0, 0, At, B0); PG8_BAR; PG8_SCHED;
            PG8_LDB(B1, 1, 1); PG8_STAGE(PG8_SB(1, 0), b3, voffB);
            PG8_BAR; PG8_WAIT_L(0); PG8_MMA(0, 1, At, B1); PG8_BAR;
            PG8_LDA(At, 1, 1); PG8_STAGE(PG8_SA(1, 0), a3, voffA);
            PG8_BAR; PG8_WAIT_L(0); PG8_MMA(1, 0, At, B0); PG8_BAR; PG8_SCHED;
            PG8_STAGE(PG8_SB(1, 1), b3 + hstepB, voffB);
            PG8_WAIT_V(6); PG8_BAR; PG8_MMA(1, 1, At, B1); PG8_BAR;
        }
        E(acc, cur, wr, wc, fr, fq);
        if (!has_next) break;
#pragma unroll
        for (int a = 0; a < 2; ++a)
#pragma unroll
            for (int b = 0; b < 2; ++b)
#pragma unroll
                for (int m = 0; m < 4; ++m)
#pragma unroll
                    for (int n = 0; n < 2; ++n) acc[a][b][m][n] = (f32x4){0.f, 0.f, 0.f, 0.f};
        cur = nxt; cA = nA; cB = nB; ++ui;
    }
    PG8_WAIT_V(0);
    if (wr == 0) PG8_BAR;
    PG8_BAR;
#undef PG8_SA
#undef PG8_SB
#undef PG8_STAGE
#undef PG8_LDA
#undef PG8_LDB
#undef PG8_MMA
#undef PG8_WAIT_V
#undef PG8_WAIT_L
#undef PG8_BAR
#undef PG8_SCHED
}
}
using pg8::Unit; using pg8::Gemm;

__device__ __forceinline__ void line_pair(u32x4& a, u32x4& b, bool lo) {
#pragma unroll
    for (int q = 0; q < 4; ++q) {
        const unsigned send = lo ? b[q] : a[q];
        const unsigned recv = (unsigned)__builtin_amdgcn_update_dpp(0, (int)send, 0x128  , 0xf, 0xf, false);
        if (lo) b[q] = recv; else a[q] = recv;
    }
}
struct EpiBf16 {
    static constexpr bool PERM = true, HAS_MID = false, LINE = true;
    bf16_t* O; int ldc; const float* ss; int sig_from; const float* rope; int rope_below; int qkv_tiles; bf16_t* gates;
    __device__ __forceinline__ bf16_t* addr(int row, int col, int pn) const {
        if (qkv_tiles > 0) {
            if (pn < qkv_tiles) return O + (size_t)(col >> 9) * ((size_t)T * 512) + ((size_t)((row >> 11) * 8 + ((col >> 6) & 7)) * SEQ + (row & (SEQ - 1))) * 64 + (col & 63);
            return gates + (size_t)row * 2048 + (col - 256 * qkv_tiles);
        }
        return O + (size_t)row * ldc + col;
    }
    __device__ __forceinline__ void operator()(const f32x4 (&acc)[2][2][4][2], const Unit& u, int wr, int wc, int fr, int fq) const {
        const int row0 = u.pm * 256 + wr * 64 + fr, col0 = u.pn * 256 + wc * 64 + 8 * fq;
        const bool sig = u.pn >= sig_from, lo = fr < 8;
        float rs8[8];
        if (ss) rstd_rows8(ss, row0, rs8);
        else {
#pragma unroll
            for (int k = 0; k < 8; ++k) rs8[k] = 1.f; }
#pragma unroll
        for (int ai = 0; ai < 2; ++ai)
#pragma unroll
            for (int m = 0; m < 4; ++m) {
                const int row = row0 + ai * 128 + m * 16;
                const float rs = rs8[ai * 4 + m];
                u32x4 o[2];
#pragma unroll
                for (int bj = 0; bj < 2; ++bj) {
                    f32x4 v0 = acc[ai][bj][m][0] * rs, v1 = acc[ai][bj][m][1] * rs;
                    if (sig) {
#pragma unroll
                        for (int j = 0; j < 4; ++j) { v0[j] = sigmoidf_(v0[j]); v1[j] = sigmoidf_(v1[j]); }
                    }
                    if (bj == 0 && u.pn < rope_below) {
                        f32x4 p0, p1;
#pragma unroll
                        for (int j = 0; j < 4; ++j) { p0[j] = __shfl_xor(v0[j], 16); p1[j] = __shfl_xor(v1[j], 16); }
                        if (fq < 2) {
                            const f32x4 c0 = *(const f32x4*)(rope + (size_t)row * 16), c1 = *(const f32x4*)(rope + (size_t)row * 16 + 4);
                            f32x4 s0 = *(const f32x4*)(rope + (size_t)row * 16 + 8), s1 = *(const f32x4*)(rope + (size_t)row * 16 + 12);
                            if (fq == 0) { s0 = -s0; s1 = -s1; }
                            v0 = v0 * c0 + p0 * s0; v1 = v1 * c1 + p1 * s1;
                        }
                    }
                    o[bj][0] = pk_bf16(v0[0], v0[1]); o[bj][1] = pk_bf16(v0[2], v0[3]); o[bj][2] = pk_bf16(v1[0], v1[1]); o[bj][3] = pk_bf16(v1[2], v1[3]);
                }
                line_pair(o[0], o[1], lo);
                const int colx = col0 + (lo ? 0 : 32);
                *(u32x4*)addr(lo ? row : row - 8, colx, u.pn) = o[0];
                *(u32x4*)addr(lo ? row + 8 : row, colx, u.pn) = o[1];
            }
    }
};
struct EpiGate {
    static constexpr bool PERM = true, HAS_MID = true, LINE = true;
    const bf16_t* gates; bf16_t* O;
    __device__ __forceinline__ void mid(f32x4 (&acc)[2][2][4][2], const Unit& u, int wr, int wc, int fr, int fq) const {
        int row0 = u.pm * 256 + wr * 64 + fr, col0 = u.pn * 256 + wc * 64 + 8 * fq;
        asm volatile("" : "+v"(row0), "+v"(col0));
        u32x4 ga[2][2], gb[2][2];
        { const bf16_t* gp = gates + (size_t)row0 * 2048 + col0;
          ga[0][0] = *(const u32x4*)gp; gb[0][0] = *(const u32x4*)(gp + 1024); ga[0][1] = *(const u32x4*)(gp + 32); gb[0][1] = *(const u32x4*)(gp + 1024 + 32); }
#pragma unroll
        for (int g = 0; g < 8; ++g) {
            const int ai = g >> 2, m = g & 3, cb = g & 1, nb = cb ^ 1;
            if (g + 1 < 8) { const int row = row0 + ((g + 1) >> 2) * 128 + ((g + 1) & 3) * 16; const bf16_t* gp = gates + (size_t)row * 2048 + col0;
                ga[nb][0] = *(const u32x4*)gp; gb[nb][0] = *(const u32x4*)(gp + 1024); ga[nb][1] = *(const u32x4*)(gp + 32); gb[nb][1] = *(const u32x4*)(gp + 1024 + 32); }
#pragma unroll
            for (int bj = 0; bj < 2; ++bj)
#pragma unroll
                for (int q = 0; q < 4; ++q) {
                    const float a0 = bflo(ga[cb][bj][q]), a1 = bfhi(ga[cb][bj][q]), b0 = fmaxf(bflo(gb[cb][bj][q]), -60.f), b1 = fmaxf(bfhi(gb[cb][bj][q]), -60.f);
                    const float r0 = (1.f + __expf(-b0)) * __builtin_amdgcn_rcpf(1.f + __expf(-a0)), r1 = (1.f + __expf(-b1)) * __builtin_amdgcn_rcpf(1.f + __expf(-a1));
                    acc[ai][bj][m][q >> 1][(q & 1) * 2] *= r0; acc[ai][bj][m][q >> 1][(q & 1) * 2 + 1] *= r1;
                }
            __builtin_amdgcn_sched_barrier(0);
        }
    }
    __device__ __forceinline__ void operator()(const f32x4 (&acc)[2][2][4][2], const Unit& u, int wr, int wc, int fr, int fq) const {
        const int row0 = u.pm * 256 + wr * 64 + fr, col0 = u.pn * 256 + wc * 64 + 8 * fq; const bool lo = fr < 8;
#pragma unroll
        for (int ai = 0; ai < 2; ++ai)
#pragma unroll
            for (int m = 0; m < 4; ++m) {
                const int row = row0 + ai * 128 + m * 16;
                u32x4 oo[2];
#pragma unroll
                for (int bj = 0; bj < 2; ++bj) {
                    const int col = col0 + bj * 32;
                    const u32x4 gb = *(const u32x4*)(gates + (size_t)row * 2048 + 1024 + col);
                    float r[8];
#pragma unroll
                    for (int q = 0; q < 4; ++q) {
                        const float b0 = fmaxf(bflo(gb[q]), -60.f), b1 = fmaxf(bfhi(gb[q]), -60.f);
                        r[2 * q] = acc[ai][bj][m][q >> 1][(q & 1) * 2] * __builtin_amdgcn_rcpf(1.f + __expf(-b0));
                        r[2 * q + 1] = acc[ai][bj][m][q >> 1][(q & 1) * 2 + 1] * __builtin_amdgcn_rcpf(1.f + __expf(-b1));
                    }
                    oo[bj][0] = pk_bf16(r[0], r[1]); oo[bj][1] = pk_bf16(r[2], r[3]); oo[bj][2] = pk_bf16(r[4], r[5]); oo[bj][3] = pk_bf16(r[6], r[7]);
                }
                line_pair(oo[0], oo[1], lo);
                const int colx = col0 + (lo ? 0 : 32);
                *(u32x4*)(O + (size_t)(lo ? row : row - 8) * DM + colx) = oo[0];
                *(u32x4*)(O + (size_t)(lo ? row + 8 : row) * DM + colx) = oo[1];
            }
    }
};
struct EpiRes {
    static constexpr bool PERM = true, HAS_MID = false, LINE = true;
    const float* R; const bf16_t* Rb; float* H; bf16_t* Hb; float* SS;
    __device__ __forceinline__ void operator()(const f32x4 (&acc)[2][2][4][2], const Unit& u, int wr, int wc, int fr, int fq) const {
        const int row0 = u.pm * 256 + wr * 64 + fr, col0 = u.pn * 256 + wc * 64 + 8 * fq; const bool lo = fr < 8;
        u32x4 rbv[2][2];
        if (!R) { rbv[0][0] = *(const u32x4*)(Rb + (size_t)row0 * DM + col0); rbv[0][1] = *(const u32x4*)(Rb + (size_t)row0 * DM + col0 + 32); }
#pragma unroll
        for (int g = 0; g < 8; ++g) {
            {
                const int ai = g >> 2, m = g & 3, cb = g & 1, nb = cb ^ 1;
                const int row = row0 + ai * 128 + m * 16;
                if (!R && g + 1 < 8) { const int rown = row0 + ((g + 1) >> 2) * 128 + ((g + 1) & 3) * 16;
                    rbv[nb][0] = *(const u32x4*)(Rb + (size_t)rown * DM + col0); rbv[nb][1] = *(const u32x4*)(Rb + (size_t)rown * DM + col0 + 32); }
                float s = 0.f; u32x4 ob[2];
#pragma unroll
                for (int bj = 0; bj < 2; ++bj) {
                    const int col = col0 + bj * 32;
                    f32x4 r0, r1;
                    if (R) { r0 = *(const f32x4*)(R + (size_t)row * DM + col); r1 = *(const f32x4*)(R + (size_t)row * DM + col + 4); }
                    else { const u32x4 rb = rbv[cb][bj];
                        r0[0] = bflo(rb[0]); r0[1] = bfhi(rb[0]); r0[2] = bflo(rb[1]); r0[3] = bfhi(rb[1]); r1[0] = bflo(rb[2]); r1[1] = bfhi(rb[2]); r1[2] = bflo(rb[3]); r1[3] = bfhi(rb[3]); }
                    const f32x4 h0 = r0 + acc[ai][bj][m][0], h1 = r1 + acc[ai][bj][m][1];
                    if (H) { *(f32x4*)(H + (size_t)row * DM + col) = h0; *(f32x4*)(H + (size_t)row * DM + col + 4) = h1; }
                    ob[bj][0] = pk_bf16(h0[0], h0[1]); ob[bj][1] = pk_bf16(h0[2], h0[3]); ob[bj][2] = pk_bf16(h1[0], h1[1]); ob[bj][3] = pk_bf16(h1[2], h1[3]);
                    s += ((h0[0] * h0[0] + h0[1] * h0[1]) + (h0[2] * h0[2] + h0[3] * h0[3])) + ((h1[0] * h1[0] + h1[1] * h1[1]) + (h1[2] * h1[2] + h1[3] * h1[3]));
                }
                if (Hb) { line_pair(ob[0], ob[1], lo); const int colx = col0 + (lo ? 0 : 32);
                    *(u32x4*)(Hb + (size_t)(lo ? row : row - 8) * DM + colx) = ob[0]; *(u32x4*)(Hb + (size_t)(lo ? row + 8 : row) * DM + colx) = ob[1]; }
                s += __shfl_xor(s, 16); s += __shfl_xor(s, 32);
                if (fq == 0) SS[(size_t)row * 16 + u.pn * 4 + wc] = s;
            }
        }
    }
};
struct EpiSwiGLU {
    static constexpr bool PERM = true, HAS_MID = false, LINE = false;
    bf16_t* O; const float* ss;
    __device__ __forceinline__ void operator()(const f32x4 (&acc)[2][2][4][2], const Unit& u, int wr, int wc, int fr, int fq) const {
        const int row0 = u.pm * 256 + wr * 64 + fr, col0 = u.pn * 128 + wc * 32 + 8 * fq;
        float rs8[8]; rstd_rows8(ss, row0, rs8);
#pragma unroll
        for (int ai = 0; ai < 2; ++ai)
#pragma unroll
            for (int m = 0; m < 4; ++m) {
                const int row = row0 + ai * 128 + m * 16;
                const float rs = rs8[ai * 4 + m];
                float r[8];
#pragma unroll
                for (int n = 0; n < 2; ++n)
#pragma unroll
                    for (int j = 0; j < 4; ++j) { const float gg = acc[ai][0][m][n][j] * rs, uu = acc[ai][1][m][n][j] * rs; r[n * 4 + j] = gg * sigmoidf_(gg) * uu; }
                u32x4 o; o[0] = pk_bf16(r[0], r[1]); o[1] = pk_bf16(r[2], r[3]); o[2] = pk_bf16(r[4], r[5]); o[3] = pk_bf16(r[6], r[7]);
                *(u32x4*)(O + (size_t)row * DFF + col0) = o;
            }
    }
};

struct Ctx { int tid, lane, wave, gw, ngw, gt, ngt; };

__device__ __forceinline__ void p_transpose(const Ctx& c, LAS unsigned char* lds, const float* W, bf16_t* Wt, int K, int N, const float* g, int mode, int& cursor, int ldw = 0, int koff = 0) {
    if (ldw == 0) ldw = K;
    LAS float* scr = (LAS float*)(lds + c.wave * 8704);
    const int nblk = N / 32, nitems = (K / 64) * nblk, lane = c.lane;
    int first = (c.gw - cursor % c.ngw + c.ngw) % c.ngw;
    for (int it = first; it < nitems; it += c.ngw) {
        const int kb = it / nblk, nb = it % nblk, k0 = 64 * kb, n0 = 32 * nb;
#pragma unroll 8
        for (int i = 0; i < 32; ++i) { const int kk = 2 * i + (lane >> 5); float v = W[(size_t)(k0 + kk) * N + n0 + (lane & 31)]; if (g) v *= g[k0 + kk]; scr[kk * 33 + (lane & 31)] = v; }
        asm volatile("s_waitcnt lgkmcnt(0)" ::: "memory");
        const int ch = lane & 7;
#pragma unroll
        for (int j = 0; j < 4; ++j) { const int n = (lane >> 3) + 8 * j; const LAS float* sp = scr + (8 * ch) * 33 + n;
            u32x4 o; o[0] = pk_bf16(sp[0], sp[33]); o[1] = pk_bf16(sp[2 * 33], sp[3 * 33]); o[2] = pk_bf16(sp[4 * 33], sp[5 * 33]); o[3] = pk_bf16(sp[6 * 33], sp[7 * 33]);
            const int nn = n0 + n, row = mode == 0 ? nn : (256 * (nn >> 7) + (nn & 127) + (mode == 2 ? 128 : 0));
            *(u32x4*)(Wt + (size_t)row * ldw + koff + k0 + 8 * ch) = o; }
        asm volatile("s_waitcnt lgkmcnt(0)" ::: "memory");
    }
    cursor += nitems;
}
__device__ __forceinline__ void p_rmsnorm_rows(const Ctx& c, const float* x, const float* g, bf16_t* out, int rows) {
    f32x4 gg[4];
#pragma unroll
    for (int j = 0; j < 4; ++j) gg[j] = ((const f32x4*)g)[c.lane + 64 * j];
    for (int r0 = c.gw; r0 < rows; r0 += 2 * c.ngw) {
        const int r1 = r0 + c.ngw; const bool has1 = r1 < rows; const int r1c = has1 ? r1 : r0;
        const f32x4* xa = (const f32x4*)(x + (size_t)r0 * DM) + c.lane; const f32x4* xb = (const f32x4*)(x + (size_t)r1c * DM) + c.lane;
        f32x4 va[4], vb[4]; float sa = 0.f, sb = 0.f;
#pragma unroll
        for (int j = 0; j < 4; ++j) { va[j] = xa[64 * j]; vb[j] = xb[64 * j]; }
#pragma unroll
        for (int j = 0; j < 4; ++j) { sa += (va[j][0] * va[j][0] + va[j][1] * va[j][1]) + (va[j][2] * va[j][2] + va[j][3] * va[j][3]); sb += (vb[j][0] * vb[j][0] + vb[j][1] * vb[j][1]) + (vb[j][2] * vb[j][2] + vb[j][3] * vb[j][3]); }
        const float ra = rsqrtf(wave_sum(sa) * (1.f / DM) + EPS), rb = rsqrtf(wave_sum(sb) * (1.f / DM) + EPS);
#pragma unroll
        for (int j = 0; j < 4; ++j) {
            u32x2 o; o[0] = pk_bf16(va[j][0] * ra * gg[j][0], va[j][1] * ra * gg[j][1]); o[1] = pk_bf16(va[j][2] * ra * gg[j][2], va[j][3] * ra * gg[j][3]);
            ((u32x2*)(out + (size_t)r0 * DM))[c.lane + 64 * j] = o;
            if (has1) { u32x2 q; q[0] = pk_bf16(vb[j][0] * rb * gg[j][0], vb[j][1] * rb * gg[j][1]); q[1] = pk_bf16(vb[j][2] * rb * gg[j][2], vb[j][3] * rb * gg[j][3]);
                ((u32x2*)(out + (size_t)r1 * DM))[c.lane + 64 * j] = q; }
        }
    }
}
__device__ __forceinline__ void p_rope_table(const Ctx& c, const int* pos, float* tab) {
    for (int i = c.gt; i < T * 8; i += c.ngt) {
        const int tok = i >> 3, f = i & 7;
        const double inv = f == 0 ? 1.0 : f == 1 ? 0.19392274474868576 : f == 2 ? 0.03760603093086393 : f == 3 ? 0.007292664737217109 : f == 4 ? 0.001414213562373095 :
                           f == 5 ? 0.0002742481756762073 : f == 6 ? 5.318295896944988e-05 : 1.031338537721246e-05;
        const double rev = (double)pos[tok] * inv * 0.15915494309189535;
        const float fr = (float)(rev - rint(rev));
        tab[(size_t)tok * 16 + f] = __builtin_amdgcn_cosf(fr);
        tab[(size_t)tok * 16 + 8 + f] = __builtin_amdgcn_sinf(fr);
    }
}
__device__ __forceinline__ void p_final(const Ctx& c, float* out, const float* ss, const float* g) {
    f32x4 gg[4];
#pragma unroll
    for (int j = 0; j < 4; ++j) gg[j] = ((const f32x4*)g)[c.lane + 64 * j];
    for (int r0 = c.gw; r0 < T; r0 += 2 * c.ngw) {
        const int r1 = r0 + c.ngw; const bool has1 = r1 < T; const int r1c = has1 ? r1 : r0;
        f32x4* xa = (f32x4*)(out + (size_t)r0 * DM) + c.lane; f32x4* xb = (f32x4*)(out + (size_t)r1c * DM) + c.lane;
        f32x4 va[4], vb[4];
#pragma unroll
        for (int j = 0; j < 4; ++j) { va[j] = xa[64 * j]; vb[j] = xb[64 * j]; }
        const float ra = rstd_of(ss, r0), rb = rstd_of(ss, r1c);
#pragma unroll
        for (int j = 0; j < 4; ++j) { xa[64 * j] = va[j] * ra * gg[j]; if (has1) xb[64 * j] = vb[j] * rb * gg[j]; }
    }
}

typedef float f32x16 __attribute__((ext_vector_type(16)));
typedef short s16x4 __attribute__((ext_vector_type(4)));
#define MFMA32(a, b, c) __builtin_amdgcn_mfma_f32_32x32x16_bf16((a), (b), (c), 0, 0, 0)
constexpr int ATT_FLAG_OFF = 40960;
#ifndef ATT_DUP_A
#define ATT_DUP_A 0
#endif
#ifndef ATT_DUP_B
#define ATT_DUP_B 0
#endif
template <int MODE, int HDIM, int KT>
__device__ __forceinline__ void attn_item(LAS unsigned char* lds, const bf16_t* Qp, int ldq, const bf16_t* Kp, const bf16_t* Vp, int ldkv, bf16_t* Op, int ldo, int q0, int nkeys) {
    constexpr int KS = HDIM / 16, DD = HDIM / 32, KROW = HDIM * 2 + 16, NCH = HDIM / 8, PER = KT * NCH / 512, NSUB = KT / 32;
    static_assert(2 * KT * KROW + 128 <= ATT_FLAG_OFF, "attention LDS tiles overlap the flag words");
    int tid = threadIdx.x; asm volatile("" : "+v"(tid));
    const int lane = tid & 63, w = __builtin_amdgcn_readfirstlane(tid >> 6), r = lane & 31, hh = lane >> 5;
    const int tq0 = q0 + 32 * w, tq = tq0 + r;
    LAS unsigned char* Ks = lds; LAS unsigned char* Vr = lds + KT * KROW;
    const int trq = (r & 15) >> 2, trp = r & 3, trb = r & 16;
    LAS unsigned* flags = (LAS unsigned*)(lds + ATT_FLAG_OFF);
    bf16x8 Qf[KS];
#pragma unroll
    for (int ks = 0; ks < KS; ++ks) Qf[ks] = *(const bf16x8*)(Qp + (size_t)tq * ldq + 16 * ks + 8 * hh);
    f32x16 Oacc[DD];
#pragma unroll
    for (int dd = 0; dd < DD; ++dd)
#pragma unroll
        for (int i = 0; i < 16; ++i) Oacc[dd][i] = 0.f;
    float m = -INFINITY, l = 0.f, run = (MODE == 1) ? 1.f : 0.f; unsigned done_w = 0u;
    float w8[8], u4[4], fgc[4], fmn[16], fbias = 0.f;
    if (MODE == 0) {
        const int cc = r & 15, e = cc & 3, f = cc >> 3; const bool act = (hh == ((cc >> 2) & 1)); const int c4 = r & 3;
#pragma unroll
        for (int i = 0; i < 8; ++i) { w8[i] = (act && (i & 3) == e && (i >> 2) == f) ? 1.f : 0.f; asm volatile("" : "+v"(w8[i])); }
        fbias = act ? 0.f : -INFINITY; asm volatile("" : "+v"(fbias));
#pragma unroll
        for (int j = 0; j < 4; ++j) { u4[j] = (j == c4) ? 1.f : 0.f; asm volatile("" : "+v"(u4[j])); }
#pragma unroll
        for (int g = 0; g < 4; ++g) { fgc[g] = (((r - 4 * hh - c4 - 8 * g) & 15) == 0) ? 2.f : 1.f; asm volatile("" : "+v"(fgc[g])); }
#pragma unroll
        for (int i = 0; i < 16; ++i) { const int dm = (r - 4 * hh - ((i & 3) + 8 * (i >> 2))) & 15; fmn[i] = 1.f + ((dm & 3) == 0 ? 1.f : 0.f) + (dm == 0 ? 1.f : 0.f); asm volatile("" : "+v"(fmn[i])); }
    }
    const int kt_hi = (MODE == 2) ? (nkeys / KT - 1) : ((q0 + 255) / KT);
    u32x4 kA[PER], vA[PER], kB[PER], vB[PER];
#define ATT_GLOAD(KR, VR, kt) do { _Pragma("unroll") for (int p_ = 0; p_ < PER; ++p_) { const int idx_ = tid + 512 * p_, key_ = idx_ / NCH, ch_ = idx_ % NCH; \
        KR[p_] = *(const u32x4*)(Kp + (size_t)(KT * (kt) + key_) * ldkv + ch_ * 8); VR[p_] = *(const u32x4*)(Vp + (size_t)(KT * (kt) + key_) * ldkv + ch_ * 8); } } while (0)
    auto stage = [&](const u32x4 (&KR)[PER], const u32x4 (&VR)[PER]) -> bool {
        if (MODE == 1 && lane == 0) flags[w] = done_w;
        __syncthreads();
#pragma unroll
        for (int p_ = 0; p_ < PER; ++p_) { const int idx_ = tid + 512 * p_, key_ = idx_ / NCH, ch_ = idx_ % NCH;
            *(LAS u32x4*)(Ks + key_ * KROW + ch_ * 16) = KR[p_];
            *(LAS u32x4*)(Vr + key_ * KROW + ch_ * 16) = VR[p_];
        }
        bool alldone = false;
        if (MODE == 1) { unsigned a = 1u;
#pragma unroll
            for (int i = 0; i < 8; ++i) a &= flags[i];
            alldone = a != 0u; }
        __syncthreads();
        return alldone;
    };
    auto qk = [&](int sub, f32x16& S) {
        bf16x8 kf[KS];
#pragma unroll
        for (int ks = 0; ks < KS; ++ks) kf[ks] = *(const LAS bf16x8*)(Ks + (32 * sub + r) * KROW + (16 * ks + 8 * hh) * 2);
#pragma unroll
        for (int i = 0; i < 16; ++i) S[i] = 0.f;
        __builtin_amdgcn_sched_barrier(0);
#pragma unroll
        for (int ks = 0; ks < KS; ++ks) S = MFMA32(kf[ks], Qf[ks], S);
    };
    auto compute = [&](int kt) {
        f32x16 Sn; bool an;
        { const int tkn = KT * kt + 32 * (NSUB - 1); an = !((MODE != 2 && tkn > tq0 + 31) || (MODE == 1 && done_w)); if (an) qk(NSUB - 1, Sn); }
#pragma unroll
        for (int sub = NSUB - 1; sub >= 0; --sub) {
            const int tk0 = KT * kt + 32 * sub;
            f32x16 S = Sn; const bool a = an;
            if (sub > 0) { const int tkn = tk0 - 32; an = !((MODE != 2 && tkn > tq0 + 31) || (MODE == 1 && done_w)); if (an) qk(sub - 1, Sn); }
            if (!a) continue;
            s16x4 vlo[DD][2], vhi[DD][2];
#pragma unroll
            for (int dd = 0; dd < DD; ++dd)
#pragma unroll
                for (int s2 = 0; s2 < 2; ++s2) {
                    LAS unsigned char* vp = Vr + (32 * sub + 16 * s2 + 4 * hh + trq) * KROW + (32 * dd + trb) * 2 + 8 * trp;
                    vlo[dd][s2] = __builtin_amdgcn_ds_read_tr16_b64_v4i16((LAS s16x4*)vp); vhi[dd][s2] = __builtin_amdgcn_ds_read_tr16_b64_v4i16((LAS s16x4*)(vp + 8 * KROW));
                }
            __builtin_amdgcn_sched_barrier(0);
            const int dbase = tq - tk0 - 4 * hh;
            const int D = tq0 - tk0;
            if (MODE == 0 || MODE == 2) {
                const float C = (MODE == 0 ? 0.125f : 0.08838834764831845f) * 1.4426950408889634f;
                float alpha, ls = 0.f, mn;
                if (MODE == 0 && D >= 544) {
                    float s1 = S[0] * w8[0], s2 = S[8] * w8[0];
#pragma unroll
                    for (int i = 1; i < 8; ++i) { s1 = fmaf(S[i], w8[i], s1); s2 = fmaf(S[8 + i], w8[i], s2); }
                    const float v1 = fmaf(s1, C, fbias), v2 = fmaf(s2, C, fbias);
                    float mx = fmaxf(v1, v2); mx = fmaxf(mx, __shfl_xor(mx, 32));
                    mn = fmaxf(m, mx);
                    alpha = __builtin_amdgcn_exp2f(m - mn);
                    const float p1 = __builtin_amdgcn_exp2f(v1 - mn), p2 = __builtin_amdgcn_exp2f(v2 - mn);
                    ls = p1 + p2;
#pragma unroll
                    for (int i = 0; i < 8; ++i) { S[i] = w8[i] * p1; S[8 + i] = w8[i] * p2; }
                } else if (MODE == 0 && D >= 160 && D <= 480) {
                    float vg[4]; float mx = -INFINITY;
#pragma unroll
                    for (int g = 0; g < 4; ++g) { vg[g] = (fmaf(S[4 * g + 3], u4[3], fmaf(S[4 * g + 2], u4[2], fmaf(S[4 * g + 1], u4[1], S[4 * g] * u4[0])))) * C; mx = fmaxf(mx, vg[g]); }
                    mx = fmaxf(mx, __shfl_xor(mx, 32));
                    mn = fmaxf(m, mx);
                    alpha = __builtin_amdgcn_exp2f(m - mn);
#pragma unroll
                    for (int g = 0; g < 4; ++g) { const float pg = fgc[g] * __builtin_amdgcn_exp2f(vg[g] - mn); ls += pg;
#pragma unroll
                        for (int j = 0; j < 4; ++j) S[4 * g + j] = u4[j] * pg; }
                } else if (MODE == 0 && D >= 32 && D <= 96) {
                    float mx = -INFINITY;
#pragma unroll
                    for (int i = 0; i < 16; ++i) { S[i] = S[i] * C; mx = fmaxf(mx, S[i]); }
                    mx = fmaxf(mx, __shfl_xor(mx, 32));
                    mn = fmaxf(m, mx);
                    alpha = __builtin_amdgcn_exp2f(m - mn);
#pragma unroll
                    for (int i = 0; i < 16; ++i) { const float p = fmn[i] * __builtin_amdgcn_exp2f(S[i] - mn); S[i] = p; ls += p; }
                } else {
                    float fm[16]; float mx = -INFINITY;
#pragma unroll
                    for (int i = 0; i < 16; ++i) {
                        float v = S[i] * C;
                        if (MODE == 0) { const int d = dbase - ((i & 3) + 8 * (i >> 2));
                            int mult = (d <= 128 ? 1 : 0) + ((((d & 3) == 0) && d <= 512) ? 1 : 0) + (((d & 15) == 0) ? 1 : 0);
                            mult = d >= 0 ? mult : 0; fm[i] = (float)mult; v = mult > 0 ? v : -INFINITY; }
                        else fm[i] = 1.f;
                        S[i] = v; mx = fmaxf(mx, v);
                    }
                    mx = fmaxf(mx, __shfl_xor(mx, 32));
                    mn = fmaxf(m, mx); const float ms = (mn == -INFINITY) ? 0.f : mn;
                    alpha = __builtin_amdgcn_exp2f(m - ms);
#pragma unroll
                    for (int i = 0; i < 16; ++i) { const float p = fm[i] * __builtin_amdgcn_exp2f(S[i] - ms); S[i] = p; ls += p; }
                }
                l = l * alpha + ls; m = mn;
                if (!__all(alpha == 1.f)) {
#pragma unroll
                    for (int dd = 0; dd < DD; ++dd) Oacc[dd] = Oacc[dd] * alpha;
                }
            } else {
                float om[16], ex[16], G[4], PG[4];
                if (D < 32) {
#pragma unroll
                    for (int i = 0; i < 16; ++i) { const int d = dbase - ((i & 3) + 8 * (i >> 2)); const bool valid = d > 0;
                        const float x = fminf(fmaxf(S[i] * (0.125f * 1.4426950408889634f), -115.f), 115.f); const float e = __builtin_amdgcn_exp2f(x); const float o1 = __builtin_amdgcn_rcpf(1.f + e);
                        om[i] = valid ? o1 : 1.f; S[i] = valid ? e * o1 : 0.f; }
                } else {
#pragma unroll
                    for (int i = 0; i < 16; ++i) {
                        const float x = fminf(fmaxf(S[i] * (0.125f * 1.4426950408889634f), -115.f), 115.f); const float e = __builtin_amdgcn_exp2f(x); const float o1 = __builtin_amdgcn_rcpf(1.f + e);
                        om[i] = o1; S[i] = e * o1; }
                }
#pragma unroll
                for (int g = 0; g < 4; ++g) { ex[4 * g + 3] = 1.f; ex[4 * g + 2] = om[4 * g + 3]; ex[4 * g + 1] = ex[4 * g + 2] * om[4 * g + 2]; ex[4 * g] = ex[4 * g + 1] * om[4 * g + 1]; G[g] = ex[4 * g] * om[4 * g]; }
#pragma unroll
                for (int g = 0; g < 4; ++g) PG[g] = __shfl_xor(G[g], 32);
                float suf = run;
#pragma unroll
                for (int g = 3; g >= 0; --g) { const float lat = suf * (hh == 0 ? PG[g] : 1.f);
                    S[4 * g + 3] = S[4 * g + 3] * lat; S[4 * g + 2] = S[4 * g + 2] * (lat * ex[4 * g + 2]); S[4 * g + 1] = S[4 * g + 1] * (lat * ex[4 * g + 1]); S[4 * g] = S[4 * g] * (lat * ex[4 * g]);
                    suf *= G[g] * PG[g]; }
                run = suf;
                done_w = __all(run < 1e-30f) ? 1u : 0u;
            }
            u32x4 pp0, pp1;
#pragma unroll
            for (int j = 0; j < 4; ++j) { pp0[j] = pk_bf16(S[2 * j], S[2 * j + 1]); pp1[j] = pk_bf16(S[8 + 2 * j], S[8 + 2 * j + 1]); }
            const bf16x8 P0 = __builtin_bit_cast(bf16x8, pp0), P1 = __builtin_bit_cast(bf16x8, pp1);
#pragma unroll
            for (int dd = 0; dd < DD; ++dd)
#pragma unroll
                for (int s2 = 0; s2 < 2; ++s2) {
                    const bf16x8 vf = __builtin_shufflevector(vlo[dd][s2], vhi[dd][s2], 0, 1, 2, 3, 4, 5, 6, 7);
                    Oacc[dd] = MFMA32(vf, s2 ? P1 : P0, Oacc[dd]);
                }
        }
    };
    ATT_GLOAD(kA, vA, kt_hi);
    if constexpr (MODE == 2) {
#pragma unroll 1
        for (int kt = kt_hi; kt >= 0; --kt) {
            stage(kA, vA);
            if (kt >= 1) ATT_GLOAD(kA, vA, kt - 1);
            compute(kt);
        }
    } else {
        if (kt_hi >= 1) ATT_GLOAD(kB, vB, kt_hi - 1);
#pragma unroll 1
        for (int kt = kt_hi; kt >= 0; kt -= 2) {
            if (stage(kA, vA)) break;
            if (kt >= 2) ATT_GLOAD(kA, vA, kt - 2);
            compute(kt);
            if (kt == 0) break;
            if (stage(kB, vB)) break;
            if (kt >= 3) ATT_GLOAD(kB, vB, kt - 3);
            compute(kt - 1);
        }
    }
#undef ATT_GLOAD
    float inv = 1.f;
    if (MODE != 1) { const float lt = l + __shfl_xor(l, 32); inv = 1.f / lt; }
#pragma unroll
    for (int dd = 0; dd < DD; ++dd)
#pragma unroll
        for (int g = 0; g < 4; g += 2) {
            unsigned a0 = pk_bf16(Oacc[dd][4 * g] * inv, Oacc[dd][4 * g + 1] * inv), a1 = pk_bf16(Oacc[dd][4 * g + 2] * inv, Oacc[dd][4 * g + 3] * inv);
            unsigned b0 = pk_bf16(Oacc[dd][4 * g + 4] * inv, Oacc[dd][4 * g + 5] * inv), b1 = pk_bf16(Oacc[dd][4 * g + 6] * inv, Oacc[dd][4 * g + 7] * inv);
            { auto x = __builtin_amdgcn_permlane32_swap(a0, b0, false, false); a0 = x[0]; b0 = x[1]; }
            { auto x = __builtin_amdgcn_permlane32_swap(a1, b1, false, false); a1 = x[0]; b1 = x[1]; }
            u32x4 o; o[0] = a0; o[1] = a1; o[2] = b0; o[3] = b1;
            *(u32x4*)(Op + (size_t)tq * ldo + 32 * dd + 8 * g + 8 * hh) = o;
        }
}
constexpr int WQ_WORD = 4096;
__device__ __forceinline__ void p_attn_ab(LAS unsigned char* lds, const bf16_t* qkv, bf16_t* OA, bf16_t* OB, unsigned* wq) {
    constexpr size_t TS = (size_t)T * 512;
    volatile LAS unsigned* slot = (volatile LAS unsigned*)(lds + ATT_FLAG_OFF + 64);
    for (;;) {
        if (threadIdx.x == 0) *slot = __hip_atomic_fetch_add(wq, 1u, __ATOMIC_RELAXED, __HIP_MEMORY_SCOPE_AGENT);
        __syncthreads();
        const unsigned it = (unsigned)__builtin_amdgcn_readfirstlane((int)*slot);
        __syncthreads();
        if (it >= 2048u) break;
        const int j = it & 1023, qb = 7 - (j >> 7), bh = j & 127, b = bh >> 3, h = bh & 7;
        const bf16_t* base = qkv + (size_t)bh * SEQ * 64;
        if (it < 1024u) attn_item<0, 64, 128>(lds, base, 64, base + TS, base + 2 * TS, 64, OA + (size_t)b * SEQ * 1024 + h * HD, 1024, qb * 256, SEQ);
        else attn_item<1, 64, 128>(lds, base + 3 * TS, 64, base + 4 * TS, base + 5 * TS, 64, OB + (size_t)b * SEQ * 1024 + h * HD, 1024, qb * 256, SEQ);
    }
}
__device__ __forceinline__ void p_attn_mem(LAS unsigned char* lds, const bf16_t* qm, const bf16_t* kvm, bf16_t* om) {
#pragma unroll 1
    for (int i = 0;; ++i) {
        Unit u; { pg8::StaticOrder S2; S2.init(T, MEMW, (int)gridDim.x, (int)blockIdx.x); if (!S2.next(i, u)) break; }
        const int b = u.pm >> 3, qb = u.pm & 7;
#pragma unroll 1
        for (int hq = 0; hq < 2; ++hq) { const int h = 2 * u.pn + hq;
            attn_item<2, 128, 64>(lds, qm + (size_t)b * SEQ * MEMW + h * 128, MEMW, kvm + (size_t)b * NMEM * 1024 + h * 128, kvm + (size_t)b * NMEM * 1024 + 512 + h * 128, 1024,
                                  om + (size_t)b * SEQ * MEMW + h * 128, MEMW, qb * 256, NMEM); }
    }
}

__device__ __forceinline__ bool sync_if(int k, cg::grid_group& grid, XcdBarrier& xb) {
    if (k == 1) { grid.sync(); xb = xcd_barrier_post(xb.bar, xb.st); }
    else if (k == 8) {
        asm volatile("s_waitcnt vmcnt(0)" ::: "memory");
        __syncthreads();
        if (threadIdx.x == 0) { __builtin_amdgcn_fence(__ATOMIC_ACQUIRE, "agent"); asm volatile("s_waitcnt vmcnt(0)" ::: "memory"); }
        __syncthreads();
    }
    else if (k > 1) xcd_barrier(xb);
    asm volatile("" ::: "memory"); return true; }
constexpr int NPHASE = 13;
#ifndef NAIVE_AB
#define NAIVE_AB 0
#endif
#ifndef NAIVE_MEM
#define NAIVE_MEM 0
#endif
#ifndef ONLY
#define ONLY -1
#endif
#ifndef DUP_MASK
#define DUP_MASK 0
#endif
#define PHASE(k) if ((ONLY < 0 || ONLY == (k)) && ph_lo <= (k) && (k) < ph_hi) if (sync_if((k), grid, xb)) for (int rep_ = 0; rep_ < (((DUP_MASK >> (k)) & 1) ? 2 : 1); ++rep_)
__global__ __launch_bounds__(512, 2) void mega(Params p, int ph_lo, int ph_hi) {
    extern __shared__ __attribute__((aligned(16))) unsigned char shm[];
    LAS unsigned char* lds = (LAS unsigned char*)shm;
    cg::grid_group grid = cg::this_grid();
    Ctx c; c.tid = threadIdx.x; c.lane = c.tid & 63; c.wave = c.tid >> 6; c.gw = blockIdx.x * 8 + c.wave; c.ngw = gridDim.x * 8; c.gt = blockIdx.x * 512 + c.tid; c.ngt = gridDim.x * 512;
    unsigned char* ws = p.ws;
    bf16_t* Wt_in = (bf16_t*)(ws + WS_WIN); bf16_t* Wt_upa = (bf16_t*)(ws + WS_WUPA); bf16_t* Wt_upb = (bf16_t*)(ws + WS_WUPB); bf16_t* Wt_out = (bf16_t*)(ws + WS_WOUT);
    bf16_t* Wt_qm = (bf16_t*)(ws + WS_WQM); bf16_t* Wt_kvm = (bf16_t*)(ws + WS_WKVM); bf16_t* Wt_om = (bf16_t*)(ws + WS_WOM); bf16_t* Wt_gu = (bf16_t*)(ws + WS_WGU); bf16_t* Wt_dn = (bf16_t*)(ws + WS_WDN);
    bf16_t* memn = (bf16_t*)(ws + WS_MEMN); bf16_t* kvm = (bf16_t*)(ws + WS_KVM);
    float* ss1 = (float*)(ws + WS_SS1); float* ss2 = (float*)(ws + WS_SS2); float* ss3 = (float*)(ws + WS_SS3); float* rope = (float*)(ws + WS_ROPE);
    bf16_t* n1 = (bf16_t*)(ws + WS_R1); bf16_t* mixed = (bf16_t*)(ws + WS_R1); bf16_t* h2b = (bf16_t*)(ws + WS_R1);
    bf16_t* proj = (bf16_t*)(ws + WS_PROJ); bf16_t* gates = (bf16_t*)(ws + WS_PROJ + 192 * MiB);
    float* h1 = (float*)(ws + WS_H1); bf16_t* h1b = (bf16_t*)(ws + WS_H1B); bf16_t* qm = (bf16_t*)(ws + WS_QM); bf16_t* om = (bf16_t*)(ws + WS_OM);
    float* h2 = (float*)(ws + WS_H2); bf16_t* act = (bf16_t*)(ws + WS_ACT); bf16_t* OA = (bf16_t*)(ws + WS_OA); bf16_t* OB = (bf16_t*)(ws + WS_OA) + 512;
    float* m1 = p.out; unsigned* bar = (unsigned*)(ws + WS_BAR);
    volatile LAS unsigned* xst = (volatile LAS unsigned*)(lds + pg8::STAGE_BYTES);
    if (c.tid == 0) { xst[0] = 0u; xst[1] = 0u; }
    __syncthreads();
    XcdBarrier xb; xb.bar = bar; xb.x = 0u; xb.st = xst;
    pg8::StaticOrder S;
    {
        PHASE(0) {
            int cur = 0;
            p_transpose(c, lds, p.w_in, Wt_in, DM, INC, nullptr, 0, cur);
            p_transpose(c, lds, p.w_ffn_gate, Wt_gu, DM, DFF, p.g_ffn, 1, cur);
            p_transpose(c, lds, p.w_ffn_up, Wt_gu, DM, DFF, p.g_ffn, 2, cur);
            p_transpose(c, lds, p.w_ffn_down, Wt_dn, DFF, DM, nullptr, 0, cur);
            p_transpose(c, lds, p.w_up_a, Wt_upa, 512, DM, nullptr, 0, cur, 1024, 0);
            p_transpose(c, lds, p.w_up_b, Wt_upa, 512, DM, nullptr, 0, cur, 1024, 512);
            p_transpose(c, lds, p.w_out, Wt_out, DM, DM, nullptr, 0, cur);
            p_transpose(c, lds, p.w_q_mem, Wt_qm, DM, MEMW, p.g_mem_q, 0, cur);
            p_transpose(c, lds, p.w_kv_mem, Wt_kvm, DM, 2 * MEMW, nullptr, 0, cur);
            p_transpose(c, lds, p.w_o_mem, Wt_om, MEMW, DM, nullptr, 0, cur);
            p_rmsnorm_rows(c, p.x, p.g_mix, n1, T);
            p_rmsnorm_rows(c, p.mem, p.g_mem_kv, memn, BATCH * NMEM);
            p_rope_table(c, p.pos, rope);
            if (blockIdx.x == 0) { for (int i = c.tid; i < XCD_BAR_WORDS; i += 512) bar[i] = 0u; if (c.tid == 0) bar[WQ_WORD] = 0u; }
        }
        PHASE(1) {
            Gemm g{n1, Wt_in, T, INC, DM}; EpiBf16 E{proj, INC, nullptr, 1 << 30, rope, 4, 12, gates};   S.init(g.M, g.N, gridDim.x, blockIdx.x); pg8::gemm_phase(lds, g, S, E);
        }
        PHASE(3) {
            { Gemm g{memn, Wt_kvm, BATCH * NMEM, 1024, DM}; EpiBf16 E{kvm, 1024, nullptr, 1 << 30, nullptr, 0, 0, nullptr}; S.init(g.M, g.N, gridDim.x, blockIdx.x); pg8::gemm_phase(lds, g, S, E); }
            p_attn_ab(lds, proj, OA, OB, bar + WQ_WORD);
        }
        PHASE(5) { Gemm g{OA, Wt_upa, T, DM, DM}; EpiGate E{gates, mixed}; S.init(g.M, g.N, gridDim.x, blockIdx.x); pg8::gemm_phase(lds, g, S, E); }
        PHASE(6) { Gemm g{mixed, Wt_out, T, DM, DM}; EpiRes E{p.x, nullptr, nullptr, h1b, ss1}; S.init(g.M, g.N, gridDim.x, blockIdx.x); pg8::gemm_phase(lds, g, S, E); }
        PHASE(7) { Gemm g{h1b, Wt_qm, T, MEMW, DM}; EpiBf16 E{qm, MEMW, ss1, 1 << 30, nullptr, 0, 0, nullptr}; S.init(g.M, g.N, gridDim.x, blockIdx.x); pg8::gemm_phase(lds, g, S, E); }
        PHASE(8) {
            p_attn_mem(lds, qm, kvm, om);
        }
        PHASE(9) { Gemm g{om, Wt_om, T, DM, MEMW}; EpiRes E{nullptr, h1b, nullptr, h2b, ss2}; S.init(g.M, g.N, gridDim.x, blockIdx.x); pg8::gemm_phase(lds, g, S, E); }
        PHASE(10) { Gemm g{h2b, Wt_gu, T, 2 * DFF, DM}; EpiSwiGLU E{act, ss2}; S.init(g.M, g.N, gridDim.x, blockIdx.x); pg8::gemm_phase(lds, g, S, E); }
        PHASE(11) { Gemm g{act, Wt_dn, T, DM, DFF}; EpiRes E{nullptr, h2b, p.out, nullptr, ss3}; S.init(g.M, g.N, gridDim.x, blockIdx.x); pg8::gemm_phase(lds, g, S, E); }
        PHASE(12) p_final(c, p.out, ss3, p.g_final);
    }
}

constexpr int LDS_BYTES = pg8::STAGE_BYTES + 16;
#ifndef ONE_LAUNCH
#define ONE_LAUNCH 1
#endif
extern "C" void kernel_launch(void* const* d_in, const int* in_sizes, int n_in, void* d_out, int out_size, void* d_ws, size_t ws_size, hipStream_t stream) {
    static int grid = 0;
    if (grid == 0) {
        if (n_in != 18 || out_size != T * DM || ws_size < WS_END) { fprintf(stderr, "kernel_launch: unexpected shapes (n_in %d out %d ws %zu)\n", n_in, out_size, ws_size); grid = -1; return; }
        int dev = 0, cus = 0, per_cu = 0;
        (void)hipGetDevice(&dev); (void)hipDeviceGetAttribute(&cus, hipDeviceAttributeMultiprocessorCount, dev);
        if (hipFuncSetAttribute((const void*)mega, hipFuncAttributeMaxDynamicSharedMemorySize, LDS_BYTES) != hipSuccess) { fprintf(stderr, "hipFuncSetAttribute failed\n"); grid = -1; return; }
        if (hipOccupancyMaxActiveBlocksPerMultiprocessor(&per_cu, (const void*)mega, 512, LDS_BYTES) != hipSuccess || per_cu < 1) { fprintf(stderr, "occupancy query: %d\n", per_cu); per_cu = 1; }
        (void)hipGetLastError();
        grid = cus * 1;
    }
    if (grid < 0) return;
    Params p{};
    p.x = (const float*)d_in[0]; p.mem = (const float*)d_in[1]; p.pos = (const int*)d_in[2]; p.g_mix = (const float*)d_in[3]; p.w_in = (const float*)d_in[4];
    p.w_up_a = (const float*)d_in[5]; p.w_up_b = (const float*)d_in[6]; p.w_out = (const float*)d_in[7]; p.g_mem_q = (const float*)d_in[8]; p.g_mem_kv = (const float*)d_in[9];
    p.w_q_mem = (const float*)d_in[10]; p.w_kv_mem = (const float*)d_in[11]; p.w_o_mem = (const float*)d_in[12]; p.g_ffn = (const float*)d_in[13];
    p.w_ffn_gate = (const float*)d_in[14]; p.w_ffn_up = (const float*)d_in[15]; p.w_ffn_down = (const float*)d_in[16]; p.g_final = (const float*)d_in[17];
    p.out = (float*)d_out; p.ws = (unsigned char*)d_ws;
#if ONE_LAUNCH
    int lo = 0, hi = NPHASE;
    void* args[] = {&p, &lo, &hi};
    hipError_t e = hipLaunchCooperativeKernel((const void*)mega, dim3(grid), dim3(512), args, LDS_BYTES, stream);
    if (e != hipSuccess) fprintf(stderr, "cooperative launch failed: %s\n", hipGetErrorString(e));
#else
    for (int ph = 0; ph < NPHASE; ++ph) hipLaunchKernelGGL(mega, dim3(grid), dim3(512), LDS_BYTES, stream, p, ph, ph + 1);
#endif
}
```

```cpp
#include <hip/hip_runtime.h>
#include <hip/hip_cooperative_groups.h>
#include <cstdio>
namespace cg = cooperative_groups;

#define LAS __attribute__((address_space(3)))
typedef unsigned short bf16_t;
typedef short bf16x8 __attribute__((ext_vector_type(8)));
typedef float f32x4 __attribute__((ext_vector_type(4)));
typedef unsigned u32x4 __attribute__((ext_vector_type(4)));
typedef unsigned u32x2 __attribute__((ext_vector_type(2)));

constexpr int BATCH = 16, SEQ = 2048, DM = 1024, T = BATCH * SEQ;
constexpr int HD = 64, NHA = 8, NHB = 8;
constexpr int INC = 5120;
constexpr int C_QA = 0, C_KA = 512, C_VA = 1024, C_QB = 1536, C_KB = 2048, C_VB = 2560, C_GA = 3072, C_GB = 4096;
constexpr int NMEM = 256, MEMW = 512, DFF = 2816;
constexpr float EPS = 1e-6f;

constexpr size_t MiB = 1ull << 20;
constexpr size_t WS_WIN = 0, WS_WUPA = 10 * MiB, WS_WUPB = 11 * MiB, WS_WOUT = 12 * MiB, WS_WQM = 14 * MiB, WS_WKVM = 15 * MiB,
                 WS_WOM = 17 * MiB, WS_WGU = 18 * MiB, WS_WDN = 29 * MiB, WS_MEMN = 36 * MiB, WS_KVM = 44 * MiB,
                 WS_SS1 = 52 * MiB, WS_SS2 = 54 * MiB, WS_SS3 = 56 * MiB, WS_ROPE = 58 * MiB, WS_BAR = 60 * MiB;
constexpr size_t WS_R1 = 64 * MiB;
constexpr size_t WS_PROJ = 128 * MiB;
constexpr size_t WS_H1 = 128 * MiB, WS_H1B = 256 * MiB, WS_QM = 320 * MiB, WS_OM = 352 * MiB, WS_H2 = 384 * MiB, WS_ACT = 128 * MiB;
constexpr size_t WS_OA = 448 * MiB, WS_OB = 480 * MiB;
constexpr size_t WS_END = 512 * MiB;

struct Params {
    const float* x; const float* mem; const int* pos; const float* g_mix; const float* w_in; const float* w_up_a; const float* w_up_b; const float* w_out;
    const float* g_mem_q; const float* g_mem_kv; const float* w_q_mem; const float* w_kv_mem; const float* w_o_mem; const float* g_ffn;
    const float* w_ffn_gate; const float* w_ffn_up; const float* w_ffn_down; const float* g_final;
    float* out; unsigned char* ws;
};

typedef float f32x2 __attribute__((ext_vector_type(2)));
typedef __bf16 bf16v2 __attribute__((ext_vector_type(2)));
__device__ __forceinline__ unsigned pk_bf16(float lo, float hi) { f32x2 v = {lo, hi}; bf16v2 r = __builtin_convertvector(v, bf16v2); return __builtin_bit_cast(unsigned, r); }
__device__ __forceinline__ bf16_t f2bf(float f) { return (bf16_t)(pk_bf16(f, 0.f) & 0xffffu); }
__device__ __forceinline__ float bf2f(bf16_t b) { return __uint_as_float(((unsigned)b) << 16); }
__device__ __forceinline__ float bflo(unsigned u) { return __uint_as_float(u << 16); }
__device__ __forceinline__ float bfhi(unsigned u) { return __uint_as_float(u & 0xffff0000u); }
__device__ __forceinline__ float wave_sum(float v) {
#pragma unroll
    for (int o = 1; o < 64; o <<= 1) v += __shfl_xor(v, o);
    return v;
}
__device__ __forceinline__ float sigmoidf_(float x) { return __builtin_amdgcn_rcpf(1.f + __builtin_amdgcn_exp2f(x * -1.4426950408889634f)); }
__device__ __forceinline__ float rstd_of(const float* ss, int row) {
    const f32x4* p = (const f32x4*)(ss + (size_t)row * 16);
    f32x4 a = p[0], b = p[1], c = p[2], d = p[3];
    float s = ((a[0] + a[1]) + (a[2] + a[3])) + ((b[0] + b[1]) + (b[2] + b[3])) + ((c[0] + c[1]) + (c[2] + c[3])) + ((d[0] + d[1]) + (d[2] + d[3]));
    return rsqrtf(s * (1.f / DM) + EPS);
}


__device__ __forceinline__ void rstd_rows8(const float* ss, int row0, float (&rs)[8]) {
#pragma unroll
    for (int h = 0; h < 4; ++h) {
        f32x4 t[2][4];
#pragma unroll
        for (int j = 0; j < 2; ++j) { const int k = 2 * h + j; const f32x4* p = (const f32x4*)(ss + (size_t)(row0 + (k >> 2) * 128 + (k & 3) * 16) * 16);
#pragma unroll
            for (int q = 0; q < 4; ++q) t[j][q] = p[q]; }
#pragma unroll
        for (int j = 0; j < 2; ++j) { const f32x4 v = (t[j][0] + t[j][1]) + (t[j][2] + t[j][3]); rs[2 * h + j] = rsqrtf(((v[0] + v[1]) + (v[2] + v[3])) * (1.f / DM) + EPS); }
        __builtin_amdgcn_sched_barrier(0);
    }
}

#define XB_TMO      128
#define XB_XCNT(j)  (256  + 64 * (j))
#define XB_XSUB(j)  (1280 + 64 * (j))
#define XB_XGEN(j)  (2304 + 64 * (j))
#define XB_TOP      3328
#define XB_TOPGEN   3392
#define XCD_BAR_WORDS 3456
#define XB_SPIN_CAP (1u << 18)
__device__ __forceinline__ unsigned xb_ld(unsigned* p)              { return __hip_atomic_load(p, __ATOMIC_RELAXED, __HIP_MEMORY_SCOPE_AGENT); }
__device__ __forceinline__ unsigned xb_add(unsigned* p, unsigned v) { return __hip_atomic_fetch_add(p, v, __ATOMIC_RELAXED, __HIP_MEMORY_SCOPE_AGENT); }
__device__ __forceinline__ unsigned xb_xcc_id() { return (unsigned)__builtin_amdgcn_s_getreg((3 << 11) | 20) & 0xFu; }
#define XB_SPIN(cond, bar) do { unsigned _sp = 0; while (cond) { __builtin_amdgcn_s_sleep(1); \
    if ((++_sp & 255u) == 0u) { if (xb_ld(&(bar)[XB_TMO])) break; if (_sp > XB_SPIN_CAP) { atomicAdd(&(bar)[XB_TMO], 1u); break; } } } } while (0)
struct XcdBarrier { unsigned* bar; unsigned x; volatile LAS unsigned* st; };
__device__ __forceinline__ XcdBarrier xcd_barrier_post(unsigned* bar, volatile LAS unsigned* st) {
    XcdBarrier b; b.bar = bar; b.x = xb_xcc_id(); b.st = st;
    if (threadIdx.x == 0) (void)xb_add(&bar[XB_XCNT(b.x)], 1u);
    return b;
}
__device__ __forceinline__ void xcd_barrier_complete(unsigned* bar, unsigned x, unsigned& nloc, unsigned& nx) {
    const unsigned G = gridDim.x * gridDim.y * gridDim.z;
    unsigned sum, cnt, mine, sp = 0u;
    for (;;) {
        sum = 0u; cnt = 0u; mine = 0u;
#pragma unroll
        for (unsigned j = 0; j < 16; ++j) { const unsigned c = xb_ld(&bar[XB_XCNT(j)]); sum += c; cnt += (c > 0u) ? 1u : 0u; mine = (j == x) ? c : mine; }
        if (sum == G) break;
        __builtin_amdgcn_s_sleep(1);
        if ((++sp & 255u) == 0u) { if (xb_ld(&bar[XB_TMO])) break; if (sp > XB_SPIN_CAP) { atomicAdd(&bar[XB_TMO], 1u); break; } }
    }
    nloc = mine > 0u ? mine : 1u; nx = cnt > 0u ? cnt : 1u;
}
__device__ __forceinline__ void xcd_barrier(const XcdBarrier& b) {
    asm volatile("s_waitcnt vmcnt(0)" ::: "memory");
    __syncthreads();
    if (threadIdx.x == 0) {
        unsigned* bar = b.bar;
        __builtin_amdgcn_s_waitcnt(0);
        unsigned nloc = b.st[0], nx = b.st[1];
        if (nloc == 0u) { xcd_barrier_complete(bar, b.x, nloc, nx); b.st[0] = nloc; b.st[1] = nx; }
        const unsigned old = xb_add(&bar[XB_XSUB(b.x)], 1u);
        const unsigned gen = old / nloc;
        if (old + 1u == (gen + 1u) * nloc) {
            __builtin_amdgcn_fence(__ATOMIC_RELEASE, "agent");
            asm volatile("s_waitcnt vmcnt(0)" ::: "memory");
            const unsigned og = xb_add(&bar[XB_TOP], 1u);
            const unsigned tg = og / nx;
            if (og + 1u == (tg + 1u) * nx) xb_add(&bar[XB_TOPGEN], 1u);
            else XB_SPIN(xb_ld(&bar[XB_TOPGEN]) == tg, bar);
            __builtin_amdgcn_fence(__ATOMIC_ACQUIRE, "agent");
            xb_add(&bar[XB_XGEN(b.x)], 1u);
            asm volatile("s_waitcnt vmcnt(0)" ::: "memory");
        } else {
            XB_SPIN(xb_ld(&bar[XB_XGEN(b.x)]) == gen, bar);
            __builtin_amdgcn_fence(__ATOMIC_ACQUIRE, "agent");
            asm volatile("s_waitcnt vmcnt(0)" ::: "memory");
        }
    }
    __syncthreads();
}

namespace pg8 {
constexpr int BM = 256, BK = 64, HALF = 128, HTB = HALF * BK * 2, STAGE_BYTES = 8 * HTB, NXCD = 8, WGM = 4;
__host__ __device__ __forceinline__ int lds_byte(int r, int c) { const int st = (r >> 4) * 2 + (c >> 5), rr = r & 15, cc = c & 31, ob = rr * 64 + cc * 2; return st * 1024 + (ob ^ (((ob >> 9) & 1) << 5)); }
__host__ __device__ __forceinline__ void stage_rc(int b, int& R, int& C) { const int st = b / 1024, sb = b % 1024, swz = sb ^ (((sb >> 9) & 1) << 5); R = (st >> 1) * 16 + swz / 64; C = (st & 1) * 32 + (swz % 64) / 2; }
__host__ __device__ __forceinline__ int perm32(int rho) { const int n = rho >> 4, i = rho & 15; return 8 * (i >> 2) + 4 * n + (i & 3); }
struct Unit { int pm, pn; };
struct Gemm { const bf16_t* A; const bf16_t* Bt; int M, N, K; };
struct StaticOrder {
    int nM, nN, nwg, G, c;
    __host__ __device__ void init(int M, int N, int G_, int c_) { nM = M / BM; nN = N / BM; nwg = nM * nN; G = G_; c = c_; }
    __host__ __device__ bool next(int i, Unit& u) const {
        const long L = (long)i * G + c; if (L >= nwg) return false;
        int wgid = (int)L; { const int q = nwg / NXCD, r = nwg % NXCD, xcd = wgid % NXCD, off = wgid / NXCD; wgid = (xcd < r ? xcd * (q + 1) : r * (q + 1) + (xcd - r) * q) + off; }
        const int nig = WGM * nN, gid = wgid / nig, fm = gid * WGM, gsz = (nM - fm) < WGM ? (nM - fm) : WGM;
        u.pm = fm + ((wgid % nig) % gsz); u.pn = (wgid % nig) / gsz; return true;
    }
};

template <class Epi>
__device__ __forceinline__ void gemm_phase(LAS unsigned char* lds, const Gemm g, const StaticOrder& S, const Epi& E) {
    int tid = threadIdx.x; asm volatile("" : "+v"(tid));
    const int wid = __builtin_amdgcn_readfirstlane(tid >> 6), lane = tid & 63, wr = wid >> 2, wc = wid & 3, fr = lane & 15, fq = lane >> 4;
    const int K = g.K, nt = K / BK;
    unsigned voffA[2], voffB[2];
#pragma unroll
    for (int i = 0; i < 2; ++i) { int R, C; stage_rc(tid * 16 + i * 8192, R, C); const int Rb = Epi::LINE ? ((R >> 5) * 64 + perm32(R & 31)) : (Epi::PERM ? ((R & ~31) + perm32(R & 31)) : R);
        voffA[i] = (unsigned)(R * K + C) * 2u; voffB[i] = (unsigned)(Rb * K + C) * 2u; }
    const size_t kstep = (size_t)(BK * 2);
    const size_t hstep = (size_t)HALF * K * 2;
    const size_t tstep = 2 * hstep;
    const size_t hstepB = Epi::LINE ? (size_t)32 * K * 2 : hstep;
    const unsigned ldsw = (unsigned)wid * 1024u;
    const int aoff = lds_byte(wr * 64 + fr, fq * 8), boff = lds_byte(wc * 32 + fr, fq * 8);
#define PG8_SA(b, h) (((b) * 2 + (h)) * HTB)
#define PG8_SB(b, h) ((4 + (b) * 2 + (h)) * HTB)
#define PG8_STAGE(bufoff, gbase, voff) do { _Pragma("unroll") for (int _i = 0; _i < 2; ++_i) \
        __builtin_amdgcn_global_load_lds((const unsigned*)((const char*)(gbase) + (voff)[_i]), (LAS unsigned*)(lds + (bufoff) + ldsw + _i * 8192), 16, 0, 0); } while (0)
#define PG8_LDA(dst, b, h) do { _Pragma("unroll") for (int m = 0; m < 4; ++m) _Pragma("unroll") for (int k = 0; k < 2; ++k) dst[m][k] = *(const LAS bf16x8*)(lds + PG8_SA(b, h) + aoff + m * 2048 + k * 1024); } while (0)
#define PG8_LDB(dst, b, h) do { _Pragma("unroll") for (int n = 0; n < 2; ++n) _Pragma("unroll") for (int k = 0; k < 2; ++k) dst[n][k] = *(const LAS bf16x8*)(lds + PG8_SB(b, h) + boff + n * 2048 + k * 1024); } while (0)
#define PG8_MMA(ai, bj, At, Bt) do { __builtin_amdgcn_s_setprio(1); _Pragma("unroll") for (int m = 0; m < 4; ++m) _Pragma("unroll") for (int n = 0; n < 2; ++n) _Pragma("unroll") for (int k = 0; k < 2; ++k) \
        acc[ai][bj][m][n] = __builtin_amdgcn_mfma_f32_16x16x32_bf16(Bt[n][k], At[m][k], acc[ai][bj][m][n], 0, 0, 0); __builtin_amdgcn_s_setprio(0); } while (0)
#define PG8_WAIT_V(n) asm volatile("s_waitcnt vmcnt(" #n ")" ::: "memory")
#define PG8_WAIT_L(n) asm volatile("s_waitcnt lgkmcnt(" #n ")" ::: "memory")
#define PG8_BAR __builtin_amdgcn_s_barrier()
#define PG8_SCHED __builtin_amdgcn_sched_barrier(0)
    Unit cur, nxt; int ui = 0;
    if (!S.next(0, cur)) return;
    f32x4 acc[2][2][4][2];
#pragma unroll
    for (int a = 0; a < 2; ++a)
#pragma unroll
        for (int b = 0; b < 2; ++b)
#pragma unroll
            for (int m = 0; m < 4; ++m)
#pragma unroll
                for (int n = 0; n < 2; ++n) acc[a][b][m][n] = (f32x4){0.f, 0.f, 0.f, 0.f};
    bf16x8 At[4][2], B0[2][2], B1[2][2];
    const char* cA = (const char*)g.A + (size_t)cur.pm * tstep; const char* cB = (const char*)g.Bt + (size_t)cur.pn * tstep;
    PG8_STAGE(PG8_SB(0, 0), cB, voffB); PG8_STAGE(PG8_SA(0, 0), cA, voffA); PG8_STAGE(PG8_SB(0, 1), cB + hstepB, voffB); PG8_STAGE(PG8_SA(0, 1), cA + hstep, voffA);
    if (wr == 1) PG8_BAR;
    PG8_WAIT_V(4); PG8_BAR;
    PG8_STAGE(PG8_SB(1, 0), cB + kstep, voffB); PG8_STAGE(PG8_SA(1, 0), cA + kstep, voffA); PG8_STAGE(PG8_SB(1, 1), cB + hstepB + kstep, voffB);
    PG8_WAIT_V(6); PG8_BAR;
    for (;;) {
        const bool has_next = S.next(ui + 1, nxt);
        const char* nA = has_next ? (const char*)g.A + (size_t)nxt.pm * tstep : cA; const char* nB = has_next ? (const char*)g.Bt + (size_t)nxt.pn * tstep : cB;
        for (int t = 0; t < nt; t += 2) {
            const bool last = (t == nt - 2);
            const char* a1 = cA + (size_t)(t + 1) * kstep;
            const char* a2 = last ? nA : cA + (size_t)(t + 2) * kstep; const char* b2 = last ? nB : cB + (size_t)(t + 2) * kstep;
            const char* a3 = a2 + kstep; const char* b3 = b2 + kstep;
            if constexpr (Epi::HAS_MID) { if (t == nt / 2) E.mid(acc, cur, wr, wc, fr, fq); }
            PG8_LDB(B0, 0, 0); PG8_SCHED; PG8_LDA(At, 0, 0); PG8_STAGE(PG8_SA(1, 1), a1 + hstep, voffA);
            PG8_WAIT_L(8); PG8_BAR; PG8_WAIT_L(0); PG8_MMA(0, 0, At, B0); PG8_BAR; PG8_SCHED;
            PG8_LDB(B1, 0, 1); PG8_STAGE(PG8_SB(0, 0), b2, voffB);
            PG8_BAR; PG8_WAIT_L(0); PG8_MMA(0, 1, At, B1); PG8_BAR;
            PG8_LDA(At, 0, 1); PG8_STAGE(PG8_SA(0, 0), a2, voffA);
            PG8_BAR; PG8_WAIT_L(0); PG8_MMA(1, 0, At, B0); PG8_BAR; PG8_SCHED;
            PG8_STAGE(PG8_SB(0, 1), b2 + hstepB, voffB);
            PG8_WAIT_V(6); PG8_BAR; PG8_MMA(1, 1, At, B1); PG8_BAR;
            PG8_LDB(B0, 1, 0); PG8_SCHED; PG8_LDA(At, 1, 0); PG8_STAGE(PG8_SA(0, 1), a2 + hstep, voffA);
            PG8_WAIT_L(8); PG8_BAR; PG8_WAIT_L(0); PG8_MMA(0, 0, At, B0); PG8_BAR; PG8_SCHED;
            PG8_LDB(B1, 1, 1); PG8_STAGE(PG8_SB(1, 0), b3, voffB);
            PG8_BAR; PG8_WAIT_L(0); PG8_MMA(0, 1, At, B1); PG8_BAR;
            PG8_LDA(At, 1, 1); PG8_STAGE(PG8_SA(1, 0), a3, voffA);
            PG8_BAR; PG8_WAIT_L(0); PG8_MMA(1, 0, At, B0); PG8_BAR; PG8_SCHED;
            PG8_STAGE(PG8_SB(1, 1), b3 + hstepB, voffB);
            PG8_WAIT_V(6); PG8_BAR; PG8_MMA(1, 1, At, B1); PG8_BAR;
        }
        E(acc, cur, wr, wc, fr, fq);
        if (!has_next) break;
#pragma unroll
        for (int a = 0; a < 2; ++a)
#pragma unroll
            for (int b = 0; b < 2; ++b)
#pragma unroll
                for (int m = 0; m < 4; ++m)
#pragma unroll
                    for (int n = 0; n < 2; ++n) acc[a][b][m][n] = (f32x4){0.f, 0.f, 0.f, 0.f};
        cur = nxt; cA = nA; cB = nB; ++ui;
    }
    PG8_WAIT_V(0);
    if (wr == 0) PG8_BAR;
    PG8_BAR;
#undef PG8_SA
#undef PG8_SB
#undef PG8_STAGE
#undef PG8_LDA
#undef PG8_LDB
#undef PG8_MMA
#undef PG8_WAIT_V
#undef PG8_WAIT_L
#undef PG8_BAR
#undef PG8_SCHED
}
}
using pg8::Unit; using pg8::Gemm;

__device__ __forceinline__ void line_pair(u32x4& a, u32x4& b, bool lo) {
#pragma unroll
    for (int q = 0; q < 4; ++q) {
        const unsigned send = lo ? b[q] : a[q];
        const unsigned recv = (unsigned)__builtin_amdgcn_update_dpp(0, (int)send, 0x128  , 0xf, 0xf, false);
        if (lo) b[q] = recv; else a[q] = recv;
    }
}
struct EpiBf16 {
    static constexpr bool PERM = true, HAS_MID = false, LINE = true;
    bf16_t* O; int ldc; const float* ss; int sig_from; const float* rope; int rope_below; int qkv_tiles; bf16_t* gates;
    __device__ __forceinline__ bf16_t* addr(int row, int col, int pn) const {
        if (qkv_tiles > 0) {
            if (pn < qkv_tiles) return O + (size_t)(col >> 9) * ((size_t)T * 512) + ((size_t)((row >> 11) * 8 + ((col >> 6) & 7)) * SEQ + (row & (SEQ - 1))) * 64 + (col & 63);
            return gates + (size_t)row * 2048 + (col - 256 * qkv_tiles);
        }
        return O + (size_t)row * ldc + col;
    }
    __device__ __forceinline__ void operator()(const f32x4 (&acc)[2][2][4][2], const Unit& u, int wr, int wc, int fr, int fq) const {
        const int row0 = u.pm * 256 + wr * 64 + fr, col0 = u.pn * 256 + wc * 64 + 8 * fq;
        const bool sig = u.pn >= sig_from, lo = fr < 8;
        float rs8[8];
        if (ss) rstd_rows8(ss, row0, rs8);
        else {
#pragma unroll
            for (int k = 0; k < 8; ++k) rs8[k] = 1.f; }
#pragma unroll
        for (int ai = 0; ai < 2; ++ai)
#pragma unroll
            for (int m = 0; m < 4; ++m) {
                const int row = row0 + ai * 128 + m * 16;
                const float rs = rs8[ai * 4 + m];
                u32x4 o[2];
#pragma unroll
                for (int bj = 0; bj < 2; ++bj) {
                    f32x4 v0 = acc[ai][bj][m][0] * rs, v1 = acc[ai][bj][m][1] * rs;
                    if (sig) {
#pragma unroll
                        for (int j = 0; j < 4; ++j) { v0[j] = sigmoidf_(v0[j]); v1[j] = sigmoidf_(v1[j]); }
                    }
                    if (bj == 0 && u.pn < rope_below) {
                        f32x4 p0, p1;
#pragma unroll
                        for (int j = 0; j < 4; ++j) { p0[j] = __shfl_xor(v0[j], 16); p1[j] = __shfl_xor(v1[j], 16); }
                        if (fq < 2) {
                            const f32x4 c0 = *(const f32x4*)(rope + (size_t)row * 16), c1 = *(const f32x4*)(rope + (size_t)row * 16 + 4);
                            f32x4 s0 = *(const f32x4*)(rope + (size_t)row * 16 + 8), s1 = *(const f32x4*)(rope + (size_t)row * 16 + 12);
                            if (fq == 0) { s0 = -s0; s1 = -s1; }
                            v0 = v0 * c0 + p0 * s0; v1 = v1 * c1 + p1 * s1;
                        }
                    }
                    o[bj][0] = pk_bf16(v0[0], v0[1]); o[bj][1] = pk_bf16(v0[2], v0[3]); o[bj][2] = pk_bf16(v1[0], v1[1]); o[bj][3] = pk_bf16(v1[2], v1[3]);
                }
                line_pair(o[0], o[1], lo);
                const int colx = col0 + (lo ? 0 : 32);
                *(u32x4*)addr(lo ? row : row - 8, colx, u.pn) = o[0];
                *(u32x4*)addr(lo ? row + 8 : row, colx, u.pn) = o[1];
            }
    }
};
struct EpiGate {
    static constexpr bool PERM = true, HAS_MID = true, LINE = true;
    const bf16_t* gates; bf16_t* O;
    __device__ __forceinline__ void mid(f32x4 (&acc)[2][2][4][2], const Unit& u, int wr, int wc, int fr, int fq) const {
        int row0 = u.pm * 256 + wr * 64 + fr, col0 = u.pn * 256 + wc * 64 + 8 * fq;
        asm volatile("" : "+v"(row0), "+v"(col0));
        u32x4 ga[2][2], gb[2][2];
        { const bf16_t* gp = gates + (size_t)row0 * 2048 + col0;
          ga[0][0] = *(const u32x4*)gp; gb[0][0] = *(const u32x4*)(gp + 1024); ga[0][1] = *(const u32x4*)(gp + 32); gb[0][1] = *(const u32x4*)(gp + 1024 + 32); }
#pragma unroll
        for (int g = 0; g < 8; ++g) {
            const int ai = g >> 2, m = g & 3, cb = g & 1, nb = cb ^ 1;
            if (g + 1 < 8) { const int row = row0 + ((g + 1) >> 2) * 128 + ((g + 1) & 3) * 16; const bf16_t* gp = gates + (size_t)row * 2048 + col0;
                ga[nb][0] = *(const u32x4*)gp; gb[nb][0] = *(const u32x4*)(gp + 1024); ga[nb][1] = *(const u32x4*)(gp + 32); gb[nb][1] = *(const u32x4*)(gp + 1024 + 32); }
#pragma unroll
            for (int bj = 0; bj < 2; ++bj)
#pragma unroll
                for (int q = 0; q < 4; ++q) {
                    const float a0 = bflo(ga[cb][bj][q]), a1 = bfhi(ga[cb][bj][q]), b0 = fmaxf(bflo(gb[cb][bj][q]), -60.f), b1 = fmaxf(bfhi(gb[cb][bj][q]), -60.f);
                    const float r0 = (1.f + __expf(-b0)) * __builtin_amdgcn_rcpf(1.f + __expf(-a0)), r1 = (1.f + __expf(-b1)) * __builtin_amdgcn_rcpf(1.f + __expf(-a1));
                    acc[ai][bj][m][q >> 1][(q & 1) * 2] *= r0; acc[ai][bj][m][q >> 1][(q & 1) * 2 + 1] *= r1;
                }
            __builtin_amdgcn_sched_barrier(0);
        }
    }
    __device__ __forceinline__ void operator()(const f32x4 (&acc)[2][2][4][2], const Unit& u, int wr, int wc, int fr, int fq) const {
        const int row0 = u.pm * 256 + wr * 64 + fr, col0 = u.pn * 256 + wc * 64 + 8 * fq; const bool lo = fr < 8;
        u32x4 gbv[2][2];
        { const bf16_t* gp = gates + (size_t)row0 * 2048 + 1024 + col0; gbv[0][0] = *(const u32x4*)gp; gbv[0][1] = *(const u32x4*)(gp + 32); }
#pragma unroll
        for (int g = 0; g < 8; ++g) {
            {
                const int ai = g >> 2, m = g & 3, cb = g & 1, nb = cb ^ 1;
                const int row = row0 + ai * 128 + m * 16;
                if (g + 1 < 8) { const bf16_t* gp = gates + (size_t)(row0 + ((g + 1) >> 2) * 128 + ((g + 1) & 3) * 16) * 2048 + 1024 + col0; gbv[nb][0] = *(const u32x4*)gp; gbv[nb][1] = *(const u32x4*)(gp + 32); }
                u32x4 oo[2];
#pragma unroll
                for (int bj = 0; bj < 2; ++bj) {
                    const u32x4 gb = gbv[cb][bj];
                    float r[8];
#pragma unroll
                    for (int q = 0; q < 4; ++q) {
                        const float b0 = fmaxf(bflo(gb[q]), -60.f), b1 = fmaxf(bfhi(gb[q]), -60.f);
                        r[2 * q] = acc[ai][bj][m][q >> 1][(q & 1) * 2] * __builtin_amdgcn_rcpf(1.f + __expf(-b0));
                        r[2 * q + 1] = acc[ai][bj][m][q >> 1][(q & 1) * 2 + 1] * __builtin_amdgcn_rcpf(1.f + __expf(-b1));
                    }
                    oo[bj][0] = pk_bf16(r[0], r[1]); oo[bj][1] = pk_bf16(r[2], r[3]); oo[bj][2] = pk_bf16(r[4], r[5]); oo[bj][3] = pk_bf16(r[6], r[7]);
                }
                line_pair(oo[0], oo[1], lo);
                const int colx = col0 + (lo ? 0 : 32);
                *(u32x4*)(O + (size_t)(lo ? row : row - 8) * DM + colx) = oo[0];
                *(u32x4*)(O + (size_t)(lo ? row + 8 : row) * DM + colx) = oo[1];
            }
        }
    }
};
struct EpiRes {
    static constexpr bool PERM = true, HAS_MID = false, LINE = true;
    const float* R; const bf16_t* Rb; float* H; bf16_t* Hb; float* SS;
    __device__ __forceinline__ void operator()(const f32x4 (&acc)[2][2][4][2], const Unit& u, int wr, int wc, int fr, int fq) const {
        const int row0 = u.pm * 256 + wr * 64 + fr, col0 = u.pn * 256 + wc * 64 + 8 * fq; const bool lo = fr < 8;
        u32x4 rbv[2][2]; f32x4 rfv[2][2][2];
        if (!R) { rbv[0][0] = *(const u32x4*)(Rb + (size_t)row0 * DM + col0); rbv[0][1] = *(const u32x4*)(Rb + (size_t)row0 * DM + col0 + 32); }
        else { const float* rp = R + (size_t)row0 * DM + col0; rfv[0][0][0] = *(const f32x4*)rp; rfv[0][0][1] = *(const f32x4*)(rp + 4); rfv[0][1][0] = *(const f32x4*)(rp + 32); rfv[0][1][1] = *(const f32x4*)(rp + 36); }
#pragma unroll
        for (int g = 0; g < 8; ++g) {
            {
                const int ai = g >> 2, m = g & 3, cb = g & 1, nb = cb ^ 1;
                const int row = row0 + ai * 128 + m * 16;
                if (g + 1 < 8) { const int rown = row0 + ((g + 1) >> 2) * 128 + ((g + 1) & 3) * 16;
                    if (!R) { rbv[nb][0] = *(const u32x4*)(Rb + (size_t)rown * DM + col0); rbv[nb][1] = *(const u32x4*)(Rb + (size_t)rown * DM + col0 + 32); }
                    else { const float* rp = R + (size_t)rown * DM + col0; rfv[nb][0][0] = *(const f32x4*)rp; rfv[nb][0][1] = *(const f32x4*)(rp + 4); rfv[nb][1][0] = *(const f32x4*)(rp + 32); rfv[nb][1][1] = *(const f32x4*)(rp + 36); } }
                float s = 0.f; u32x4 ob[2];
#pragma unroll
                for (int bj = 0; bj < 2; ++bj) {
                    const int col = col0 + bj * 32;
                    f32x4 r0, r1;
                    if (R) { r0 = rfv[cb][bj][0]; r1 = rfv[cb][bj][1]; }
                    else { const u32x4 rb = rbv[cb][bj];
                        r0[0] = bflo(rb[0]); r0[1] = bfhi(rb[0]); r0[2] = bflo(rb[1]); r0[3] = bfhi(rb[1]); r1[0] = bflo(rb[2]); r1[1] = bfhi(rb[2]); r1[2] = bflo(rb[3]); r1[3] = bfhi(rb[3]); }
                    const f32x4 h0 = r0 + acc[ai][bj][m][0], h1 = r1 + acc[ai][bj][m][1];
                    if (H) { *(f32x4*)(H + (size_t)row * DM + col) = h0; *(f32x4*)(H + (size_t)row * DM + col + 4) = h1; }
                    ob[bj][0] = pk_bf16(h0[0], h0[1]); ob[bj][1] = pk_bf16(h0[2], h0[3]); ob[bj][2] = pk_bf16(h1[0], h1[1]); ob[bj][3] = pk_bf16(h1[2], h1[3]);
                    s += ((h0[0] * h0[0] + h0[1] * h0[1]) + (h0[2] * h0[2] + h0[3] * h0[3])) + ((h1[0] * h1[0] + h1[1] * h1[1]) + (h1[2] * h1[2] + h1[3] * h1[3]));
                }
                if (Hb) { line_pair(ob[0], ob[1], lo); const int colx = col0 + (lo ? 0 : 32);
                    *(u32x4*)(Hb + (size_t)(lo ? row : row - 8) * DM + colx) = ob[0]; *(u32x4*)(Hb + (size_t)(lo ? row + 8 : row) * DM + colx) = ob[1]; }
                s += __shfl_xor(s, 16); s += __shfl_xor(s, 32);
                if (fq == 0) SS[(size_t)row * 16 + u.pn * 4 + wc] = s;
            }
        }
    }
};
struct EpiSwiGLU {
    static constexpr bool PERM = true, HAS_MID = false, LINE = false;
    bf16_t* O; const float* ss;
    __device__ __forceinline__ void operator()(const f32x4 (&acc)[2][2][4][2], const Unit& u, int wr, int wc, int fr, int fq) const {
        const int row0 = u.pm * 256 + wr * 64 + fr, col0 = u.pn * 128 + wc * 32 + 8 * fq;
        float rs8[8]; rstd_rows8(ss, row0, rs8);
#pragma unroll
        for (int ai = 0; ai < 2; ++ai)
#pragma unroll
            for (int m = 0; m < 4; ++m) {
                const int row = row0 + ai * 128 + m * 16;
                const float rs = rs8[ai * 4 + m];
                float r[8];
#pragma unroll
                for (int n = 0; n < 2; ++n)
#pragma unroll
                    for (int j = 0; j < 4; ++j) { const float gg = acc[ai][0][m][n][j] * rs, uu = acc[ai][1][m][n][j] * rs; r[n * 4 + j] = gg * sigmoidf_(gg) * uu; }
                u32x4 o; o[0] = pk_bf16(r[0], r[1]); o[1] = pk_bf16(r[2], r[3]); o[2] = pk_bf16(r[4], r[5]); o[3] = pk_bf16(r[6], r[7]);
                *(u32x4*)(O + (size_t)row * DFF + col0) = o;
            }
    }
};

struct Ctx { int tid, lane, wave, gw, ngw, gt, ngt; };

__device__ __forceinline__ void p_transpose(const Ctx& c, LAS unsigned char* lds, const float* W, bf16_t* Wt, int K, int N, const float* g, int mode, int& cursor, int ldw = 0, int koff = 0) {
    if (ldw == 0) ldw = K;
    LAS float* scr = (LAS float*)(lds + c.wave * 8704);
    const int nblk = N / 32, nitems = (K / 64) * nblk, lane = c.lane;
    int first = (c.gw - cursor % c.ngw + c.ngw) % c.ngw;
    for (int it = first; it < nitems; it += c.ngw) {
        const int kb = it / nblk, nb = it % nblk, k0 = 64 * kb, n0 = 32 * nb;
#pragma unroll 8
        for (int i = 0; i < 32; ++i) { const int kk = 2 * i + (lane >> 5); float v = W[(size_t)(k0 + kk) * N + n0 + (lane & 31)]; if (g) v *= g[k0 + kk]; scr[kk * 33 + (lane & 31)] = v; }
        asm volatile("s_waitcnt lgkmcnt(0)" ::: "memory");
        const int ch = lane & 7;
#pragma unroll
        for (int j = 0; j < 4; ++j) { const int n = (lane >> 3) + 8 * j; const LAS float* sp = scr + (8 * ch) * 33 + n;
            u32x4 o; o[0] = pk_bf16(sp[0], sp[33]); o[1] = pk_bf16(sp[2 * 33], sp[3 * 33]); o[2] = pk_bf16(sp[4 * 33], sp[5 * 33]); o[3] = pk_bf16(sp[6 * 33], sp[7 * 33]);
            const int nn = n0 + n, row = mode == 0 ? nn : (256 * (nn >> 7) + (nn & 127) + (mode == 2 ? 128 : 0));
            *(u32x4*)(Wt + (size_t)row * ldw + koff + k0 + 8 * ch) = o; }
        asm volatile("s_waitcnt lgkmcnt(0)" ::: "memory");
    }
    cursor += nitems;
}
__device__ __forceinline__ void p_rmsnorm_rows(const Ctx& c, const float* x, const float* g, bf16_t* out, int rows) {
    f32x4 gg[4];
#pragma unroll
    for (int j = 0; j < 4; ++j) gg[j] = ((const f32x4*)g)[c.lane + 64 * j];
    for (int r0 = c.gw; r0 < rows; r0 += 2 * c.ngw) {
        const int r1 = r0 + c.ngw; const bool has1 = r1 < rows; const int r1c = has1 ? r1 : r0;
        const f32x4* xa = (const f32x4*)(x + (size_t)r0 * DM) + c.lane; const f32x4* xb = (const f32x4*)(x + (size_t)r1c * DM) + c.lane;
        f32x4 va[4], vb[4]; float sa = 0.f, sb = 0.f;
#pragma unroll
        for (int j = 0; j < 4; ++j) { va[j] = xa[64 * j]; vb[j] = xb[64 * j]; }
#pragma unroll
        for (int j = 0; j < 4; ++j) { sa += (va[j][0] * va[j][0] + va[j][1] * va[j][1]) + (va[j][2] * va[j][2] + va[j][3] * va[j][3]); sb += (vb[j][0] * vb[j][0] + vb[j][1] * vb[j][1]) + (vb[j][2] * vb[j][2] + vb[j][3] * vb[j][3]); }
        const float ra = rsqrtf(wave_sum(sa) * (1.f / DM) + EPS), rb = rsqrtf(wave_sum(sb) * (1.f / DM) + EPS);
#pragma unroll
        for (int j = 0; j < 4; ++j) {
            u32x2 o; o[0] = pk_bf16(va[j][0] * ra * gg[j][0], va[j][1] * ra * gg[j][1]); o[1] = pk_bf16(va[j][2] * ra * gg[j][2], va[j][3] * ra * gg[j][3]);
            ((u32x2*)(out + (size_t)r0 * DM))[c.lane + 64 * j] = o;
            if (has1) { u32x2 q; q[0] = pk_bf16(vb[j][0] * rb * gg[j][0], vb[j][1] * rb * gg[j][1]); q[1] = pk_bf16(vb[j][2] * rb * gg[j][2], vb[j][3] * rb * gg[j][3]);
                ((u32x2*)(out + (size_t)r1 * DM))[c.lane + 64 * j] = q; }
        }
    }
}
__device__ __forceinline__ void p_rope_table(const Ctx& c, const int* pos, float* tab) {
    for (int i = c.gt; i < T * 8; i += c.ngt) {
        const int tok = i >> 3, f = i & 7;
        const double inv = f == 0 ? 1.0 : f == 1 ? 0.19392274474868576 : f == 2 ? 0.03760603093086393 : f == 3 ? 0.007292664737217109 : f == 4 ? 0.001414213562373095 :
                           f == 5 ? 0.0002742481756762073 : f == 6 ? 5.318295896944988e-05 : 1.031338537721246e-05;
        const double rev = (double)pos[tok] * inv * 0.15915494309189535;
        const float fr = (float)(rev - rint(rev));
        tab[(size_t)tok * 16 + f] = __builtin_amdgcn_cosf(fr);
        tab[(size_t)tok * 16 + 8 + f] = __builtin_amdgcn_sinf(fr);
    }
}
__device__ __forceinline__ void p_final(const Ctx& c, float* out, const float* ss, const float* g) {
    f32x4 gg[4];
#pragma unroll
    for (int j = 0; j < 4; ++j) gg[j] = ((const f32x4*)g)[c.lane + 64 * j];
    for (int r0 = c.gw; r0 < T; r0 += 2 * c.ngw) {
        const int r1 = r0 + c.ngw; const bool has1 = r1 < T; const int r1c = has1 ? r1 : r0;
        f32x4* xa = (f32x4*)(out + (size_t)r0 * DM) + c.lane; f32x4* xb = (f32x4*)(out + (size_t)r1c * DM) + c.lane;
        f32x4 va[4], vb[4];
#pragma unroll
        for (int j = 0; j < 4; ++j) { va[j] = xa[64 * j]; vb[j] = xb[64 * j]; }
        const float ra = rstd_of(ss, r0), rb = rstd_of(ss, r1c);
#pragma unroll
        for (int j = 0; j < 4; ++j) { xa[64 * j] = va[j] * ra * gg[j]; if (has1) xb[64 * j] = vb[j] * rb * gg[j]; }
    }
}

typedef float f32x16 __attribute__((ext_vector_type(16)));
typedef short s16x4 __attribute__((ext_vector_type(4)));
#define MFMA32(a, b, c) __builtin_amdgcn_mfma_f32_32x32x16_bf16((a), (b), (c), 0, 0, 0)
constexpr int ATT_FLAG_OFF = 40960;
#ifndef ATT_DUP_A
#define ATT_DUP_A 0
#endif
#ifndef ATT_DUP_B
#define ATT_DUP_B 0
#endif
template <int MODE, int HDIM, int KT>
__device__ __forceinline__ void attn_item(LAS unsigned char* lds, const bf16_t* Qp, int ldq, const bf16_t* Kp, const bf16_t* Vp, int ldkv, bf16_t* Op, int ldo, int q0, int nkeys) {
    constexpr int KS = HDIM / 16, DD = HDIM / 32, KROW = HDIM * 2 + 16, NCH = HDIM / 8, PER = KT * NCH / 512, NSUB = KT / 32;
    static_assert(2 * KT * KROW + 128 <= ATT_FLAG_OFF, "attention LDS tiles overlap the flag words");
    int tid = threadIdx.x; asm volatile("" : "+v"(tid));
    const int lane = tid & 63, w = __builtin_amdgcn_readfirstlane(tid >> 6), r = lane & 31, hh = lane >> 5;
    const int tq0 = q0 + 32 * w, tq = tq0 + r;
    LAS unsigned char* Ks = lds; LAS unsigned char* Vr = lds + KT * KROW;
    const int trq = (r & 15) >> 2, trp = r & 3, trb = r & 16;
    LAS unsigned* flags = (LAS unsigned*)(lds + ATT_FLAG_OFF);
    bf16x8 Qf[KS];
#pragma unroll
    for (int ks = 0; ks < KS; ++ks) Qf[ks] = *(const bf16x8*)(Qp + (size_t)tq * ldq + 16 * ks + 8 * hh);
    f32x16 Oacc[DD];
#pragma unroll
    for (int dd = 0; dd < DD; ++dd)
#pragma unroll
        for (int i = 0; i < 16; ++i) Oacc[dd][i] = 0.f;
    float m = -INFINITY, l = 0.f, run = (MODE == 1) ? 1.f : 0.f; unsigned done_w = 0u;
    float w8[8], u4[4], fgc[4], fmn[16], fbias = 0.f;
    if (MODE == 0) {
        const int cc = r & 15, e = cc & 3, f = cc >> 3; const bool act = (hh == ((cc >> 2) & 1)); const int c4 = r & 3;
#pragma unroll
        for (int i = 0; i < 8; ++i) { w8[i] = (act && (i & 3) == e && (i >> 2) == f) ? 1.f : 0.f; asm volatile("" : "+v"(w8[i])); }
        fbias = act ? 0.f : -INFINITY; asm volatile("" : "+v"(fbias));
#pragma unroll
        for (int j = 0; j < 4; ++j) { u4[j] = (j == c4) ? 1.f : 0.f; asm volatile("" : "+v"(u4[j])); }
#pragma unroll
        for (int g = 0; g < 4; ++g) { fgc[g] = (((r - 4 * hh - c4 - 8 * g) & 15) == 0) ? 2.f : 1.f; asm volatile("" : "+v"(fgc[g])); }
#pragma unroll
        for (int i = 0; i < 16; ++i) { const int dm = (r - 4 * hh - ((i & 3) + 8 * (i >> 2))) & 15; fmn[i] = 1.f + ((dm & 3) == 0 ? 1.f : 0.f) + (dm == 0 ? 1.f : 0.f); asm volatile("" : "+v"(fmn[i])); }
    }
    const int kt_hi = (MODE == 2) ? (nkeys / KT - 1) : ((q0 + 255) / KT);
    u32x4 kA[PER], vA[PER], kB[PER], vB[PER];
#define ATT_GLOAD(KR, VR, kt) do { _Pragma("unroll") for (int p_ = 0; p_ < PER; ++p_) { const int idx_ = tid + 512 * p_, key_ = idx_ / NCH, ch_ = idx_ % NCH; \
        KR[p_] = *(const u32x4*)(Kp + (size_t)(KT * (kt) + key_) * ldkv + ch_ * 8); VR[p_] = *(const u32x4*)(Vp + (size_t)(KT * (kt) + key_) * ldkv + ch_ * 8); } } while (0)
    auto stage = [&](const u32x4 (&KR)[PER], const u32x4 (&VR)[PER]) -> bool {
        if (MODE == 1 && lane == 0) flags[w] = done_w;
        __syncthreads();
#pragma unroll
        for (int p_ = 0; p_ < PER; ++p_) { const int idx_ = tid + 512 * p_, key_ = idx_ / NCH, ch_ = idx_ % NCH;
            *(LAS u32x4*)(Ks + key_ * KROW + ch_ * 16) = KR[p_];
            *(LAS u32x4*)(Vr + key_ * KROW + ch_ * 16) = VR[p_];
        }
        bool alldone = false;
        if (MODE == 1) { unsigned a = 1u;
#pragma unroll
            for (int i = 0; i < 8; ++i) a &= flags[i];
            alldone = a != 0u; }
        __syncthreads();
        return alldone;
    };
    auto qk = [&](int sub, f32x16& S) {
        bf16x8 kf[KS];
#pragma unroll
        for (int ks = 0; ks < KS; ++ks) kf[ks] = *(const LAS bf16x8*)(Ks + (32 * sub + r) * KROW + (16 * ks + 8 * hh) * 2);
#pragma unroll
        for (int i = 0; i < 16; ++i) S[i] = 0.f;
        __builtin_amdgcn_sched_barrier(0);
#pragma unroll
        for (int ks = 0; ks < KS; ++ks) S = MFMA32(kf[ks], Qf[ks], S);
    };
    auto compute = [&](int kt) {
        f32x16 Sn; bool an;
        { const int tkn = KT * kt + 32 * (NSUB - 1); an = !((MODE != 2 && tkn > tq0 + 31) || (MODE == 1 && done_w)); if (an) qk(NSUB - 1, Sn); }
#pragma unroll
        for (int sub = NSUB - 1; sub >= 0; --sub) {
            const int tk0 = KT * kt + 32 * sub;
            f32x16 S = Sn; const bool a = an;
            if (sub > 0) { const int tkn = tk0 - 32; an = !((MODE != 2 && tkn > tq0 + 31) || (MODE == 1 && done_w)); if (an) qk(sub - 1, Sn); }
            if (!a) continue;
            s16x4 vlo[DD][2], vhi[DD][2];
#pragma unroll
            for (int dd = 0; dd < DD; ++dd)
#pragma unroll
                for (int s2 = 0; s2 < 2; ++s2) {
                    LAS unsigned char* vp = Vr + (32 * sub + 16 * s2 + 4 * hh + trq) * KROW + (32 * dd + trb) * 2 + 8 * trp;
                    vlo[dd][s2] = __builtin_amdgcn_ds_read_tr16_b64_v4i16((LAS s16x4*)vp); vhi[dd][s2] = __builtin_amdgcn_ds_read_tr16_b64_v4i16((LAS s16x4*)(vp + 8 * KROW));
                }
            __builtin_amdgcn_sched_barrier(0);
            const int dbase = tq - tk0 - 4 * hh;
            const int D = tq0 - tk0;
            if (MODE == 0 || MODE == 2) {
                const float C = (MODE == 0 ? 0.125f : 0.08838834764831845f) * 1.4426950408889634f;
                float alpha, ls = 0.f, mn;
                if (MODE == 0 && D >= 544) {
                    float s1 = S[0] * w8[0], s2 = S[8] * w8[0];
#pragma unroll
                    for (int i = 1; i < 8; ++i) { s1 = fmaf(S[i], w8[i], s1); s2 = fmaf(S[8 + i], w8[i], s2); }
                    const float v1 = fmaf(s1, C, fbias), v2 = fmaf(s2, C, fbias);
                    float mx = fmaxf(v1, v2); mx = fmaxf(mx, __shfl_xor(mx, 32));
                    mn = fmaxf(m, mx);
                    alpha = __builtin_amdgcn_exp2f(m - mn);
                    const float p1 = __builtin_amdgcn_exp2f(v1 - mn), p2 = __builtin_amdgcn_exp2f(v2 - mn);
                    ls = p1 + p2;
#pragma unroll
                    for (int i = 0; i < 8; ++i) { S[i] = w8[i] * p1; S[8 + i] = w8[i] * p2; }
                } else if (MODE == 0 && D >= 160 && D <= 480) {
                    float vg[4]; float mx = -INFINITY;
#pragma unroll
                    for (int g = 0; g < 4; ++g) { vg[g] = (fmaf(S[4 * g + 3], u4[3], fmaf(S[4 * g + 2], u4[2], fmaf(S[4 * g + 1], u4[1], S[4 * g] * u4[0])))) * C; mx = fmaxf(mx, vg[g]); }
                    mx = fmaxf(mx, __shfl_xor(mx, 32));
                    mn = fmaxf(m, mx);
                    alpha = __builtin_amdgcn_exp2f(m - mn);
#pragma unroll
                    for (int g = 0; g < 4; ++g) { const float pg = fgc[g] * __builtin_amdgcn_exp2f(vg[g] - mn); ls += pg;
#pragma unroll
                        for (int j = 0; j < 4; ++j) S[4 * g + j] = u4[j] * pg; }
                } else if (MODE == 0 && D >= 32 && D <= 96) {
                    float mx = -INFINITY;
#pragma unroll
                    for (int i = 0; i < 16; ++i) { S[i] = S[i] * C; mx = fmaxf(mx, S[i]); }
                    mx = fmaxf(mx, __shfl_xor(mx, 32));
                    mn = fmaxf(m, mx);
                    alpha = __builtin_amdgcn_exp2f(m - mn);
#pragma unroll
                    for (int i = 0; i < 16; ++i) { const float p = fmn[i] * __builtin_amdgcn_exp2f(S[i] - mn); S[i] = p; ls += p; }
                } else {
                    float fm[16]; float mx = -INFINITY;
#pragma unroll
                    for (int i = 0; i < 16; ++i) {
                        float v = S[i] * C;
                        if (MODE == 0) { const int d = dbase - ((i & 3) + 8 * (i >> 2));
                            int mult = (d <= 128 ? 1 : 0) + ((((d & 3) == 0) && d <= 512) ? 1 : 0) + (((d & 15) == 0) ? 1 : 0);
                            mult = d >= 0 ? mult : 0; fm[i] = (float)mult; v = mult > 0 ? v : -INFINITY; }
                        else fm[i] = 1.f;
                        S[i] = v; mx = fmaxf(mx, v);
                    }
                    mx = fmaxf(mx, __shfl_xor(mx, 32));
                    mn = fmaxf(m, mx); const float ms = (mn == -INFINITY) ? 0.f : mn;
                    alpha = __builtin_amdgcn_exp2f(m - ms);
#pragma unroll
                    for (int i = 0; i < 16; ++i) { const float p = fm[i] * __builtin_amdgcn_exp2f(S[i] - ms); S[i] = p; ls += p; }
                }
                l = l * alpha + ls; m = mn;
                if (!__all(alpha == 1.f)) {
#pragma unroll
                    for (int dd = 0; dd < DD; ++dd) Oacc[dd] = Oacc[dd] * alpha;
                }
            } else {
                float om[16], ex[16], G[4], PG[4];
                if (D < 32) {
#pragma unroll
                    for (int i = 0; i < 16; ++i) { const int d = dbase - ((i & 3) + 8 * (i >> 2)); const bool valid = d > 0;
                        const float x = fminf(fmaxf(S[i] * (0.125f * 1.4426950408889634f), -115.f), 115.f); const float e = __builtin_amdgcn_exp2f(x); const float o1 = __builtin_amdgcn_rcpf(1.f + e);
                        om[i] = valid ? o1 : 1.f; S[i] = valid ? e * o1 : 0.f; }
                } else {
#pragma unroll
                    for (int i = 0; i < 16; ++i) {
                        const float x = fminf(fmaxf(S[i] * (0.125f * 1.4426950408889634f), -115.f), 115.f); const float e = __builtin_amdgcn_exp2f(x); const float o1 = __builtin_amdgcn_rcpf(1.f + e);
                        om[i] = o1; S[i] = e * o1; }
                }
#pragma unroll
                for (int g = 0; g < 4; ++g) { ex[4 * g + 3] = 1.f; ex[4 * g + 2] = om[4 * g + 3]; ex[4 * g + 1] = ex[4 * g + 2] * om[4 * g + 2]; ex[4 * g] = ex[4 * g + 1] * om[4 * g + 1]; G[g] = ex[4 * g] * om[4 * g]; }
#pragma unroll
                for (int g = 0; g < 4; ++g) PG[g] = __shfl_xor(G[g], 32);
                float suf = run;
#pragma unroll
                for (int g = 3; g >= 0; --g) { const float lat = suf * (hh == 0 ? PG[g] : 1.f);
                    S[4 * g + 3] = S[4 * g + 3] * lat; S[4 * g + 2] = S[4 * g + 2] * (lat * ex[4 * g + 2]); S[4 * g + 1] = S[4 * g + 1] * (lat * ex[4 * g + 1]); S[4 * g] = S[4 * g] * (lat * ex[4 * g]);
                    suf *= G[g] * PG[g]; }
                run = suf;
                done_w = __all(run < 1e-30f) ? 1u : 0u;
            }
            u32x4 pp0, pp1;
#pragma unroll
            for (int j = 0; j < 4; ++j) { pp0[j] = pk_bf16(S[2 * j], S[2 * j + 1]); pp1[j] = pk_bf16(S[8 + 2 * j], S[8 + 2 * j + 1]); }
            const bf16x8 P0 = __builtin_bit_cast(bf16x8, pp0), P1 = __builtin_bit_cast(bf16x8, pp1);
#pragma unroll
            for (int dd = 0; dd < DD; ++dd)
#pragma unroll
                for (int s2 = 0; s2 < 2; ++s2) {
                    const bf16x8 vf = __builtin_shufflevector(vlo[dd][s2], vhi[dd][s2], 0, 1, 2, 3, 4, 5, 6, 7);
                    Oacc[dd] = MFMA32(vf, s2 ? P1 : P0, Oacc[dd]);
                }
        }
    };
    ATT_GLOAD(kA, vA, kt_hi);
    if constexpr (MODE == 2) {
#pragma unroll 1
        for (int kt = kt_hi; kt >= 0; --kt) {
            stage(kA, vA);
            if (kt >= 1) ATT_GLOAD(kA, vA, kt - 1);
            compute(kt);
        }
    } else {
        if (kt_hi >= 1) ATT_GLOAD(kB, vB, kt_hi - 1);
#pragma unroll 1
        for (int kt = kt_hi; kt >= 0; kt -= 2) {
            if (stage(kA, vA)) break;
            if (kt >= 2) ATT_GLOAD(kA, vA, kt - 2);
            compute(kt);
            if (kt == 0) break;
            if (stage(kB, vB)) break;
            if (kt >= 3) ATT_GLOAD(kB, vB, kt - 3);
            compute(kt - 1);
        }
    }
#undef ATT_GLOAD
    float inv = 1.f;
    if (MODE != 1) { const float lt = l + __shfl_xor(l, 32); inv = 1.f / lt; }
#pragma unroll
    for (int dd = 0; dd < DD; ++dd)
#pragma unroll
        for (int g = 0; g < 4; g += 2) {
            unsigned a0 = pk_bf16(Oacc[dd][4 * g] * inv, Oacc[dd][4 * g + 1] * inv), a1 = pk_bf16(Oacc[dd][4 * g + 2] * inv, Oacc[dd][4 * g + 3] * inv);
            unsigned b0 = pk_bf16(Oacc[dd][4 * g + 4] * inv, Oacc[dd][4 * g + 5] * inv), b1 = pk_bf16(Oacc[dd][4 * g + 6] * inv, Oacc[dd][4 * g + 7] * inv);
            { auto x = __builtin_amdgcn_permlane32_swap(a0, b0, false, false); a0 = x[0]; b0 = x[1]; }
            { auto x = __builtin_amdgcn_permlane32_swap(a1, b1, false, false); a1 = x[0]; b1 = x[1]; }
            u32x4 o; o[0] = a0; o[1] = a1; o[2] = b0; o[3] = b1;
            *(u32x4*)(Op + (size_t)tq * ldo + 32 * dd + 8 * g + 8 * hh) = o;
        }
}
constexpr int WQ_WORD = 4096;
__device__ __forceinline__ void p_attn_ab(LAS unsigned char* lds, const bf16_t* qkv, bf16_t* OA, bf16_t* OB, unsigned* wq) {
    constexpr size_t TS = (size_t)T * 512;
    volatile LAS unsigned* slot = (volatile LAS unsigned*)(lds + ATT_FLAG_OFF + 64);
    for (;;) {
        if (threadIdx.x == 0) *slot = __hip_atomic_fetch_add(wq, 1u, __ATOMIC_RELAXED, __HIP_MEMORY_SCOPE_AGENT);
        __syncthreads();
        const unsigned it = (unsigned)__builtin_amdgcn_readfirstlane((int)*slot);
        __syncthreads();
        if (it >= 2048u) break;
        const int j = it & 1023, qb = 7 - (j >> 7), bh = j & 127, b = bh >> 3, h = bh & 7;
        const bf16_t* base = qkv + (size_t)bh * SEQ * 64;
        if (it < 1024u) attn_item<0, 64, 128>(lds, base, 64, base + TS, base + 2 * TS, 64, OA + (size_t)b * SEQ * 1024 + h * HD, 1024, qb * 256, SEQ);
        else attn_item<1, 64, 128>(lds, base + 3 * TS, 64, base + 4 * TS, base + 5 * TS, 64, OB + (size_t)b * SEQ * 1024 + h * HD, 1024, qb * 256, SEQ);
    }
}
__device__ __forceinline__ void p_attn_mem(LAS unsigned char* lds, const bf16_t* qm, const bf16_t* kvm, bf16_t* om) {
#pragma unroll 1
    for (int i = 0;; ++i) {
        Unit u; { pg8::StaticOrder S2; S2.init(T, MEMW, (int)gridDim.x, (int)blockIdx.x); if (!S2.next(i, u)) break; }
        const int b = u.pm >> 3, qb = u.pm & 7;
#pragma unroll 1
        for (int hq = 0; hq < 2; ++hq) { const int h = 2 * u.pn + hq;
            attn_item<2, 128, 64>(lds, qm + (size_t)b * SEQ * MEMW + h * 128, MEMW, kvm + (size_t)b * NMEM * 1024 + h * 128, kvm + (size_t)b * NMEM * 1024 + 512 + h * 128, 1024,
                                  om + (size_t)b * SEQ * MEMW + h * 128, MEMW, qb * 256, NMEM); }
    }
}

__device__ __forceinline__ bool sync_if(int k, cg::grid_group& grid, XcdBarrier& xb) {
    if (k == 1) { grid.sync(); xb = xcd_barrier_post(xb.bar, xb.st); }
    else if (k == 8) {
        asm volatile("s_waitcnt vmcnt(0)" ::: "memory");
        __syncthreads();
        if (threadIdx.x == 0) { __builtin_amdgcn_fence(__ATOMIC_ACQUIRE, "agent"); asm volatile("s_waitcnt vmcnt(0)" ::: "memory"); }
        __syncthreads();
    }
    else if (k > 1) xcd_barrier(xb);
    asm volatile("" ::: "memory"); return true; }
constexpr int NPHASE = 13;
#ifndef NAIVE_AB
#define NAIVE_AB 0
#endif
#ifndef NAIVE_MEM
#define NAIVE_MEM 0
#endif
#ifndef ONLY
#define ONLY -1
#endif
#ifndef DUP_MASK
#define DUP_MASK 0
#endif
#define PHASE(k) if ((ONLY < 0 || ONLY == (k)) && ph_lo <= (k) && (k) < ph_hi) if (sync_if((k), grid, xb)) for (int rep_ = 0; rep_ < (((DUP_MASK >> (k)) & 1) ? 2 : 1); ++rep_)
__global__ __launch_bounds__(512, 2) void mega(Params p, int ph_lo, int ph_hi) {
    extern __shared__ __attribute__((aligned(16))) unsigned char shm[];
    LAS unsigned char* lds = (LAS unsigned char*)shm;
    cg::grid_group grid = cg::this_grid();
    Ctx c; c.tid = threadIdx.x; c.lane = c.tid & 63; c.wave = c.tid >> 6; c.gw = blockIdx.x * 8 + c.wave; c.ngw = gridDim.x * 8; c.gt = blockIdx.x * 512 + c.tid; c.ngt = gridDim.x * 512;
    unsigned char* ws = p.ws;
    bf16_t* Wt_in = (bf16_t*)(ws + WS_WIN); bf16_t* Wt_upa = (bf16_t*)(ws + WS_WUPA); bf16_t* Wt_upb = (bf16_t*)(ws + WS_WUPB); bf16_t* Wt_out = (bf16_t*)(ws + WS_WOUT);
    bf16_t* Wt_qm = (bf16_t*)(ws + WS_WQM); bf16_t* Wt_kvm = (bf16_t*)(ws + WS_WKVM); bf16_t* Wt_om = (bf16_t*)(ws + WS_WOM); bf16_t* Wt_gu = (bf16_t*)(ws + WS_WGU); bf16_t* Wt_dn = (bf16_t*)(ws + WS_WDN);
    bf16_t* memn = (bf16_t*)(ws + WS_MEMN); bf16_t* kvm = (bf16_t*)(ws + WS_KVM);
    float* ss1 = (float*)(ws + WS_SS1); float* ss2 = (float*)(ws + WS_SS2); float* ss3 = (float*)(ws + WS_SS3); float* rope = (float*)(ws + WS_ROPE);
    bf16_t* n1 = (bf16_t*)(ws + WS_R1); bf16_t* mixed = (bf16_t*)(ws + WS_R1); bf16_t* h2b = (bf16_t*)(ws + WS_R1);
    bf16_t* proj = (bf16_t*)(ws + WS_PROJ); bf16_t* gates = (bf16_t*)(ws + WS_PROJ + 192 * MiB);
    float* h1 = (float*)(ws + WS_H1); bf16_t* h1b = (bf16_t*)(ws + WS_H1B); bf16_t* qm = (bf16_t*)(ws + WS_QM); bf16_t* om = (bf16_t*)(ws + WS_OM);
    float* h2 = (float*)(ws + WS_H2); bf16_t* act = (bf16_t*)(ws + WS_ACT); bf16_t* OA = (bf16_t*)(ws + WS_OA); bf16_t* OB = (bf16_t*)(ws + WS_OA) + 512;
    float* m1 = p.out; unsigned* bar = (unsigned*)(ws + WS_BAR);
    volatile LAS unsigned* xst = (volatile LAS unsigned*)(lds + pg8::STAGE_BYTES);
    if (c.tid == 0) { xst[0] = 0u; xst[1] = 0u; }
    __syncthreads();
    XcdBarrier xb; xb.bar = bar; xb.x = 0u; xb.st = xst;
    pg8::StaticOrder S;
    {
        PHASE(0) {
            int cur = 0;
            p_transpose(c, lds, p.w_in, Wt_in, DM, INC, nullptr, 0, cur);
            p_transpose(c, lds, p.w_ffn_gate, Wt_gu, DM, DFF, p.g_ffn, 1, cur);
            p_transpose(c, lds, p.w_ffn_up, Wt_gu, DM, DFF, p.g_ffn, 2, cur);
            p_transpose(c, lds, p.w_ffn_down, Wt_dn, DFF, DM, nullptr, 0, cur);
            p_transpose(c, lds, p.w_up_a, Wt_upa, 512, DM, nullptr, 0, cur, 1024, 0);
            p_transpose(c, lds, p.w_up_b, Wt_upa, 512, DM, nullptr, 0, cur, 1024, 512);
            p_transpose(c, lds, p.w_out, Wt_out, DM, DM, nullptr, 0, cur);
            p_transpose(c, lds, p.w_q_mem, Wt_qm, DM, MEMW, p.g_mem_q, 0, cur);
            p_transpose(c, lds, p.w_kv_mem, Wt_kvm, DM, 2 * MEMW, nullptr, 0, cur);
            p_transpose(c, lds, p.w_o_mem, Wt_om, MEMW, DM, nullptr, 0, cur);
            p_rmsnorm_rows(c, p.x, p.g_mix, n1, T);
            p_rmsnorm_rows(c, p.mem, p.g_mem_kv, memn, BATCH * NMEM);
            p_rope_table(c, p.pos, rope);
            if (blockIdx.x == 0) { for (int i = c.tid; i < XCD_BAR_WORDS; i += 512) bar[i] = 0u; if (c.tid == 0) bar[WQ_WORD] = 0u; }
        }
        PHASE(1) {
            Gemm g{n1, Wt_in, T, INC, DM}; EpiBf16 E{proj, INC, nullptr, 1 << 30, rope, 4, 12, gates};   S.init(g.M, g.N, gridDim.x, blockIdx.x); pg8::gemm_phase(lds, g, S, E);
        }
        PHASE(3) {
            { Gemm g{memn, Wt_kvm, BATCH * NMEM, 1024, DM}; EpiBf16 E{kvm, 1024, nullptr, 1 << 30, nullptr, 0, 0, nullptr}; S.init(g.M, g.N, gridDim.x, blockIdx.x); pg8::gemm_phase(lds, g, S, E); }
            p_attn_ab(lds, proj, OA, OB, bar + WQ_WORD);
        }
        PHASE(5) { Gemm g{OA, Wt_upa, T, DM, DM}; EpiGate E{gates, mixed}; S.init(g.M, g.N, gridDim.x, blockIdx.x); pg8::gemm_phase(lds, g, S, E); }
        PHASE(6) { Gemm g{mixed, Wt_out, T, DM, DM}; EpiRes E{p.x, nullptr, nullptr, h1b, ss1}; S.init(g.M, g.N, gridDim.x, blockIdx.x); pg8::gemm_phase(lds, g, S, E); }
        PHASE(7) { Gemm g{h1b, Wt_qm, T, MEMW, DM}; EpiBf16 E{qm, MEMW, ss1, 1 << 30, nullptr, 0, 0, nullptr}; S.init(g.M, g.N, gridDim.x, blockIdx.x); pg8::gemm_phase(lds, g, S, E); }
        PHASE(8) {
            p_attn_mem(lds, qm, kvm, om);
        }
        PHASE(9) { Gemm g{om, Wt_om, T, DM, MEMW}; EpiRes E{nullptr, h1b, nullptr, h2b, ss2}; S.init(g.M, g.N, gridDim.x, blockIdx.x); pg8::gemm_phase(lds, g, S, E); }
        PHASE(10) { Gemm g{h2b, Wt_gu, T, 2 * DFF, DM}; EpiSwiGLU E{act, ss2}; S.init(g.M, g.N, gridDim.x, blockIdx.x); pg8::gemm_phase(lds, g, S, E); }
        PHASE(11) { Gemm g{act, Wt_dn, T, DM, DFF}; EpiRes E{nullptr, h2b, p.out, nullptr, ss3}; S.init(g.M, g.N, gridDim.x, blockIdx.x); pg8::gemm_phase(lds, g, S, E); }
        PHASE(12) p_final(c, p.out, ss3, p.g_final);
    }
}

constexpr int LDS_BYTES = pg8::STAGE_BYTES + 16;
#ifndef ONE_LAUNCH
#define ONE_LAUNCH 1
#endif
extern "C" void kernel_launch(void* const* d_in, const int* in_sizes, int n_in, void* d_out, int out_size, void* d_ws, size_t ws_size, hipStream_t stream) {
    static int grid = 0;
    if (grid == 0) {
        if (n_in != 18 || out_size != T * DM || ws_size < WS_END) { fprintf(stderr, "kernel_launch: unexpected shapes (n_in %d out %d ws %zu)\n", n_in, out_size, ws_size); grid = -1; return; }
        int dev = 0, cus = 0, per_cu = 0;
        (void)hipGetDevice(&dev); (void)hipDeviceGetAttribute(&cus, hipDeviceAttributeMultiprocessorCount, dev);
        if (hipFuncSetAttribute((const void*)mega, hipFuncAttributeMaxDynamicSharedMemorySize, LDS_BYTES) != hipSuccess) { fprintf(stderr, "hipFuncSetAttribute failed\n"); grid = -1; return; }
        if (hipOccupancyMaxActiveBlocksPerMultiprocessor(&per_cu, (const void*)mega, 512, LDS_BYTES) != hipSuccess || per_cu < 1) { fprintf(stderr, "occupancy query: %d\n", per_cu); per_cu = 1; }
        (void)hipGetLastError();
        grid = cus * 1;
    }
    if (grid < 0) return;
    Params p{};
    p.x = (const float*)d_in[0]; p.mem = (const float*)d_in[1]; p.pos = (const int*)d_in[2]; p.g_mix = (const float*)d_in[3]; p.w_in = (const float*)d_in[4];
    p.w_up_a = (const float*)d_in[5]; p.w_up_b = (const float*)d_in[6]; p.w_out = (const float*)d_in[7]; p.g_mem_q = (const float*)d_in[8]; p.g_mem_kv = (const float*)d_in[9];
    p.w_q_mem = (const float*)d_in[10]; p.w_kv_mem = (const float*)d_in[11]; p.w_o_mem = (const float*)d_in[12]; p.g_ffn = (const float*)d_in[13];
    p.w_ffn_gate = (const float*)d_in[14]; p.w_ffn_up = (const float*)d_in[15]; p.w_ffn_down = (const float*)d_in[16]; p.g_final = (const float*)d_in[17];
    p.out = (float*)d_out; p.ws = (unsigned char*)d_ws;
#if ONE_LAUNCH
    int lo = 0, hi = NPHASE;
    void* args[] = {&p, &lo, &hi};
    hipError_t e = hipLaunchCooperativeKernel((const void*)mega, dim3(grid), dim3(512), args, LDS_BYTES, stream);
    if (e != hipSuccess) fprintf(stderr, "cooperative launch failed: %s\n", hipGetErrorString(e));
#else
    for (int ph = 0; ph < NPHASE; ++ph) hipLaunchKernelGGL(mega, dim3(grid), dim3(512), LDS_BYTES, stream, p, ph, ph + 1);
#endif
}
```

```cpp
#include <hip/hip_runtime.h>
#include <hip/hip_cooperative_groups.h>
#include <cstdio>
namespace cg = cooperative_groups;

#define LAS __attribute__((address_space(3)))
typedef unsigned short bf16_t;
typedef short bf16x8 __attribute__((ext_vector_type(8)));
typedef float f32x4 __attribute__((ext_vector_type(4)));
typedef unsigned u32x4 __attribute__((ext_vector_type(4)));
typedef unsigned u32x2 __attribute__((ext_vector_type(2)));

constexpr int BATCH = 16, SEQ = 2048, DM = 1024, T = BATCH * SEQ;
constexpr int HD = 64, NHA = 8, NHB = 8;
constexpr int INC = 5120;
constexpr int C_QA = 0, C_KA = 512, C_VA = 1024, C_QB = 1536, C_KB = 2048, C_VB = 2560, C_GA = 3072, C_GB = 4096;
constexpr int NMEM = 256, MEMW = 512, DFF = 2816;
constexpr float EPS = 1e-6f;

constexpr size_t MiB = 1ull << 20;
constexpr size_t WS_WIN = 0, WS_WUPA = 10 * MiB, WS_WUPB = 11 * MiB, WS_WOUT = 12 * MiB, WS_WQM = 14 * MiB, WS_WKVM = 15 * MiB,
                 WS_WOM = 17 * MiB, WS_WGU = 18 * MiB, WS_WDN = 29 * MiB, WS_MEMN = 36 * MiB, WS_KVM = 44 * MiB,
                 WS_SS1 = 52 * MiB, WS_SS2 = 54 * MiB, WS_SS3 = 56 * MiB, WS_ROPE = 58 * MiB, WS_BAR = 60 * MiB;
constexpr size_t WS_R1 = 64 * MiB;
constexpr size_t WS_PROJ = 128 * MiB;
constexpr size_t WS_H1 = 128 * MiB, WS_H1B = 256 * MiB, WS_QM = 320 * MiB, WS_OM = 352 * MiB, WS_H2 = 384 * MiB, WS_ACT = 128 * MiB;
constexpr size_t WS_OA = 448 * MiB, WS_OB = 480 * MiB;
constexpr size_t WS_END = 512 * MiB;

struct Params {
    const float* x; const float* mem; const int* pos; const float* g_mix; const float* w_in; const float* w_up_a; const float* w_up_b; const float* w_out;
    const float* g_mem_q; const float* g_mem_kv; const float* w_q_mem; const float* w_kv_mem; const float* w_o_mem; const float* g_ffn;
    const float* w_ffn_gate; const float* w_ffn_up; const float* w_ffn_down; const float* g_final;
    float* out; unsigned char* ws;
};

typedef float f32x2 __attribute__((ext_vector_type(2)));
typedef __bf16 bf16v2 __attribute__((ext_vector_type(2)));
__device__ __forceinline__ unsigned pk_bf16(float lo, float hi) { f32x2 v = {lo, hi}; bf16v2 r = __builtin_convertvector(v, bf16v2); return __builtin_bit_cast(unsigned, r); }
__device__ __forceinline__ bf16_t f2bf(float f) { return (bf16_t)(pk_bf16(f, 0.f) & 0xffffu); }
__device__ __forceinline__ float bf2f(bf16_t b) { return __uint_as_float(((unsigned)b) << 16); }
__device__ __forceinline__ float bflo(unsigned u) { return __uint_as_float(u << 16); }
__device__ __forceinline__ float bfhi(unsigned u) { return __uint_as_float(u & 0xffff0000u); }
__device__ __forceinline__ float wave_sum(float v) {
#pragma unroll
    for (int o = 1; o < 64; o <<= 1) v += __shfl_xor(v, o);
    return v;
}
__device__ __forceinline__ float sigmoidf_(float x) { return __builtin_amdgcn_rcpf(1.f + __builtin_amdgcn_exp2f(x * -1.4426950408889634f)); }
__device__ __forceinline__ float rstd_of(const float* ss, int row) {
    const f32x4* p = (const f32x4*)(ss + (size_t)row * 16);
    f32x4 a = p[0], b = p[1], c = p[2], d = p[3];
    float s = ((a[0] + a[1]) + (a[2] + a[3])) + ((b[0] + b[1]) + (b[2] + b[3])) + ((c[0] + c[1]) + (c[2] + c[3])) + ((d[0] + d[1]) + (d[2] + d[3]));
    return rsqrtf(s * (1.f / DM) + EPS);
}


__device__ __forceinline__ void rstd_rows8(const float* ss, int row0, int fq, float (&rs)[8]) {
    f32x4 t[8];
#pragma unroll
    for (int k = 0; k < 8; ++k) t[k] = ((const f32x4*)(ss + (size_t)(row0 + (k >> 2) * 128 + (k & 3) * 16) * 16))[fq];
#pragma unroll
    for (int k = 0; k < 8; ++k) { float v = (t[k][0] + t[k][1]) + (t[k][2] + t[k][3]); v += __shfl_xor(v, 16); v += __shfl_xor(v, 32); rs[k] = rsqrtf(v * (1.f / DM) + EPS); }
    __builtin_amdgcn_sched_barrier(0);
}

#define XB_TMO      128
#define XB_XCNT(j)  (256  + 64 * (j))
#define XB_XSUB(j)  (1280 + 64 * (j))
#define XB_XGEN(j)  (2304 + 64 * (j))
#define XB_TOP      3328
#define XB_TOPGEN   3392
#define XCD_BAR_WORDS 3456
#define XB_SPIN_CAP (1u << 18)
__device__ __forceinline__ unsigned xb_ld(unsigned* p)              { return __hip_atomic_load(p, __ATOMIC_RELAXED, __HIP_MEMORY_SCOPE_AGENT); }
__device__ __forceinline__ unsigned xb_add(unsigned* p, unsigned v) { return __hip_atomic_fetch_add(p, v, __ATOMIC_RELAXED, __HIP_MEMORY_SCOPE_AGENT); }
__device__ __forceinline__ unsigned xb_xcc_id() { return (unsigned)__builtin_amdgcn_s_getreg((3 << 11) | 20) & 0xFu; }
#define XB_SPIN(cond, bar) do { unsigned _sp = 0; while (cond) { __builtin_amdgcn_s_sleep(1); \
    if ((++_sp & 255u) == 0u) { if (xb_ld(&(bar)[XB_TMO])) break; if (_sp > XB_SPIN_CAP) { atomicAdd(&(bar)[XB_TMO], 1u); break; } } } } while (0)
struct XcdBarrier { unsigned* bar; unsigned x; volatile LAS unsigned* st; };
__device__ __forceinline__ XcdBarrier xcd_barrier_post(unsigned* bar, volatile LAS unsigned* st) {
    XcdBarrier b; b.bar = bar; b.x = xb_xcc_id(); b.st = st;
    if (threadIdx.x == 0) (void)xb_add(&bar[XB_XCNT(b.x)], 1u);
    return b;
}
__device__ __forceinline__ void xcd_barrier_complete(unsigned* bar, unsigned x, unsigned& nloc, unsigned& nx) {
    const unsigned G = gridDim.x * gridDim.y * gridDim.z;
    unsigned sum, cnt, mine, sp = 0u;
    for (;;) {
        sum = 0u; cnt = 0u; mine = 0u;
#pragma unroll
        for (unsigned j = 0; j < 16; ++j) { const unsigned c = xb_ld(&bar[XB_XCNT(j)]); sum += c; cnt += (c > 0u) ? 1u : 0u; mine = (j == x) ? c : mine; }
        if (sum == G) break;
        __builtin_amdgcn_s_sleep(1);
        if ((++sp & 255u) == 0u) { if (xb_ld(&bar[XB_TMO])) break; if (sp > XB_SPIN_CAP) { atomicAdd(&bar[XB_TMO], 1u); break; } }
    }
    nloc = mine > 0u ? mine : 1u; nx = cnt > 0u ? cnt : 1u;
}
__device__ __forceinline__ void xcd_barrier(const XcdBarrier& b) {
    asm volatile("s_waitcnt vmcnt(0)" ::: "memory");
    __syncthreads();
    if (threadIdx.x == 0) {
        unsigned* bar = b.bar;
        __builtin_amdgcn_s_waitcnt(0);
        unsigned nloc = b.st[0], nx = b.st[1];
        if (nloc == 0u) { xcd_barrier_complete(bar, b.x, nloc, nx); b.st[0] = nloc; b.st[1] = nx; }
        const unsigned old = xb_add(&bar[XB_XSUB(b.x)], 1u);
        const unsigned gen = old / nloc;
        if (old + 1u == (gen + 1u) * nloc) {
            __builtin_amdgcn_fence(__ATOMIC_RELEASE, "agent");
            asm volatile("s_waitcnt vmcnt(0)" ::: "memory");
            const unsigned og = xb_add(&bar[XB_TOP], 1u);
            const unsigned tg = og / nx;
            if (og + 1u == (tg + 1u) * nx) xb_add(&bar[XB_TOPGEN], 1u);
            else XB_SPIN(xb_ld(&bar[XB_TOPGEN]) == tg, bar);
            __builtin_amdgcn_fence(__ATOMIC_ACQUIRE, "agent");
            xb_add(&bar[XB_XGEN(b.x)], 1u);
            asm volatile("s_waitcnt vmcnt(0)" ::: "memory");
        } else {
            XB_SPIN(xb_ld(&bar[XB_XGEN(b.x)]) == gen, bar);
            __builtin_amdgcn_fence(__ATOMIC_ACQUIRE, "agent");
            asm volatile("s_waitcnt vmcnt(0)" ::: "memory");
        }
    }
    __syncthreads();
}

namespace pg8 {
constexpr int BM = 256, BK = 64, HALF = 128, HTB = HALF * BK * 2, STAGE_BYTES = 8 * HTB, NXCD = 8, WGM = 4;
__host__ __device__ __forceinline__ int lds_byte(int r, int c) { const int st = (r >> 4) * 2 + (c >> 5), rr = r & 15, cc = c & 31, ob = rr * 64 + cc * 2; return st * 1024 + (ob ^ (((ob >> 9) & 1) << 5)); }
__host__ __device__ __forceinline__ void stage_rc(int b, int& R, int& C) { const int st = b / 1024, sb = b % 1024, swz = sb ^ (((sb >> 9) & 1) << 5); R = (st >> 1) * 16 + swz / 64; C = (st & 1) * 32 + (swz % 64) / 2; }
__host__ __device__ __forceinline__ int perm32(int rho) { const int n = rho >> 4, i = rho & 15; return 8 * (i >> 2) + 4 * n + (i & 3); }
struct Unit { int pm, pn; };
struct Gemm { const bf16_t* A; const bf16_t* Bt; int M, N, K; };
struct StaticOrder {
    int nM, nN, nwg, G, c;
    __host__ __device__ void init(int M, int N, int G_, int c_) { nM = M / BM; nN = N / BM; nwg = nM * nN; G = G_; c = c_; }
    __host__ __device__ bool next(int i, Unit& u) const {
        const long L = (long)i * G + c; if (L >= nwg) return false;
        int wgid = (int)L; { const int q = nwg / NXCD, r = nwg % NXCD, xcd = wgid % NXCD, off = wgid / NXCD; wgid = (xcd < r ? xcd * (q + 1) : r * (q + 1) + (xcd - r) * q) + off; }
        const int nig = WGM * nN, gid = wgid / nig, fm = gid * WGM, gsz = (nM - fm) < WGM ? (nM - fm) : WGM;
        u.pm = fm + ((wgid % nig) % gsz); u.pn = (wgid % nig) / gsz; return true;
    }
};

template <class Epi>
__device__ __forceinline__ void gemm_phase(LAS unsigned char* lds, const Gemm g, const StaticOrder& S, const Epi& E) {
    int tid = threadIdx.x; asm volatile("" : "+v"(tid));
    const int wid = __builtin_amdgcn_readfirstlane(tid >> 6), lane = tid & 63, wr = wid >> 2, wc = wid & 3, fr = lane & 15, fq = lane >> 4;
    const int K = g.K, nt = K / BK;
    unsigned voffA[2], voffB[2];
#pragma unroll
    for (int i = 0; i < 2; ++i) { int R, C; stage_rc(tid * 16 + i * 8192, R, C); const int Rb = Epi::LINE ? ((R >> 5) * 64 + perm32(R & 31)) : (Epi::PERM ? ((R & ~31) + perm32(R & 31)) : R);
        voffA[i] = (unsigned)(R * K + C) * 2u; voffB[i] = (unsigned)(Rb * K + C) * 2u; }
    const size_t kstep = (size_t)(BK * 2);
    const size_t hstep = (size_t)HALF * K * 2;
    const size_t tstep = 2 * hstep;
    const size_t hstepB = Epi::LINE ? (size_t)32 * K * 2 : hstep;
    const unsigned ldsw = (unsigned)wid * 1024u;
    const int aoff = lds_byte(wr * 64 + fr, fq * 8), boff = lds_byte(wc * 32 + fr, fq * 8);
#define PG8_SA(b, h) (((b) * 2 + (h)) * HTB)
#define PG8_SB(b, h) ((4 + (b) * 2 + (h)) * HTB)
#define PG8_STAGE(bufoff, gbase, voff) do { _Pragma("unroll") for (int _i = 0; _i < 2; ++_i) \
        __builtin_amdgcn_global_load_lds((const unsigned*)((const char*)(gbase) + (voff)[_i]), (LAS unsigned*)(lds + (bufoff) + ldsw + _i * 8192), 16, 0, 0); } while (0)
#define PG8_LDA(dst, b, h) do { _Pragma("unroll") for (int m = 0; m < 4; ++m) _Pragma("unroll") for (int k = 0; k < 2; ++k) dst[m][k] = *(const LAS bf16x8*)(lds + PG8_SA(b, h) + aoff + m * 2048 + k * 1024); } while (0)
#define PG8_LDB(dst, b, h) do { _Pragma("unroll") for (int n = 0; n < 2; ++n) _Pragma("unroll") for (int k = 0; k < 2; ++k) dst[n][k] = *(const LAS bf16x8*)(lds + PG8_SB(b, h) + boff + n * 2048 + k * 1024); } while (0)
#define PG8_MMA(ai, bj, At, Bt) do { __builtin_amdgcn_s_setprio(1); _Pragma("unroll") for (int m = 0; m < 4; ++m) _Pragma("unroll") for (int n = 0; n < 2; ++n) _Pragma("unroll") for (int k = 0; k < 2; ++k) \
        acc[ai][bj][m][n] = __builtin_amdgcn_mfma_f32_16x16x32_bf16(Bt[n][k], At[m][k], acc[ai][bj][m][n], 0, 0, 0); __builtin_amdgcn_s_setprio(0); } while (0)
#define PG8_WAIT_V(n) asm volatile("s_waitcnt vmcnt(" #n ")" ::: "memory")
#define PG8_WAIT_L(n) asm volatile("s_waitcnt lgkmcnt(" #n ")" ::: "memory")
#define PG8_BAR __builtin_amdgcn_s_barrier()
#define PG8_SCHED __builtin_amdgcn_sched_barrier(0)
    Unit cur, nxt; int ui = 0;
    if (!S.next(0, cur)) return;
    f32x4 acc[2][2][4][2];
#pragma unroll
    for (int a = 0; a < 2; ++a)
#pragma unroll
        for (int b = 0; b < 2; ++b)
#pragma unroll
            for (int m = 0; m < 4; ++m)
#pragma unroll
                for (int n = 0; n < 2; ++n) acc[a][b][m][n] = (f32x4){0.f, 0.f, 0.f, 0.f};
    bf16x8 At[4][2], B0[2][2], B1[2][2];
    const char* cA = (const char*)g.A + (size_t)cur.pm * tstep; const char* cB = (const char*)g.Bt + (size_t)cur.pn * tstep;
    PG8_STAGE(PG8_SB(0, 0), cB, voffB); PG8_STAGE(PG8_SA(0, 0), cA, voffA); PG8_STAGE(PG8_SB(0, 1), cB + hstepB, voffB); PG8_STAGE(PG8_SA(0, 1), cA + hstep, voffA);
    if (wr == 1) PG8_BAR;
    PG8_WAIT_V(4); PG8_BAR;
    PG8_STAGE(PG8_SB(1, 0), cB + kstep, voffB); PG8_STAGE(PG8_SA(1, 0), cA + kstep, voffA); PG8_STAGE(PG8_SB(1, 1), cB + hstepB + kstep, voffB);
    PG8_WAIT_V(6); PG8_BAR;
    for (;;) {
        const bool has_next = S.next(ui + 1, nxt);
        const char* nA = has_next ? (const char*)g.A + (size_t)nxt.pm * tstep : cA; const char* nB = has_next ? (const char*)g.Bt + (size_t)nxt.pn * tstep : cB;
        for (int t = 0; t < nt; t += 2) {
            const bool last = (t == nt - 2);
            const char* a1 = cA + (size_t)(t + 1) * kstep;
            const char* a2 = last ? nA : cA + (size_t)(t + 2) * kstep; const char* b2 = last ? nB : cB + (size_t)(t + 2) * kstep;
            const char* a3 = a2 + kstep; const char* b3 = b2 + kstep;
            if constexpr (Epi::HAS_MID) { if (t == nt / 2) E.mid(acc, cur, wr, wc, fr, fq); }
            PG8_LDB(B0, 0, 0); PG8_SCHED; PG8_LDA(At, 0, 0); PG8_STAGE(PG8_SA(1, 1), a1 + hstep, voffA);
            PG8_WAIT_L(8); PG8_BAR; PG8_WAIT_L(0); PG8_MMA(0, 0, At, B0); PG8_BAR; PG8_SCHED;
            PG8_LDB(B1, 0, 1); PG8_STAGE(PG8_SB(0, 0), b2, voffB);
            PG8_BAR; PG8_WAIT_L(0); PG8_MMA(0, 1, At, B1); PG8_BAR;
            PG8_LDA(At, 0, 1); PG8_STAGE(PG8_SA(0, 0), a2, voffA);
            PG8_BAR; PG8_WAIT_L(0); PG8_MMA(1, 0, At, B0); PG8_BAR; PG8_SCHED;
            PG8_STAGE(PG8_SB(0, 1), b2 + hstepB, voffB);
            PG8_WAIT_V(6); PG8_BAR; PG8_MMA(1, 1, At, B1); PG8_BAR;
            PG8_LDB(B0, 1, 0); PG8_SCHED; PG8_LDA(At, 1, 0); PG8_STAGE(PG8_SA(0, 1), a2 + hstep, voffA);
            PG8_WAIT_L(8); PG8_BAR; PG8_WAIT_L(0); PG8_MMA(0, 0, At, B0); PG8_BAR; PG8_SCHED;
            PG8_LDB(B1, 1, 1); PG8_STAGE(PG8_SB(1, 0), b3, voffB);
            PG8_BAR; PG8_WAIT_L(0); PG8_MMA(0, 1, At, B1); PG8_BAR;
            PG8_LDA(At, 1, 1); PG8_STAGE(PG8_SA(1, 0), a3, voffA);
            PG8_BAR; PG8_WAIT_L(0); PG8_MMA(1, 0, At, B0); PG8_BAR; PG8_SCHED;
            PG8_STAGE(PG8_SB(1, 1), b3 + hstepB, voffB);
            PG8_WAIT_V(6); PG8_BAR; PG8_MMA(1, 1, At, B1); PG8_BAR;
        }
        E(acc, cur, wr, wc, fr, fq);
        if (!has_next) break;
#pragma unroll
        for (int a = 0; a < 2; ++a)
#pragma unroll
            for (int b = 0; b < 2; ++b)
#pragma unroll
                for (int m = 0; m < 4; ++m)
#pragma unroll
                    for (int n = 0; n < 2; ++n) acc[a][b][m][n] = (f32x4){0.f, 0.f, 0.f, 0.f};
        cur = nxt; cA = nA; cB = nB; ++ui;
    }
    PG8_WAIT_V(0);
    if (wr == 0) PG8_BAR;
    PG8_BAR;
#undef PG8_SA
#undef PG8_SB
#undef PG8_STAGE
#undef PG8_LDA
#undef PG8_LDB
#undef PG8_MMA
#undef PG8_WAIT_V
#undef PG8_WAIT_L
#undef PG8_BAR
#undef PG8_SCHED
}
}
using pg8::Unit; using pg8::Gemm;

__device__ __forceinline__ void line_pair(u32x4& a, u32x4& b, bool lo) {
#pragma unroll
    for (int q = 0; q < 4; ++q) {
        const unsigned send = lo ? b[q] : a[q];
        const unsigned recv = (unsigned)__builtin_amdgcn_update_dpp(0, (int)send, 0x128  , 0xf, 0xf, false);
        if (lo) b[q] = recv; else a[q] = recv;
    }
}
struct EpiBf16 {
    static constexpr bool PERM = true, HAS_MID = false, LINE = true;
    bf16_t* O; int ldc; const float* ss; int sig_from; const float* rope; int rope_below; int qkv_tiles; bf16_t* gates;
    __device__ __forceinline__ bf16_t* addr(int row, int col, int pn) const {
        if (qkv_tiles > 0) {
            if (pn < qkv_tiles) return O + (size_t)(col >> 9) * ((size_t)T * 512) + ((size_t)((row >> 11) * 8 + ((col >> 6) & 7)) * SEQ + (row & (SEQ - 1))) * 64 + (col & 63);
            return gates + (size_t)row * 2048 + (col - 256 * qkv_tiles);
        }
        return O + (size_t)row * ldc + col;
    }
    __device__ __forceinline__ void operator()(const f32x4 (&acc)[2][2][4][2], const Unit& u, int wr, int wc, int fr, int fq) const {
        const int row0 = u.pm * 256 + wr * 64 + fr, col0 = u.pn * 256 + wc * 64 + 8 * fq;
        const bool sig = u.pn >= sig_from, lo = fr < 8;
        float rs8[8];
        if (ss) rstd_rows8(ss, row0, fq, rs8);
        else {
#pragma unroll
            for (int k = 0; k < 8; ++k) rs8[k] = 1.f; }
#pragma unroll
        for (int ai = 0; ai < 2; ++ai)
#pragma unroll
            for (int m = 0; m < 4; ++m) {
                const int row = row0 + ai * 128 + m * 16;
                const float rs = rs8[ai * 4 + m];
                u32x4 o[2];
#pragma unroll
                for (int bj = 0; bj < 2; ++bj) {
                    f32x4 v0 = acc[ai][bj][m][0] * rs, v1 = acc[ai][bj][m][1] * rs;
                    if (sig) {
#pragma unroll
                        for (int j = 0; j < 4; ++j) { v0[j] = sigmoidf_(v0[j]); v1[j] = sigmoidf_(v1[j]); }
                    }
                    if (bj == 0 && u.pn < rope_below) {
                        f32x4 p0, p1;
#pragma unroll
                        for (int j = 0; j < 4; ++j) { p0[j] = __shfl_xor(v0[j], 16); p1[j] = __shfl_xor(v1[j], 16); }
                        if (fq < 2) {
                            const f32x4 c0 = *(const f32x4*)(rope + (size_t)row * 16), c1 = *(const f32x4*)(rope + (size_t)row * 16 + 4);
                            f32x4 s0 = *(const f32x4*)(rope + (size_t)row * 16 + 8), s1 = *(const f32x4*)(rope + (size_t)row * 16 + 12);
                            if (fq == 0) { s0 = -s0; s1 = -s1; }
                            v0 = v0 * c0 + p0 * s0; v1 = v1 * c1 + p1 * s1;
                        }
                    }
                    o[bj][0] = pk_bf16(v0[0], v0[1]); o[bj][1] = pk_bf16(v0[2], v0[3]); o[bj][2] = pk_bf16(v1[0], v1[1]); o[bj][3] = pk_bf16(v1[2], v1[3]);
                }
                line_pair(o[0], o[1], lo);
                const int colx = col0 + (lo ? 0 : 32);
                *(u32x4*)addr(lo ? row : row - 8, colx, u.pn) = o[0];
                *(u32x4*)addr(lo ? row + 8 : row, colx, u.pn) = o[1];
            }
    }
};
struct EpiGate {
    static constexpr bool PERM = true, HAS_MID = true, LINE = true;
    const bf16_t* gates; bf16_t* O;
    __device__ __forceinline__ void mid(f32x4 (&acc)[2][2][4][2], const Unit& u, int wr, int wc, int fr, int fq) const {
        int row0 = u.pm * 256 + wr * 64 + fr, col0 = u.pn * 256 + wc * 64 + 8 * fq;
        asm volatile("" : "+v"(row0), "+v"(col0));
        u32x4 ga[2][2], gb[2][2];
        { const bf16_t* gp = gates + (size_t)row0 * 2048 + col0;
          ga[0][0] = *(const u32x4*)gp; gb[0][0] = *(const u32x4*)(gp + 1024); ga[0][1] = *(const u32x4*)(gp + 32); gb[0][1] = *(const u32x4*)(gp + 1024 + 32); }
#pragma unroll
        for (int g = 0; g < 8; ++g) {
            const int ai = g >> 2, m = g & 3, cb = g & 1, nb = cb ^ 1;
            if (g + 1 < 8) { const int row = row0 + ((g + 1) >> 2) * 128 + ((g + 1) & 3) * 16; const bf16_t* gp = gates + (size_t)row * 2048 + col0;
                ga[nb][0] = *(const u32x4*)gp; gb[nb][0] = *(const u32x4*)(gp + 1024); ga[nb][1] = *(const u32x4*)(gp + 32); gb[nb][1] = *(const u32x4*)(gp + 1024 + 32); }
#pragma unroll
            for (int bj = 0; bj < 2; ++bj)
#pragma unroll
                for (int q = 0; q < 4; ++q) {
                    const float a0 = bflo(ga[cb][bj][q]), a1 = bfhi(ga[cb][bj][q]), b0 = fmaxf(bflo(gb[cb][bj][q]), -60.f), b1 = fmaxf(bfhi(gb[cb][bj][q]), -60.f);
                    const float r0 = (1.f + __expf(-b0)) * __builtin_amdgcn_rcpf(1.f + __expf(-a0)), r1 = (1.f + __expf(-b1)) * __builtin_amdgcn_rcpf(1.f + __expf(-a1));
                    acc[ai][bj][m][q >> 1][(q & 1) * 2] *= r0; acc[ai][bj][m][q >> 1][(q & 1) * 2 + 1] *= r1;
                }
            __builtin_amdgcn_sched_barrier(0);
        }
    }
    __device__ __forceinline__ void operator()(const f32x4 (&acc)[2][2][4][2], const Unit& u, int wr, int wc, int fr, int fq) const {
        const int row0 = u.pm * 256 + wr * 64 + fr, col0 = u.pn * 256 + wc * 64 + 8 * fq; const bool lo = fr < 8;
        u32x4 gbv[2][2];
        { const bf16_t* gp = gates + (size_t)row0 * 2048 + 1024 + col0; gbv[0][0] = *(const u32x4*)gp; gbv[0][1] = *(const u32x4*)(gp + 32); }
#pragma unroll
        for (int g = 0; g < 8; ++g) {
            {
                const int ai = g >> 2, m = g & 3, cb = g & 1, nb = cb ^ 1;
                const int row = row0 + ai * 128 + m * 16;
                if (g + 1 < 8) { const bf16_t* gp = gates + (size_t)(row0 + ((g + 1) >> 2) * 128 + ((g + 1) & 3) * 16) * 2048 + 1024 + col0; gbv[nb][0] = *(const u32x4*)gp; gbv[nb][1] = *(const u32x4*)(gp + 32); }
                u32x4 oo[2];
#pragma unroll
                for (int bj = 0; bj < 2; ++bj) {
                    const u32x4 gb = gbv[cb][bj];
                    float r[8];
#pragma unroll
                    for (int q = 0; q < 4; ++q) {
                        const float b0 = fmaxf(bflo(gb[q]), -60.f), b1 = fmaxf(bfhi(gb[q]), -60.f);
                        r[2 * q] = acc[ai][bj][m][q >> 1][(q & 1) * 2] * __builtin_amdgcn_rcpf(1.f + __expf(-b0));
                        r[2 * q + 1] = acc[ai][bj][m][q >> 1][(q & 1) * 2 + 1] * __builtin_amdgcn_rcpf(1.f + __expf(-b1));
                    }
                    oo[bj][0] = pk_bf16(r[0], r[1]); oo[bj][1] = pk_bf16(r[2], r[3]); oo[bj][2] = pk_bf16(r[4], r[5]); oo[bj][3] = pk_bf16(r[6], r[7]);
                }
                line_pair(oo[0], oo[1], lo);
                const int colx = col0 + (lo ? 0 : 32);
                *(u32x4*)(O + (size_t)(lo ? row : row - 8) * DM + colx) = oo[0];
                *(u32x4*)(O + (size_t)(lo ? row + 8 : row) * DM + colx) = oo[1];
            }
        }
    }
};
struct EpiRes {
    static constexpr bool PERM = true, HAS_MID = false, LINE = true;
    const float* R; const bf16_t* Rb; float* H; bf16_t* Hb; float* SS;
    __device__ __forceinline__ void operator()(const f32x4 (&acc)[2][2][4][2], const Unit& u, int wr, int wc, int fr, int fq) const {
        const int row0 = u.pm * 256 + wr * 64 + fr, col0 = u.pn * 256 + wc * 64 + 8 * fq; const bool lo = fr < 8;
        u32x4 rbv[2][2]; f32x4 rfv[2][2][2];
        if (!R) { rbv[0][0] = *(const u32x4*)(Rb + (size_t)row0 * DM + col0); rbv[0][1] = *(const u32x4*)(Rb + (size_t)row0 * DM + col0 + 32); }
        else { const float* rp = R + (size_t)row0 * DM + col0; rfv[0][0][0] = *(const f32x4*)rp; rfv[0][0][1] = *(const f32x4*)(rp + 4); rfv[0][1][0] = *(const f32x4*)(rp + 32); rfv[0][1][1] = *(const f32x4*)(rp + 36); }
#pragma unroll
        for (int g = 0; g < 8; ++g) {
            {
                const int ai = g >> 2, m = g & 3, cb = g & 1, nb = cb ^ 1;
                const int row = row0 + ai * 128 + m * 16;
                if (g + 1 < 8) { const int rown = row0 + ((g + 1) >> 2) * 128 + ((g + 1) & 3) * 16;
                    if (!R) { rbv[nb][0] = *(const u32x4*)(Rb + (size_t)rown * DM + col0); rbv[nb][1] = *(const u32x4*)(Rb + (size_t)rown * DM + col0 + 32); }
                    else { const float* rp = R + (size_t)rown * DM + col0; rfv[nb][0][0] = *(const f32x4*)rp; rfv[nb][0][1] = *(const f32x4*)(rp + 4); rfv[nb][1][0] = *(const f32x4*)(rp + 32); rfv[nb][1][1] = *(const f32x4*)(rp + 36); } }
                float s = 0.f; u32x4 ob[2];
#pragma unroll
                for (int bj = 0; bj < 2; ++bj) {
                    const int col = col0 + bj * 32;
                    f32x4 r0, r1;
                    if (R) { r0 = rfv[cb][bj][0]; r1 = rfv[cb][bj][1]; }
                    else { const u32x4 rb = rbv[cb][bj];
                        r0[0] = bflo(rb[0]); r0[1] = bfhi(rb[0]); r0[2] = bflo(rb[1]); r0[3] = bfhi(rb[1]); r1[0] = bflo(rb[2]); r1[1] = bfhi(rb[2]); r1[2] = bflo(rb[3]); r1[3] = bfhi(rb[3]); }
                    const f32x4 h0 = r0 + acc[ai][bj][m][0], h1 = r1 + acc[ai][bj][m][1];
                    if (H) { *(f32x4*)(H + (size_t)row * DM + col) = h0; *(f32x4*)(H + (size_t)row * DM + col + 4) = h1; }
                    ob[bj][0] = pk_bf16(h0[0], h0[1]); ob[bj][1] = pk_bf16(h0[2], h0[3]); ob[bj][2] = pk_bf16(h1[0], h1[1]); ob[bj][3] = pk_bf16(h1[2], h1[3]);
                    s += ((h0[0] * h0[0] + h0[1] * h0[1]) + (h0[2] * h0[2] + h0[3] * h0[3])) + ((h1[0] * h1[0] + h1[1] * h1[1]) + (h1[2] * h1[2] + h1[3] * h1[3]));
                }
                if (Hb) { line_pair(ob[0], ob[1], lo); const int colx = col0 + (lo ? 0 : 32);
                    *(u32x4*)(Hb + (size_t)(lo ? row : row - 8) * DM + colx) = ob[0]; *(u32x4*)(Hb + (size_t)(lo ? row + 8 : row) * DM + colx) = ob[1]; }
                s += __shfl_xor(s, 16); s += __shfl_xor(s, 32);
                if (fq == 0) SS[(size_t)row * 16 + u.pn * 4 + wc] = s;
            }
        }
    }
};
struct EpiSwiGLU {
    static constexpr bool PERM = true, HAS_MID = false, LINE = false;
    bf16_t* O; const float* ss;
    __device__ __forceinline__ void operator()(const f32x4 (&acc)[2][2][4][2], const Unit& u, int wr, int wc, int fr, int fq) const {
        const int row0 = u.pm * 256 + wr * 64 + fr, col0 = u.pn * 128 + wc * 32 + 8 * fq;
        float rs8[8]; rstd_rows8(ss, row0, fq, rs8);
#pragma unroll
        for (int ai = 0; ai < 2; ++ai)
#pragma unroll
            for (int m = 0; m < 4; ++m) {
                const int row = row0 + ai * 128 + m * 16;
                const float rs = rs8[ai * 4 + m];
                float r[8];
#pragma unroll
                for (int n = 0; n < 2; ++n)
#pragma unroll
                    for (int j = 0; j < 4; ++j) { const float gg = acc[ai][0][m][n][j] * rs, uu = acc[ai][1][m][n][j] * rs; r[n * 4 + j] = gg * sigmoidf_(gg) * uu; }
                u32x4 o; o[0] = pk_bf16(r[0], r[1]); o[1] = pk_bf16(r[2], r[3]); o[2] = pk_bf16(r[4], r[5]); o[3] = pk_bf16(r[6], r[7]);
                *(u32x4*)(O + (size_t)row * DFF + col0) = o;
            }
    }
};

struct Ctx { int tid, lane, wave, gw, ngw, gt, ngt; };

__device__ __forceinline__ void p_transpose(const Ctx& c, LAS unsigned char* lds, const float* W, bf16_t* Wt, int K, int N, const float* g, int mode, int& cursor, int ldw = 0, int koff = 0) {
    if (ldw == 0) ldw = K;
    LAS float* scr = (LAS float*)(lds + c.wave * 8704);
    const int nblk = N / 32, nitems = (K / 64) * nblk, lane = c.lane;
    int first = (c.gw - cursor % c.ngw + c.ngw) % c.ngw;
    for (int it = first; it < nitems; it += c.ngw) {
        const int kb = it / nblk, nb = it % nblk, k0 = 64 * kb, n0 = 32 * nb;
#pragma unroll 8
        for (int i = 0; i < 32; ++i) { const int kk = 2 * i + (lane >> 5); float v = W[(size_t)(k0 + kk) * N + n0 + (lane & 31)]; if (g) v *= g[k0 + kk]; scr[kk * 33 + (lane & 31)] = v; }
        asm volatile("s_waitcnt lgkmcnt(0)" ::: "memory");
        const int ch = lane & 7;
#pragma unroll
        for (int j = 0; j < 4; ++j) { const int n = (lane >> 3) + 8 * j; const LAS float* sp = scr + (8 * ch) * 33 + n;
            u32x4 o; o[0] = pk_bf16(sp[0], sp[33]); o[1] = pk_bf16(sp[2 * 33], sp[3 * 33]); o[2] = pk_bf16(sp[4 * 33], sp[5 * 33]); o[3] = pk_bf16(sp[6 * 33], sp[7 * 33]);
            const int nn = n0 + n, row = mode == 0 ? nn : (256 * (nn >> 7) + (nn & 127) + (mode == 2 ? 128 : 0));
            *(u32x4*)(Wt + (size_t)row * ldw + koff + k0 + 8 * ch) = o; }
        asm volatile("s_waitcnt lgkmcnt(0)" ::: "memory");
    }
    cursor += nitems;
}
__device__ __forceinline__ void p_rmsnorm_rows(const Ctx& c, const float* x, const float* g, bf16_t* out, int rows) {
    f32x4 gg[4];
#pragma unroll
    for (int j = 0; j < 4; ++j) gg[j] = ((const f32x4*)g)[c.lane + 64 * j];
    for (int r0 = c.gw; r0 < rows; r0 += 2 * c.ngw) {
        const int r1 = r0 + c.ngw; const bool has1 = r1 < rows; const int r1c = has1 ? r1 : r0;
        const f32x4* xa = (const f32x4*)(x + (size_t)r0 * DM) + c.lane; const f32x4* xb = (const f32x4*)(x + (size_t)r1c * DM) + c.lane;
        f32x4 va[4], vb[4]; float sa = 0.f, sb = 0.f;
#pragma unroll
        for (int j = 0; j < 4; ++j) { va[j] = xa[64 * j]; vb[j] = xb[64 * j]; }
#pragma unroll
        for (int j = 0; j < 4; ++j) { sa += (va[j][0] * va[j][0] + va[j][1] * va[j][1]) + (va[j][2] * va[j][2] + va[j][3] * va[j][3]); sb += (vb[j][0] * vb[j][0] + vb[j][1] * vb[j][1]) + (vb[j][2] * vb[j][2] + vb[j][3] * vb[j][3]); }
        const float ra = rsqrtf(wave_sum(sa) * (1.f / DM) + EPS), rb = rsqrtf(wave_sum(sb) * (1.f / DM) + EPS);
#pragma unroll
        for (int j = 0; j < 4; ++j) {
            u32x2 o; o[0] = pk_bf16(va[j][0] * ra * gg[j][0], va[j][1] * ra * gg[j][1]); o[1] = pk_bf16(va[j][2] * ra * gg[j][2], va[j][3] * ra * gg[j][3]);
            ((u32x2*)(out + (size_t)r0 * DM))[c.lane + 64 * j] = o;
            if (has1) { u32x2 q; q[0] = pk_bf16(vb[j][0] * rb * gg[j][0], vb[j][1] * rb * gg[j][1]); q[1] = pk_bf16(vb[j][2] * rb * gg[j][2], vb[j][3] * rb * gg[j][3]);
                ((u32x2*)(out + (size_t)r1 * DM))[c.lane + 64 * j] = q; }
        }
    }
}
__device__ __forceinline__ void p_rope_table(const Ctx& c, const int* pos, float* tab) {
    for (int i = c.gt; i < T * 8; i += c.ngt) {
        const int tok = i >> 3, f = i & 7;
        const double inv = f == 0 ? 1.0 : f == 1 ? 0.19392274474868576 : f == 2 ? 0.03760603093086393 : f == 3 ? 0.007292664737217109 : f == 4 ? 0.001414213562373095 :
                           f == 5 ? 0.0002742481756762073 : f == 6 ? 5.318295896944988e-05 : 1.031338537721246e-05;
        const double rev = (double)pos[tok] * inv * 0.15915494309189535;
        const float fr = (float)(rev - rint(rev));
        tab[(size_t)tok * 16 + f] = __builtin_amdgcn_cosf(fr);
        tab[(size_t)tok * 16 + 8 + f] = __builtin_amdgcn_sinf(fr);
    }
}
__device__ __forceinline__ void p_final(const Ctx& c, float* out, const float* ss, const float* g) {
    f32x4 gg[4];
#pragma unroll
    for (int j = 0; j < 4; ++j) gg[j] = ((const f32x4*)g)[c.lane + 64 * j];
    for (int r0 = c.gw; r0 < T; r0 += 2 * c.ngw) {
        const int r1 = r0 + c.ngw; const bool has1 = r1 < T; const int r1c = has1 ? r1 : r0;
        f32x4* xa = (f32x4*)(out + (size_t)r0 * DM) + c.lane; f32x4* xb = (f32x4*)(out + (size_t)r1c * DM) + c.lane;
        f32x4 va[4], vb[4];
#pragma unroll
        for (int j = 0; j < 4; ++j) { va[j] = xa[64 * j]; vb[j] = xb[64 * j]; }
        const float ra = rstd_of(ss, r0), rb = rstd_of(ss, r1c);
#pragma unroll
        for (int j = 0; j < 4; ++j) { xa[64 * j] = va[j] * ra * gg[j]; if (has1) xb[64 * j] = vb[j] * rb * gg[j]; }
    }
}

typedef float f32x16 __attribute__((ext_vector_type(16)));
typedef short s16x4 __attribute__((ext_vector_type(4)));
#define MFMA32(a, b, c) __builtin_amdgcn_mfma_f32_32x32x16_bf16((a), (b), (c), 0, 0, 0)
constexpr int ATT_FLAG_OFF = 40960;
#ifndef ATT_DUP_A
#define ATT_DUP_A 0
#endif
#ifndef ATT_DUP_B
#define ATT_DUP_B 0
#endif
template <int MODE, int HDIM, int KT>
__device__ __forceinline__ void attn_item(LAS unsigned char* lds, const bf16_t* Qp, int ldq, const bf16_t* Kp, const bf16_t* Vp, int ldkv, bf16_t* Op, int ldo, int q0, int nkeys) {
    constexpr int KS = HDIM / 16, DD = HDIM / 32, KROW = HDIM * 2 + 16, NCH = HDIM / 8, PER = KT * NCH / 512, NSUB = KT / 32;
    static_assert(2 * KT * KROW + 128 <= ATT_FLAG_OFF, "attention LDS tiles overlap the flag words");
    int tid = threadIdx.x; asm volatile("" : "+v"(tid));
    const int lane = tid & 63, w = __builtin_amdgcn_readfirstlane(tid >> 6), r = lane & 31, hh = lane >> 5;
    const int tq0 = q0 + 32 * w, tq = tq0 + r;
    LAS unsigned char* Ks = lds; LAS unsigned char* Vr = lds + KT * KROW;
    const int trq = (r & 15) >> 2, trp = r & 3, trb = r & 16;
    LAS unsigned* flags = (LAS unsigned*)(lds + ATT_FLAG_OFF);
    bf16x8 Qf[KS];
#pragma unroll
    for (int ks = 0; ks < KS; ++ks) Qf[ks] = *(const bf16x8*)(Qp + (size_t)tq * ldq + 16 * ks + 8 * hh);
    f32x16 Oacc[DD];
#pragma unroll
    for (int dd = 0; dd < DD; ++dd)
#pragma unroll
        for (int i = 0; i < 16; ++i) Oacc[dd][i] = 0.f;
    float m = -INFINITY, l = 0.f, run = (MODE == 1) ? 1.f : 0.f; unsigned done_w = 0u;
    float w8[8], u4[4], fgc[4], fmn[16], fbias = 0.f;
    if (MODE == 0) {
        const int cc = r & 15, e = cc & 3, f = cc >> 3; const bool act = (hh == ((cc >> 2) & 1)); const int c4 = r & 3;
#pragma unroll
        for (int i = 0; i < 8; ++i) { w8[i] = (act && (i & 3) == e && (i >> 2) == f) ? 1.f : 0.f; asm volatile("" : "+v"(w8[i])); }
        fbias = act ? 0.f : -INFINITY; asm volatile("" : "+v"(fbias));
#pragma unroll
        for (int j = 0; j < 4; ++j) { u4[j] = (j == c4) ? 1.f : 0.f; asm volatile("" : "+v"(u4[j])); }
#pragma unroll
        for (int g = 0; g < 4; ++g) { fgc[g] = (((r - 4 * hh - c4 - 8 * g) & 15) == 0) ? 2.f : 1.f; asm volatile("" : "+v"(fgc[g])); }
#pragma unroll
        for (int i = 0; i < 16; ++i) { const int dm = (r - 4 * hh - ((i & 3) + 8 * (i >> 2))) & 15; fmn[i] = 1.f + ((dm & 3) == 0 ? 1.f : 0.f) + (dm == 0 ? 1.f : 0.f); asm volatile("" : "+v"(fmn[i])); }
    }
    const int kt_hi = (MODE == 2) ? (nkeys / KT - 1) : ((q0 + 255) / KT);
    u32x4 kA[PER], vA[PER], kB[PER], vB[PER];
#define ATT_GLOAD(KR, VR, kt) do { _Pragma("unroll") for (int p_ = 0; p_ < PER; ++p_) { const int idx_ = tid + 512 * p_, key_ = idx_ / NCH, ch_ = idx_ % NCH; \
        KR[p_] = *(const u32x4*)(Kp + (size_t)(KT * (kt) + key_) * ldkv + ch_ * 8); VR[p_] = *(const u32x4*)(Vp + (size_t)(KT * (kt) + key_) * ldkv + ch_ * 8); } } while (0)
    auto stage = [&](const u32x4 (&KR)[PER], const u32x4 (&VR)[PER]) -> bool {
        if (MODE == 1 && lane == 0) flags[w] = done_w;
        __syncthreads();
#pragma unroll
        for (int p_ = 0; p_ < PER; ++p_) { const int idx_ = tid + 512 * p_, key_ = idx_ / NCH, ch_ = idx_ % NCH;
            *(LAS u32x4*)(Ks + key_ * KROW + ch_ * 16) = KR[p_];
            *(LAS u32x4*)(Vr + key_ * KROW + ch_ * 16) = VR[p_];
        }
        bool alldone = false;
        if (MODE == 1) { unsigned a = 1u;
#pragma unroll
            for (int i = 0; i < 8; ++i) a &= flags[i];
            alldone = a != 0u; }
        __syncthreads();
        return alldone;
    };
    auto qk = [&](int sub, f32x16& S) {
        bf16x8 kf[KS];
#pragma unroll
        for (int ks = 0; ks < KS; ++ks) kf[ks] = *(const LAS bf16x8*)(Ks + (32 * sub + r) * KROW + (16 * ks + 8 * hh) * 2);
#pragma unroll
        for (int i = 0; i < 16; ++i) S[i] = 0.f;
        __builtin_amdgcn_sched_barrier(0);
#pragma unroll
        for (int ks = 0; ks < KS; ++ks) S = MFMA32(kf[ks], Qf[ks], S);
    };
    auto compute = [&](int kt) {
        f32x16 Sn; bool an;
        { const int tkn = KT * kt + 32 * (NSUB - 1); an = !((MODE != 2 && tkn > tq0 + 31) || (MODE == 1 && done_w)); if (an) qk(NSUB - 1, Sn); }
#pragma unroll
        for (int sub = NSUB - 1; sub >= 0; --sub) {
            const int tk0 = KT * kt + 32 * sub;
            f32x16 S = Sn; const bool a = an;
            if (sub > 0) { const int tkn = tk0 - 32; an = !((MODE != 2 && tkn > tq0 + 31) || (MODE == 1 && done_w)); if (an) qk(sub - 1, Sn); }
            if (!a) continue;
            s16x4 vlo[DD][2], vhi[DD][2];
#pragma unroll
            for (int dd = 0; dd < DD; ++dd)
#pragma unroll
                for (int s2 = 0; s2 < 2; ++s2) {
                    LAS unsigned char* vp = Vr + (32 * sub + 16 * s2 + 4 * hh + trq) * KROW + (32 * dd + trb) * 2 + 8 * trp;
                    vlo[dd][s2] = __builtin_amdgcn_ds_read_tr16_b64_v4i16((LAS s16x4*)vp); vhi[dd][s2] = __builtin_amdgcn_ds_read_tr16_b64_v4i16((LAS s16x4*)(vp + 8 * KROW));
                }
            __builtin_amdgcn_sched_barrier(0);
            const int dbase = tq - tk0 - 4 * hh;
            const int D = tq0 - tk0;
            if (MODE == 0 || MODE == 2) {
                const float C = (MODE == 0 ? 0.125f : 0.08838834764831845f) * 1.4426950408889634f;
                float alpha, ls = 0.f, mn;
                if (MODE == 0 && D >= 544) {
                    float s1 = S[0] * w8[0], s2 = S[8] * w8[0];
#pragma unroll
                    for (int i = 1; i < 8; ++i) { s1 = fmaf(S[i], w8[i], s1); s2 = fmaf(S[8 + i], w8[i], s2); }
                    const float v1 = fmaf(s1, C, fbias), v2 = fmaf(s2, C, fbias);
                    float mx = fmaxf(v1, v2); mx = fmaxf(mx, __shfl_xor(mx, 32));
                    mn = fmaxf(m, mx);
                    alpha = __builtin_amdgcn_exp2f(m - mn);
                    const float p1 = __builtin_amdgcn_exp2f(v1 - mn), p2 = __builtin_amdgcn_exp2f(v2 - mn);
                    ls = p1 + p2;
#pragma unroll
                    for (int i = 0; i < 8; ++i) { S[i] = w8[i] * p1; S[8 + i] = w8[i] * p2; }
                } else if (MODE == 0 && D >= 160 && D <= 480) {
                    float vg[4]; float mx = -INFINITY;
#pragma unroll
                    for (int g = 0; g < 4; ++g) { vg[g] = (fmaf(S[4 * g + 3], u4[3], fmaf(S[4 * g + 2], u4[2], fmaf(S[4 * g + 1], u4[1], S[4 * g] * u4[0])))) * C; mx = fmaxf(mx, vg[g]); }
                    mx = fmaxf(mx, __shfl_xor(mx, 32));
                    mn = fmaxf(m, mx);
                    alpha = __builtin_amdgcn_exp2f(m - mn);
#pragma unroll
                    for (int g = 0; g < 4; ++g) { const float pg = fgc[g] * __builtin_amdgcn_exp2f(vg[g] - mn); ls += pg;
#pragma unroll
                        for (int j = 0; j < 4; ++j) S[4 * g + j] = u4[j] * pg; }
                } else if (MODE == 0 && D >= 32 && D <= 96) {
                    float mx = -INFINITY;
#pragma unroll
                    for (int i = 0; i < 16; ++i) { S[i] = S[i] * C; mx = fmaxf(mx, S[i]); }
                    mx = fmaxf(mx, __shfl_xor(mx, 32));
                    mn = fmaxf(m, mx);
                    alpha = __builtin_amdgcn_exp2f(m - mn);
#pragma unroll
                    for (int i = 0; i < 16; ++i) { const float p = fmn[i] * __builtin_amdgcn_exp2f(S[i] - mn); S[i] = p; ls += p; }
                } else {
                    float fm[16]; float mx = -INFINITY;
#pragma unroll
                    for (int i = 0; i < 16; ++i) {
                        float v = S[i] * C;
                        if (MODE == 0) { const int d = dbase - ((i & 3) + 8 * (i >> 2));
                            int mult = (d <= 128 ? 1 : 0) + ((((d & 3) == 0) && d <= 512) ? 1 : 0) + (((d & 15) == 0) ? 1 : 0);
                            mult = d >= 0 ? mult : 0; fm[i] = (float)mult; v = mult > 0 ? v : -INFINITY; }
                        else fm[i] = 1.f;
                        S[i] = v; mx = fmaxf(mx, v);
                    }
                    mx = fmaxf(mx, __shfl_xor(mx, 32));
                    mn = fmaxf(m, mx); const float ms = (mn == -INFINITY) ? 0.f : mn;
                    alpha = __builtin_amdgcn_exp2f(m - ms);
#pragma unroll
                    for (int i = 0; i < 16; ++i) { const float p = fm[i] * __builtin_amdgcn_exp2f(S[i] - ms); S[i] = p; ls += p; }
                }
                l = l * alpha + ls; m = mn;
                if (!__all(alpha == 1.f)) {
#pragma unroll
                    for (int dd = 0; dd < DD; ++dd) Oacc[dd] = Oacc[dd] * alpha;
                }
            } else {
                float om[16], ex[16], G[4], PG[4];
                if (D < 32) {
#pragma unroll
                    for (int i = 0; i < 16; ++i) { const int d = dbase - ((i & 3) + 8 * (i >> 2)); const bool valid = d > 0;
                        const float x = fminf(fmaxf(S[i] * (0.125f * 1.4426950408889634f), -115.f), 115.f); const float e = __builtin_amdgcn_exp2f(x); const float o1 = __builtin_amdgcn_rcpf(1.f + e);
                        om[i] = valid ? o1 : 1.f; S[i] = valid ? e * o1 : 0.f; }
                } else {
#pragma unroll
                    for (int i = 0; i < 16; ++i) {
                        const float x = fminf(fmaxf(S[i] * (0.125f * 1.4426950408889634f), -115.f), 115.f); const float e = __builtin_amdgcn_exp2f(x); const float o1 = __builtin_amdgcn_rcpf(1.f + e);
                        om[i] = o1; S[i] = e * o1; }
                }
#pragma unroll
                for (int g = 0; g < 4; ++g) { ex[4 * g + 3] = 1.f; ex[4 * g + 2] = om[4 * g + 3]; ex[4 * g + 1] = ex[4 * g + 2] * om[4 * g + 2]; ex[4 * g] = ex[4 * g + 1] * om[4 * g + 1]; G[g] = ex[4 * g] * om[4 * g]; }
#pragma unroll
                for (int g = 0; g < 4; ++g) PG[g] = __shfl_xor(G[g], 32);
                float suf = run;
#pragma unroll
                for (int g = 3; g >= 0; --g) { const float lat = suf * (hh == 0 ? PG[g] : 1.f);
                    S[4 * g + 3] = S[4 * g + 3] * lat; S[4 * g + 2] = S[4 * g + 2] * (lat * ex[4 * g + 2]); S[4 * g + 1] = S[4 * g + 1] * (lat * ex[4 * g + 1]); S[4 * g] = S[4 * g] * (lat * ex[4 * g]);
                    suf *= G[g] * PG[g]; }
                run = suf;
                done_w = __all(run < 1e-30f) ? 1u : 0u;
            }
            u32x4 pp0, pp1;
#pragma unroll
            for (int j = 0; j < 4; ++j) { pp0[j] = pk_bf16(S[2 * j], S[2 * j + 1]); pp1[j] = pk_bf16(S[8 + 2 * j], S[8 + 2 * j + 1]); }
            const bf16x8 P0 = __builtin_bit_cast(bf16x8, pp0), P1 = __builtin_bit_cast(bf16x8, pp1);
#pragma unroll
            for (int dd = 0; dd < DD; ++dd)
#pragma unroll
                for (int s2 = 0; s2 < 2; ++s2) {
                    const bf16x8 vf = __builtin_shufflevector(vlo[dd][s2], vhi[dd][s2], 0, 1, 2, 3, 4, 5, 6, 7);
                    Oacc[dd] = MFMA32(vf, s2 ? P1 : P0, Oacc[dd]);
                }
        }
    };
    ATT_GLOAD(kA, vA, kt_hi);
    if constexpr (MODE == 2) {
#pragma unroll 1
        for (int kt = kt_hi; kt >= 0; --kt) {
            stage(kA, vA);
            if (kt >= 1) ATT_GLOAD(kA, vA, kt - 1);
            compute(kt);
        }
    } else {
        if (kt_hi >= 1) ATT_GLOAD(kB, vB, kt_hi - 1);
#pragma unroll 1
        for (int kt = kt_hi; kt >= 0; kt -= 2) {
            if (stage(kA, vA)) break;
            if (kt >= 2) ATT_GLOAD(kA, vA, kt - 2);
            compute(kt);
            if (kt == 0) break;
            if (stage(kB, vB)) break;
            if (kt >= 3) ATT_GLOAD(kB, vB, kt - 3);
            compute(kt - 1);
        }
    }
#undef ATT_GLOAD
    float inv = 1.f;
    if (MODE != 1) { const float lt = l + __shfl_xor(l, 32); inv = 1.f / lt; }
#pragma unroll
    for (int dd = 0; dd < DD; ++dd)
#pragma unroll
        for (int g = 0; g < 4; g += 2) {
            unsigned a0 = pk_bf16(Oacc[dd][4 * g] * inv, Oacc[dd][4 * g + 1] * inv), a1 = pk_bf16(Oacc[dd][4 * g + 2] * inv, Oacc[dd][4 * g + 3] * inv);
            unsigned b0 = pk_bf16(Oacc[dd][4 * g + 4] * inv, Oacc[dd][4 * g + 5] * inv), b1 = pk_bf16(Oacc[dd][4 * g + 6] * inv, Oacc[dd][4 * g + 7] * inv);
            { auto x = __builtin_amdgcn_permlane32_swap(a0, b0, false, false); a0 = x[0]; b0 = x[1]; }
            { auto x = __builtin_amdgcn_permlane32_swap(a1, b1, false, false); a1 = x[0]; b1 = x[1]; }
            u32x4 o; o[0] = a0; o[1] = a1; o[2] = b0; o[3] = b1;
            *(u32x4*)(Op + (size_t)tq * ldo + 32 * dd + 8 * g + 8 * hh) = o;
        }
}
constexpr int WQ_WORD = 4096;
__device__ __forceinline__ void p_attn_ab(LAS unsigned char* lds, const bf16_t* qkv, bf16_t* OA, bf16_t* OB, unsigned* wq) {
    constexpr size_t TS = (size_t)T * 512;
    volatile LAS unsigned* slot = (volatile LAS unsigned*)(lds + ATT_FLAG_OFF + 64);
    for (;;) {
        if (threadIdx.x == 0) *slot = __hip_atomic_fetch_add(wq, 1u, __ATOMIC_RELAXED, __HIP_MEMORY_SCOPE_AGENT);
        __syncthreads();
        const unsigned it = (unsigned)__builtin_amdgcn_readfirstlane((int)*slot);
        __syncthreads();
        if (it >= 2048u) break;
        const int j = it & 1023, qb = 7 - (j >> 7), bh = j & 127, b = bh >> 3, h = bh & 7;
        const bf16_t* base = qkv + (size_t)bh * SEQ * 64;
        if (it < 1024u) attn_item<0, 64, 128>(lds, base, 64, base + TS, base + 2 * TS, 64, OA + (size_t)b * SEQ * 1024 + h * HD, 1024, qb * 256, SEQ);
        else attn_item<1, 64, 128>(lds, base + 3 * TS, 64, base + 4 * TS, base + 5 * TS, 64, OB + (size_t)b * SEQ * 1024 + h * HD, 1024, qb * 256, SEQ);
    }
}
__device__ __forceinline__ void p_attn_mem(LAS unsigned char* lds, const bf16_t* qm, const bf16_t* kvm, bf16_t* om) {
#pragma unroll 1
    for (int i = 0;; ++i) {
        Unit u; { pg8::StaticOrder S2; S2.init(T, MEMW, (int)gridDim.x, (int)blockIdx.x); if (!S2.next(i, u)) break; }
        const int b = u.pm >> 3, qb = u.pm & 7;
#pragma unroll 1
        for (int hq = 0; hq < 2; ++hq) { const int h = 2 * u.pn + hq;
            attn_item<2, 128, 64>(lds, qm + (size_t)b * SEQ * MEMW + h * 128, MEMW, kvm + (size_t)b * NMEM * 1024 + h * 128, kvm + (size_t)b * NMEM * 1024 + 512 + h * 128, 1024,
                                  om + (size_t)b * SEQ * MEMW + h * 128, MEMW, qb * 256, NMEM); }
    }
}

__device__ __forceinline__ bool sync_if(int k, cg::grid_group& grid, XcdBarrier& xb) {
    if (k == 1) { grid.sync(); xb = xcd_barrier_post(xb.bar, xb.st); }
    else if (k == 8) {
        asm volatile("s_waitcnt vmcnt(0)" ::: "memory");
        __syncthreads();
        if (threadIdx.x == 0) { __builtin_amdgcn_fence(__ATOMIC_ACQUIRE, "agent"); asm volatile("s_waitcnt vmcnt(0)" ::: "memory"); }
        __syncthreads();
    }
    else if (k > 1) xcd_barrier(xb);
    asm volatile("" ::: "memory"); return true; }
constexpr int NPHASE = 13;
#ifndef NAIVE_AB
#define NAIVE_AB 0
#endif
#ifndef NAIVE_MEM
#define NAIVE_MEM 0
#endif
#ifndef ONLY
#define ONLY -1
#endif
#ifndef DUP_MASK
#define DUP_MASK 0
#endif
#define PHASE(k) if ((ONLY < 0 || ONLY == (k)) && ph_lo <= (k) && (k) < ph_hi) if (sync_if((k), grid, xb)) for (int rep_ = 0; rep_ < (((DUP_MASK >> (k)) & 1) ? 2 : 1); ++rep_)
__global__ __launch_bounds__(512, 2) void mega(Params p, int ph_lo, int ph_hi) {
    extern __shared__ __attribute__((aligned(16))) unsigned char shm[];
    LAS unsigned char* lds = (LAS unsigned char*)shm;
    cg::grid_group grid = cg::this_grid();
    Ctx c; c.tid = threadIdx.x; c.lane = c.tid & 63; c.wave = c.tid >> 6; c.gw = blockIdx.x * 8 + c.wave; c.ngw = gridDim.x * 8; c.gt = blockIdx.x * 512 + c.tid; c.ngt = gridDim.x * 512;
    unsigned char* ws = p.ws;
    bf16_t* Wt_in = (bf16_t*)(ws + WS_WIN); bf16_t* Wt_upa = (bf16_t*)(ws + WS_WUPA); bf16_t* Wt_upb = (bf16_t*)(ws + WS_WUPB); bf16_t* Wt_out = (bf16_t*)(ws + WS_WOUT);
    bf16_t* Wt_qm = (bf16_t*)(ws + WS_WQM); bf16_t* Wt_kvm = (bf16_t*)(ws + WS_WKVM); bf16_t* Wt_om = (bf16_t*)(ws + WS_WOM); bf16_t* Wt_gu = (bf16_t*)(ws + WS_WGU); bf16_t* Wt_dn = (bf16_t*)(ws + WS_WDN);
    bf16_t* memn = (bf16_t*)(ws + WS_MEMN); bf16_t* kvm = (bf16_t*)(ws + WS_KVM);
    float* ss1 = (float*)(ws + WS_SS1); float* ss2 = (float*)(ws + WS_SS2); float* ss3 = (float*)(ws + WS_SS3); float* rope = (float*)(ws + WS_ROPE);
    bf16_t* n1 = (bf16_t*)(ws + WS_R1); bf16_t* mixed = (bf16_t*)(ws + WS_R1); bf16_t* h2b = (bf16_t*)(ws + WS_R1);
    bf16_t* proj = (bf16_t*)(ws + WS_PROJ); bf16_t* gates = (bf16_t*)(ws + WS_PROJ + 192 * MiB);
    float* h1 = (float*)(ws + WS_H1); bf16_t* h1b = (bf16_t*)(ws + WS_H1B); bf16_t* qm = (bf16_t*)(ws + WS_QM); bf16_t* om = (bf16_t*)(ws + WS_OM);
    float* h2 = (float*)(ws + WS_H2); bf16_t* act = (bf16_t*)(ws + WS_ACT); bf16_t* OA = (bf16_t*)(ws + WS_OA); bf16_t* OB = (bf16_t*)(ws + WS_OA) + 512;
    float* m1 = p.out; unsigned* bar = (unsigned*)(ws + WS_BAR);
    volatile LAS unsigned* xst = (volatile LAS unsigned*)(lds + pg8::STAGE_BYTES);
    if (c.tid == 0) { xst[0] = 0u; xst[1] = 0u; }
    __syncthreads();
    XcdBarrier xb; xb.bar = bar; xb.x = 0u; xb.st = xst;
    pg8::StaticOrder S;
    {
        PHASE(0) {
            int cur = 0;
            p_transpose(c, lds, p.w_in, Wt_in, DM, INC, nullptr, 0, cur);
            p_transpose(c, lds, p.w_ffn_gate, Wt_gu, DM, DFF, p.g_ffn, 1, cur);
            p_transpose(c, lds, p.w_ffn_up, Wt_gu, DM, DFF, p.g_ffn, 2, cur);
            p_transpose(c, lds, p.w_ffn_down, Wt_dn, DFF, DM, nullptr, 0, cur);
            p_transpose(c, lds, p.w_up_a, Wt_upa, 512, DM, nullptr, 0, cur, 1024, 0);
            p_transpose(c, lds, p.w_up_b, Wt_upa, 512, DM, nullptr, 0, cur, 1024, 512);
            p_transpose(c, lds, p.w_out, Wt_out, DM, DM, nullptr, 0, cur);
            p_transpose(c, lds, p.w_q_mem, Wt_qm, DM, MEMW, p.g_mem_q, 0, cur);
            p_transpose(c, lds, p.w_kv_mem, Wt_kvm, DM, 2 * MEMW, nullptr, 0, cur);
            p_transpose(c, lds, p.w_o_mem, Wt_om, MEMW, DM, nullptr, 0, cur);
            p_rmsnorm_rows(c, p.x, p.g_mix, n1, T);
            p_rmsnorm_rows(c, p.mem, p.g_mem_kv, memn, BATCH * NMEM);
            p_rope_table(c, p.pos, rope);
            if (blockIdx.x == 0) { for (int i = c.tid; i < XCD_BAR_WORDS; i += 512) bar[i] = 0u; if (c.tid == 0) bar[WQ_WORD] = 0u; }
        }
        PHASE(1) {
            Gemm g{n1, Wt_in, T, INC, DM}; EpiBf16 E{proj, INC, nullptr, 1 << 30, rope, 4, 12, gates};   S.init(g.M, g.N, gridDim.x, blockIdx.x); pg8::gemm_phase(lds, g, S, E);
        }
        PHASE(3) {
            { Gemm g{memn, Wt_kvm, BATCH * NMEM, 1024, DM}; EpiBf16 E{kvm, 1024, nullptr, 1 << 30, nullptr, 0, 0, nullptr}; S.init(g.M, g.N, gridDim.x, blockIdx.x); pg8::gemm_phase(lds, g, S, E); }
            p_attn_ab(lds, proj, OA, OB, bar + WQ_WORD);
        }
        PHASE(5) { Gemm g{OA, Wt_upa, T, DM, DM}; EpiGate E{gates, mixed}; S.init(g.M, g.N, gridDim.x, blockIdx.x); pg8::gemm_phase(lds, g, S, E); }
        PHASE(6) { Gemm g{mixed, Wt_out, T, DM, DM}; EpiRes E{p.x, nullptr, nullptr, h1b, ss1}; S.init(g.M, g.N, gridDim.x, blockIdx.x); pg8::gemm_phase(lds, g, S, E); }
        PHASE(7) { Gemm g{h1b, Wt_qm, T, MEMW, DM}; EpiBf16 E{qm, MEMW, ss1, 1 << 30, nullptr, 0, 0, nullptr}; S.init(g.M, g.N, gridDim.x, blockIdx.x); pg8::gemm_phase(lds, g, S, E); }
        PHASE(8) {
            p_attn_mem(lds, qm, kvm, om);
        }
        PHASE(9) { Gemm g{om, Wt_om, T, DM, MEMW}; EpiRes E{nullptr, h1b, nullptr, h2b, ss2}; S.init(g.M, g.N, gridDim.x, blockIdx.x); pg8::gemm_phase(lds, g, S, E); }
        PHASE(10) { Gemm g{h2b, Wt_gu, T, 2 * DFF, DM}; EpiSwiGLU E{act, ss2}; S.init(g.M, g.N, gridDim.x, blockIdx.x); pg8::gemm_phase(lds, g, S, E); }
        PHASE(11) { Gemm g{act, Wt_dn, T, DM, DFF}; EpiRes E{nullptr, h2b, p.out, nullptr, ss3}; S.init(g.M, g.N, gridDim.x, blockIdx.x); pg8::gemm_phase(lds, g, S, E); }
        PHASE(12) p_final(c, p.out, ss3, p.g_final);
    }
}

constexpr int LDS_BYTES = pg8::STAGE_BYTES + 16;
#ifndef ONE_LAUNCH
#define ONE_LAUNCH 1
#endif
extern "C" void kernel_launch(void* const* d_in, const int* in_sizes, int n_in, void* d_out, int out_size, void* d_ws, size_t ws_size, hipStream_t stream) {
    static int grid = 0;
    if (grid == 0) {
        if (n_in != 18 || out_size != T * DM || ws_size < WS_END) { fprintf(stderr, "kernel_launch: unexpected shapes (n_in %d out %d ws %zu)\n", n_in, out_size, ws_size); grid = -1; return; }
        int dev = 0, cus = 0, per_cu = 0;
        (void)hipGetDevice(&dev); (void)hipDeviceGetAttribute(&cus, hipDeviceAttributeMultiprocessorCount, dev);
        if (hipFuncSetAttribute((const void*)mega, hipFuncAttributeMaxDynamicSharedMemorySize, LDS_BYTES) != hipSuccess) { fprintf(stderr, "hipFuncSetAttribute failed\n"); grid = -1; return; }
        if (hipOccupancyMaxActiveBlocksPerMultiprocessor(&per_cu, (const void*)mega, 512, LDS_BYTES) != hipSuccess || per_cu < 1) { fprintf(stderr, "occupancy query: %d\n", per_cu); per_cu = 1; }
        (void)hipGetLastError();
        grid = cus * 1;
    }
    if (grid < 0) return;
    Params p{};
    p.x = (const float*)d_in[0]; p.mem = (const float*)d_in[1]; p.pos = (const int*)d_in[2]; p.g_mix = (const float*)d_in[3]; p.w_in = (const float*)d_in[4];
    p.w_up_a = (const float*)d_in[5]; p.w_up_b = (const float*)d_in[6]; p.w_out = (const float*)d_in[7]; p.g_mem_q = (const float*)d_in[8]; p.g_mem_kv = (const float*)d_in[9];
    p.w_q_mem = (const float*)d_in[10]; p.w_kv_mem = (const float*)d_in[11]; p.w_o_mem = (const float*)d_in[12]; p.g_ffn = (const float*)d_in[13];
    p.w_ffn_gate = (const float*)d_in[14]; p.w_ffn_up = (const float*)d_in[15]; p.w_ffn_down = (const float*)d_in[16]; p.g_final = (const float*)d_in[17];
    p.out = (float*)d_out; p.ws = (unsigned char*)d_ws;
#if ONE_LAUNCH
    int lo = 0, hi = NPHASE;
    void* args[] = {&p, &lo, &hi};
    hipError_t e = hipLaunchCooperativeKernel((const void*)mega, dim3(grid), dim3(512), args, LDS_BYTES, stream);
    if (e != hipSuccess) fprintf(stderr, "cooperative launch failed: %s\n", hipGetErrorString(e));
#else
    for (int ph = 0; ph < NPHASE; ++ph) hipLaunchKernelGGL(mega, dim3(grid), dim3(512), LDS_BYTES, stream, p, ph, ph + 1);
#endif
}
```
